# Optimizing an MI355X kernel written in HIP

```python
import math
import jax, jax.numpy as jnp
from jax import lax
import numpy as np

D_MODEL = 1024
BATCH = 2
SEQ = 8192
DEPTH = 2

CHUNK = 64
Q_BLOCK = 128
EPS = 1e-6

DA_HEADS = 4
DA_HEAD_DIM = 32
DA_V_DIM = 2 * DA_HEAD_DIM
DA_WIDTH = DA_HEADS * DA_V_DIM
DA_QK = DA_HEADS * 2 * DA_HEAD_DIM
SSM_HEADS = 8
SSM_HEAD_DIM = 64
SSM_WIDTH = SSM_HEADS * SSM_HEAD_DIM
SSM_STATE = 64
SSM_GROUPS = 2
SSM_CONV = 4
SSM_CONV_CH = SSM_WIDTH + 2 * SSM_GROUPS * SSM_STATE
RET_HEADS = 4
RET_KEY_DIM = 64
RET_V_DIM = 64
RET_WIDTH = RET_HEADS * RET_V_DIM
RET_QK = RET_HEADS * RET_KEY_DIM
ROPE_BASE = 10000.0

MIX_WIDTH = DA_WIDTH + SSM_WIDTH + RET_WIDTH
IN_SIZES = (DA_QK, DA_QK, DA_WIDTH,
            SSM_WIDTH, SSM_CONV_CH, SSM_HEADS,
            RET_QK, RET_QK, RET_WIDTH, RET_WIDTH)
IN_TOTAL = sum(IN_SIZES)

REL_BUCKETS = 32
REL_MAX_DIST = 128

FFN_DENSE = 2752
N_EXPERTS = 8
TOP_K = 2
FFN_EXPERT = 3584
N_DENSE_LAYERS = (DEPTH + 1) // 2
N_MOE_LAYERS = DEPTH // 2

kernel_name = "hybrid_diffattn_ssd_retention_moe"


def _split_points():
    pts, acc = [], 0
    for n in IN_SIZES[:-1]:
        acc += n
        pts.append(acc)
    return pts


def rmsnorm(x, g):
    xf = x.astype(jnp.float32)
    y = xf * lax.rsqrt(jnp.mean(xf * xf, axis=-1, keepdims=True) + EPS)
    return (y * g.astype(jnp.float32)).astype(x.dtype)


def t5_bucket(rel):
    half = REL_BUCKETS // 2
    max_exact = half // 2
    ret = jnp.where(rel > 0, half, 0)
    n = jnp.abs(rel)
    nf = jnp.maximum(n, 1).astype(jnp.float32)
    large = max_exact + (jnp.log(nf / max_exact) / math.log(REL_MAX_DIST / max_exact)
                         * (half - max_exact)).astype(jnp.int32)
    large = jnp.minimum(large, half - 1)
    return ret + jnp.where(n < max_exact, n, large)


def rotary(u):
    s, dh = u.shape[1], u.shape[-1]
    inv = 1.0 / (ROPE_BASE ** (jnp.arange(0, dh, 2, dtype=jnp.float32) / dh))
    ang = jnp.arange(s, dtype=jnp.float32)[:, None] * inv[None, :]
    cos = jnp.cos(ang)[None, :, None, :]
    sin = jnp.sin(ang)[None, :, None, :]
    u1, u2 = u[..., : dh // 2], u[..., dh // 2:]
    return jnp.concatenate([u1 * cos - u2 * sin, u1 * sin + u2 * cos], axis=-1).astype(u.dtype)


def diff_attention(q, k, v, lam, lam_init, rel_table, head_gain):
    b, s = q.shape[:2]
    nblk = s // Q_BLOCK
    scale = DA_HEAD_DIM ** -0.5
    k_pos = jnp.arange(s)
    qb = q.reshape(b, nblk, Q_BLOCK, DA_HEADS, 2, DA_HEAD_DIM).transpose(1, 0, 2, 3, 4, 5)

    def block(args):
        q_blk, i = args
        q_pos = i * Q_BLOCK + jnp.arange(Q_BLOCK)
        bias = rel_table[t5_bucket(k_pos[None, :] - q_pos[:, None])]
        bias = bias.astype(jnp.float32).transpose(2, 0, 1)
        allowed = (k_pos[None, :] // CHUNK) <= (q_pos[:, None] // CHUNK)
        logits = jnp.einsum('bqhtd,bkhtd->bhtqk', q_blk, k).astype(jnp.float32) * scale
        logits = jnp.where(allowed, logits + bias[None, :, None], -jnp.inf)
        p = jax.nn.softmax(logits, axis=-1)
        attn = p[:, :, 0] - lam * p[:, :, 1]
        return jnp.einsum('bhqk,bkhe->bqhe', attn.astype(v.dtype), v)

    out = lax.map(block, (qb, jnp.arange(nblk)))
    out = out.transpose(1, 0, 2, 3, 4).reshape(b, s, DA_HEADS, DA_V_DIM)
    out = rmsnorm(out, head_gain) * (1.0 - lam_init)
    return out.reshape(b, s, DA_WIDTH)


def causal_dwconv(u, w, bias):
    c = u.shape[-1]
    y = lax.conv_general_dilated(u, w[:, None, :].astype(u.dtype), window_strides=(1,),
                                 padding=[(SSM_CONV - 1, 0)],
                                 dimension_numbers=('NWC', 'WIO', 'NWC'),
                                 feature_group_count=c)
    return y + bias


def ssd_mixer(z, xbc_raw, dt_raw, conv_w, conv_b, dt_bias, a_log, d_skip, norm_g):
    b, s, _ = z.shape
    nc = s // CHUNK
    rep = SSM_HEADS // SSM_GROUPS
    xbc = jax.nn.silu(causal_dwconv(xbc_raw, conv_w, conv_b))
    xs, bm, cm = jnp.split(xbc, [SSM_WIDTH, SSM_WIDTH + SSM_GROUPS * SSM_STATE], axis=-1)
    xs = xs.reshape(b, nc, CHUNK, SSM_HEADS, SSM_HEAD_DIM)
    bm = jnp.repeat(bm.reshape(b, nc, CHUNK, SSM_GROUPS, SSM_STATE), rep, axis=3)
    cm = jnp.repeat(cm.reshape(b, nc, CHUNK, SSM_GROUPS, SSM_STATE), rep, axis=3)
    dt = jax.nn.softplus(dt_raw.astype(jnp.float32) + dt_bias)
    a = (-jnp.exp(a_log) * dt).reshape(b, nc, CHUNK, SSM_HEADS).transpose(0, 3, 1, 2)
    a_cs = jnp.cumsum(a, axis=-1)
    xdt = xs * dt.reshape(b, nc, CHUNK, SSM_HEADS)[..., None]
    causal = jnp.tril(jnp.ones((CHUNK, CHUNK), dtype=bool))
    seg = a_cs[..., :, None] - a_cs[..., None, :]
    lmat = jnp.exp(jnp.where(causal, seg, -jnp.inf))
    cb = jnp.einsum('bclhn,bcshn->bhcls', cm, bm) * lmat
    y_diag = jnp.einsum('bhcls,bcshp->bclhp', cb, xdt)
    decay_states = jnp.exp(a_cs[..., -1:] - a_cs)
    states = jnp.einsum('bclhn,bhcl,bclhp->bchpn', bm, decay_states, xdt)
    chunk_decay = jnp.exp(a_cs[..., -1])

    def step(h, inp):
        st, dec = inp
        return h * dec[..., None, None] + st, h

    h0 = jnp.zeros((b, SSM_HEADS, SSM_HEAD_DIM, SSM_STATE), states.dtype)
    _, prev = lax.scan(step, h0, (states.transpose(1, 0, 2, 3, 4), chunk_decay.transpose(2, 0, 1)))
    prev = prev.transpose(1, 0, 2, 3, 4)
    y_off = jnp.einsum('bclhn,bchpn,bhcl->bclhp', cm, prev, jnp.exp(a_cs))
    y = (y_diag + y_off + xs * d_skip[:, None]).reshape(b, s, SSM_WIDTH)
    y = (y * jax.nn.silu(z)).reshape(b, s, SSM_GROUPS, SSM_WIDTH // SSM_GROUPS)
    y = rmsnorm(y, norm_g.reshape(SSM_GROUPS, SSM_WIDTH // SSM_GROUPS))
    return y.reshape(b, s, SSM_WIDTH)


def retention(q, k, v, g, head_gain):
    b, s, _ = q.shape
    nc = s // CHUNK
    q = rotary(q.reshape(b, s, RET_HEADS, RET_KEY_DIM))
    k = rotary(k.reshape(b, s, RET_HEADS, RET_KEY_DIM)) * (RET_KEY_DIM ** -0.5)
    v = v.reshape(b, nc, CHUNK, RET_HEADS, RET_V_DIM)
    q = q.reshape(b, nc, CHUNK, RET_HEADS, RET_KEY_DIM)
    k = k.reshape(b, nc, CHUNK, RET_HEADS, RET_KEY_DIM)
    log_gamma = jnp.log1p(-jnp.power(2.0, -5.0 - jnp.arange(RET_HEADS, dtype=jnp.float32)))
    idx = jnp.arange(CHUNK, dtype=jnp.float32)
    intra_decay = jnp.exp(log_gamma[:, None, None] * jnp.abs(idx[:, None] - idx[None, :]))
    scores = jnp.einsum('bclhd,bcshd->bhcls', q, k) * intra_decay[:, None]
    o_intra = jnp.einsum('bhcls,bcshe->bclhe', scores, v)
    key_decay = jnp.exp(log_gamma[:, None] * (CHUNK - 1 - idx)[None, :])
    kv = jnp.einsum('bcshd,hs,bcshe->bchde', k, key_decay, v)
    chunk_decay = jnp.exp(log_gamma * CHUNK)

    def step(state, kv_c):
        return state * chunk_decay[:, None, None] + kv_c, state

    s0 = jnp.zeros((b, RET_HEADS, RET_KEY_DIM, RET_V_DIM), kv.dtype)
    _, prev = lax.scan(step, s0, kv.transpose(1, 0, 2, 3, 4))
    prev = prev.transpose(1, 0, 2, 3, 4)
    query_decay = jnp.exp(log_gamma[:, None] * (idx + 1.0)[None, :])
    o_cross = jnp.einsum('bclhd,bchde,hl->bclhe', q, prev, query_decay)
    o = (o_intra + o_cross).reshape(b, s, RET_HEADS, RET_V_DIM)
    o = rmsnorm(o, head_gain).reshape(b, s, RET_WIDTH)
    return jax.nn.silu(g) * o


def swiglu(h, w_gate, w_up, w_down):
    return (jax.nn.silu(h @ w_gate) * (h @ w_up)) @ w_down


def moe_swiglu(h, router_w, e_gate, e_up, e_down):
    b, s, d = h.shape
    t = h.reshape(b * s, d)
    logits = (t @ router_w).astype(jnp.float32)
    top_val, top_idx = lax.top_k(logits, TOP_K)
    gates = jax.nn.softmax(top_val, axis=-1)
    combine = jnp.sum(jax.nn.one_hot(top_idx, N_EXPERTS, dtype=jnp.float32) * gates[..., None], axis=1)
    out = jnp.zeros_like(t)
    for e in range(N_EXPERTS):
        y = swiglu(t, e_gate[e], e_up[e], e_down[e])
        out = out + combine[:, e:e + 1].astype(t.dtype) * y
    return out.reshape(b, s, d)


def setup_inputs(seed: int = 0) -> dict:
    key = jax.random.key(seed)
    ks = jax.random.split(key, 32)
    f32 = jnp.float32
    nrm = lambda k, shape, sc: jax.random.normal(k, shape, f32) * sc
    gain = lambda k, shape: 1.0 + 0.02 * jax.random.normal(k, shape, f32)
    dt0 = jnp.exp(jax.random.uniform(ks[13], (DEPTH, SSM_HEADS), f32, math.log(1e-3), math.log(1e-1)))
    return {
        "x": nrm(ks[0], (BATCH, SEQ, D_MODEL), 1.0),
        "w_in": nrm(ks[1], (DEPTH, D_MODEL, IN_TOTAL), D_MODEL ** -0.5),
        "w_out": nrm(ks[2], (DEPTH, MIX_WIDTH, D_MODEL), MIX_WIDTH ** -0.5),
        "attn_norm": gain(ks[3], (DEPTH, D_MODEL)),
        "ffn_norm": gain(ks[4], (DEPTH, D_MODEL)),
        "final_norm": gain(ks[5], (D_MODEL,)),
        "rel_bias": nrm(ks[6], (REL_BUCKETS, DA_HEADS), 0.3),
        "lambda_q1": nrm(ks[7], (DEPTH, DA_HEAD_DIM), 0.1),
        "lambda_k1": nrm(ks[8], (DEPTH, DA_HEAD_DIM), 0.1),
        "lambda_q2": nrm(ks[9], (DEPTH, DA_HEAD_DIM), 0.1),
        "lambda_k2": nrm(ks[10], (DEPTH, DA_HEAD_DIM), 0.1),
        "da_head_norm": gain(ks[11], (DEPTH, DA_V_DIM)),
        "conv_w": nrm(ks[12], (DEPTH, SSM_CONV, SSM_CONV_CH), SSM_CONV ** -0.5),
        "conv_b": nrm(ks[14], (DEPTH, SSM_CONV_CH), 0.02),
        "dt_bias": dt0 + jnp.log(-jnp.expm1(-dt0)),
        "a_log": jnp.log(jax.random.uniform(ks[15], (DEPTH, SSM_HEADS), f32, 1.0, 16.0)),
        "d_skip": 1.0 + 0.1 * jax.random.normal(ks[16], (DEPTH, SSM_HEADS), f32),
        "ssm_norm": gain(ks[17], (DEPTH, SSM_WIDTH)),
        "ret_head_norm": gain(ks[18], (DEPTH, RET_V_DIM)),
        "w_gate": nrm(ks[19], (N_DENSE_LAYERS, D_MODEL, FFN_DENSE), D_MODEL ** -0.5),
        "w_up": nrm(ks[20], (N_DENSE_LAYERS, D_MODEL, FFN_DENSE), D_MODEL ** -0.5),
        "w_down": nrm(ks[21], (N_DENSE_LAYERS, FFN_DENSE, D_MODEL), FFN_DENSE ** -0.5),
        "router_w": nrm(ks[22], (N_MOE_LAYERS, D_MODEL, N_EXPERTS), D_MODEL ** -0.5),
        "e_gate": nrm(ks[23], (N_MOE_LAYERS, N_EXPERTS, D_MODEL, FFN_EXPERT), D_MODEL ** -0.5),
        "e_up": nrm(ks[24], (N_MOE_LAYERS, N_EXPERTS, D_MODEL, FFN_EXPERT), D_MODEL ** -0.5),
        "e_down": nrm(ks[25], (N_MOE_LAYERS, N_EXPERTS, FFN_EXPERT, D_MODEL), FFN_EXPERT ** -0.5),
    }


def reference(x, w_in, w_out, attn_norm, ffn_norm, final_norm, rel_bias,
              lambda_q1, lambda_k1, lambda_q2, lambda_k2, da_head_norm,
              conv_w, conv_b, dt_bias, a_log, d_skip, ssm_norm, ret_head_norm,
              w_gate, w_up, w_down, router_w, e_gate, e_up, e_down):
    b, s, _ = x.shape
    split_pts = _split_points()
    for layer in range(DEPTH):
        h = rmsnorm(x, attn_norm[layer])
        proj = h @ w_in[layer]
        (da_q, da_k, da_v, ssm_z, ssm_xbc, ssm_dt,
         ret_q, ret_k, ret_v, ret_g) = jnp.split(proj, split_pts, axis=-1)
        lam_init = 0.8 - 0.6 * math.exp(-0.3 * layer)
        lam = (jnp.exp(jnp.sum(lambda_q1[layer] * lambda_k1[layer]).astype(jnp.float32))
               - jnp.exp(jnp.sum(lambda_q2[layer] * lambda_k2[layer]).astype(jnp.float32)) + lam_init)
        out_a = diff_attention(da_q.reshape(b, s, DA_HEADS, 2, DA_HEAD_DIM),
                               da_k.reshape(b, s, DA_HEADS, 2, DA_HEAD_DIM),
                               da_v.reshape(b, s, DA_HEADS, DA_V_DIM),
                               lam, lam_init, rel_bias, da_head_norm[layer])
        out_b = ssd_mixer(ssm_z, ssm_xbc, ssm_dt, conv_w[layer], conv_b[layer], dt_bias[layer],
                          a_log[layer], d_skip[layer], ssm_norm[layer])
        out_c = retention(ret_q, ret_k, ret_v, ret_g, ret_head_norm[layer])
        mix = jnp.concatenate([out_a.astype(x.dtype), out_b.astype(x.dtype), out_c.astype(x.dtype)], axis=-1)
        x = x + mix @ w_out[layer]
        h = rmsnorm(x, ffn_norm[layer])
        if layer % 2 == 0:
            i = layer // 2
            x = x + swiglu(h, w_gate[i], w_up[i], w_down[i])
        else:
            i = layer // 2
            x = x + moe_swiglu(h, router_w[i], e_gate[i], e_up[i], e_down[i])
    return rmsnorm(x, final_norm)
```

```cpp
#include <hip/hip_runtime.h>
#include <cstdio>
#include <cstdint>
namespace pg8 {
#define PG8_LAS __attribute__((address_space(3)))
typedef unsigned short bf16_t;
typedef short bf16x8 __attribute__((ext_vector_type(8)));
typedef float f32x4 __attribute__((ext_vector_type(4)));
typedef unsigned u32x4 __attribute__((ext_vector_type(4)));
constexpr int BM = 256, BK = 64, HALF = 128, HTB = HALF * BK * 2  , STAGE_BYTES = 8 * HTB, NXCD = 8, WGM = 8;

__host__ __device__ __forceinline__ int lds_byte(int r, int c) { const int st = (r >> 4) * 2 + (c >> 5), rr = r & 15, cc = c & 31, ob = rr * 64 + cc * 2; return st * 1024 + (ob ^ (((ob >> 9) & 1) << 5)); }
__host__ __device__ __forceinline__ void stage_rc(int b, int& R, int& C) { const int st = b / 1024, sb = b % 1024, swz = sb ^ (((sb >> 9) & 1) << 5); R = (st >> 1) * 16 + swz / 64; C = (st & 1) * 32 + (swz % 64) / 2; }
__host__ __device__ __forceinline__ int perm32(int rho) { const int n = rho >> 4, i = rho & 15; return 8 * (i >> 2) + 4 * n + (i & 3); }

struct Unit { int pm, pn, cn, po, e, j; };
struct Gemm { const bf16_t* A; const bf16_t* Bt; int K; };

struct StaticOrder {
    int nM, nN, nwg, G, c;
    __host__ __device__ void init(int M, int N, int G_, int c_) { nM = M / BM; nN = N / BM; nwg = nM * nN; G = G_; c = c_; }
    __host__ __device__ bool next(int i, Unit& u) const {
        const long L = (long)i * G + c; if (L >= nwg) return false;
        int wgid = (int)L; { const int q = nwg / NXCD, r = nwg % NXCD, xcd = wgid % NXCD, off = wgid / NXCD; wgid = (xcd < r ? xcd * (q + 1) : r * (q + 1) + (xcd - r) * q) + off; }
        const int nig = WGM * nN, gid = wgid / nig, fm = gid * WGM, gsz = (nM - fm) < WGM ? (nM - fm) : WGM;
        u.pm = fm + ((wgid % nig) % gsz); u.pn = (wgid % nig) / gsz; u.cn = u.pn; u.po = u.pm; u.e = 0; u.j = 0; return true;
    }
};
struct GroupedOrder {
    int nN, p0, np, G, c, a_local;
    const PG8_LAS int* meta;
    __device__ __forceinline__ bool next(int i, Unit& u) const {
        const int L = i * G + c; if (L >= np * nN) return false;
        const int pl = L / nN, n = L - pl * nN, p = p0 + pl;
        int e = 0;
#pragma unroll
        for (int k = 1; k < 8; ++k) e += (p >= meta[8 + k]) ? 1 : 0;
        e = __builtin_amdgcn_readfirstlane(e);
        u.e = e; u.j = 0; u.pm = a_local ? pl : p; u.po = a_local ? p : pl; u.pn = e * nN + n; u.cn = n; return true;
    }
};

__device__ __forceinline__ unsigned cvt_pk_bf16(float lo, float hi) { unsigned r; asm volatile("v_cvt_pk_bf16_f32 %0, %1, %2" : "=v"(r) : "v"(lo), "v"(hi)); return r; }

struct EpiBf16 {
    static constexpr bool PERM = true;
    bf16_t* O; int ldc;
    __device__ __forceinline__ void operator()(const f32x4 (&acc)[2][2][4][2], const Unit& u, int wr, int wc, int fr, int fq) const {
        const int row0 = u.po * BM + wr * 64 + fr, col0 = u.cn * BM + wc * 32 + 8 * fq;
#pragma unroll
        for (int ai = 0; ai < 2; ++ai)
#pragma unroll
            for (int m = 0; m < 4; ++m) { bf16_t* rowp = O + (size_t)(row0 + ai * HALF + m * 16) * ldc + col0;
#pragma unroll
                for (int bj = 0; bj < 2; ++bj) { const f32x4 v0 = acc[ai][bj][m][0], v1 = acc[ai][bj][m][1];
                    u32x4 w; w.x = cvt_pk_bf16(v0[0], v0[1]); w.y = cvt_pk_bf16(v0[2], v0[3]); w.z = cvt_pk_bf16(v1[0], v1[1]); w.w = cvt_pk_bf16(v1[2], v1[3]);
                    *(u32x4*)(rowp + bj * HALF) = w; } }
    }
};
__device__ __forceinline__ float silu_mul(float g, float u) { return g * u * __builtin_amdgcn_rcpf(1.0f + __builtin_amdgcn_exp2f(-1.4426950408889634f * g)); }
struct EpiSwiGLU {
    static constexpr bool PERM = true;
    bf16_t* O; int ldc;
    __device__ __forceinline__ void operator()(const f32x4 (&acc)[2][2][4][2], const Unit& u, int wr, int wc, int fr, int fq) const {
        const int row0 = u.po * BM + wr * 64 + fr, col0 = u.cn * HALF + wc * 32 + 8 * fq;
#pragma unroll
        for (int ai = 0; ai < 2; ++ai)
#pragma unroll
            for (int m = 0; m < 4; ++m) { bf16_t* rowp = O + (size_t)(row0 + ai * HALF + m * 16) * ldc + col0;
                const f32x4 g0 = acc[ai][0][m][0], g1 = acc[ai][0][m][1], u0 = acc[ai][1][m][0], u1 = acc[ai][1][m][1];
                u32x4 w; w.x = cvt_pk_bf16(silu_mul(g0[0], u0[0]), silu_mul(g0[1], u0[1])); w.y = cvt_pk_bf16(silu_mul(g0[2], u0[2]), silu_mul(g0[3], u0[3]));
                w.z = cvt_pk_bf16(silu_mul(g1[0], u1[0]), silu_mul(g1[1], u1[1])); w.w = cvt_pk_bf16(silu_mul(g1[2], u1[2]), silu_mul(g1[3], u1[3]));
                *(u32x4*)rowp = w; asm volatile("" ::: "memory"); }
    }
};
struct EpiResF32 {
    static constexpr bool PERM = false;
    const float* base; float* out; int ldc;
    __device__ __forceinline__ void operator()(const f32x4 (&acc)[2][2][4][2], const Unit& u, int wr, int wc, int fr, int fq) const {
        const int row0 = u.po * BM + wr * 64 + fr, col0 = u.cn * BM + wc * 32 + 4 * fq;
#pragma unroll
        for (int ai = 0; ai < 2; ++ai)
#pragma unroll
            for (int m = 0; m < 4; ++m) { const size_t off = (size_t)(row0 + ai * HALF + m * 16) * ldc + col0;
#pragma unroll
                for (int bj = 0; bj < 2; ++bj)
#pragma unroll
                    for (int n = 0; n < 2; ++n) { const f32x4 bs = *(const f32x4*)(base + off + bj * HALF + n * 16); *(f32x4*)(out + off + bj * HALF + n * 16) = bs + acc[ai][bj][m][n]; }
                asm volatile("" ::: "memory"); }
    }
};
template <class Epi, class Sched, bool ALIGN_EPI>
__device__ __forceinline__ void gemm_phase(PG8_LAS unsigned char* lds, const Gemm g, const Sched& S, const Epi& E) {
    int tid_ = threadIdx.x; asm volatile("" : "+v"(tid_));
    const int tid = tid_, wid = __builtin_amdgcn_readfirstlane(tid >> 6), lane = tid & 63, wr = wid >> 2, wc = wid & 3, fr = lane & 15, fq = lane >> 4;
    const int K = g.K, nt = K / BK;
    unsigned voffA[2], voffB[2];
#pragma unroll
    for (int i = 0; i < 2; ++i) { int R, C; stage_rc(tid * 16 + i * 8192, R, C); const int Rb = Epi::PERM ? ((R & ~31) + perm32(R & 31)) : R;
        voffA[i] = (unsigned)(R * K + C) * 2u; voffB[i] = (unsigned)(Rb * K + C) * 2u; }
    const size_t kstep = (size_t)(BK * 2);
    const size_t hstep = (size_t)HALF * K * 2;
    const size_t tstep = 2 * hstep;
    const unsigned ldsw = (unsigned)wid * 1024u;
    const int aoff = lds_byte(wr * 64 + fr, fq * 8), boff = lds_byte(wc * 32 + fr, fq * 8);
#define PG8_SA(b, h) (((b) * 2 + (h)) * HTB)
#define PG8_SB(b, h) ((4 + (b) * 2 + (h)) * HTB)
#define PG8_STAGE(bufoff, gbase, voff) do { _Pragma("unroll") for (int _i = 0; _i < 2; ++_i) \
        __builtin_amdgcn_global_load_lds((const unsigned*)((const char*)(gbase) + (voff)[_i]), (PG8_LAS unsigned*)(lds + (bufoff) + ldsw + _i * 8192), 16, 0, 0); } while (0)
#define PG8_LDA(dst, b, h) do { _Pragma("unroll") for (int m = 0; m < 4; ++m) _Pragma("unroll") for (int k = 0; k < 2; ++k) dst[m][k] = *(const PG8_LAS bf16x8*)(lds + PG8_SA(b, h) + aoff + m * 2048 + k * 1024); } while (0)
#define PG8_LDB(dst, b, h) do { _Pragma("unroll") for (int n = 0; n < 2; ++n) _Pragma("unroll") for (int k = 0; k < 2; ++k) dst[n][k] = *(const PG8_LAS bf16x8*)(lds + PG8_SB(b, h) + boff + n * 2048 + k * 1024); } while (0)
#define PG8_MMA(ai, bj, At, Bt) do { __builtin_amdgcn_s_setprio(1); _Pragma("unroll") for (int m = 0; m < 4; ++m) _Pragma("unroll") for (int n = 0; n < 2; ++n) _Pragma("unroll") for (int k = 0; k < 2; ++k) \
        acc[ai][bj][m][n] = __builtin_amdgcn_mfma_f32_16x16x32_bf16(Bt[n][k], At[m][k], acc[ai][bj][m][n], 0, 0, 0); __builtin_amdgcn_s_setprio(0); } while (0)
#define PG8_WAIT_V(n) asm volatile("s_waitcnt vmcnt(" #n ")" ::: "memory")
#define PG8_WAIT_L(n) asm volatile("s_waitcnt lgkmcnt(" #n ")" ::: "memory")
#define PG8_BAR __builtin_amdgcn_s_barrier()
#define PG8_SCHED __builtin_amdgcn_sched_barrier(0)
    Unit cur, nxt; int ui = 0;
    if (!S.next(0, cur)) return;
    f32x4 acc[2][2][4][2];
#pragma unroll
    for (int a = 0; a < 2; ++a)
#pragma unroll
        for (int b = 0; b < 2; ++b)
#pragma unroll
            for (int m = 0; m < 4; ++m)
#pragma unroll
                for (int n = 0; n < 2; ++n) acc[a][b][m][n] = (f32x4){0.f, 0.f, 0.f, 0.f};
    bf16x8 At[4][2], B0[2][2], B1[2][2];
    const char* cA = (const char*)g.A + (size_t)cur.pm * tstep; const char* cB = (const char*)g.Bt + (size_t)cur.pn * tstep;
    PG8_STAGE(PG8_SB(0, 0), cB, voffB); PG8_STAGE(PG8_SB(0, 1), cB + hstep, voffB); PG8_STAGE(PG8_SA(0, 0), cA, voffA); PG8_STAGE(PG8_SA(0, 1), cA + hstep, voffA);
    if (wr == 1) PG8_BAR;
    PG8_WAIT_V(2); PG8_BAR;
    PG8_STAGE(PG8_SB(1, 0), cB + kstep, voffB); PG8_STAGE(PG8_SA(1, 0), cA + kstep, voffA); PG8_STAGE(PG8_SB(1, 1), cB + hstep + kstep, voffB);
    PG8_WAIT_V(6); PG8_BAR;
    for (;;) {
        const bool has_next = S.next(ui + 1, nxt);
        const char* nA = has_next ? (const char*)g.A + (size_t)nxt.pm * tstep : cA; const char* nB = has_next ? (const char*)g.Bt + (size_t)nxt.pn * tstep : cB;
        for (int t = 0; t < nt; t += 2) {
            const bool last = (t == nt - 2);
            const char* a1 = cA + (size_t)(t + 1) * kstep;
            const char* a2 = last ? nA : cA + (size_t)(t + 2) * kstep; const char* b2 = last ? nB : cB + (size_t)(t + 2) * kstep;
            const char* a3 = a2 + kstep; const char* b3 = b2 + kstep;
            PG8_LDB(B0, 0, 0); PG8_LDB(B1, 0, 1); PG8_SCHED; PG8_LDA(At, 0, 0); PG8_STAGE(PG8_SA(1, 1), a1 + hstep, voffA);
            PG8_WAIT_V(8); PG8_WAIT_L(0); PG8_BAR; PG8_MMA(0, 0, At, B0); PG8_MMA(0, 1, At, B1); PG8_BAR; PG8_SCHED;
            PG8_LDA(At, 0, 1); PG8_STAGE(PG8_SB(0, 0), b2, voffB); PG8_STAGE(PG8_SB(0, 1), b2 + hstep, voffB); PG8_STAGE(PG8_SA(0, 0), a2, voffA);
            PG8_WAIT_V(8); PG8_WAIT_L(0); PG8_BAR; PG8_MMA(1, 0, At, B0); PG8_MMA(1, 1, At, B1); PG8_BAR; PG8_SCHED;
            PG8_LDB(B0, 1, 0); PG8_LDB(B1, 1, 1); PG8_SCHED; PG8_LDA(At, 1, 0); PG8_STAGE(PG8_SA(0, 1), a2 + hstep, voffA);
            PG8_WAIT_V(8); PG8_WAIT_L(0); PG8_BAR; PG8_MMA(0, 0, At, B0); PG8_MMA(0, 1, At, B1); PG8_BAR; PG8_SCHED;
            PG8_LDA(At, 1, 1); PG8_STAGE(PG8_SB(1, 0), b3, voffB); PG8_STAGE(PG8_SB(1, 1), b3 + hstep, voffB); PG8_STAGE(PG8_SA(1, 0), a3, voffA);
            PG8_WAIT_V(8); PG8_WAIT_L(0); PG8_BAR; PG8_MMA(1, 0, At, B0); PG8_MMA(1, 1, At, B1); PG8_BAR; PG8_SCHED;
        }
        if constexpr (ALIGN_EPI) { if (wr == 0) PG8_BAR; }
        E(acc, cur, wr, wc, fr, fq);
        if (!has_next) break;
#pragma unroll
        for (int a = 0; a < 2; ++a)
#pragma unroll
            for (int b = 0; b < 2; ++b)
#pragma unroll
                for (int m = 0; m < 4; ++m)
#pragma unroll
                    for (int n = 0; n < 2; ++n) acc[a][b][m][n] = (f32x4){0.f, 0.f, 0.f, 0.f};
        cur = nxt; cA = nA; cB = nB; ++ui;
        if constexpr (ALIGN_EPI) { if (wr == 1) PG8_BAR; }
    }
    PG8_WAIT_V(0);
    if constexpr (!ALIGN_EPI) { if (wr == 0) PG8_BAR; }
    PG8_BAR;
#undef PG8_SA
#undef PG8_SB
#undef PG8_STAGE
#undef PG8_LDA
#undef PG8_LDB
#undef PG8_MMA
#undef PG8_WAIT_V
#undef PG8_WAIT_L
#undef PG8_BAR
#undef PG8_SCHED
}
}
constexpr int NWAVES = 8;
constexpr int SEQ = 8192, M = 16384, D = 1024, NIN = 3080, NPROJ = 3072;
constexpr int FD = 2752, FDP = 2816, FE = 3584, NEXP = 8;
constexpr float EPS = 1e-6f, LOG2E = 1.4426950408889634f;
constexpr int PC_Q = 0, PC_K = 256, PC_V = 512, PC_Z = 768, PC_XBC = 1280, PC_RQ = 2048, PC_RK = 2304, PC_RV = 2560, PC_RG = 2816;
constexpr size_t MiB = 1u << 20;
constexpr size_t WS_CTL = 0, CTL_ZERO_BYTES = 1 * MiB;
constexpr size_t WS_WIN = 2 * MiB;
constexpr size_t WS_WOUT = 14 * MiB;
constexpr size_t WS_WGU = 18 * MiB;
constexpr size_t WS_WD = 29 * MiB;
constexpr size_t WS_EGU = 35 * MiB;
constexpr size_t WS_ED = 147 * MiB;
constexpr size_t WS_XN = 203 * MiB;
constexpr size_t WS_MIX = 235 * MiB;
constexpr size_t WS_BIG = 303 * MiB;
constexpr size_t WS_SMALL = 422 * MiB;
constexpr size_t WS_DT = WS_SMALL, WS_TI = WS_SMALL + 512 * 1024, WS_TG = WS_SMALL + 768 * 1024, WS_LIST = WS_SMALL + 1024 * 1024;
constexpr size_t WS_END = 426 * MiB;
constexpr int SLAB_PANELS = 68;
constexpr int CW_BAR = 4096;
constexpr int CW_CNT = 8192;
constexpr int RING_BYTES = 131072;
constexpr int LDSCTL_OFF = RING_BYTES, MISC_OFF = LDSCTL_OFF + 320;
constexpr int LDS_BYTES = 147456;
#define GAS __attribute__((address_space(1)))
#define LAS __attribute__((address_space(3)))
typedef unsigned short bf16;
typedef unsigned v4u __attribute__((ext_vector_type(4)));
typedef float f32x4 __attribute__((ext_vector_type(4)));
typedef short bf16x8 __attribute__((ext_vector_type(8)));
typedef GAS unsigned gu32;
typedef GAS unsigned long long gu64;
#define RLX_AGENT __ATOMIC_RELAXED, __HIP_MEMORY_SCOPE_AGENT
#define LDS_WAIT() asm volatile("s_waitcnt lgkmcnt(0)" ::: "memory")
#define VM_WAIT() asm volatile("s_waitcnt vmcnt(0)" ::: "memory")
__device__ __forceinline__ unsigned long long rt() { return __builtin_amdgcn_s_memrealtime(); }
__device__ __forceinline__ unsigned f2bf(float f) { unsigned u = __builtin_bit_cast(unsigned, f); return (u + 0x7fffu + ((u >> 16) & 1u)) >> 16; }
__device__ __forceinline__ unsigned pk2(float lo, float hi) { return f2bf(lo) | (f2bf(hi) << 16); }

#define XB_TMO      128
#define XB_XCNT(j)  (256  + 64 * (j))
#define XB_XSUB(j)  (1280 + 64 * (j))
#define XB_XGEN(j)  (2304 + 64 * (j))
#define XB_TOP      3328
#define XB_TOPGEN   3392
#define XCD_BAR_WORDS 3456
#define XB_SPIN_CAP (1u << 18)

__device__ __forceinline__ unsigned xb_ld(unsigned* p)              { return __hip_atomic_load(p, __ATOMIC_RELAXED, __HIP_MEMORY_SCOPE_AGENT); }
__device__ __forceinline__ unsigned xb_add(unsigned* p, unsigned v) { return __hip_atomic_fetch_add(p, v, __ATOMIC_RELAXED, __HIP_MEMORY_SCOPE_AGENT); }
__device__ __forceinline__ unsigned xb_xcc_id() { return (unsigned)__builtin_amdgcn_s_getreg((3 << 11) | 20) & 0xFu; }
#define XB_SPIN(cond, bar) do { unsigned _sp = 0; while (cond) { __builtin_amdgcn_s_sleep(1); \
    if ((++_sp & 255u) == 0u) { if (xb_ld(&(bar)[XB_TMO])) break; if (_sp > XB_SPIN_CAP) { atomicAdd(&(bar)[XB_TMO], 1u); break; } } } } while (0)

struct XcdBarrier {
    unsigned* bar; unsigned x;
    volatile LAS unsigned* st;
};

__device__ __forceinline__ XcdBarrier xcd_barrier_post(unsigned* bar, volatile LAS unsigned* st) {
    XcdBarrier b; b.bar = bar; b.x = xb_xcc_id(); b.st = st;
    if (threadIdx.x == 0) (void)xb_add(&bar[XB_XCNT(b.x)], 1u);
    return b;
}
__device__ __forceinline__ void xcd_barrier_complete(unsigned* bar, unsigned x, unsigned& nloc, unsigned& nx) {
    const unsigned G = gridDim.x * gridDim.y * gridDim.z;
    unsigned sum, cnt, mine, sp = 0u;
    for (;;) {
        sum = 0u; cnt = 0u; mine = 0u;
#pragma unroll
        for (unsigned j = 0; j < 16; ++j) { const unsigned c = xb_ld(&bar[XB_XCNT(j)]); sum += c; cnt += (c > 0u) ? 1u : 0u; mine = (j == x) ? c : mine; }
        if (sum == G) break;
        __builtin_amdgcn_s_sleep(1);
        if ((++sp & 255u) == 0u) { if (xb_ld(&bar[XB_TMO])) break; if (sp > XB_SPIN_CAP) { atomicAdd(&bar[XB_TMO], 1u); break; } }
    }
    nloc = mine > 0u ? mine : 1u; nx = cnt > 0u ? cnt : 1u;
}

__device__ __forceinline__ void xcd_barrier(const XcdBarrier& b) {
    asm volatile("s_waitcnt vmcnt(0)" ::: "memory");
    __syncthreads();
    if (threadIdx.x == 0) {
        unsigned* bar = b.bar;
        __builtin_amdgcn_s_waitcnt(0);
        unsigned nloc = b.st[0], nx = b.st[1];
        if (nloc == 0u) { xcd_barrier_complete(bar, b.x, nloc, nx); b.st[0] = nloc; b.st[1] = nx; }
        const unsigned old = xb_add(&bar[XB_XSUB(b.x)], 1u);
        const unsigned gen = old / nloc;
        if (old + 1u == (gen + 1u) * nloc) {
            __builtin_amdgcn_fence(__ATOMIC_RELEASE, "agent");
            asm volatile("s_waitcnt vmcnt(0)" ::: "memory");
            const unsigned og = xb_add(&bar[XB_TOP], 1u);
            const unsigned tg = og / nx;
            if (og + 1u == (tg + 1u) * nx) xb_add(&bar[XB_TOPGEN], 1u);
            else XB_SPIN(xb_ld(&bar[XB_TOPGEN]) == tg, bar);
            __builtin_amdgcn_fence(__ATOMIC_ACQUIRE, "agent");
            xb_add(&bar[XB_XGEN(b.x)], 1u);
            asm volatile("s_waitcnt vmcnt(0)" ::: "memory");
        } else {
            XB_SPIN(xb_ld(&bar[XB_XGEN(b.x)]) == gen, bar);
            __builtin_amdgcn_fence(__ATOMIC_ACQUIRE, "agent");
            asm volatile("s_waitcnt vmcnt(0)" ::: "memory");
        }
    }
    __syncthreads();
}

struct Args { const float* in[26]; float* out; unsigned char* ws; };
struct Frame {
    LAS unsigned char* lds;
    volatile LAS unsigned* MISC;
    LAS int* META;
    gu32* ctl;
    unsigned char* ws; float* out;
    int tid, lane, wave, G, bx;
};
__device__ __forceinline__ float bf2f(unsigned short u) { return __uint_as_float((unsigned)u << 16); }
__device__ __forceinline__ float bflo(unsigned w) { return __uint_as_float(w << 16); }
__device__ __forceinline__ float bfhi(unsigned w) { return __uint_as_float(w & 0xffff0000u); }
__device__ __forceinline__ float wave_sum(float v) {
#pragma unroll
    for (int o = 1; o < 64; o <<= 1) v += __shfl_xor(v, o);
    return v;
}
__device__ __forceinline__ float silu_f(float v) { return v * __builtin_amdgcn_rcpf(1.0f + __builtin_amdgcn_exp2f(-LOG2E * v)); }

__device__ __forceinline__ void tr_item(const float* W, int ldw, int k0, int nsrc0, bool valid, bf16* WT, int ldk, int drow0, float scale, LAS float* scr, int lane) {
    if (valid) {
#pragma unroll 8
        for (int i = 0; i < 32; ++i) { const int kk = 2 * i + (lane >> 5); scr[kk * 33 + (lane & 31)] = W[(size_t)(k0 + kk) * ldw + nsrc0 + (lane & 31)] * scale; }
    } else {
#pragma unroll 8
        for (int i = 0; i < 32; ++i) { const int kk = 2 * i + (lane >> 5); scr[kk * 33 + (lane & 31)] = 0.f; }
    }
    LDS_WAIT(); asm volatile("" ::: "memory");
    const int c = lane & 7;
#pragma unroll
    for (int j = 0; j < 4; ++j) { const int n = (lane >> 3) + 8 * j; const LAS float* s = scr + (8 * c) * 33 + n;
        v4u o; o.x = pk2(s[0 * 33], s[1 * 33]); o.y = pk2(s[2 * 33], s[3 * 33]); o.z = pk2(s[4 * 33], s[5 * 33]); o.w = pk2(s[6 * 33], s[7 * 33]);
        *(GAS v4u*)(WT + (size_t)(drow0 + n) * ldk + k0 + 8 * c) = o; }
    LDS_WAIT(); asm volatile("" ::: "memory");
}
constexpr float C2Q = 0.17677669529663687f * LOG2E;
__device__ __forceinline__ void p0_weights(Frame& F, const Args& A) {
    LAS float* scr = (LAS float*)(F.lds + F.wave * 16384);
    const int gw = F.bx * NWAVES + F.wave, NGW = F.G * NWAVES;
    constexpr int I_IN = 96 * 16, I_OUT = 32 * 16, I_GU = 176 * 16, I_D = 32 * 44, I_EGU = 224 * 16, I_ED = 32 * 56;
    constexpr int NITEMS = 2 * I_IN + 2 * I_OUT + I_GU + I_D + NEXP * I_EGU + NEXP * I_ED;
    for (int it = gw; it < NITEMS; it += NGW) {
        int r = it;
        if (r < 2 * I_IN) { const int l = r / I_IN; r -= l * I_IN; const int kb = r / 96, nb = r % 96;
            const float sc = nb < 8 ? C2Q : ((nb >= 72 && nb < 80) ? 0.125f : 1.0f);
            tr_item(A.in[1] + (size_t)l * D * NIN, NIN, kb * 64, nb < 64 ? nb * 32 : nb * 32 + 8, true, ((bf16*)(F.ws + WS_WIN)) + (size_t)l * NPROJ * D, D, nb * 32, sc, scr, F.lane); continue; }
        r -= 2 * I_IN;
        if (r < 2 * I_OUT) { const int l = r / I_OUT; r -= l * I_OUT; const int kb = r / 32, nb = r % 32;
            tr_item(A.in[2] + (size_t)l * D * D, D, kb * 64, nb * 32, true, ((bf16*)(F.ws + WS_WOUT)) + (size_t)l * D * D, D, nb * 32, 1.0f, scr, F.lane); continue; }
        r -= 2 * I_OUT;
        if (r < I_GU) { const int kb = r / 176, nb = r % 176, t = nb >> 3, sub = nb & 7; const int f = t * 128 + (sub & 3) * 32;
            tr_item(sub < 4 ? A.in[19] : A.in[20], FD, kb * 64, f, f < FD, ((bf16*)(F.ws + WS_WGU)), D, nb * 32, 1.0f, scr, F.lane); continue; }
        r -= I_GU;
        if (r < I_D) { const int kb = r / 32, nb = r % 32;
            tr_item(A.in[21], D, kb * 64, nb * 32, kb * 64 < FD, ((bf16*)(F.ws + WS_WD)), FDP, nb * 32, 1.0f, scr, F.lane); continue; }
        r -= I_D;
        if (r < NEXP * I_EGU) { const int e = r / I_EGU; r -= e * I_EGU; const int kb = r / 224, nb = r % 224, t = nb >> 3, sub = nb & 7; const int f = t * 128 + (sub & 3) * 32;
            tr_item((sub < 4 ? A.in[23] : A.in[24]) + (size_t)e * D * FE, FE, kb * 64, f, true, ((bf16*)(F.ws + WS_EGU)) + (size_t)e * 2 * FE * D, D, nb * 32, 1.0f, scr, F.lane); continue; }
        r -= NEXP * I_EGU;
        { const int e = r / I_ED; r -= e * I_ED; const int kb = r / 32, nb = r % 32;
            tr_item(A.in[25] + (size_t)e * FE * D, D, kb * 64, nb * 32, true, ((bf16*)(F.ws + WS_ED)) + (size_t)e * D * FE, FE, nb * 32, 1.0f, scr, F.lane); }
    }
}

template <int MODE>
__device__ __forceinline__ void norm_phase(Frame& F, const float* src, const float* gain, const float* wx, int ldw) {
    LAS float* Wl = (LAS float*)F.lds;
    if (MODE != 0) {
        for (int idx = F.tid; idx < 8 * D; idx += NWAVES * 64) { const int k = idx >> 3, j = idx & 7; Wl[j * D + k] = wx[(size_t)k * ldw + j]; }
        __syncthreads();
    }
    const int gw = F.bx * NWAVES + F.wave, NGW = F.G * NWAVES;
    f32x4 g4[4];
#pragma unroll
    for (int j = 0; j < 4; ++j) g4[j] = ((const f32x4*)gain)[F.lane + 64 * j];
    for (int m = gw; m < M; m += NGW) {
        const f32x4* xr = (const f32x4*)(src + (size_t)m * D) + F.lane;
        f32x4 v[4]; float s = 0.f;
#pragma unroll
        for (int j = 0; j < 4; ++j) { v[j] = xr[64 * j]; s += (v[j].x * v[j].x + v[j].y * v[j].y) + (v[j].z * v[j].z + v[j].w * v[j].w); }
        const float rstd = __builtin_amdgcn_rsqf(wave_sum(s) * (1.f / D) + EPS);
        unsigned long long* o8 = (unsigned long long*)(((bf16*)(F.ws + WS_XN)) + (size_t)m * D) + F.lane;
#pragma unroll
        for (int j = 0; j < 4; ++j) { v[j] = v[j] * rstd * g4[j]; o8[64 * j] = (unsigned long long)pk2(v[j].x, v[j].y) | ((unsigned long long)pk2(v[j].z, v[j].w) << 32); }
        if (MODE != 0) {
            float ex[8];
#pragma unroll
            for (int e = 0; e < 8; ++e) { float a = 0.f;
#pragma unroll
                for (int j = 0; j < 4; ++j) { const f32x4 w = *(const LAS f32x4*)(Wl + e * D + 4 * F.lane + 256 * j); a += (v[j].x * w.x + v[j].y * w.y) + (v[j].z * w.z + v[j].w * w.w); }
                ex[e] = wave_sum(a); }
            if (MODE == 1) {
                float val = ex[0];
#pragma unroll
                for (int e = 1; e < 8; ++e) val = (F.lane == e) ? ex[e] : val;
                if (F.lane < 8) ((float*)(F.ws + WS_DT))[(size_t)m * 8 + F.lane] = val;
            } else {
                int e0 = 0; float v0 = ex[0];
#pragma unroll
                for (int e = 1; e < 8; ++e) if (ex[e] > v0) { v0 = ex[e]; e0 = e; }
                int e1 = -1; float v1 = -3.0e38f;
#pragma unroll
                for (int e = 0; e < 8; ++e) if (e != e0 && ex[e] > v1) { v1 = ex[e]; e1 = e; }
                if (F.lane == 0) {
                    const float g0 = 1.0f / (1.0f + __expf(v1 - v0)), g1 = 1.0f - g0;
                    const int pos0 = (int)atomicAdd((unsigned*)(F.ctl + CW_CNT + 64 * e0), 1u), pos1 = (int)atomicAdd((unsigned*)(F.ctl + CW_CNT + 64 * e1), 1u);
                    ((int*)(F.ws + WS_LIST))[e0 * 16384 + pos0] = m; ((int*)(F.ws + WS_LIST))[e1 * 16384 + pos1] = m;
                    ((int*)(F.ws + WS_TI))[m * 4 + 0] = e0 | (e1 << 8); ((int*)(F.ws + WS_TI))[m * 4 + 1] = pos0; ((int*)(F.ws + WS_TI))[m * 4 + 2] = pos1; ((int*)(F.ws + WS_TI))[m * 4 + 3] = 0;
                    ((float*)(F.ws + WS_TG))[m * 2 + 0] = g0; ((float*)(F.ws + WS_TG))[m * 2 + 1] = g1;
                }
            }
        }
    }
    if (MODE != 0) __syncthreads();
}
__device__ __forceinline__ void combine_phase(Frame& F, const Args& A) {
    const int gw = F.bx * NWAVES + F.wave, NGW = F.G * NWAVES;
    f32x4 g4[4];
#pragma unroll
    for (int j = 0; j < 4; ++j) g4[j] = ((const f32x4*)A.in[5])[F.lane + 64 * j];
    for (int m = gw; m < M; m += NGW) {
        const int ti = ((int*)(F.ws + WS_TI))[m * 4], e0 = ti & 255, e1 = ti >> 8;
        const size_t r0 = (size_t)F.META[8 + e0] * 256 + ((int*)(F.ws + WS_TI))[m * 4 + 1], r1 = (size_t)F.META[8 + e1] * 256 + ((int*)(F.ws + WS_TI))[m * 4 + 2];
        const float g0 = ((float*)(F.ws + WS_TG))[m * 2], g1 = ((float*)(F.ws + WS_TG))[m * 2 + 1];
        f32x4* xr = (f32x4*)(F.out + (size_t)m * D) + F.lane;
        const uint2* y0 = (const uint2*)(((bf16*)(F.ws + WS_MIX)) + r0 * D) + F.lane; const uint2* y1 = (const uint2*)(((bf16*)(F.ws + WS_MIX)) + r1 * D) + F.lane;
        f32x4 v[4]; float s = 0.f;
#pragma unroll
        for (int j = 0; j < 4; ++j) { const uint2 a = y0[64 * j], b = y1[64 * j]; v[j] = xr[64 * j];
            v[j].x += g0 * bflo(a.x) + g1 * bflo(b.x); v[j].y += g0 * bfhi(a.x) + g1 * bfhi(b.x); v[j].z += g0 * bflo(a.y) + g1 * bflo(b.y); v[j].w += g0 * bfhi(a.y) + g1 * bfhi(b.y);
            s += (v[j].x * v[j].x + v[j].y * v[j].y) + (v[j].z * v[j].z + v[j].w * v[j].w); }
        const float rstd = __builtin_amdgcn_rsqf(wave_sum(s) * (1.f / D) + EPS);
#pragma unroll
        for (int j = 0; j < 4; ++j) xr[64 * j] = v[j] * rstd * g4[j];
    }
}
__device__ __forceinline__ int t5_bucket(int rel) {
    const int n = rel < 0 ? -rel : rel;
    int b = n < 8 ? n : n < 12 ? 8 : n < 16 ? 9 : n < 23 ? 10 : n < 32 ? 11 : n < 46 ? 12 : n < 64 ? 13 : n < 91 ? 14 : 15;
    return rel > 0 ? b + 16 : b;
}
__device__ __forceinline__ void unpack8(const v4u w, float* f) { f[0] = bflo(w.x); f[1] = bfhi(w.x); f[2] = bflo(w.y); f[3] = bfhi(w.y); f[4] = bflo(w.z); f[5] = bfhi(w.z); f[6] = bflo(w.w); f[7] = bfhi(w.w); }

__device__ __forceinline__ void attn_naive_unit(Frame& F, const Args& A, int l, int b, int h, int qb, float lam, float lam_init) {
    LAS float* Ks = (LAS float*)F.lds;
    LAS float* Vs = Ks + 4096;
    LAS float* Bt = Vs + 4096;
    LAS float* Ob = (LAS float*)(F.lds + 36864);
    const int tid = F.tid, t = tid >> 8, r = tid & 255;
    const int Q0 = qb * 256, row = Q0 + r; const size_t grow = (size_t)b * SEQ + row;
    const bf16* PROJ = (const bf16*)(F.ws + WS_BIG);
    __syncthreads();
    if (tid < 192) Bt[tid] = A.in[6][t5_bucket(tid - 128) * 4 + h] * LOG2E;
    f32x4 q4[8];
    { const v4u* qp = (const v4u*)(PROJ + grow * NPROJ + PC_Q + h * 64 + t * 32);
#pragma unroll
      for (int i = 0; i < 4; ++i) { const v4u w = qp[i]; q4[2 * i] = (f32x4){bflo(w.x), bfhi(w.x), bflo(w.y), bfhi(w.y)}; q4[2 * i + 1] = (f32x4){bflo(w.z), bfhi(w.z), bflo(w.w), bfhi(w.w)}; } }
    f32x4 O4[16];
#pragma unroll
    for (int e = 0; e < 16; ++e) O4[e] = (f32x4){0.f, 0.f, 0.f, 0.f};
    float mrun = -1.0e30f, lsum = 0.f;
    const int cq = row >> 6, nck = (Q0 >> 6) + 4;
    for (int ck = 0; ck < nck; ++ck) {
        __syncthreads();
        { const int key = tid >> 3, seg = tid & 7; const bf16* kp = PROJ + ((size_t)b * SEQ + ck * 64 + key) * NPROJ + PC_K + h * 64 + seg * 8;
          const v4u kw = *(const v4u*)kp, vw = *(const v4u*)(kp + 256);
          LAS f32x4* kd = (LAS f32x4*)(Ks + (seg >> 2) * 2048 + key * 32 + (seg & 3) * 8); LAS f32x4* vd = (LAS f32x4*)(Vs + key * 64 + seg * 8);
          kd[0] = (f32x4){bflo(kw.x), bfhi(kw.x), bflo(kw.y), bfhi(kw.y)}; kd[1] = (f32x4){bflo(kw.z), bfhi(kw.z), bflo(kw.w), bfhi(kw.w)};
          vd[0] = (f32x4){bflo(vw.x), bfhi(vw.x), bflo(vw.y), bfhi(vw.y)}; vd[1] = (f32x4){bflo(vw.z), bfhi(vw.z), bflo(vw.w), bfhi(vw.w)}; }
        __syncthreads();
        if (ck <= cq) {
            const int kbase = ck * 64 - row;
#pragma unroll 1
            for (int j = 0; j < 64; ++j) {
                const LAS f32x4* kr = (const LAS f32x4*)(Ks + t * 2048 + j * 32);
                f32x4 a4 = q4[0] * kr[0];
#pragma unroll
                for (int d = 1; d < 8; ++d) a4 += q4[d] * kr[d];
                int rel = kbase + j; rel = rel < -128 ? -128 : rel;
                const float sj = (a4.x + a4.y) + (a4.z + a4.w) + Bt[rel + 128];
                if (sj > mrun) { const float sc = __builtin_amdgcn_exp2f(mrun - sj); lsum *= sc;
#pragma unroll
                    for (int e = 0; e < 16; ++e) O4[e] *= sc;
                    mrun = sj; }
                const float p = __builtin_amdgcn_exp2f(sj - mrun); lsum += p;
                const LAS f32x4* vr = (const LAS f32x4*)(Vs + j * 64);
#pragma unroll
                for (int e = 0; e < 16; ++e) O4[e] += vr[e] * p;
            }
        }
    }
    __syncthreads();
    const float inv = 1.0f / lsum;
    if (t == 1) {
#pragma unroll
        for (int e = 0; e < 16; ++e) *(LAS f32x4*)(Ob + r * 68 + 4 * e) = O4[e] * inv; }
    __syncthreads();
    if (t == 0) { f32x4 ss4 = (f32x4){0.f, 0.f, 0.f, 0.f};
#pragma unroll
        for (int e = 0; e < 16; ++e) { const f32x4 o = O4[e] * inv - *(const LAS f32x4*)(Ob + r * 68 + 4 * e) * lam; O4[e] = o; ss4 += o * o; }
        const float rstd = __builtin_amdgcn_rsqf(((ss4.x + ss4.y) + (ss4.z + ss4.w)) * (1.f / 64.f) + EPS) * (1.0f - lam_init);
        const f32x4* gn = (const f32x4*)(A.in[11] + l * 64); v4u* op = (v4u*)((bf16*)(F.ws + WS_MIX) + grow * D + h * 64);
#pragma unroll
        for (int e = 0; e < 16; e += 2) { const f32x4 o0 = O4[e] * gn[e] * rstd, o1 = O4[e + 1] * gn[e + 1] * rstd;
            v4u w; w.x = pk2(o0.x, o0.y); w.y = pk2(o0.z, o0.w); w.z = pk2(o1.x, o1.y); w.w = pk2(o1.z, o1.w); op[e >> 1] = w; } }
    __syncthreads();
}

__device__ __forceinline__ void ssd_naive_unit(Frame& F, const Args& A, int l, int b, int g) {
    LAS float* xs = (LAS float*)F.lds;
    LAS float* Bs = xs + 64 * 256;
    LAS float* Cs = Bs + 4096;
    LAS float* dts = Cs + 4096;
    LAS float* dAs = dts + 256;
    const int tid = F.tid, hh = tid >> 7, p = (tid & 127) >> 1, nh = tid & 1, head = g * 4 + hh;
    const float Dk = A.in[16][l * 8 + head];
    float hst[32];
#pragma unroll
    for (int i = 0; i < 32; ++i) hst[i] = 0.f;
    int ch = 0; float w0 = 0.f, w1 = 0.f, w2 = 0.f, w3 = 0.f, cb = 0.f, r0 = 0.f, r1 = 0.f, r2 = 0.f;
    if (tid < 384) { ch = tid < 256 ? g * 256 + tid : tid < 320 ? 512 + g * 64 + (tid - 256) : 640 + g * 64 + (tid - 320);
        const float* cw = A.in[12] + (size_t)l * 4 * 768; w0 = cw[ch]; w1 = cw[768 + ch]; w2 = cw[2 * 768 + ch]; w3 = cw[3 * 768 + ch]; cb = A.in[13][l * 768 + ch]; }
    for (int c = 0; c < SEQ / 64; ++c) {
        __syncthreads();
        const size_t rowb = (size_t)b * SEQ + c * 64;
        if (tid < 384) { const bf16* src = ((bf16*)(F.ws + WS_BIG)) + rowb * NPROJ + PC_XBC + ch; LAS float* dst = tid < 256 ? xs + tid : tid < 320 ? Bs + (tid - 256) : Cs + (tid - 320); const int dstr = tid < 256 ? 256 : 64;
            _Pragma("unroll 16") for (int tt = 0; tt < 64; ++tt) { const float r3 = bf2f(src[(size_t)tt * NPROJ]); const float v = cb + r0 * w0 + r1 * w1 + r2 * w2 + r3 * w3; dst[tt * dstr] = silu_f(v); r0 = r1; r1 = r2; r2 = r3; } }
        else if (tid < 384 + 64) { const int tt = tid - 384;
#pragma unroll
            for (int k = 0; k < 4; ++k) { const int hd = g * 4 + k; const float xr = ((float*)(F.ws + WS_DT))[(rowb + tt) * 8 + hd] + A.in[14][l * 8 + hd]; const float dt = xr > 20.f ? xr : log1pf(__expf(xr));
                dts[tt * 4 + k] = dt; dAs[tt * 4 + k] = __expf(-__expf(A.in[15][l * 8 + hd]) * dt); } }
        __syncthreads();
        for (int tt = 0; tt < 64; ++tt) {
            const float x = xs[tt * 256 + hh * 64 + p], dt = dts[tt * 4 + hh], dA = dAs[tt * 4 + hh], cx = dt * x;
            const LAS float* Br = Bs + tt * 64 + nh * 32; const LAS float* Cr = Cs + tt * 64 + nh * 32; float a = 0.f;
#pragma unroll
            for (int i = 0; i < 32; i += 4) { const f32x4 bb = *(const LAS f32x4*)(Br + i), cc = *(const LAS f32x4*)(Cr + i);
                hst[i] = hst[i] * dA + cx * bb.x; hst[i + 1] = hst[i + 1] * dA + cx * bb.y; hst[i + 2] = hst[i + 2] * dA + cx * bb.z; hst[i + 3] = hst[i + 3] * dA + cx * bb.w;
                a += (hst[i] * cc.x + hst[i + 1] * cc.y) + (hst[i + 2] * cc.z + hst[i + 3] * cc.w); }
            a += __shfl_xor(a, 1);
            if (nh == 0) xs[tt * 256 + hh * 64 + p] = a + Dk * x;
        }
        __syncthreads();
        for (int k = 0; k < 8; ++k) { const int tt = F.wave * 8 + k; const size_t row = rowb + tt;
            const f32x4 y = *(const LAS f32x4*)(xs + tt * 256 + 4 * F.lane); const uint2 zz = *(const uint2*)(((bf16*)(F.ws + WS_BIG)) + row * NPROJ + PC_Z + g * 256 + 4 * F.lane);
            f32x4 v; v.x = y.x * silu_f(bflo(zz.x)); v.y = y.y * silu_f(bfhi(zz.x)); v.z = y.z * silu_f(bflo(zz.y)); v.w = y.w * silu_f(bfhi(zz.y));
            const float rstd = __builtin_amdgcn_rsqf(wave_sum((v.x * v.x + v.y * v.y) + (v.z * v.z + v.w * v.w)) * (1.f / 256.f) + EPS);
            const f32x4 gn = *(const f32x4*)(A.in[17] + l * 512 + g * 256 + 4 * F.lane);
            uint2 o; o.x = pk2(v.x * rstd * gn.x, v.y * rstd * gn.y); o.y = pk2(v.z * rstd * gn.z, v.w * rstd * gn.w);
            *(uint2*)(((bf16*)(F.ws + WS_MIX)) + row * D + 256 + g * 256 + 4 * F.lane) = o; }
    }
    __syncthreads();
}

__device__ __forceinline__ void ret_naive_unit(Frame& F, const Args& A, int l, int b, int h) {
    constexpr int ST = 68;
    LAS float* qs = (LAS float*)F.lds; LAS float* ks = qs + 64 * ST; LAS float* vs = ks + 64 * ST; LAS float* sc = vs + 64 * ST; LAS float* Ss = sc + 64 * ST; LAS float* os = Ss + 64 * ST;
    const int tid = F.tid, ra = tid >> 3, eg = tid & 7;
    const float gam = 1.0f - exp2f(-5.0f - (float)h), lg2 = log2f(gam), g64 = exp2f(lg2 * 64.f);
    float Sreg[8];
#pragma unroll
    for (int i = 0; i < 8; ++i) Sreg[i] = 0.f;
    __syncthreads();
#pragma unroll
    for (int i = 0; i < 8; ++i) Ss[ra * ST + eg * 8 + i] = 0.f;
    for (int c = 0; c < SEQ / 64; ++c) {
        __syncthreads();
        const size_t rowb = (size_t)b * SEQ + c * 64;
        { const int tok = ra, seg = eg; const bf16* rp = ((bf16*)(F.ws + WS_BIG)) + (rowb + tok) * NPROJ;
          if (seg < 4) { float ql[8], qh[8], kl[8], kh[8];
              unpack8(*(const v4u*)(rp + PC_RQ + h * 64 + seg * 8), ql); unpack8(*(const v4u*)(rp + PC_RQ + h * 64 + 32 + seg * 8), qh);
              unpack8(*(const v4u*)(rp + PC_RK + h * 64 + seg * 8), kl); unpack8(*(const v4u*)(rp + PC_RK + h * 64 + 32 + seg * 8), kh);
              const float pos = (float)(c * 64 + tok);
#pragma unroll
              for (int i = 0; i < 8; ++i) { const int fi = seg * 8 + i; const float invf = exp2f(-(float)fi * (13.287712379549449f / 32.0f)); const float ang = pos * invf;
                  double rev = (double)ang * 0.15915494309189535; rev -= __builtin_rint(rev); const float fr = (float)rev;
                  const float sn = __builtin_amdgcn_sinf(fr), cs = __builtin_amdgcn_cosf(fr);
                  qs[tok * ST + fi] = ql[i] * cs - qh[i] * sn; qs[tok * ST + fi + 32] = ql[i] * sn + qh[i] * cs;
                  ks[tok * ST + fi] = kl[i] * cs - kh[i] * sn; ks[tok * ST + fi + 32] = kl[i] * sn + kh[i] * cs; } }
          else { float va[8], vb[8]; const int c0 = (seg - 4) * 16; unpack8(*(const v4u*)(rp + PC_RV + h * 64 + c0), va); unpack8(*(const v4u*)(rp + PC_RV + h * 64 + c0 + 8), vb);
#pragma unroll
              for (int i = 0; i < 8; ++i) { vs[tok * ST + c0 + i] = va[i]; vs[tok * ST + c0 + 8 + i] = vb[i]; } } }
        __syncthreads();
        { float a[8];
#pragma unroll
          for (int jj = 0; jj < 8; ++jj) a[jj] = 0.f;
          for (int d = 0; d < 64; d += 4) { const f32x4 qq = *(const LAS f32x4*)(qs + ra * ST + d);
#pragma unroll
              for (int jj = 0; jj < 8; ++jj) { const f32x4 kk = *(const LAS f32x4*)(ks + (jj * 8 + eg) * ST + d); a[jj] += (qq.x * kk.x + qq.y * kk.y) + (qq.z * kk.z + qq.w * kk.w); } }
#pragma unroll
          for (int jj = 0; jj < 8; ++jj) { const int s = jj * 8 + eg; const int dd = ra > s ? ra - s : s - ra; sc[ra * ST + s] = a[jj] * exp2f(lg2 * (float)dd); } }
        __syncthreads();
        { float a[8];
#pragma unroll
          for (int i = 0; i < 8; ++i) a[i] = 0.f;
          for (int s = 0; s < 64; ++s) { const float w = sc[ra * ST + s]; const f32x4 v0 = *(const LAS f32x4*)(vs + s * ST + eg * 8), v1 = *(const LAS f32x4*)(vs + s * ST + eg * 8 + 4);
              a[0] += w * v0.x; a[1] += w * v0.y; a[2] += w * v0.z; a[3] += w * v0.w; a[4] += w * v1.x; a[5] += w * v1.y; a[6] += w * v1.z; a[7] += w * v1.w; }
          const float qd = exp2f(lg2 * (float)(ra + 1));
          for (int d = 0; d < 64; ++d) { const float w = qs[ra * ST + d] * qd; const f32x4 v0 = *(const LAS f32x4*)(Ss + d * ST + eg * 8), v1 = *(const LAS f32x4*)(Ss + d * ST + eg * 8 + 4);
              a[0] += w * v0.x; a[1] += w * v0.y; a[2] += w * v0.z; a[3] += w * v0.w; a[4] += w * v1.x; a[5] += w * v1.y; a[6] += w * v1.z; a[7] += w * v1.w; }
#pragma unroll
          for (int i = 0; i < 8; ++i) os[ra * ST + eg * 8 + i] = a[i]; }
        __syncthreads();
        { float a[8];
#pragma unroll
          for (int i = 0; i < 8; ++i) a[i] = 0.f;
          for (int s = 0; s < 64; ++s) { const float w = ks[s * ST + ra] * exp2f(lg2 * (float)(63 - s)); const f32x4 v0 = *(const LAS f32x4*)(vs + s * ST + eg * 8), v1 = *(const LAS f32x4*)(vs + s * ST + eg * 8 + 4);
              a[0] += w * v0.x; a[1] += w * v0.y; a[2] += w * v0.z; a[3] += w * v0.w; a[4] += w * v1.x; a[5] += w * v1.y; a[6] += w * v1.z; a[7] += w * v1.w; }
#pragma unroll
          for (int i = 0; i < 8; ++i) { Sreg[i] = Sreg[i] * g64 + a[i]; Ss[ra * ST + eg * 8 + i] = Sreg[i]; } }
        for (int k = 0; k < 8; ++k) { const int tok = F.wave * 8 + k; const size_t row = rowb + tok;
            const float v = os[tok * ST + F.lane]; const float rstd = __builtin_amdgcn_rsqf(wave_sum(v * v) * (1.f / 64.f) + EPS);
            const float gt = bf2f(((bf16*)(F.ws + WS_BIG))[row * NPROJ + PC_RG + h * 64 + F.lane]);
            ((bf16*)(F.ws + WS_MIX))[row * D + 768 + h * 64 + F.lane] = (bf16)f2bf(silu_f(gt) * v * rstd * A.in[18][l * 64 + F.lane]); }
    }
    __syncthreads();
}
__device__ __forceinline__ void mixer_phase_naive(Frame& F, const Args& A, int l) {
    const float lam_init = 0.8f - 0.6f * __expf(-0.3f * (float)l);
    float d1 = 0.f, d2 = 0.f;
    for (int i = 0; i < 32; ++i) { d1 += A.in[7][l * 32 + i] * A.in[8][l * 32 + i]; d2 += A.in[9][l * 32 + i] * A.in[10][l * 32 + i]; }
    const float lam = __expf(d1) - __expf(d2) + lam_init;
    if (F.bx < 8) ret_naive_unit(F, A, l, F.bx >> 2, F.bx & 3);
    else if (F.bx < 12) ssd_naive_unit(F, A, l, (F.bx - 8) >> 1, (F.bx - 8) & 1);
    else { const int na = F.G - 12, j = F.bx - 12;
        for (int rnd = 0;; ++rnd) { const int i = (rnd & 1) ? (rnd + 1) * na - 1 - j : rnd * na + j; if (i >= 256) break;
            const int qb = 31 - (i >> 3), bh = i & 7; attn_naive_unit(F, A, l, bh >> 2, bh & 3, qb, lam, lam_init); } }
}
__device__ __forceinline__ void gather_phase(Frame& F) {
    const int gw = F.bx * NWAVES + F.wave, NGW = F.G * NWAVES, nrows = F.META[16] * 256;
    const bf16* XN = (const bf16*)(F.ws + WS_XN); bf16* XG = (bf16*)(F.ws + WS_MIX); const int* LIST = (const int*)(F.ws + WS_LIST);
    for (int row = gw; row < nrows; row += NGW) {
        const int p = row >> 8, r = row & 255; int e = 0;
#pragma unroll
        for (int k = 1; k < 8; ++k) e += (p >= F.META[8 + k]) ? 1 : 0;
        const int pos = (p - F.META[8 + e]) * 256 + r;
        v4u a = (v4u){0u, 0u, 0u, 0u}, b = a;
        if (pos < F.META[e]) { const int tok = LIST[e * 16384 + pos]; const v4u* s = (const v4u*)(XN + (size_t)tok * D) + F.lane; a = s[0]; b = s[64]; }
        v4u* d = (v4u*)(XG + (size_t)row * D) + F.lane; d[0] = a; d[64] = b;
    }
}
#define GRID_BAR() xcd_barrier(bar)
#define WSB(off) ((bf16*)(F.ws + (off)))
template <int l>
__device__ __forceinline__ void layer_body(Frame& F, const Args& args, const XcdBarrier& bar) {

        { pg8::Gemm g{WSB(WS_XN), WSB(WS_WIN) + (size_t)l * NPROJ * D, D}; pg8::StaticOrder S; S.init(M, NPROJ, F.G, F.bx);
          pg8::EpiBf16 E{WSB(WS_BIG), NPROJ};
          pg8::gemm_phase<pg8::EpiBf16, pg8::StaticOrder, true>(F.lds, g, S, E); }
        GRID_BAR();
        mixer_phase_naive(F, args, l);
        GRID_BAR();
        { pg8::Gemm g{WSB(WS_MIX), WSB(WS_WOUT) + (size_t)l * D * D, D}; pg8::StaticOrder S; S.init(M, D, F.G, F.bx);
          pg8::EpiResF32 E{l == 0 ? args.in[0] : F.out, F.out, D};
          pg8::gemm_phase<pg8::EpiResF32, pg8::StaticOrder, false>(F.lds, g, S, E); }
        GRID_BAR();
        if constexpr (l == 0) {
            norm_phase<0>(F, F.out, args.in[4], nullptr, 0);
            GRID_BAR();
            { pg8::Gemm g{WSB(WS_XN), WSB(WS_WGU), D}; pg8::StaticOrder S; S.init(M, 2 * FDP, F.G, F.bx);
              pg8::EpiSwiGLU E{WSB(WS_BIG), FDP};
              pg8::gemm_phase<pg8::EpiSwiGLU, pg8::StaticOrder, true>(F.lds, g, S, E); }
            GRID_BAR();
            { pg8::Gemm g{WSB(WS_BIG), WSB(WS_WD), FDP}; pg8::StaticOrder S; S.init(M, D, F.G, F.bx);
              pg8::EpiResF32 E{F.out, F.out, D};
              pg8::gemm_phase<pg8::EpiResF32, pg8::StaticOrder, false>(F.lds, g, S, E); }
            GRID_BAR();
            norm_phase<1>(F, F.out, args.in[3] + D, args.in[1] + (size_t)D * NIN + 2048, NIN);
            GRID_BAR();
        } else {
            norm_phase<2>(F, F.out, args.in[4] + D, args.in[22], 8);
            GRID_BAR();
            if (F.tid == 0) { int acc = 0;
                for (int e = 0; e < 8; ++e) { const int c = (int)__hip_atomic_load(F.ctl + CW_CNT + 64 * e, RLX_AGENT); F.META[e] = c; F.META[8 + e] = acc; acc += (c + 255) >> 8; }
                F.META[16] = acc; }
            __syncthreads();
            gather_phase(F);
            GRID_BAR();
            const int ptot = F.META[16];
            for (int slab = 0; slab < 2; ++slab) {
                const int p0 = slab * SLAB_PANELS; int np = ptot - p0; np = np < 0 ? 0 : (np > SLAB_PANELS ? SLAB_PANELS : np);
                { pg8::Gemm g{WSB(WS_MIX), WSB(WS_EGU), D}; pg8::GroupedOrder S{2 * FE / 256, p0, np, F.G, F.bx, 0, F.META};
                  pg8::EpiSwiGLU E{WSB(WS_BIG), FE};
                  pg8::gemm_phase<pg8::EpiSwiGLU, pg8::GroupedOrder, true>(F.lds, g, S, E); }
                GRID_BAR();
                { pg8::Gemm g{WSB(WS_BIG), WSB(WS_ED), FE}; pg8::GroupedOrder S{D / 256, p0, np, F.G, F.bx, 1, F.META};
                  pg8::EpiBf16 E{WSB(WS_MIX), D};
                  pg8::gemm_phase<pg8::EpiBf16, pg8::GroupedOrder, true>(F.lds, g, S, E); }
                GRID_BAR();
            }
            combine_phase(F, args);
        }
}
__global__ void __launch_bounds__(NWAVES * 64, 2) mk_fwd(Args args) {
    extern __shared__ __attribute__((aligned(16))) unsigned char lds[];
    Frame F;
    F.lds = (LAS unsigned char*)lds;
    F.MISC = (volatile LAS unsigned*)(F.lds + MISC_OFF);
    F.META = (LAS int*)(F.lds + MISC_OFF + 64);
    F.tid = threadIdx.x; F.lane = F.tid & 63; F.wave = __builtin_amdgcn_readfirstlane(F.tid >> 6);
    F.G = gridDim.x; F.bx = blockIdx.x;
    F.ws = args.ws; F.out = args.out;
    F.ctl = (gu32*)(F.ws + WS_CTL);
    for (int u = F.tid; u < (LDS_BYTES - LDSCTL_OFF) / 4; u += NWAVES * 64) ((LAS unsigned*)(F.lds + LDSCTL_OFF))[u] = 0u;
    __syncthreads();
    XcdBarrier bar = xcd_barrier_post((unsigned*)(F.ctl + CW_BAR), F.MISC + 8);
    p0_weights(F, args);
    __syncthreads();
    norm_phase<1>(F, args.in[0], args.in[3], args.in[1] + 2048, NIN);
    GRID_BAR();
    layer_body<0>(F, args, bar);
    layer_body<1>(F, args, bar);
}

extern "C" void kernel_launch(void* const* d_in, const int* in_sizes, int n_in, void* d_out, int out_size, void* d_ws, size_t ws_size, hipStream_t stream) {
    static int grid = 0;
    if (grid == 0) {
        if (n_in != 26 || in_sizes[0] != M * D || out_size != M * D || ws_size < WS_END) { fprintf(stderr, "kernel_launch: unexpected shapes (n_in %d, in0 %d, out %d, ws %zu); nothing launched\n", n_in, n_in > 0 ? in_sizes[0] : -1, out_size, ws_size); grid = -1; return; }
        int dev = 0, cus = 0, per_cu = 0;
        if (hipGetDevice(&dev) != hipSuccess || hipDeviceGetAttribute(&cus, hipDeviceAttributeMultiprocessorCount, dev) != hipSuccess) { grid = -1; return; }
        if (hipFuncSetAttribute((const void*)mk_fwd, hipFuncAttributeMaxDynamicSharedMemorySize, LDS_BYTES) != hipSuccess) { fprintf(stderr, "kernel_launch: hipFuncSetAttribute failed\n"); grid = -1; return; }
        if (hipOccupancyMaxActiveBlocksPerMultiprocessor(&per_cu, (const void*)mk_fwd, NWAVES * 64, LDS_BYTES) != hipSuccess || per_cu < 1) fprintf(stderr, "kernel_launch: occupancy query reports %d blocks per CU\n", per_cu);
        (void)hipGetLastError();
        grid = cus;
    }
    if (grid < 0) return;
    if (hipMemsetAsync((char*)d_ws + WS_CTL, 0, CTL_ZERO_BYTES, stream) != hipSuccess) return;
    Args a{};
    for (int i = 0; i < 26; ++i) a.in[i] = (const float*)d_in[i];
    a.out = (float*)d_out; a.ws = (unsigned char*)d_ws;
    hipLaunchKernelGGL(mk_fwd, dim3(grid), dim3(NWAVES * 64), LDS_BYTES, stream, a);
}
```

```cpp
#include <hip/hip_runtime.h>
#include <cstdio>
#include <cstdint>
namespace pg8 {
#define PG8_LAS __attribute__((address_space(3)))
typedef unsigned short bf16_t;
typedef short bf16x8 __attribute__((ext_vector_type(8)));
typedef float f32x4 __attribute__((ext_vector_type(4)));
typedef unsigned u32x4 __attribute__((ext_vector_type(4)));
constexpr int BM = 256, BK = 64, HALF = 128, HTB = HALF * BK * 2  , STAGE_BYTES = 8 * HTB, NXCD = 8, WGM = 8;

__host__ __device__ __forceinline__ int lds_byte(int r, int c) { const int st = (r >> 4) * 2 + (c >> 5), rr = r & 15, cc = c & 31, ob = rr * 64 + cc * 2; return st * 1024 + (ob ^ (((ob >> 9) & 1) << 5)); }
__host__ __device__ __forceinline__ void stage_rc(int b, int& R, int& C) { const int st = b / 1024, sb = b % 1024, swz = sb ^ (((sb >> 9) & 1) << 5); R = (st >> 1) * 16 + swz / 64; C = (st & 1) * 32 + (swz % 64) / 2; }
__host__ __device__ __forceinline__ int perm32(int rho) { const int n = rho >> 4, i = rho & 15; return 8 * (i >> 2) + 4 * n + (i & 3); }

struct Unit { int pm, pn, cn, po, e, j, koff, kt, split; };
struct Gemm { const bf16_t* A; const bf16_t* Bt; int K; };

struct StaticOrder {
    int nM, nN, nwg, G, c;
    __host__ __device__ void init(int M, int N, int G_, int c_) { nM = M / BM; nN = N / BM; nwg = nM * nN; G = G_; c = c_; }
    __host__ __device__ bool next(int i, Unit& u) const {
        const long L = (long)i * G + c; if (L >= nwg) return false;
        int wgid = (int)L; { const int q = nwg / NXCD, r = nwg % NXCD, xcd = wgid % NXCD, off = wgid / NXCD; wgid = (xcd < r ? xcd * (q + 1) : r * (q + 1) + (xcd - r) * q) + off; }
        const int nig = WGM * nN, gid = wgid / nig, fm = gid * WGM, gsz = (nM - fm) < WGM ? (nM - fm) : WGM;
        u.pm = fm + ((wgid % nig) % gsz); u.pn = (wgid % nig) / gsz; u.cn = u.pn; u.po = u.pm; u.e = 0; u.j = 0; u.koff = 0; u.kt = 0; u.split = 0; return true;
    }
};
struct GroupedOrder {
    int nN, p0, np, G, c, a_local;
    const PG8_LAS int* meta;
    int ksb, kst;
    __device__ __forceinline__ bool next(int i, Unit& u) const {
        int pl, n, koff = 0, kt = 0, split = 0;
        if (a_local && nN == 4 && G == 256) {
            {
            const int nfull = np < 128 ? np : 128, pl0 = ((c >> 3) >> 2) * 8 + (c & 7);
            const int nmine = (pl0 < nfull ? 1 : 0) + (64 + pl0 < nfull ? 1 : 0);
            if (i < nmine) { pl = i * 64 + pl0; n = (c >> 3) & 3; }
            else if (i == nmine) { if (c >= (np - nfull) * 28) return false; pl = nfull + c / 28; const int rem = c - (c / 28) * 28; n = rem / 7; koff = (rem - n * 7) * ksb; kt = kst; split = 1; }
            else return false;
            }
        } else { const int L = i * G + c; if (L >= np * nN) return false; pl = L / nN; n = L - pl * nN; }
        const int p = p0 + pl;
        int e = 0;
#pragma unroll
        for (int k = 1; k < 8; ++k) e += (p >= meta[8 + k]) ? 1 : 0;
        e = __builtin_amdgcn_readfirstlane(e);
        u.e = e; u.j = 0; u.pm = a_local ? pl : p; u.po = a_local ? p : pl; u.pn = e * nN + n; u.cn = n; u.koff = koff; u.kt = kt; u.split = split; return true;
    }
};

__device__ __forceinline__ unsigned cvt_pk_bf16(float lo, float hi) { unsigned r; asm volatile("v_cvt_pk_bf16_f32 %0, %1, %2" : "=v"(r) : "v"(lo), "v"(hi)); return r; }

#ifdef EPI_NT
#define PG8_ST16(p, v) __builtin_nontemporal_store((v), (u32x4*)(p))
#define PG8_ST16F(p, v) __builtin_nontemporal_store((v), (f32x4*)(p))
#else
#define PG8_ST16(p, v) (*(u32x4*)(p) = (v))
#define PG8_ST16F(p, v) (*(f32x4*)(p) = (v))
#endif
struct EpiBf16 {
    static constexpr bool PERM = true, AFTER_DRAIN = false;
    bf16_t* O; int ldc;
    __device__ __forceinline__ void operator()(const f32x4 (&acc)[2][2][4][2], const Unit& u, int wr, int wc, int fr, int fq) const {
        const int row0 = u.po * BM + wr * 64 + fr, col0 = u.cn * BM + wc * 32 + 8 * fq;
#pragma unroll
        for (int ai = 0; ai < 2; ++ai)
#pragma unroll
            for (int m = 0; m < 4; ++m) { bf16_t* rowp = O + (size_t)(row0 + ai * HALF + m * 16) * ldc + col0;
#pragma unroll
                for (int bj = 0; bj < 2; ++bj) { const f32x4 v0 = acc[ai][bj][m][0], v1 = acc[ai][bj][m][1];
                    u32x4 w; w.x = cvt_pk_bf16(v0[0], v0[1]); w.y = cvt_pk_bf16(v0[2], v0[3]); w.z = cvt_pk_bf16(v1[0], v1[1]); w.w = cvt_pk_bf16(v1[2], v1[3]);
                    PG8_ST16(rowp + bj * HALF, w); } }
    }
};
__device__ __forceinline__ float silu_mul(float g, float u) { return g * u * __builtin_amdgcn_rcpf(1.0f + __builtin_amdgcn_exp2f(-1.4426950408889634f * g)); }
struct EpiSwiGLU {
    static constexpr bool PERM = true, AFTER_DRAIN = false;
    bf16_t* O; int ldc;
    __device__ __forceinline__ void operator()(const f32x4 (&acc)[2][2][4][2], const Unit& u, int wr, int wc, int fr, int fq) const {
        const int row0 = u.po * BM + wr * 64 + fr, col0 = u.cn * HALF + wc * 32 + 8 * fq;
#pragma unroll
        for (int ai = 0; ai < 2; ++ai)
#pragma unroll
            for (int m = 0; m < 4; ++m) { bf16_t* rowp = O + (size_t)(row0 + ai * HALF + m * 16) * ldc + col0;
                const f32x4 g0 = acc[ai][0][m][0], g1 = acc[ai][0][m][1], u0 = acc[ai][1][m][0], u1 = acc[ai][1][m][1];
                u32x4 w; w.x = cvt_pk_bf16(silu_mul(g0[0], u0[0]), silu_mul(g0[1], u0[1])); w.y = cvt_pk_bf16(silu_mul(g0[2], u0[2]), silu_mul(g0[3], u0[3]));
                w.z = cvt_pk_bf16(silu_mul(g1[0], u1[0]), silu_mul(g1[1], u1[1])); w.w = cvt_pk_bf16(silu_mul(g1[2], u1[2]), silu_mul(g1[3], u1[3]));
                PG8_ST16(rowp, w); asm volatile("" ::: "memory"); }
    }
};
struct EpiBf16S {
    static constexpr bool PERM = true, AFTER_DRAIN = false;
    bf16_t* O; int ldc; const float* sa; const float* sb;
    __device__ __forceinline__ void operator()(const int __attribute__((ext_vector_type(4))) (&acc)[2][2][4][2], const Unit& u, int wr, int wc, int fr, int fq) const {
        const int row0 = u.po * BM + wr * 64 + fr, col0 = u.cn * BM + wc * 32 + 8 * fq;
        const float* sbp = sb + (size_t)u.pn * BM + wc * 32 + 8 * fq;
        f32x4 s4[2][2];
#pragma unroll
        for (int bj = 0; bj < 2; ++bj) { s4[bj][0] = *(const f32x4*)(sbp + bj * HALF); s4[bj][1] = *(const f32x4*)(sbp + bj * HALF + 4); }
        float av[2][4];
#pragma unroll
        for (int ai = 0; ai < 2; ++ai)
#pragma unroll
            for (int m = 0; m < 4; ++m) av[ai][m] = sa[(size_t)u.pm * BM + wr * 64 + fr + ai * HALF + m * 16];
#pragma unroll
        for (int ai = 0; ai < 2; ++ai)
#pragma unroll
            for (int m = 0; m < 4; ++m) { bf16_t* rowp = O + (size_t)(row0 + ai * HALF + m * 16) * ldc + col0;
                const float a = av[ai][m];
#pragma unroll
                for (int bj = 0; bj < 2; ++bj) { const f32x4 v0 = __builtin_convertvector(acc[ai][bj][m][0], f32x4) * s4[bj][0] * a, v1 = __builtin_convertvector(acc[ai][bj][m][1], f32x4) * s4[bj][1] * a;
                    u32x4 w; w.x = cvt_pk_bf16(v0[0], v0[1]); w.y = cvt_pk_bf16(v0[2], v0[3]); w.z = cvt_pk_bf16(v1[0], v1[1]); w.w = cvt_pk_bf16(v1[2], v1[3]);
                    PG8_ST16(rowp + bj * HALF, w); }
                asm volatile("" ::: "memory"); }
    }
};
__device__ __forceinline__ unsigned pk4_fp8(float a, float b, float c, float d) {
    a = __builtin_amdgcn_fmed3f(a, -448.f, 448.f); b = __builtin_amdgcn_fmed3f(b, -448.f, 448.f); c = __builtin_amdgcn_fmed3f(c, -448.f, 448.f); d = __builtin_amdgcn_fmed3f(d, -448.f, 448.f);
    int w = __builtin_amdgcn_cvt_pk_fp8_f32(a, b, 0, false); w = __builtin_amdgcn_cvt_pk_fp8_f32(c, d, w, true); return (unsigned)w; }
template <bool F8OUT> struct EpiSwiGLU8 {
    static constexpr bool PERM = true, AFTER_DRAIN = false;
    bf16_t* O; int ldc; const float* sa; const float* sb;
    __device__ __forceinline__ void operator()(const int __attribute__((ext_vector_type(4))) (&acc)[2][2][4][2], const Unit& u, int wr, int wc, int fr, int fq) const {
        const int row0 = u.po * BM + wr * 64 + fr, col0 = u.cn * HALF + wc * 32 + 8 * fq;
        const float* sbp = sb + (size_t)u.pn * BM + wc * 32 + 8 * fq;
        const f32x4 sg0 = *(const f32x4*)(sbp), sg1 = *(const f32x4*)(sbp + 4), su0 = *(const f32x4*)(sbp + HALF), su1 = *(const f32x4*)(sbp + HALF + 4);
        float av[2][4];
#pragma unroll
        for (int ai = 0; ai < 2; ++ai)
#pragma unroll
            for (int m = 0; m < 4; ++m) av[ai][m] = sa[(size_t)u.pm * BM + wr * 64 + fr + ai * HALF + m * 16];
#pragma unroll
        for (int ai = 0; ai < 2; ++ai)
#pragma unroll
            for (int m = 0; m < 4; ++m) {
                const float a = av[ai][m];
                const f32x4 g0 = __builtin_convertvector(acc[ai][0][m][0], f32x4) * sg0 * a, g1 = __builtin_convertvector(acc[ai][0][m][1], f32x4) * sg1 * a;
                const f32x4 u0 = __builtin_convertvector(acc[ai][1][m][0], f32x4) * su0 * a, u1 = __builtin_convertvector(acc[ai][1][m][1], f32x4) * su1 * a;
                if constexpr (F8OUT) { unsigned char* rowp = (unsigned char*)O + (size_t)(row0 + ai * HALF + m * 16) * ldc + col0;
                    typedef unsigned u32x2 __attribute__((ext_vector_type(2))); u32x2 w;
                    w.x = pk4_fp8(silu_mul(g0[0], u0[0]), silu_mul(g0[1], u0[1]), silu_mul(g0[2], u0[2]), silu_mul(g0[3], u0[3]));
                    w.y = pk4_fp8(silu_mul(g1[0], u1[0]), silu_mul(g1[1], u1[1]), silu_mul(g1[2], u1[2]), silu_mul(g1[3], u1[3]));
                    *(u32x2*)rowp = w;
                } else { bf16_t* rowp = O + (size_t)(row0 + ai * HALF + m * 16) * ldc + col0;
                    u32x4 w; w.x = cvt_pk_bf16(silu_mul(g0[0], u0[0]), silu_mul(g0[1], u0[1])); w.y = cvt_pk_bf16(silu_mul(g0[2], u0[2]), silu_mul(g0[3], u0[3]));
                    w.z = cvt_pk_bf16(silu_mul(g1[0], u1[0]), silu_mul(g1[1], u1[1])); w.w = cvt_pk_bf16(silu_mul(g1[2], u1[2]), silu_mul(g1[3], u1[3]));
                    PG8_ST16(rowp, w); }
                asm volatile("" ::: "memory"); }
    }
};
struct EpiYMoE {
    static constexpr bool PERM = true, AFTER_DRAIN = false;
    bf16_t* O; bf16_t* Ypart; int ldc; const float* sb; int ksb;
    __device__ __forceinline__ void operator()(const f32x4 (&acc)[2][2][4][2], const Unit& u, int wr, int wc, int fr, int fq) const {
        const int col0 = u.cn * BM + wc * 32 + 8 * fq;
        bf16_t* base = u.split ? Ypart + ((size_t)(u.koff / ksb) * 2048 + (size_t)(u.po - 128) * BM) * ldc : O + (size_t)u.po * BM * ldc;
        const int row0 = wr * 64 + fr;
        const float* sbp = sb + (size_t)u.pn * BM + wc * 32 + 8 * fq;
        f32x4 s4[2][2];
#pragma unroll
        for (int bj = 0; bj < 2; ++bj) { s4[bj][0] = *(const f32x4*)(sbp + bj * HALF); s4[bj][1] = *(const f32x4*)(sbp + bj * HALF + 4); }
#pragma unroll
        for (int ai = 0; ai < 2; ++ai)
#pragma unroll
            for (int m = 0; m < 4; ++m) { bf16_t* rowp = base + (size_t)(row0 + ai * HALF + m * 16) * ldc + col0;
#pragma unroll
                for (int bj = 0; bj < 2; ++bj) { const f32x4 v0 = acc[ai][bj][m][0] * s4[bj][0], v1 = acc[ai][bj][m][1] * s4[bj][1];
                    u32x4 w; w.x = cvt_pk_bf16(v0[0], v0[1]); w.y = cvt_pk_bf16(v0[2], v0[3]); w.z = cvt_pk_bf16(v1[0], v1[1]); w.w = cvt_pk_bf16(v1[2], v1[3]);
                    PG8_ST16(rowp + bj * HALF, w); }
                asm volatile("" ::: "memory"); }
    }
};
template <bool BASE_F32> struct EpiResBf {
    static constexpr bool PERM = true, AFTER_DRAIN = false;
    const void* base; bf16_t* out; int ldc; const float* sb;
    __device__ __forceinline__ void operator()(const f32x4 (&acc)[2][2][4][2], const Unit& u, int wr, int wc, int fr, int fq) const {
        const int row0 = u.po * BM + wr * 64 + fr, col0 = u.cn * BM + wc * 32 + 8 * fq;
        f32x4 s[2][2];
#pragma unroll
        for (int bj = 0; bj < 2; ++bj) { s[bj][0] = (f32x4){1.f, 1.f, 1.f, 1.f}; s[bj][1] = s[bj][0]; if (sb) { s[bj][0] = *(const f32x4*)(sb + col0 + bj * HALF); s[bj][1] = *(const f32x4*)(sb + col0 + bj * HALF + 4); } }
        if constexpr (BASE_F32) {
#pragma unroll
            for (int ai = 0; ai < 2; ++ai) {
                f32x4 b[4][2][2];
#pragma unroll
                for (int m = 0; m < 4; ++m)
#pragma unroll
                    for (int bj = 0; bj < 2; ++bj) { const float* bp = (const float*)base + (size_t)(row0 + ai * HALF + m * 16) * ldc + col0 + bj * HALF; b[m][bj][0] = *(const f32x4*)bp; b[m][bj][1] = *(const f32x4*)(bp + 4); }
#pragma unroll
                for (int m = 0; m < 4; ++m) { const size_t off = (size_t)(row0 + ai * HALF + m * 16) * ldc + col0;
#pragma unroll
                    for (int bj = 0; bj < 2; ++bj) { const f32x4 v0 = b[m][bj][0] + acc[ai][bj][m][0] * s[bj][0], v1 = b[m][bj][1] + acc[ai][bj][m][1] * s[bj][1];
                        u32x4 w; w.x = cvt_pk_bf16(v0[0], v0[1]); w.y = cvt_pk_bf16(v0[2], v0[3]); w.z = cvt_pk_bf16(v1[0], v1[1]); w.w = cvt_pk_bf16(v1[2], v1[3]);
                        PG8_ST16(out + off + bj * HALF, w); } }
                asm volatile("" ::: "memory"); }
        } else {
            u32x4 b[2][4][2];
#pragma unroll
            for (int ai = 0; ai < 2; ++ai)
#pragma unroll
                for (int m = 0; m < 4; ++m)
#pragma unroll
                    for (int bj = 0; bj < 2; ++bj) b[ai][m][bj] = *(const u32x4*)((const bf16_t*)base + (size_t)(row0 + ai * HALF + m * 16) * ldc + col0 + bj * HALF);
#pragma unroll
            for (int ai = 0; ai < 2; ++ai)
#pragma unroll
                for (int m = 0; m < 4; ++m) { const size_t off = (size_t)(row0 + ai * HALF + m * 16) * ldc + col0;
#pragma unroll
                    for (int bj = 0; bj < 2; ++bj) { const u32x4 w0 = b[ai][m][bj];
                        const f32x4 b0 = (f32x4){__uint_as_float(w0.x << 16), __uint_as_float(w0.x & 0xffff0000u), __uint_as_float(w0.y << 16), __uint_as_float(w0.y & 0xffff0000u)};
                        const f32x4 b1 = (f32x4){__uint_as_float(w0.z << 16), __uint_as_float(w0.z & 0xffff0000u), __uint_as_float(w0.w << 16), __uint_as_float(w0.w & 0xffff0000u)};
                        const f32x4 v0 = b0 + acc[ai][bj][m][0] * s[bj][0], v1 = b1 + acc[ai][bj][m][1] * s[bj][1];
                        u32x4 w; w.x = cvt_pk_bf16(v0[0], v0[1]); w.y = cvt_pk_bf16(v0[2], v0[3]); w.z = cvt_pk_bf16(v1[0], v1[1]); w.w = cvt_pk_bf16(v1[2], v1[3]);
                        PG8_ST16(out + off + bj * HALF, w); }
                    asm volatile("" ::: "memory"); }
        }
    }
};
struct EpiResF32 {
    static constexpr bool PERM = false, AFTER_DRAIN = false;
    const float* base; float* out; int ldc; const float* sb;
    __device__ __forceinline__ void operator()(const f32x4 (&acc)[2][2][4][2], const Unit& u, int wr, int wc, int fr, int fq) const {
        const int row0 = u.po * BM + wr * 64 + fr, col0 = u.cn * BM + wc * 32 + 4 * fq;
#pragma unroll
        for (int ai = 0; ai < 2; ++ai)
#pragma unroll
            for (int m = 0; m < 4; ++m) { const size_t off = (size_t)(row0 + ai * HALF + m * 16) * ldc + col0;
#pragma unroll
                for (int bj = 0; bj < 2; ++bj)
#pragma unroll
                    for (int n = 0; n < 2; ++n) { const f32x4 bs = *(const f32x4*)(base + off + bj * HALF + n * 16);
                        const f32x4 s = sb ? *(const f32x4*)(sb + col0 + bj * HALF + n * 16) : (f32x4){1.f, 1.f, 1.f, 1.f};
                        PG8_ST16F(out + off + bj * HALF + n * 16, bs + acc[ai][bj][m][n] * s); }
                asm volatile("" ::: "memory"); }
    }
};
typedef int i32x4 __attribute__((ext_vector_type(4)));
template <bool I8> struct AccT { typedef f32x4 type; };
template <> struct AccT<true> { typedef i32x4 type; };
template <bool I8> __device__ __forceinline__ typename AccT<I8>::type mma16(const bf16x8 b, const bf16x8 a, const typename AccT<I8>::type c);
template <> __device__ __forceinline__ f32x4 mma16<false>(const bf16x8 b, const bf16x8 a, const f32x4 c) { return __builtin_amdgcn_mfma_f32_16x16x32_bf16(b, a, c, 0, 0, 0); }
template <> __device__ __forceinline__ i32x4 mma16<true>(const bf16x8 b, const bf16x8 a, const i32x4 c) { return __builtin_amdgcn_mfma_i32_16x16x64_i8(__builtin_bit_cast(i32x4, b), __builtin_bit_cast(i32x4, a), c, 0, 0, 0); }
typedef int i32x8 __attribute__((ext_vector_type(8)));
__device__ __forceinline__ void mma_f8(f32x4& c, const i32x8 b, const i32x8 a, const int one) {
    asm volatile("v_mfma_scale_f32_16x16x128_f8f6f4 %0, %1, %2, %0, %3, %3 op_sel_hi:[0,0,0]" : "+v"(c) : "v"(b), "v"(a), "v"(one));
}
template <class Epi, class Sched, bool ALIGN_EPI, bool I8 = false, bool F8 = false>
__device__ __forceinline__ void gemm_phase(PG8_LAS unsigned char* lds, const Gemm g, const Sched& S, const Epi& E) {
    int tid_ = threadIdx.x; asm volatile("" : "+v"(tid_));
    const int tid = tid_, wid = __builtin_amdgcn_readfirstlane(tid >> 6), lane = tid & 63, wr = wid >> 2, wc = wid & 3, fr = lane & 15, fq = lane >> 4;
    const int K = g.K, nt = K / BK;
    unsigned voffA[2], voffB[2];
#pragma unroll
    for (int i = 0; i < 2; ++i) { int R, C; stage_rc(tid * 16 + i * 8192, R, C); const int Rb = Epi::PERM ? ((R & ~31) + perm32(R & 31)) : R;
        voffA[i] = (unsigned)(R * K + C) * 2u; voffB[i] = (unsigned)(Rb * K + C) * 2u; }
    const size_t kstep = (size_t)(BK * 2);
    const size_t hstep = (size_t)HALF * K * 2;
    const size_t tstep = 2 * hstep;
    const unsigned ldsw = (unsigned)wid * 1024u;
    const int aoff = lds_byte(wr * 64 + fr, fq * 8), boff = lds_byte(wc * 32 + fr, fq * 8);
#define PG8_SA(b, h) (((b) * 2 + (h)) * HTB)
#define PG8_SB(b, h) ((4 + (b) * 2 + (h)) * HTB)
#define PG8_STAGE(bufoff, gbase, voff) do { _Pragma("unroll") for (int _i = 0; _i < 2; ++_i) \
        __builtin_amdgcn_global_load_lds((const unsigned*)((const char*)(gbase) + (voff)[_i]), (PG8_LAS unsigned*)(lds + (bufoff) + ldsw + _i * 8192), 16, 0, 0); } while (0)
#define PG8_LDA(dst, b, h) do { if constexpr (F8) { _Pragma("unroll") for (int m = 0; m < 4; ++m) { const i32x4 lo_ = *(const PG8_LAS i32x4*)(lds + PG8_SA(b, h) + aoff + m * 2048), hi_ = *(const PG8_LAS i32x4*)(lds + PG8_SA(b, h) + aoff + m * 2048 + 1024); dst##8[m] = __builtin_shufflevector(lo_, hi_, 0, 1, 2, 3, 4, 5, 6, 7); } } \
        else { _Pragma("unroll") for (int m = 0; m < 4; ++m) _Pragma("unroll") for (int k = 0; k < 2; ++k) dst[m][k] = *(const PG8_LAS bf16x8*)(lds + PG8_SA(b, h) + aoff + m * 2048 + k * 1024); } } while (0)
#define PG8_LDB(dst, b, h) do { if constexpr (F8) { _Pragma("unroll") for (int n = 0; n < 2; ++n) { const i32x4 lo_ = *(const PG8_LAS i32x4*)(lds + PG8_SB(b, h) + boff + n * 2048), hi_ = *(const PG8_LAS i32x4*)(lds + PG8_SB(b, h) + boff + n * 2048 + 1024); dst##8[n] = __builtin_shufflevector(lo_, hi_, 0, 1, 2, 3, 4, 5, 6, 7); } } \
        else { _Pragma("unroll") for (int n = 0; n < 2; ++n) _Pragma("unroll") for (int k = 0; k < 2; ++k) dst[n][k] = *(const PG8_LAS bf16x8*)(lds + PG8_SB(b, h) + boff + n * 2048 + k * 1024); } } while (0)
#define PG8_MMA(ai, bj, At, Bt) do { __builtin_amdgcn_s_setprio(1); \
        if constexpr (F8) { _Pragma("unroll") for (int m = 0; m < 4; ++m) _Pragma("unroll") for (int n = 0; n < 2; ++n) mma_f8(acc[ai][bj][m][n], Bt##8[n], At##8[m], f8one); } \
        else { _Pragma("unroll") for (int m = 0; m < 4; ++m) _Pragma("unroll") for (int n = 0; n < 2; ++n) _Pragma("unroll") for (int k = 0; k < 2; ++k) \
            acc[ai][bj][m][n] = mma16<I8>(Bt[n][k], At[m][k], acc[ai][bj][m][n]); } __builtin_amdgcn_s_setprio(0); } while (0)
#define PG8_WAIT_V(n) asm volatile("s_waitcnt vmcnt(" #n ")" ::: "memory")
#define PG8_WAIT_L(n) asm volatile("s_waitcnt lgkmcnt(" #n ")" ::: "memory")
#define PG8_BAR __builtin_amdgcn_s_barrier()
#define PG8_SCHED __builtin_amdgcn_sched_barrier(0)
    Unit cur, nxt; int ui = 0;
    if (!S.next(0, cur)) return;
    typedef typename AccT<I8>::type acc_t;
    acc_t acc[2][2][4][2];
#pragma unroll
    for (int a = 0; a < 2; ++a)
#pragma unroll
        for (int b = 0; b < 2; ++b)
#pragma unroll
            for (int m = 0; m < 4; ++m)
#pragma unroll
                for (int n = 0; n < 2; ++n) acc[a][b][m][n] = (acc_t){0, 0, 0, 0};
    bf16x8 At[4][2], B0[2][2], B1[2][2];
    int f8one = 0x7f7f7f7f; asm volatile("" : "+v"(f8one));
    i32x8 At8[4], B08[2], B18[2];
    const char* cA = (const char*)g.A + (size_t)cur.pm * tstep + cur.koff; const char* cB = (const char*)g.Bt + (size_t)cur.pn * tstep + cur.koff;
    PG8_STAGE(PG8_SB(0, 0), cB, voffB); PG8_STAGE(PG8_SB(0, 1), cB + hstep, voffB); PG8_STAGE(PG8_SA(0, 0), cA, voffA); PG8_STAGE(PG8_SA(0, 1), cA + hstep, voffA);
    if (wr == 1) PG8_BAR;
    PG8_WAIT_V(2); PG8_BAR;
    PG8_STAGE(PG8_SB(1, 0), cB + kstep, voffB); PG8_STAGE(PG8_SA(1, 0), cA + kstep, voffA); PG8_STAGE(PG8_SB(1, 1), cB + hstep + kstep, voffB);
    PG8_WAIT_V(6); PG8_BAR;
    for (;;) {
        const bool has_next = S.next(ui + 1, nxt);
        const char* nA = has_next ? (const char*)g.A + (size_t)nxt.pm * tstep + nxt.koff : cA; const char* nB = has_next ? (const char*)g.Bt + (size_t)nxt.pn * tstep + nxt.koff : cB;
        const int ntc = cur.kt ? cur.kt : nt;
        for (int t = 0; t < ntc; t += 2) {
            const bool last = (t == ntc - 2);
            const char* a1 = cA + (size_t)(t + 1) * kstep;
            const char* a2 = last ? nA : cA + (size_t)(t + 2) * kstep; const char* b2 = last ? nB : cB + (size_t)(t + 2) * kstep;
            const char* a3 = a2 + kstep; const char* b3 = b2 + kstep;
            PG8_LDB(B0, 0, 0); PG8_LDB(B1, 0, 1); PG8_SCHED; PG8_LDA(At, 0, 0); PG8_STAGE(PG8_SA(1, 1), a1 + hstep, voffA);
            PG8_WAIT_V(8); PG8_WAIT_L(0); PG8_BAR; PG8_MMA(0, 0, At, B0); PG8_MMA(0, 1, At, B1); PG8_BAR; PG8_SCHED;
            PG8_LDA(At, 0, 1); PG8_STAGE(PG8_SB(0, 0), b2, voffB); PG8_STAGE(PG8_SB(0, 1), b2 + hstep, voffB); PG8_STAGE(PG8_SA(0, 0), a2, voffA);
            PG8_WAIT_V(8); PG8_WAIT_L(0); PG8_BAR; PG8_MMA(1, 0, At, B0); PG8_MMA(1, 1, At, B1); PG8_BAR; PG8_SCHED;
            PG8_LDB(B0, 1, 0); PG8_LDB(B1, 1, 1); PG8_SCHED; PG8_LDA(At, 1, 0); PG8_STAGE(PG8_SA(0, 1), a2 + hstep, voffA);
            PG8_WAIT_V(8); PG8_WAIT_L(0); PG8_BAR; PG8_MMA(0, 0, At, B0); PG8_MMA(0, 1, At, B1); PG8_BAR; PG8_SCHED;
            PG8_LDA(At, 1, 1); PG8_STAGE(PG8_SB(1, 0), b3, voffB); PG8_STAGE(PG8_SB(1, 1), b3 + hstep, voffB); PG8_STAGE(PG8_SA(1, 0), a3, voffA);
            PG8_WAIT_V(8); PG8_WAIT_L(0); PG8_BAR; PG8_MMA(1, 0, At, B0); PG8_MMA(1, 1, At, B1); PG8_BAR; PG8_SCHED;
        }
        if constexpr (ALIGN_EPI) { if (wr == 0) PG8_BAR; }
        if constexpr (F8) asm volatile("s_nop 15\n\ts_nop 15" ::: "memory");
        if constexpr (!Epi::AFTER_DRAIN) E(acc, cur, wr, wc, fr, fq);
#if defined(DBL_PHASE) && DBL_PHASE == 30
        if constexpr (I8) { asm volatile("" ::: "memory"); E(acc, cur, wr, wc, fr, fq); }
#endif
        if (!has_next) break;
#pragma unroll
        for (int a = 0; a < 2; ++a)
#pragma unroll
            for (int b = 0; b < 2; ++b)
#pragma unroll
                for (int m = 0; m < 4; ++m)
#pragma unroll
                    for (int n = 0; n < 2; ++n) acc[a][b][m][n] = (acc_t){0, 0, 0, 0};
        cur = nxt; cA = nA; cB = nB; ++ui;
        if constexpr (ALIGN_EPI) { if (wr == 1) PG8_BAR; }
    }
    PG8_WAIT_V(0);
    if constexpr (!ALIGN_EPI) { if (wr == 0) PG8_BAR; }
    PG8_BAR;
    if constexpr (Epi::AFTER_DRAIN) E.fused(acc, cur, wr, wc, fr, fq, lds, wid, lane);
#undef PG8_SA
#undef PG8_SB
#undef PG8_STAGE
#undef PG8_LDA
#undef PG8_LDB
#undef PG8_MMA
#undef PG8_WAIT_V
#undef PG8_WAIT_L
#undef PG8_BAR
#undef PG8_SCHED
}
}
constexpr int NWAVES = 8;
constexpr int SEQ = 8192, M = 16384, D = 1024, NIN = 3080, NPROJ = 3072;
constexpr int FD = 2752, FDP = 2816, FE = 3584, NEXP = 8;
constexpr float EPS = 1e-6f, LOG2E = 1.4426950408889634f;
constexpr int PC_Q = 0, PC_K = 256, PC_V = 512, PC_Z = 768, PC_XBC = 1280, PC_RQ = 2048, PC_RK = 2304, PC_RV = 2560, PC_RG = 2816;
constexpr size_t MiB = 1u << 20;
constexpr size_t WS_CTL = 0, CTL_ZERO_BYTES = 1 * MiB;
constexpr size_t WS_WIN = 2 * MiB;
constexpr size_t WS_WOUT = 14 * MiB;
constexpr size_t WS_WGU = 18 * MiB;
constexpr size_t WS_WD = 29 * MiB;
constexpr size_t WS_EGU = 35 * MiB;
constexpr size_t WS_ED = 147 * MiB;
constexpr size_t WS_XN = 203 * MiB;
constexpr size_t WS_MIX = 235 * MiB;
constexpr size_t WS_BIG = 303 * MiB;
constexpr size_t WS_SMALL = 430 * MiB;
constexpr size_t WS_DT = WS_SMALL, WS_TI = WS_SMALL + 512 * 1024, WS_TG = WS_SMALL + 768 * 1024, WS_LIST = WS_SMALL + 1024 * 1024;
constexpr size_t WS_XCH = 434 * MiB;
constexpr size_t WS_END = 438 * MiB;
constexpr size_t WS_SST = 203 * MiB;
constexpr size_t WS_RST = 219 * MiB;
constexpr size_t WS_QR = 227 * MiB;
constexpr size_t WS_YD = 267 * MiB;
constexpr size_t WS_OI = 283 * MiB;
constexpr size_t WS_XC = 399 * MiB;
constexpr size_t WS_SBD = WS_SMALL + 2176 * 1024, WS_SBE = WS_SMALL + 2240 * 1024;
constexpr size_t WS_SBI = WS_SMALL + 2900 * 1024;
constexpr size_t WS_SBWD = WS_SMALL + 2930 * 1024, WS_SBED = WS_SMALL + 2940 * 1024;
constexpr size_t WS_XR = 91 * MiB;
constexpr size_t WS_XNS = WS_SMALL + 2560 * 1024, WS_XGS = WS_SMALL + 2688 * 1024;
constexpr size_t WS_XG8 = 269 * MiB;
constexpr size_t WS_DTOT = WS_SMALL + 1536 * 1024, WS_EOFF = WS_SMALL + 1600 * 1024;
constexpr int SLAB0_PANELS = 64, SLAB1_MAX = 72;
constexpr int CW_BAR = 4096;
constexpr int CW_SEAM = 16384, SEAM_BANK = 64 * 64;
constexpr int CW_CNT = 8192;
constexpr int RING_BYTES = 131072;
constexpr int LDSCTL_OFF = RING_BYTES, MISC_OFF = LDSCTL_OFF + 320;
constexpr int LDS_BYTES = 147456;
#define GAS __attribute__((address_space(1)))
#define LAS __attribute__((address_space(3)))
typedef unsigned short bf16;
typedef unsigned v4u __attribute__((ext_vector_type(4)));
typedef float f32x4 __attribute__((ext_vector_type(4)));
typedef short bf16x8 __attribute__((ext_vector_type(8)));
typedef GAS unsigned gu32;
typedef GAS unsigned long long gu64;
#define RLX_AGENT __ATOMIC_RELAXED, __HIP_MEMORY_SCOPE_AGENT
#define LDS_WAIT() asm volatile("s_waitcnt lgkmcnt(0)" ::: "memory")
#define VM_WAIT() asm volatile("s_waitcnt vmcnt(0)" ::: "memory")
__device__ __forceinline__ unsigned long long rt() { return __builtin_amdgcn_s_memrealtime(); }
__device__ __forceinline__ unsigned f2bf(float f) { unsigned u = __builtin_bit_cast(unsigned, f); return (u + 0x7fffu + ((u >> 16) & 1u)) >> 16; }
typedef float f32x2_t __attribute__((ext_vector_type(2))); typedef __bf16 bf16x2_t __attribute__((ext_vector_type(2)));
__device__ __forceinline__ unsigned pk2(float lo, float hi) { f32x2_t v = {lo, hi}; bf16x2_t b = __builtin_convertvector(v, bf16x2_t); return __builtin_bit_cast(unsigned, b); }

#define XB_TMO      128
#define XB_XCNT(j)  (256  + 64 * (j))
#define XB_XSUB(j)  (1280 + 64 * (j))
#define XB_XGEN(j)  (2304 + 64 * (j))
#define XB_TOP      3328
#define XB_TOPGEN   3392
#define XCD_BAR_WORDS 3456
#define XB_SPIN_CAP (1u << 18)

__device__ __forceinline__ unsigned xb_ld(unsigned* p)              { return __hip_atomic_load(p, __ATOMIC_RELAXED, __HIP_MEMORY_SCOPE_AGENT); }
__device__ __forceinline__ unsigned xb_add(unsigned* p, unsigned v) { return __hip_atomic_fetch_add(p, v, __ATOMIC_RELAXED, __HIP_MEMORY_SCOPE_AGENT); }
__device__ __forceinline__ unsigned xb_xcc_id() { return (unsigned)__builtin_amdgcn_s_getreg((3 << 11) | 20) & 0xFu; }
#define XB_SPIN(cond, bar) do { unsigned _sp = 0; while (cond) { __builtin_amdgcn_s_sleep(1); \
    if ((++_sp & 255u) == 0u) { if (xb_ld(&(bar)[XB_TMO])) break; if (_sp > XB_SPIN_CAP) { atomicAdd(&(bar)[XB_TMO], 1u); break; } } } } while (0)

struct XcdBarrier {
    unsigned* bar; unsigned x;
    volatile LAS unsigned* st;
};

__device__ __forceinline__ XcdBarrier xcd_barrier_post(unsigned* bar, volatile LAS unsigned* st) {
    XcdBarrier b; b.bar = bar; b.x = xb_xcc_id(); b.st = st;
    if (threadIdx.x == 0) (void)xb_add(&bar[XB_XCNT(b.x)], 1u);
    return b;
}
__device__ __forceinline__ void xcd_barrier_complete(unsigned* bar, unsigned x, unsigned& nloc, unsigned& nx) {
    const unsigned G = gridDim.x * gridDim.y * gridDim.z;
    unsigned sum, cnt, mine, sp = 0u;
    for (;;) {
        sum = 0u; cnt = 0u; mine = 0u;
#pragma unroll
        for (unsigned j = 0; j < 16; ++j) { const unsigned c = xb_ld(&bar[XB_XCNT(j)]); sum += c; cnt += (c > 0u) ? 1u : 0u; mine = (j == x) ? c : mine; }
        if (sum == G) break;
        __builtin_amdgcn_s_sleep(1);
        if ((++sp & 255u) == 0u) { if (xb_ld(&bar[XB_TMO])) break; if (sp > XB_SPIN_CAP) { atomicAdd(&bar[XB_TMO], 1u); break; } }
    }
    nloc = mine > 0u ? mine : 1u; nx = cnt > 0u ? cnt : 1u;
}

__device__ __forceinline__ void xcd_barrier(const XcdBarrier& b) {
    asm volatile("s_waitcnt vmcnt(0)" ::: "memory");
    __syncthreads();
    if (threadIdx.x == 0) {
        unsigned* bar = b.bar;
        __builtin_amdgcn_s_waitcnt(0);
        unsigned nloc = b.st[0], nx = b.st[1];
        if (nloc == 0u) { xcd_barrier_complete(bar, b.x, nloc, nx); b.st[0] = nloc; b.st[1] = nx; }
        const unsigned old = xb_add(&bar[XB_XSUB(b.x)], 1u);
        const unsigned gen = old / nloc;
        if (old + 1u == (gen + 1u) * nloc) {
            __builtin_amdgcn_fence(__ATOMIC_RELEASE, "agent");
            asm volatile("s_waitcnt vmcnt(0)" ::: "memory");
            const unsigned og = xb_add(&bar[XB_TOP], 1u);
            const unsigned tg = og / nx;
            if (og + 1u == (tg + 1u) * nx) xb_add(&bar[XB_TOPGEN], 1u);
            else XB_SPIN(xb_ld(&bar[XB_TOPGEN]) == tg, bar);
            __builtin_amdgcn_fence(__ATOMIC_ACQUIRE, "agent");
            xb_add(&bar[XB_XGEN(b.x)], 1u);
            asm volatile("s_waitcnt vmcnt(0)" ::: "memory");
        } else {
            XB_SPIN(xb_ld(&bar[XB_XGEN(b.x)]) == gen, bar);
            __builtin_amdgcn_fence(__ATOMIC_ACQUIRE, "agent");
            asm volatile("s_waitcnt vmcnt(0)" ::: "memory");
        }
    }
    __syncthreads();
}

struct Args { const float* in[26]; float* out; unsigned char* ws; };
struct Frame {
    LAS unsigned char* lds;
    volatile LAS unsigned* MISC;
    LAS int* META;
    gu32* ctl;
    unsigned char* ws; float* out;
    int tid, lane, wave, G, bx;
};
__device__ __forceinline__ Frame refresh(const Frame& f) { Frame r = f; int t = threadIdx.x; asm volatile("" : "+v"(t)); r.tid = t; r.lane = t & 63; r.wave = __builtin_amdgcn_readfirstlane(t >> 6); return r; }
__device__ __forceinline__ float bf2f(unsigned short u) { return __uint_as_float((unsigned)u << 16); }
__device__ __forceinline__ float bflo(unsigned w) { return __uint_as_float(w << 16); }
__device__ __forceinline__ float bfhi(unsigned w) { return __uint_as_float(w & 0xffff0000u); }
__device__ __forceinline__ float wave_sum(float v) {
#pragma unroll
    for (int o = 1; o < 64; o <<= 1) v += __shfl_xor(v, o);
    return v;
}
__device__ __forceinline__ float silu_f(float v) { return v * __builtin_amdgcn_rcpf(1.0f + __builtin_amdgcn_exp2f(-LOG2E * v)); }

__device__ __forceinline__ void tr_item(const float* W, int ldw, int k0, int nsrc0, bool valid, bf16* WT, int ldk, int drow0, float scale, LAS float* scr, int lane) {
    (void)scr;
    const int c4 = lane & 7, r8 = lane >> 3;
    f32x4 v[8];
    if (valid) { const float* wp = W + (size_t)(k0 + 8 * r8) * ldw + nsrc0 + 4 * c4;
#pragma unroll
        for (int i = 0; i < 8; ++i) v[i] = *(const f32x4*)(wp + (size_t)i * ldw) * scale;
    } else {
#pragma unroll
        for (int i = 0; i < 8; ++i) v[i] = (f32x4){0.f, 0.f, 0.f, 0.f};
    }
#pragma unroll
    for (int j = 0; j < 4; ++j) { v4u o; o.x = pk2(v[0][j], v[1][j]); o.y = pk2(v[2][j], v[3][j]); o.z = pk2(v[4][j], v[5][j]); o.w = pk2(v[6][j], v[7][j]);
        *(GAS v4u*)(WT + (size_t)(drow0 + 4 * c4 + j) * ldk + k0 + 8 * r8) = o; }
}
__device__ __forceinline__ void q_item(const float* W, int ldw, int nsrc0, bool valid, signed char* WT8, int drow0, float* sb, float post, LAS unsigned char* lds, int wave, int lane) {
    LAS float* cm = (LAS float*)lds;
    const int c4 = lane & 7, rs = lane >> 3;
    f32x4 v[16]; f32x4 mx = (f32x4){0.f, 0.f, 0.f, 0.f};
    if (valid) { const float* wp = W + (size_t)(wave * 128 + 16 * rs) * ldw + nsrc0 + 4 * c4;
#pragma unroll
        for (int i = 0; i < 16; ++i) v[i] = *(const f32x4*)(wp + (size_t)i * ldw);
#pragma unroll
        for (int i = 0; i < 16; ++i) { mx.x = fmaxf(mx.x, fabsf(v[i].x)); mx.y = fmaxf(mx.y, fabsf(v[i].y)); mx.z = fmaxf(mx.z, fabsf(v[i].z)); mx.w = fmaxf(mx.w, fabsf(v[i].w)); }
    } else {
#pragma unroll
        for (int i = 0; i < 16; ++i) v[i] = (f32x4){0.f, 0.f, 0.f, 0.f};
    }
#pragma unroll
    for (int o = 8; o < 64; o <<= 1) { mx.x = fmaxf(mx.x, __shfl_xor(mx.x, o)); mx.y = fmaxf(mx.y, __shfl_xor(mx.y, o)); mx.z = fmaxf(mx.z, __shfl_xor(mx.z, o)); mx.w = fmaxf(mx.w, __shfl_xor(mx.w, o)); }
    __syncthreads();
    if (rs == 0) *(LAS f32x4*)(cm + wave * 32 + 4 * c4) = mx;
    __syncthreads();
    f32x4 bm = *(const LAS f32x4*)(cm + 4 * c4);
#pragma unroll
    for (int w = 1; w < 8; ++w) { const f32x4 t = *(const LAS f32x4*)(cm + w * 32 + 4 * c4); bm.x = fmaxf(bm.x, t.x); bm.y = fmaxf(bm.y, t.y); bm.z = fmaxf(bm.z, t.z); bm.w = fmaxf(bm.w, t.w); }
    f32x4 sc; sc.x = bm.x > 0.f ? 127.0f / bm.x : 0.f; sc.y = bm.y > 0.f ? 127.0f / bm.y : 0.f; sc.z = bm.z > 0.f ? 127.0f / bm.z : 0.f; sc.w = bm.w > 0.f ? 127.0f / bm.w : 0.f;
#pragma unroll
    for (int j = 0; j < 4; ++j) { v4u o;
#pragma unroll
        for (int g = 0; g < 4; ++g) { const int q0 = (int)rintf(v[4 * g][j] * sc[j]), q1 = (int)rintf(v[4 * g + 1][j] * sc[j]), q2 = (int)rintf(v[4 * g + 2][j] * sc[j]), q3 = (int)rintf(v[4 * g + 3][j] * sc[j]);
            o[g] = (unsigned)(q0 & 255) | ((unsigned)(q1 & 255) << 8) | ((unsigned)(q2 & 255) << 16) | ((unsigned)(q3 & 255) << 24); }
        *(GAS v4u*)(WT8 + (size_t)(drow0 + 4 * c4 + j) * 1024 + wave * 128 + 16 * rs) = o; }
    if (wave == 0 && rs == 0) *(f32x4*)(sb + drow0 + 4 * c4) = bm * ((1.0f / 127.0f) * post);
}
__device__ __forceinline__ void f8_item(const float* W, int Kvalid, int Kdst, int nsrc0, unsigned char* WT8, int drow0, float* sb, LAS unsigned char* lds, int wave, int lane) {
    LAS float* cm = (LAS float*)lds;
    const int c4 = lane & 7, rs = lane >> 3, slot = wave * 8 + rs;
    const float* wp = W + nsrc0 + 4 * c4;
    f32x4 mx = (f32x4){0.f, 0.f, 0.f, 0.f};
#pragma unroll 16
    for (int k = slot; k < Kvalid; k += 64) { const f32x4 v = *(const f32x4*)(wp + (size_t)k * 1024); mx.x = fmaxf(mx.x, fabsf(v.x)); mx.y = fmaxf(mx.y, fabsf(v.y)); mx.z = fmaxf(mx.z, fabsf(v.z)); mx.w = fmaxf(mx.w, fabsf(v.w)); }
#pragma unroll
    for (int o = 8; o < 64; o <<= 1) { mx.x = fmaxf(mx.x, __shfl_xor(mx.x, o)); mx.y = fmaxf(mx.y, __shfl_xor(mx.y, o)); mx.z = fmaxf(mx.z, __shfl_xor(mx.z, o)); mx.w = fmaxf(mx.w, __shfl_xor(mx.w, o)); }
    __syncthreads();
    if (rs == 0) *(LAS f32x4*)(cm + wave * 32 + 4 * c4) = mx;
    __syncthreads();
    f32x4 bm = *(const LAS f32x4*)(cm + 4 * c4);
#pragma unroll
    for (int w = 1; w < 8; ++w) { const f32x4 t = *(const LAS f32x4*)(cm + w * 32 + 4 * c4); bm.x = fmaxf(bm.x, t.x); bm.y = fmaxf(bm.y, t.y); bm.z = fmaxf(bm.z, t.z); bm.w = fmaxf(bm.w, t.w); }
    f32x4 sc; sc.x = bm.x > 0.f ? 384.0f / bm.x : 0.f; sc.y = bm.y > 0.f ? 384.0f / bm.y : 0.f; sc.z = bm.z > 0.f ? 384.0f / bm.z : 0.f; sc.w = bm.w > 0.f ? 384.0f / bm.w : 0.f;
    for (int q = slot; q * 16 < Kdst; q += 64) {
        f32x4 v[16];
#pragma unroll
        for (int i = 0; i < 16; ++i) { const int k = q * 16 + i; v[i] = k < Kvalid ? *(const f32x4*)(wp + (size_t)k * 1024) : (f32x4){0.f, 0.f, 0.f, 0.f}; }
#pragma unroll
        for (int j = 0; j < 4; ++j) { v4u o;
#pragma unroll
            for (int g = 0; g < 4; ++g) o[g] = pg8::pk4_fp8(v[4 * g][j] * sc[j], v[4 * g + 1][j] * sc[j], v[4 * g + 2][j] * sc[j], v[4 * g + 3][j] * sc[j]);
            *(GAS v4u*)(WT8 + (size_t)(drow0 + 4 * c4 + j) * Kdst + q * 16) = o; }
    }
    if (wave == 0 && rs == 0) *(f32x4*)(sb + drow0 + 4 * c4) = bm * (1.0f / 384.0f);
}
constexpr float C2Q = 0.17677669529663687f * LOG2E;
__device__ __forceinline__ void p0_weights(Frame& F_, const Args& A) {
    Frame F = refresh(F_);
    for (int it0 = F.bx; it0 < 192 + 176 + 32; it0 += F.G) { int it = it0;
        if (it >= 192 + 176) { const int nb = it - 368; f8_item(A.in[21], FD, FDP, nb * 32, (unsigned char*)(F.ws + WS_WD), nb * 32, (float*)(F.ws + WS_SBWD), (LAS unsigned char*)F.lds, F.wave, F.lane); continue; }
        if (it < 192) { const int l = it / 96, nb = it - l * 96; const float post = nb < 8 ? C2Q : ((nb >= 72 && nb < 80) ? 0.125f : 1.0f);
            q_item(A.in[1] + (size_t)l * D * NIN, NIN, nb < 64 ? nb * 32 : nb * 32 + 8, true, (signed char*)(F.ws + WS_WIN) + (size_t)l * NPROJ * D, nb * 32, (float*)(F.ws + WS_SBI) + l * NPROJ, post, (LAS unsigned char*)F.lds, F.wave, F.lane); continue; }
        it -= 192;
        { const int nb = it, t = nb >> 3, sub = nb & 7, fcol = t * 128 + (sub & 3) * 32;
            q_item(sub < 4 ? A.in[19] : A.in[20], FD, fcol, fcol < FD, (signed char*)(F.ws + WS_WGU), nb * 32, (float*)(F.ws + WS_SBD), 1.0f, (LAS unsigned char*)F.lds, F.wave, F.lane); }
    }
    __syncthreads();
    LAS float* scr = (LAS float*)(F.lds + F.wave * 16384);
    const int gw = F.bx * NWAVES + F.wave, NGW = F.G * NWAVES;
    constexpr int I_OUT = 32 * 16;
    for (int it = gw; it < 2 * I_OUT; it += NGW) { const int l = it / I_OUT, r = it - l * I_OUT, kb = r / 32, nb = r % 32;
        tr_item(A.in[2] + (size_t)l * D * D, D, kb * 64, nb * 32, true, ((bf16*)(F.ws + WS_WOUT)) + (size_t)l * D * D, D, nb * 32, 1.0f, scr, F.lane); }
}
__device__ __forceinline__ void expert_weights(Frame& F_, const Args& A) {
    Frame F = refresh(F_);
    for (int r = F.bx; r < NEXP * 224; r += F.G) { const int e = r / 224, nb = r - e * 224, t = nb >> 3, sub = nb & 7, fcol = t * 128 + (sub & 3) * 32;
        q_item((sub < 4 ? A.in[23] : A.in[24]) + (size_t)e * D * FE, FE, fcol, true, (signed char*)(F.ws + WS_EGU) + (size_t)e * 2 * FE * D, nb * 32, (float*)(F.ws + WS_SBE) + e * 2 * FE, 1.0f, (LAS unsigned char*)F.lds, F.wave, F.lane); }
    for (int r = F.bx; r < NEXP * 32; r += F.G) { const int e = r >> 5, nb = r & 31;
        f8_item(A.in[25] + (size_t)e * FE * D, FE, FE, nb * 32, (unsigned char*)(F.ws + WS_ED) + (size_t)e * D * FE, nb * 32, (float*)(F.ws + WS_SBED) + e * D, (LAS unsigned char*)F.lds, F.wave, F.lane); }
    __syncthreads();
}

template <int MODE, bool OUT8 = false, bool SRC16 = false>
__device__ __forceinline__ void norm_phase(Frame& F_, const float* src, const float* gain, const float* wx, int ldw) {
    Frame F = refresh(F_);
    LAS float* Wl = (LAS float*)F.lds;
    if (MODE != 0) {
        for (int idx = F.tid; idx < 8 * D; idx += NWAVES * 64) { const int k = idx >> 3, j = idx & 7; Wl[j * D + k] = wx[(size_t)k * ldw + j]; }
        __syncthreads();
    }
    const int hl = F.lane & 31, hw = F.lane >> 5, gw = F.bx * NWAVES + F.wave, NGW = F.G * NWAVES;
    f32x4 g8[4][2];
#pragma unroll
    for (int j = 0; j < 4; ++j) { g8[j][0] = *(const f32x4*)(gain + 8 * (hl + 32 * j)); g8[j][1] = *(const f32x4*)(gain + 8 * (hl + 32 * j) + 4); }
#define NP_HSUM(x) do { _Pragma("unroll") for (int o_ = 1; o_ < 32; o_ <<= 1) x += __shfl_xor(x, o_); } while (0)
    for (int m = 2 * gw + hw; m < M; m += 2 * NGW) {
        f32x4 v[4][2]; float s = 0.f;
        if constexpr (SRC16) { const v4u* xr = (const v4u*)((const bf16*)src + (size_t)m * D) + hl;
#pragma unroll
            for (int j = 0; j < 4; ++j) { const v4u w = xr[32 * j]; v[j][0] = (f32x4){bflo(w.x), bfhi(w.x), bflo(w.y), bfhi(w.y)}; v[j][1] = (f32x4){bflo(w.z), bfhi(w.z), bflo(w.w), bfhi(w.w)}; }
        } else { const f32x4* xr = (const f32x4*)(src + (size_t)m * D) + 2 * hl;
#pragma unroll
            for (int j = 0; j < 4; ++j) { v[j][0] = xr[64 * j]; v[j][1] = xr[64 * j + 1]; } }
#pragma unroll
        for (int j = 0; j < 4; ++j)
#pragma unroll
            for (int t = 0; t < 2; ++t) s += (v[j][t].x * v[j][t].x + v[j][t].y * v[j][t].y) + (v[j][t].z * v[j][t].z + v[j][t].w * v[j][t].w);
        NP_HSUM(s);
        const float rstd = __builtin_amdgcn_rsqf(s * (1.f / D) + EPS);
        float amax = 0.f;
#pragma unroll
        for (int j = 0; j < 4; ++j)
#pragma unroll
            for (int t = 0; t < 2; ++t) { v[j][t] = v[j][t] * rstd * g8[j][t]; amax = fmaxf(amax, fmaxf(fmaxf(fabsf(v[j][t].x), fabsf(v[j][t].y)), fmaxf(fabsf(v[j][t].z), fabsf(v[j][t].w)))); }
        if (!OUT8) {
            v4u* o16 = (v4u*)(((bf16*)(F.ws + WS_XN)) + (size_t)m * D) + hl;
#pragma unroll
            for (int j = 0; j < 4; ++j) { v4u o; o.x = pk2(v[j][0].x, v[j][0].y); o.y = pk2(v[j][0].z, v[j][0].w); o.z = pk2(v[j][1].x, v[j][1].y); o.w = pk2(v[j][1].z, v[j][1].w); o16[32 * j] = o; }
        } else {
#pragma unroll
            for (int o = 1; o < 32; o <<= 1) amax = fmaxf(amax, __shfl_xor(amax, o));
            const float qs = amax > 0.f ? 127.0f / amax : 0.f;
            uint2* o8 = (uint2*)(F.ws + WS_XN + (size_t)m * D) + hl;
#pragma unroll
            for (int j = 0; j < 4; ++j) { uint2 o;
                { const int q0 = (int)rintf(v[j][0].x * qs), q1 = (int)rintf(v[j][0].y * qs), q2 = (int)rintf(v[j][0].z * qs), q3 = (int)rintf(v[j][0].w * qs); o.x = (unsigned)(q0 & 255) | ((unsigned)(q1 & 255) << 8) | ((unsigned)(q2 & 255) << 16) | ((unsigned)(q3 & 255) << 24); }
                { const int q0 = (int)rintf(v[j][1].x * qs), q1 = (int)rintf(v[j][1].y * qs), q2 = (int)rintf(v[j][1].z * qs), q3 = (int)rintf(v[j][1].w * qs); o.y = (unsigned)(q0 & 255) | ((unsigned)(q1 & 255) << 8) | ((unsigned)(q2 & 255) << 16) | ((unsigned)(q3 & 255) << 24); }
                o8[32 * j] = o; }
            if (hl == 0) ((float*)(F.ws + WS_XNS))[m] = amax * (1.0f / 127.0f);
        }
        if (MODE != 0) {
            float ex[8];
#pragma unroll
            for (int e = 0; e < 8; ++e) { float a = 0.f;
#pragma unroll
                for (int j = 0; j < 4; ++j) { const f32x4 w0 = *(const LAS f32x4*)(Wl + e * D + 8 * (hl + 32 * j)), w1 = *(const LAS f32x4*)(Wl + e * D + 8 * (hl + 32 * j) + 4);
                    a += (v[j][0].x * w0.x + v[j][0].y * w0.y) + (v[j][0].z * w0.z + v[j][0].w * w0.w) + (v[j][1].x * w1.x + v[j][1].y * w1.y) + (v[j][1].z * w1.z + v[j][1].w * w1.w); }
                NP_HSUM(a); ex[e] = a; asm volatile("" ::: "memory"); }
            if (MODE == 1) {
                float val = ex[0];
#pragma unroll
                for (int e = 1; e < 8; ++e) val = (hl == e) ? ex[e] : val;
                if (hl < 8) ((float*)(F.ws + WS_DT))[(size_t)m * 8 + hl] = val;
            } else {
                int e0 = 0; float v0 = ex[0];
#pragma unroll
                for (int e = 1; e < 8; ++e) if (ex[e] > v0) { v0 = ex[e]; e0 = e; }
                int e1 = -1; float v1 = -3.0e38f;
#pragma unroll
                for (int e = 0; e < 8; ++e) if (e != e0 && ex[e] > v1) { v1 = ex[e]; e1 = e; }
                if (hl == 0) {
                    const float g0 = 1.0f / (1.0f + __expf(v1 - v0)), g1 = 1.0f - g0;
                    const int pos0 = (int)atomicAdd((unsigned*)(F.ctl + CW_CNT + 64 * e0), 1u), pos1 = (int)atomicAdd((unsigned*)(F.ctl + CW_CNT + 64 * e1), 1u);
                    ((int*)(F.ws + WS_LIST))[e0 * 16384 + pos0] = m; ((int*)(F.ws + WS_LIST))[e1 * 16384 + pos1] = m;
                    ((int*)(F.ws + WS_TI))[m * 4 + 0] = e0 | (e1 << 8); ((int*)(F.ws + WS_TI))[m * 4 + 1] = pos0; ((int*)(F.ws + WS_TI))[m * 4 + 2] = pos1; ((int*)(F.ws + WS_TI))[m * 4 + 3] = 0;
                    ((float*)(F.ws + WS_TG))[m * 2 + 0] = g0; ((float*)(F.ws + WS_TG))[m * 2 + 1] = g1;
                }
            }
        }
    }
#undef NP_HSUM
    if (MODE != 0) __syncthreads();
}
__device__ __forceinline__ void combine_phase(Frame& F_, const Args& A) {
    Frame F = refresh(F_);
    const int hl = F.lane & 31, hw = F.lane >> 5, gw = F.bx * NWAVES + F.wave, NGW = F.G * NWAVES;
    f32x4 g8[4][2];
#pragma unroll
    for (int j = 0; j < 4; ++j) { g8[j][0] = *(const f32x4*)(A.in[5] + 8 * (hl + 32 * j)); g8[j][1] = *(const f32x4*)(A.in[5] + 8 * (hl + 32 * j) + 4); }
    for (int m = 2 * gw + hw; m < M; m += 2 * NGW) {
        const int ti = ((int*)(F.ws + WS_TI))[m * 4], e0 = ti & 255, e1 = ti >> 8;
        const size_t r0 = (size_t)F.META[8 + e0] * 256 + ((int*)(F.ws + WS_TI))[m * 4 + 1], r1 = (size_t)F.META[8 + e1] * 256 + ((int*)(F.ws + WS_TI))[m * 4 + 2];
        const float g0 = ((float*)(F.ws + WS_TG))[m * 2], g1 = ((float*)(F.ws + WS_TG))[m * 2 + 1];
        const v4u* xb = (const v4u*)((const bf16*)(F.ws + WS_XR) + (size_t)m * D) + hl;
        const v4u* y0 = (const v4u*)(((const bf16*)(F.ws + WS_MIX)) + r0 * D) + hl; const v4u* y1 = (const v4u*)(((const bf16*)(F.ws + WS_MIX)) + r1 * D) + hl;
        const v4u* z0 = (const v4u*)(((const bf16*)(F.ws + WS_XN)) + (r0 >= 32768 ? r0 - 32768 : 0) * D) + hl; const v4u* z1 = (const v4u*)(((const bf16*)(F.ws + WS_XN)) + (r1 >= 32768 ? r1 - 32768 : 0) * D) + hl;
        f32x4 v[4][2]; float s = 0.f;
#define CB_LO(w_) ((f32x4){bflo((w_).x), bfhi((w_).x), bflo((w_).y), bfhi((w_).y)})
#define CB_HI(w_) ((f32x4){bflo((w_).z), bfhi((w_).z), bflo((w_).w), bfhi((w_).w)})
#pragma unroll
        for (int j = 0; j < 4; ++j) { f32x4 ya0, ya1, yb0, yb1;
            if (r0 >= 32768) { ya0 = (f32x4){0.f, 0.f, 0.f, 0.f}; ya1 = ya0;
#pragma unroll
                for (int ks = 0; ks < 7; ++ks) { const v4u a = z0[(size_t)ks * 2048 * 128 + 32 * j]; ya0 += CB_LO(a); ya1 += CB_HI(a); } }
            else { const v4u a = y0[32 * j]; ya0 = CB_LO(a); ya1 = CB_HI(a); }
            if (r1 >= 32768) { yb0 = (f32x4){0.f, 0.f, 0.f, 0.f}; yb1 = yb0;
#pragma unroll
                for (int ks = 0; ks < 7; ++ks) { const v4u b = z1[(size_t)ks * 2048 * 128 + 32 * j]; yb0 += CB_LO(b); yb1 += CB_HI(b); } }
            else { const v4u b = y1[32 * j]; yb0 = CB_LO(b); yb1 = CB_HI(b); }
            const v4u xw = xb[32 * j];
            v[j][0] = CB_LO(xw) + ya0 * g0 + yb0 * g1; v[j][1] = CB_HI(xw) + ya1 * g0 + yb1 * g1;
            s += (v[j][0].x * v[j][0].x + v[j][0].y * v[j][0].y) + (v[j][0].z * v[j][0].z + v[j][0].w * v[j][0].w) + (v[j][1].x * v[j][1].x + v[j][1].y * v[j][1].y) + (v[j][1].z * v[j][1].z + v[j][1].w * v[j][1].w); }
#undef CB_LO
#undef CB_HI
#pragma unroll
        for (int o = 1; o < 32; o <<= 1) s += __shfl_xor(s, o);
        const float rstd = __builtin_amdgcn_rsqf(s * (1.f / D) + EPS);
        f32x4* xr = (f32x4*)(F.out + (size_t)m * D) + 2 * hl;
#pragma unroll
        for (int j = 0; j < 4; ++j) { xr[64 * j] = v[j][0] * rstd * g8[j][0]; xr[64 * j + 1] = v[j][1] * rstd * g8[j][1]; }
    }
}
__device__ __forceinline__ int t5_bucket(int rel) {
    const int n = rel < 0 ? -rel : rel;
    int b = n < 8 ? n : n < 12 ? 8 : n < 16 ? 9 : n < 23 ? 10 : n < 32 ? 11 : n < 46 ? 12 : n < 64 ? 13 : n < 91 ? 14 : 15;
    return rel > 0 ? b + 16 : b;
}
__device__ __forceinline__ void unpack8(const v4u w, float* f) { f[0] = bflo(w.x); f[1] = bfhi(w.x); f[2] = bflo(w.y); f[3] = bfhi(w.y); f[4] = bflo(w.z); f[5] = bfhi(w.z); f[6] = bflo(w.w); f[7] = bfhi(w.w); }

namespace pg8 {
template <int MODE> struct EpiResNorm {
    static constexpr bool PERM = false, AFTER_DRAIN = true;
    const float* base; float* out; const float* gain; const float* wx; int ldw;
    unsigned char* ws; unsigned* cnt;
    __device__ __forceinline__ void fused(f32x4 (&acc)[2][2][4][2], const Unit& u, int wr, int wc, int fr, int fq, PG8_LAS unsigned char* lds, int wid, int lane) const {
        PG8_LAS float* Wt = (PG8_LAS float*)lds;
        PG8_LAS float* P = (PG8_LAS float*)(lds + 8192);
        PG8_LAS float* S = (PG8_LAS float*)(lds + 8192 + 49152);
        PG8_LAS unsigned* flag = (PG8_LAS unsigned*)(lds + 8192 + 49152 + 1024);
        const int tid = wid * 64 + lane, ldc = 1024;
        if (MODE != 0) { for (int idx = tid; idx < 2048; idx += 512) { const int e = idx >> 8, c = idx & 255; Wt[idx] = wx[(size_t)(u.cn * BM + c) * ldw + e]; } }
        const int col0 = u.cn * BM + wc * 32 + 4 * fq;
        f32x4 g4[2][2];
#pragma unroll
        for (int bj = 0; bj < 2; ++bj)
#pragma unroll
            for (int n = 0; n < 2; ++n) g4[bj][n] = *(const f32x4*)(gain + col0 + bj * HALF + n * 16);
        asm volatile("s_waitcnt lgkmcnt(0)" ::: "memory"); __builtin_amdgcn_s_barrier(); asm volatile("" ::: "memory");
#pragma unroll
        for (int ai = 0; ai < 2; ++ai)
#pragma unroll
            for (int m = 0; m < 4; ++m) { const int r = ai * HALF + wr * 64 + m * 16 + fr; const size_t off = (size_t)(u.po * BM + r) * ldc + col0;
                float st[10];
#pragma unroll
                for (int k = 0; k < 10; ++k) st[k] = 0.f;
#pragma unroll
                for (int bj = 0; bj < 2; ++bj)
#pragma unroll
                    for (int n = 0; n < 2; ++n) { const f32x4 bs = *(const f32x4*)(base + off + bj * HALF + n * 16); const f32x4 x1 = bs + acc[ai][bj][m][n]; acc[ai][bj][m][n] = x1;
                        *(f32x4*)(out + off + bj * HALF + n * 16) = x1;
                        const f32x4 xg = x1 * g4[bj][n];
                        st[0] += (x1.x * x1.x + x1.y * x1.y) + (x1.z * x1.z + x1.w * x1.w);
                        st[1] = fmaxf(st[1], fmaxf(fmaxf(fabsf(xg.x), fabsf(xg.y)), fmaxf(fabsf(xg.z), fabsf(xg.w))));
                        if (MODE != 0) { const int cl = bj * HALF + wc * 32 + n * 16 + 4 * fq;
#pragma unroll
                            for (int e = 0; e < 8; ++e) { const f32x4 w = *(const PG8_LAS f32x4*)(Wt + e * 256 + cl); st[2 + e] += (xg.x * w.x + xg.y * w.y) + (xg.z * w.z + xg.w * w.w); if (e & 1) asm volatile("" ::: "memory"); } } }
                st[0] += __shfl_xor(st[0], 16); st[0] += __shfl_xor(st[0], 32); st[1] = fmaxf(st[1], __shfl_xor(st[1], 16)); st[1] = fmaxf(st[1], __shfl_xor(st[1], 32));
                if (MODE != 0) {
#pragma unroll
                    for (int e = 0; e < 8; ++e) { st[2 + e] += __shfl_xor(st[2 + e], 16); st[2 + e] += __shfl_xor(st[2 + e], 32); } }
                if (fq == 0) { PG8_LAS float* p = P + (r * 4 + wc) * 12;
                    p[0] = st[0]; p[1] = st[1];
                    if (MODE != 0) {
#pragma unroll
                        for (int e = 0; e < 8; ++e) p[2 + e] = st[2 + e]; } }
                asm volatile("" ::: "memory"); }
        asm volatile("s_waitcnt lgkmcnt(0)" ::: "memory"); __builtin_amdgcn_s_barrier(); asm volatile("" ::: "memory");
        const int row = wid * 32 + (lane & 31);
        unsigned long long* slot = (unsigned long long*)((float*)(ws + WS_XCH) + ((size_t)(u.po * BM + row) * 4 + u.cn) * 12);
        if (lane < 32) { float t[10];
#pragma unroll
            for (int k = 0; k < 10; ++k) { const float a = P[(row * 4 + 0) * 12 + k], b = P[(row * 4 + 1) * 12 + k], c = P[(row * 4 + 2) * 12 + k], d = P[(row * 4 + 3) * 12 + k];
                t[k] = (k == 1) ? fmaxf(fmaxf(a, b), fmaxf(c, d)) : (a + b) + (c + d); }
#pragma unroll
            for (int k = 0; k < 5; ++k) __hip_atomic_store(slot + k, ((unsigned long long)__float_as_uint(t[2 * k + 1]) << 32) | __float_as_uint(t[2 * k]), __ATOMIC_RELAXED, __HIP_MEMORY_SCOPE_AGENT); }
        asm volatile("s_waitcnt vmcnt(0)" ::: "memory");
        if (lane == 0) __hip_atomic_fetch_add(cnt + 64 * u.po, 1u, __ATOMIC_RELAXED, __HIP_MEMORY_SCOPE_AGENT);
        if (wid == 0) {
            const unsigned long long t0 = __builtin_amdgcn_s_memrealtime();
            for (;;) {
                if ((unsigned)__builtin_amdgcn_readfirstlane(__hip_atomic_load(cnt + 64 * u.po, __ATOMIC_RELAXED, __HIP_MEMORY_SCOPE_AGENT)) >= 32u) break;
                if (__builtin_amdgcn_s_memrealtime() - t0 > 2000000ull) break;
                __builtin_amdgcn_s_sleep(2);
            }
            __builtin_amdgcn_fence(__ATOMIC_ACQUIRE, "agent");
            if (lane == 0) flag[0] = 1u;
        }
        asm volatile("s_waitcnt vmcnt(0) lgkmcnt(0)" ::: "memory"); __builtin_amdgcn_s_barrier(); asm volatile("" ::: "memory");
        if (lane < 32) { const unsigned long long* sl = (const unsigned long long*)((const float*)(ws + WS_XCH) + (size_t)(u.po * BM + row) * 4 * 12);
            float t[10];
#pragma unroll
            for (int k = 0; k < 10; ++k) t[k] = 0.f;
#pragma unroll
            for (int tl = 0; tl < 4; ++tl)
#pragma unroll
                for (int k = 0; k < 5; ++k) { const unsigned long long w = __hip_atomic_load(sl + tl * 6 + k, __ATOMIC_RELAXED, __HIP_MEMORY_SCOPE_AGENT);
                    const float lo = __uint_as_float((unsigned)w), hi = __uint_as_float((unsigned)(w >> 32));
                    if (k == 0) { t[0] += lo; t[1] = fmaxf(t[1], hi); } else { t[2 * k] += lo; t[2 * k + 1] += hi; } }
            const float rstd = __builtin_amdgcn_rsqf(t[0] * (1.f / 1024.f) + 1e-6f), arow = t[1] * rstd;
            S[row] = arow > 0.f ? rstd * (127.0f / arow) : 0.f;
            if (u.cn == 0) { const size_t grow = (size_t)u.po * BM + row;
                ((float*)(ws + WS_XNS))[grow] = arow * (1.0f / 127.0f);
                if (MODE == 1) { *(f32x4*)((float*)(ws + WS_DT) + grow * 8) = (f32x4){t[2] * rstd, t[3] * rstd, t[4] * rstd, t[5] * rstd}; *(f32x4*)((float*)(ws + WS_DT) + grow * 8 + 4) = (f32x4){t[6] * rstd, t[7] * rstd, t[8] * rstd, t[9] * rstd}; }
                if (MODE == 2) { float ex[8];
#pragma unroll
                    for (int e = 0; e < 8; ++e) ex[e] = t[2 + e] * rstd;
                    int e0 = 0; float v0 = ex[0];
#pragma unroll
                    for (int e = 1; e < 8; ++e) if (ex[e] > v0) { v0 = ex[e]; e0 = e; }
                    int e1 = -1; float v1 = -3.0e38f;
#pragma unroll
                    for (int e = 0; e < 8; ++e) if (e != e0 && ex[e] > v1) { v1 = ex[e]; e1 = e; }
                    const float g0 = 1.0f / (1.0f + __expf(v1 - v0)), g1 = 1.0f - g0; const int mtok = (int)grow;
                    unsigned* ctl = (unsigned*)(ws + WS_CTL);
                    const int pos0 = (int)atomicAdd(ctl + CW_CNT + 64 * e0, 1u), pos1 = (int)atomicAdd(ctl + CW_CNT + 64 * e1, 1u);
                    int* LIST = (int*)(ws + WS_LIST); int* TI = (int*)(ws + WS_TI); float* TG = (float*)(ws + WS_TG);
                    LIST[e0 * 16384 + pos0] = mtok; LIST[e1 * 16384 + pos1] = mtok;
                    TI[mtok * 4 + 0] = e0 | (e1 << 8); TI[mtok * 4 + 1] = pos0; TI[mtok * 4 + 2] = pos1; TI[mtok * 4 + 3] = 0;
                    TG[mtok * 2 + 0] = g0; TG[mtok * 2 + 1] = g1; } } }
        asm volatile("s_waitcnt lgkmcnt(0)" ::: "memory"); __builtin_amdgcn_s_barrier(); asm volatile("" ::: "memory");
        unsigned char* XN8 = ws + WS_XN;
#pragma unroll
        for (int ai = 0; ai < 2; ++ai)
#pragma unroll
            for (int m = 0; m < 4; ++m) { const int r = ai * HALF + wr * 64 + m * 16 + fr; const float s = S[r]; unsigned char* rowp = XN8 + (size_t)(u.po * BM + r) * 1024 + col0;
#pragma unroll
                for (int bj = 0; bj < 2; ++bj)
#pragma unroll
                    for (int n = 0; n < 2; ++n) { const f32x4 q = acc[ai][bj][m][n] * g4[bj][n] * s;
                        const int q0 = (int)rintf(q.x), q1 = (int)rintf(q.y), q2 = (int)rintf(q.z), q3 = (int)rintf(q.w);
                        *(unsigned*)(rowp + bj * HALF + n * 16) = (unsigned)(q0 & 255) | ((unsigned)(q1 & 255) << 8) | ((unsigned)(q2 & 255) << 16) | ((unsigned)(q3 & 255) << 24); } }
    }
};
}
namespace att {
typedef short v4i16_t __attribute__((ext_vector_type(4)));
typedef short s16x4 __attribute__((ext_vector_type(4)));
typedef float f32x16 __attribute__((ext_vector_type(16)));
constexpr int NSLOT = 3, SLOTB = 8192;
constexpr int LDS_K = 0, LDS_V = NSLOT * SLOTB, LDS_BT = 2 * NSLOT * SLOTB, LDS_WS = LDS_BT + 2048, LDS_OST = LDS_WS + 2048, OST_W = 32 * 68, LDS_END = LDS_OST + 8 * OST_W * 4;
static_assert(LDS_END <= RING_BYTES, "attention LDS map");
constexpr float THR = 8.0f;
__device__ __forceinline__ s16x4 vtr(const LAS char* p) { return __builtin_bit_cast(s16x4, __builtin_amdgcn_ds_read_tr16_b64_v4i16((LAS v4i16_t*)p)); }
__device__ __forceinline__ int crow(int r, int hi) { return (r & 3) + 8 * (r >> 2) + 4 * hi; }
__device__ __forceinline__ float xhalf_max(float v) { auto rr = __builtin_amdgcn_permlane32_swap(__float_as_uint(v), __float_as_uint(v), false, false); return fmaxf(__uint_as_float(rr[0]), __uint_as_float(rr[1])); }
__device__ __forceinline__ float xhalf_sum(float v) { auto rr = __builtin_amdgcn_permlane32_swap(__float_as_uint(v), __float_as_uint(v), false, false); return __uint_as_float(rr[0]) + __uint_as_float(rr[1]); }
#define ATT_WAIT_BAR(N) asm volatile("s_waitcnt vmcnt(" #N ") lgkmcnt(0)\n\ts_barrier" ::: "memory")

__device__ __forceinline__ void attn_unit(Frame& F_, const Args& A, int l, int b, int h, int qb, float lam, float oscale) {
    Frame F = refresh(F_);
    const int tid = F.tid, lane = tid & 63, wid = F.wave, r32 = lane & 31, hi = lane >> 5, t = wid >> 2, wq = wid & 3;
    const int Q0 = qb * 128, row0 = Q0 + 32 * wq, NT = 2 * qb + 2, cq = 2 * qb + (wq >> 1);
    const bf16* PROJ = (const bf16*)(F.ws + WS_BIG); const size_t rb = (size_t)b * SEQ;
    LAS char* L = (LAS char*)F.lds;
    LAS float* Bt = (LAS float*)(L + LDS_BT); LAS float* wsf = (LAS float*)(L + LDS_WS) + wid * 64; LAS float* stg = (LAS float*)(L + LDS_OST) + wid * OST_W;
    ATT_WAIT_BAR(0);
    const float cb = A.in[6][15 * 4 + h] * LOG2E;
    if (tid < 320) Bt[tid] = A.in[6][t5_bucket(tid - 255) * 4 + h] * LOG2E - cb;
    bf16x8 qr[2];
#pragma unroll
    for (int s = 0; s < 2; ++s) qr[s] = *(const bf16x8*)(PROJ + (rb + row0 + r32) * NPROJ + PC_Q + h * 64 + t * 32 + s * 16 + hi * 8);
    const int krow = wid * 8 + (lane >> 3);
    const bf16* ksrc = PROJ + (rb + krow) * NPROJ + PC_K + h * 64 + (((lane & 7) ^ (krow & 7)) * 8);
    const bf16* vsrc = PROJ + (rb + 16 * (wid & 3) + (lane >> 2)) * NPROJ + PC_V + h * 64 + (wid >> 2) * 32 + (lane & 3) * 8;
#define ATT_DMA(tile, sl) do { \
        __builtin_amdgcn_global_load_lds((const unsigned*)(ksrc + (size_t)(tile) * 64 * NPROJ), (LAS unsigned*)(L + LDS_K + (sl) * SLOTB + wid * 1024), 16, 0, 0); \
        __builtin_amdgcn_global_load_lds((const unsigned*)(vsrc + (size_t)(tile) * 64 * NPROJ), (LAS unsigned*)(L + LDS_V + (sl) * SLOTB + wid * 1024), 16, 0, 0); } while (0)
    ATT_DMA(0, 0); ATT_DMA(1, 1);
    f32x16 o0, o1, zero16;
#pragma unroll
    for (int r = 0; r < 16; ++r) { o0[r] = 0.f; o1[r] = 0.f; zero16[r] = 0.f; }
    float lsum = 0.f;
    const int kf0 = r32 * 128 + (((t * 4 + hi) ^ (r32 & 7)) * 16), kf1 = r32 * 128 + (((t * 4 + 2 + hi) ^ (r32 & 7)) * 16);
    const int vfo = ((lane >> 4) & 1) * 32 + (lane & 3) * 8 + (4 * hi + ((lane & 15) >> 2)) * 64;
    int slot = 0;
    for (int tile = 0; tile < NT; ++tile) {
        if (tile + 1 < NT) ATT_WAIT_BAR(2); else ATT_WAIT_BAR(0);
        if (tile + 2 < NT) { const int s2 = slot >= 1 ? slot - 1 : 2; ATT_DMA(tile + 2, s2); }
        if (tile <= cq) {
            const LAS char* Ks = L + LDS_K + slot * SLOTB; const LAS char* Vs = L + LDS_V + slot * SLOTB + vfo;
            f32x16 p0, p1;
            { const bf16x8 k00 = *(const LAS bf16x8*)(Ks + kf0), k01 = *(const LAS bf16x8*)(Ks + kf1), k10 = *(const LAS bf16x8*)(Ks + 4096 + kf0), k11 = *(const LAS bf16x8*)(Ks + 4096 + kf1);
              p0 = __builtin_amdgcn_mfma_f32_32x32x16_bf16(k00, qr[0], zero16, 0, 0, 0); p0 = __builtin_amdgcn_mfma_f32_32x32x16_bf16(k01, qr[1], p0, 0, 0, 0);
              p1 = __builtin_amdgcn_mfma_f32_32x32x16_bf16(k10, qr[0], zero16, 0, 0, 0); p1 = __builtin_amdgcn_mfma_f32_32x32x16_bf16(k11, qr[1], p1, 0, 0, 0); }
            const int K0 = tile * 64;
            if (K0 > row0 - 154) {
                const LAS float* bp = Bt + (K0 - row0 + 255 + 4 * hi - r32);
#pragma unroll
                for (int r = 0; r < 16; ++r) { p0[r] += bp[(r & 3) + 8 * (r >> 2)]; p1[r] += bp[32 + (r & 3) + 8 * (r >> 2)]; }
            }
            float sacc = 0.f;
#pragma unroll
            for (int r = 0; r < 16; ++r) { p0[r] = __builtin_amdgcn_exp2f(p0[r]); p1[r] = __builtin_amdgcn_exp2f(p1[r]); sacc += p0[r] + p1[r]; }
            lsum += sacc;
            bf16x8 pa[4];
            { v4u w;
              w.x = pk2(p0[0], p0[1]); w.y = pk2(p0[2], p0[3]); w.z = pk2(p0[4], p0[5]); w.w = pk2(p0[6], p0[7]); pa[0] = __builtin_bit_cast(bf16x8, w);
              w.x = pk2(p0[8], p0[9]); w.y = pk2(p0[10], p0[11]); w.z = pk2(p0[12], p0[13]); w.w = pk2(p0[14], p0[15]); pa[1] = __builtin_bit_cast(bf16x8, w);
              w.x = pk2(p1[0], p1[1]); w.y = pk2(p1[2], p1[3]); w.z = pk2(p1[4], p1[5]); w.w = pk2(p1[6], p1[7]); pa[2] = __builtin_bit_cast(bf16x8, w);
              w.x = pk2(p1[8], p1[9]); w.y = pk2(p1[10], p1[11]); w.z = pk2(p1[12], p1[13]); w.w = pk2(p1[14], p1[15]); pa[3] = __builtin_bit_cast(bf16x8, w); }
#pragma unroll
            for (int k = 0; k < 4; ++k) {
                const s16x4 a0 = vtr(Vs + k * 1024), a1 = vtr(Vs + k * 1024 + 512), c0 = vtr(Vs + 4096 + k * 1024), c1 = vtr(Vs + 4096 + k * 1024 + 512);
                const bf16x8 v0 = (bf16x8){a0[0], a0[1], a0[2], a0[3], a1[0], a1[1], a1[2], a1[3]}, v1 = (bf16x8){c0[0], c0[1], c0[2], c0[3], c1[0], c1[1], c1[2], c1[3]};
                o0 = __builtin_amdgcn_mfma_f32_32x32x16_bf16(pa[k], v0, o0, 0, 0, 0);
                o1 = __builtin_amdgcn_mfma_f32_32x32x16_bf16(pa[k], v1, o1, 0, 0, 0);
            }
        }
        slot = slot == 2 ? 0 : slot + 1;
    }
    lsum = xhalf_sum(lsum);
    if (hi == 0) wsf[32 + r32] = lsum;
    asm volatile("s_waitcnt lgkmcnt(0)" ::: "memory");
#pragma unroll
    for (int r = 0; r < 16; ++r) { const int q = crow(r, hi); const float rl = __builtin_amdgcn_rcpf(wsf[32 + q]); stg[q * 68 + r32] = o0[r] * rl; stg[q * 68 + 32 + r32] = o1[r] * rl; }
    ATT_WAIT_BAR(0);
    if (t == 0) {
        const LAS float* s1 = stg + 4 * OST_W; const float* gn = A.in[11] + l * 64; bf16* MIXp = (bf16*)(F.ws + WS_MIX);
#pragma unroll
        for (int i = 0; i < 4; ++i) { const int row = i * 8 + (lane >> 3), ch = lane & 7;
            const f32x4 a0 = *(const LAS f32x4*)(stg + row * 68 + ch * 8), a1 = *(const LAS f32x4*)(stg + row * 68 + ch * 8 + 4), b0 = *(const LAS f32x4*)(s1 + row * 68 + ch * 8), b1 = *(const LAS f32x4*)(s1 + row * 68 + ch * 8 + 4);
            const f32x4 x0 = a0 - b0 * lam, x1 = a1 - b1 * lam;
            float ss = (x0.x * x0.x + x0.y * x0.y) + (x0.z * x0.z + x0.w * x0.w) + (x1.x * x1.x + x1.y * x1.y) + (x1.z * x1.z + x1.w * x1.w);
            ss += __shfl_xor(ss, 1); ss += __shfl_xor(ss, 2); ss += __shfl_xor(ss, 4);
            const float rstd = __builtin_amdgcn_rsqf(ss * (1.f / 64.f) + EPS) * oscale;
            const f32x4 g0 = *(const f32x4*)(gn + ch * 8), g1 = *(const f32x4*)(gn + ch * 8 + 4);
            v4u w; w.x = pk2(x0.x * rstd * g0.x, x0.y * rstd * g0.y); w.y = pk2(x0.z * rstd * g0.z, x0.w * rstd * g0.w); w.z = pk2(x1.x * rstd * g1.x, x1.y * rstd * g1.y); w.w = pk2(x1.z * rstd * g1.z, x1.w * rstd * g1.w);
            *(v4u*)(MIXp + (rb + row0 + row) * D + h * 64 + ch * 8) = w; }
    }
#undef ATT_DMA
}
}
namespace ssd {
typedef unsigned u32x2 __attribute__((ext_vector_type(2)));
using att::f32x16; using att::s16x4; using att::vtr; using att::crow;
constexpr int XS = 0, BK = 32768, CK = 40960, BW = 49152, HB = 81920, SM = 114688, CW = 122880;
constexpr int SM_VL = 0, SM_US = 256, SM_EO = 512, SM_WS = 768, SM_DT = 1024, SM_DK = 1028, SM_AK = 1032, SM_DB = 1036, SM_GN = 1040;
#define SSD_BAR() asm volatile("s_waitcnt lgkmcnt(0)\n\ts_barrier" ::: "memory")
__device__ __forceinline__ bf16x8 trfrag(const LAS char* p) { const s16x4 a = vtr(p), b = vtr(p + 512); return (bf16x8){a[0], a[1], a[2], a[3], b[0], b[1], b[2], b[3]}; }
__device__ __forceinline__ bf16x8 packfrag(const f32x16& x, int s) { v4u w; w.x = pk2(x[8 * s], x[8 * s + 1]); w.y = pk2(x[8 * s + 2], x[8 * s + 3]); w.z = pk2(x[8 * s + 4], x[8 * s + 5]); w.w = pk2(x[8 * s + 6], x[8 * s + 7]); return __builtin_bit_cast(bf16x8, w); }
#define SSD_LO(q_) ((f32x4){bflo((q_).x), bfhi((q_).x), bflo((q_).y), bfhi((q_).y)})
#define SSD_HI(q_) ((f32x4){bflo((q_).z), bfhi((q_).z), bflo((q_).w), bfhi((q_).w)})

__device__ __forceinline__ void ssd_m1_unit(Frame& F_, const Args& A, int l, int b, int c, int g) {
    Frame F = refresh(F_);
    const int tid = F.tid, lane = tid & 63, wid = F.wave, r32 = lane & 31, hi = lane >> 5, hh = wid >> 1, lh = wid & 1;
    LAS char* L = (LAS char*)F.lds; LAS float* sm = (LAS float*)(L + SM); LAS float* cwl = (LAS float*)(L + CW);
    const bf16* PROJ = (const bf16*)(F.ws + WS_BIG); const float* DTg = (const float*)(F.ws + WS_DT);
    bf16* XC = (bf16*)(F.ws + WS_XC); bf16* YD = (bf16*)(F.ws + WS_YD); bf16* SST = (bf16*)(F.ws + WS_SST);
    const size_t rowb = (size_t)b * SEQ + (size_t)c * 64;
    const int tg = tid / 48, cc = tid - tg * 48;
    const int gcol = PC_XBC + (cc < 32 ? g * 256 + cc * 8 : cc < 40 ? 512 + g * 64 + (cc - 32) * 8 : 640 + g * 64 + (cc - 40) * 8);
    v4u raw[11];
#pragma unroll
    for (int i = 0; i < 11; ++i) { const int trow = c * 64 + 8 * tg - 3 + i; raw[i] = (tid < 384 && trow >= 0) ? *(const v4u*)(PROJ + ((size_t)b * SEQ + trow) * NPROJ + gcol) : (v4u){0u, 0u, 0u, 0u}; }
    f32x4 d4 = (f32x4){0.f, 0.f, 0.f, 0.f};
    if (wid == 7) d4 = *(const f32x4*)(DTg + (rowb + lane) * 8 + g * 4);
    SSD_BAR();
    for (int i = tid; i < 5 * 384; i += 512) { const int w = i / 384, li = i - w * 384; const int ch = li < 256 ? g * 256 + li : li < 320 ? 512 + g * 64 + (li - 256) : 640 + g * 64 + (li - 320);
        cwl[i] = w < 4 ? A.in[12][(size_t)l * 4 * 768 + w * 768 + ch] : A.in[13][l * 768 + ch]; }
    if (tid < 4) { sm[SM_AK + tid] = -__expf(A.in[15][l * 8 + g * 4 + tid]); sm[SM_DB + tid] = A.in[14][l * 8 + g * 4 + tid]; }
    SSD_BAR();
    if (tid < 384) {
        const int dsto = cc < 32 ? XS + (cc >> 3) * 8192 + ((cc & 7) >> 2) * 4096 + ((cc & 3) * 8) * 2 : cc < 40 ? BK + (cc - 32) * 1024 : CK + (cc - 40) * 1024;
        const int dstr = cc < 32 ? 64 : 16;
        const int xcol = cc < 32 ? g * 256 + cc * 8 : 512 + g * 64 + (cc - 40) * 8;
        const f32x4 w0a = *(const LAS f32x4*)(cwl + cc * 8), w0b = *(const LAS f32x4*)(cwl + cc * 8 + 4), w1a = *(const LAS f32x4*)(cwl + 384 + cc * 8), w1b = *(const LAS f32x4*)(cwl + 384 + cc * 8 + 4);
        const f32x4 w2a = *(const LAS f32x4*)(cwl + 768 + cc * 8), w2b = *(const LAS f32x4*)(cwl + 768 + cc * 8 + 4), w3a = *(const LAS f32x4*)(cwl + 1152 + cc * 8), w3b = *(const LAS f32x4*)(cwl + 1152 + cc * 8 + 4);
        const f32x4 cba = *(const LAS f32x4*)(cwl + 1536 + cc * 8), cbb = *(const LAS f32x4*)(cwl + 1536 + cc * 8 + 4);
#pragma unroll
        for (int j = 0; j < 8; ++j) {
            const f32x4 va = cba + SSD_LO(raw[j]) * w0a + SSD_LO(raw[j + 1]) * w1a + SSD_LO(raw[j + 2]) * w2a + SSD_LO(raw[j + 3]) * w3a;
            const f32x4 vb = cbb + SSD_HI(raw[j]) * w0b + SSD_HI(raw[j + 1]) * w1b + SSD_HI(raw[j + 2]) * w2b + SSD_HI(raw[j + 3]) * w3b;
            v4u o; o.x = pk2(silu_f(va.x), silu_f(va.y)); o.y = pk2(silu_f(va.z), silu_f(va.w)); o.z = pk2(silu_f(vb.x), silu_f(vb.y)); o.w = pk2(silu_f(vb.z), silu_f(vb.w));
            *(LAS v4u*)(L + dsto + (8 * tg + j) * dstr) = o;
            if (cc < 32 || cc >= 40) *(v4u*)(XC + (rowb + 8 * tg + j) * 640 + xcol) = o;
        }
    } else if (wid == 7) {
        float dtr[4] = {d4.x, d4.y, d4.z, d4.w}; float tot[4];
#pragma unroll
        for (int k = 0; k < 4; ++k) { const float Ak = sm[SM_AK + k], dbk = sm[SM_DB + k];
            const float xr = dtr[k] + dbk; const float dt = xr > 20.f ? xr : log1pf(__expf(xr));
            float acs = Ak * dt;
#pragma unroll
            for (int o = 1; o < 64; o <<= 1) { const float u = __shfl_up(acs, o); if (lane >= o) acs += u; }
            tot[k] = __shfl(acs, 63);
            sm[SM_VL + k * 64 + lane] = acs * LOG2E; sm[SM_US + k * 64 + lane] = acs * LOG2E - __log2f(dt);
            sm[SM_WS + k * 64 + lane] = __expf(tot[k] - acs) * dt; dtr[k] = __expf(acs); }
        *(f32x4*)((float*)(F.ws + WS_EOFF) + (rowb + lane) * 8 + g * 4) = (f32x4){dtr[0], dtr[1], dtr[2], dtr[3]};
        if (lane == 0) *(f32x4*)((float*)(F.ws + WS_DTOT) + ((size_t)(b * 128 + c)) * 8 + g * 4) = (f32x4){__expf(tot[0]), __expf(tot[1]), __expf(tot[2]), __expf(tot[3])};
    }
    SSD_BAR();
    { const int s = tid >> 3, nc = tid & 7; const v4u b8 = *(const LAS v4u*)(L + BK + nc * 1024 + s * 16);
      const f32x4 ba = SSD_LO(b8), bb = SSD_HI(b8);
#pragma unroll
      for (int k = 0; k < 4; ++k) { const float w = sm[SM_WS + k * 64 + s]; v4u o; o.x = pk2(ba.x * w, ba.y * w); o.y = pk2(ba.z * w, ba.w * w); o.z = pk2(bb.x * w, bb.y * w); o.w = pk2(bb.z * w, bb.w * w);
          *(LAS v4u*)(L + BW + k * 8192 + (nc >> 2) * 4096 + s * 64 + (nc & 3) * 16) = o; } }
    SSD_BAR();
    const int kfo = hi * 1024 + r32 * 16;
    const int vfo = ((lane >> 4) & 1) * 32 + (lane & 3) * 8 + (4 * hi + ((lane & 15) >> 2)) * 64;
    f32x16 y0, y1, h0, h1;
#pragma unroll
    for (int r = 0; r < 16; ++r) { y0[r] = 0.f; y1[r] = 0.f; h0[r] = 0.f; h1[r] = 0.f; }
    {
        bf16x8 cf[4];
#pragma unroll
        for (int ks = 0; ks < 4; ++ks) cf[ks] = *(const LAS bf16x8*)(L + CK + kfo + ks * 2048 + lh * 512);
        const float vl = sm[SM_VL + hh * 64 + 32 * lh + r32];
#pragma unroll
        for (int sb = 0; sb < 2; ++sb) {
            if (sb <= lh) {
                f32x16 T;
#pragma unroll
                for (int r = 0; r < 16; ++r) T[r] = 0.f;
#pragma unroll
                for (int ks = 0; ks < 4; ++ks) { const bf16x8 bfr = *(const LAS bf16x8*)(L + BK + kfo + ks * 2048 + sb * 512); T = __builtin_amdgcn_mfma_f32_32x32x16_bf16(bfr, cf[ks], T, 0, 0, 0); }
#pragma unroll
                for (int r = 0; r < 16; ++r) { const float us = sm[SM_US + hh * 64 + 32 * sb + crow(r, hi)]; float w = T[r] * __builtin_amdgcn_exp2f(vl - us);
                    if (sb == lh && crow(r, hi) > r32) w = 0.f; T[r] = w; }
                const bf16x8 pa0 = packfrag(T, 0), pa1 = packfrag(T, 1);
                const LAS char* xb = L + XS + hh * 8192 + vfo + sb * 2048;
                const bf16x8 x00 = trfrag(xb), x01 = trfrag(xb + 4096), x10 = trfrag(xb + 1024), x11 = trfrag(xb + 4096 + 1024);
                y0 = __builtin_amdgcn_mfma_f32_32x32x16_bf16(pa0, x00, y0, 0, 0, 0); y1 = __builtin_amdgcn_mfma_f32_32x32x16_bf16(pa0, x01, y1, 0, 0, 0);
                y0 = __builtin_amdgcn_mfma_f32_32x32x16_bf16(pa1, x10, y0, 0, 0, 0); y1 = __builtin_amdgcn_mfma_f32_32x32x16_bf16(pa1, x11, y1, 0, 0, 0);
            }
        }
#pragma unroll
        for (int ks = 0; ks < 4; ++ks) { const bf16x8 xa = trfrag(L + XS + hh * 8192 + lh * 4096 + vfo + ks * 1024), b0 = trfrag(L + BW + hh * 8192 + vfo + ks * 1024), b1 = trfrag(L + BW + hh * 8192 + 4096 + vfo + ks * 1024);
            h0 = __builtin_amdgcn_mfma_f32_32x32x16_bf16(xa, b0, h0, 0, 0, 0); h1 = __builtin_amdgcn_mfma_f32_32x32x16_bf16(xa, b1, h1, 0, 0, 0); }
    }
    { bf16* img = SST + ((size_t)((b * 128 + c) * 8 + g * 4 + hh)) * 4096;
#pragma unroll
      for (int r = 0; r < 16; ++r) { const int p = 32 * lh + crow(r, hi);
          img[(r32 >> 3) * 512 + p * 8 + (r32 & 7)] = (bf16)f2bf(h0[r]); img[(4 + (r32 >> 3)) * 512 + p * 8 + (r32 & 7)] = (bf16)f2bf(h1[r]); } }
    SSD_BAR();
#pragma unroll
    for (int r = 0; r < 16; ++r) { const int lrow = 32 * lh + crow(r, hi);
        *(LAS unsigned short*)(L + BW + (lrow * 256 + hh * 64 + r32) * 2) = (unsigned short)f2bf(y0[r]);
        *(LAS unsigned short*)(L + BW + (lrow * 256 + hh * 64 + 32 + r32) * 2) = (unsigned short)f2bf(y1[r]); }
    SSD_BAR();
#pragma unroll
    for (int k = 0; k < 4; ++k) { const int tk = wid * 8 + 2 * k + (lane >> 5), chn = (lane & 31) * 8;
        *(v4u*)(YD + (rowb + tk) * 512 + g * 256 + chn) = *(const LAS v4u*)(L + BW + (tk * 256 + chn) * 2); }
}

__device__ __forceinline__ void ssd_m3_unit(Frame& F_, const Args& A, int l, int b, int c, int g) {
    Frame F = refresh(F_);
    const int tid = F.tid, lane = tid & 63, wid = F.wave, r32 = lane & 31, hi = lane >> 5, hh = wid >> 1, lh = wid & 1;
    LAS char* L = (LAS char*)F.lds; LAS float* sm = (LAS float*)(L + SM);
    const bf16* PROJ = (const bf16*)(F.ws + WS_BIG); const bf16* XC = (const bf16*)(F.ws + WS_XC); const bf16* YD = (const bf16*)(F.ws + WS_YD); const bf16* SST = (const bf16*)(F.ws + WS_SST);
    bf16* MIXp = (bf16*)(F.ws + WS_MIX);
    const size_t rowb = (size_t)b * SEQ + (size_t)c * 64;
    const v4u c8 = *(const v4u*)(XC + (rowb + (tid >> 3)) * 640 + 512 + g * 64 + (tid & 7) * 8);
    v4u hp[4];
    { const v4u* src = (const v4u*)(SST + ((size_t)((b * 128 + c) * 8 + g * 4)) * 4096);
#pragma unroll
      for (int i = 0; i < 4; ++i) hp[i] = src[tid + 512 * i]; }
    float eo = 0.f; if (tid < 256) eo = ((const float*)(F.ws + WS_EOFF))[(rowb + (tid & 63)) * 8 + g * 4 + (tid >> 6)];
    SSD_BAR();
    *(LAS v4u*)(L + CK + (tid & 7) * 1024 + (tid >> 3) * 16) = c8;
#pragma unroll
    for (int i = 0; i < 4; ++i) *(LAS v4u*)(L + HB + (tid + 512 * i) * 16) = hp[i];
    if (tid < 256) { sm[SM_EO + tid] = eo; sm[SM_GN + tid] = A.in[17][l * 512 + g * 256 + tid]; }
    if (tid < 4) sm[SM_DK + tid] = A.in[16][l * 8 + g * 4 + tid];
    SSD_BAR();
    const int kfo = hi * 1024 + r32 * 16;
    f32x16 y0, y1;
#pragma unroll
    for (int r = 0; r < 16; ++r) { y0[r] = 0.f; y1[r] = 0.f; }
#pragma unroll
    for (int ks = 0; ks < 4; ++ks) { const bf16x8 cf = *(const LAS bf16x8*)(L + CK + kfo + ks * 2048 + lh * 512);
        const bf16x8 h0 = *(const LAS bf16x8*)(L + HB + hh * 8192 + kfo + ks * 2048), h1 = *(const LAS bf16x8*)(L + HB + hh * 8192 + kfo + ks * 2048 + 512);
        y0 = __builtin_amdgcn_mfma_f32_32x32x16_bf16(cf, h0, y0, 0, 0, 0); y1 = __builtin_amdgcn_mfma_f32_32x32x16_bf16(cf, h1, y1, 0, 0, 0); }
#pragma unroll
    for (int r = 0; r < 16; ++r) { const int lrow = 32 * lh + crow(r, hi); const float e = sm[SM_EO + hh * 64 + lrow];
        *(LAS unsigned short*)(L + BW + (lrow * 256 + hh * 64 + r32) * 2) = (unsigned short)f2bf(y0[r] * e);
        *(LAS unsigned short*)(L + BW + (lrow * 256 + hh * 64 + 32 + r32) * 2) = (unsigned short)f2bf(y1[r] * e); }
    SSD_BAR();
    const float Dk = sm[SM_DK + (lane >> 4)]; const f32x4 gn4 = *(const LAS f32x4*)(sm + SM_GN + 4 * lane);
    u32x2 zr[8], xr[8], yr[8];
#pragma unroll
    for (int k = 0; k < 8; ++k) { const size_t row = rowb + wid * 8 + k; zr[k] = *(const u32x2*)(PROJ + row * NPROJ + PC_Z + g * 256 + 4 * lane); xr[k] = *(const u32x2*)(XC + row * 640 + g * 256 + 4 * lane); yr[k] = *(const u32x2*)(YD + row * 512 + g * 256 + 4 * lane); }
#pragma unroll
    for (int k = 0; k < 8; ++k) { const int tk = wid * 8 + k;
        const u32x2 yo = *(const LAS u32x2*)(L + BW + (tk * 256 + 4 * lane) * 2);
        f32x4 v; v.x = (bflo(yo.x) + bflo(yr[k].x) + Dk * bflo(xr[k].x)) * silu_f(bflo(zr[k].x)); v.y = (bfhi(yo.x) + bfhi(yr[k].x) + Dk * bfhi(xr[k].x)) * silu_f(bfhi(zr[k].x));
        v.z = (bflo(yo.y) + bflo(yr[k].y) + Dk * bflo(xr[k].y)) * silu_f(bflo(zr[k].y)); v.w = (bfhi(yo.y) + bfhi(yr[k].y) + Dk * bfhi(xr[k].y)) * silu_f(bfhi(zr[k].y));
        const float rstd = __builtin_amdgcn_rsqf(wave_sum((v.x * v.x + v.y * v.y) + (v.z * v.z + v.w * v.w)) * (1.f / 256.f) + EPS);
        u32x2 o; o.x = pk2(v.x * rstd * gn4.x, v.y * rstd * gn4.y); o.y = pk2(v.z * rstd * gn4.z, v.w * rstd * gn4.w);
        *(u32x2*)(MIXp + (rowb + tk) * D + 256 + g * 256 + 4 * lane) = o; }
}

__device__ __forceinline__ void scan_unit(Frame& F_, int kind, int u) {
    Frame F = refresh(F_);
    const int e = u * 1024 + F.tid * 2, nh = kind == 0 ? 8 : 4;
    const int idx = e & 4095, head = (e >> 12) & (nh - 1), b = e >> (kind == 0 ? 15 : 14);
    unsigned* base = (unsigned*)((bf16*)(F.ws + (kind == 0 ? WS_SST : WS_RST)) + ((size_t)(b * 128) * nh + head) * 4096 + idx);
    const size_t cstride = (size_t)nh * 4096 / 2;
    const float* dtot = (const float*)(F.ws + WS_DTOT) + (size_t)(b * 128) * 8 + head;
    const float gdec = exp2f(64.f * log2f(1.0f - exp2f(-5.0f - (float)head)));
    float h0 = 0.f, h1 = 0.f;
    for (int c0 = 0; c0 < 128; c0 += 16) {
        unsigned v[16]; float d[16];
#pragma unroll
        for (int i = 0; i < 16; ++i) { v[i] = base[(size_t)(c0 + i) * cstride]; d[i] = kind == 0 ? dtot[(size_t)(c0 + i) * 8] : gdec; }
#pragma unroll
        for (int i = 0; i < 16; ++i) { base[(size_t)(c0 + i) * cstride] = pk2(h0, h1); h0 = d[i] * h0 + bflo(v[i]); h1 = d[i] * h1 + bfhi(v[i]); }
    }
}
#undef SSD_LO
#undef SSD_HI
}
namespace ret {
using att::f32x16; using att::crow; using ssd::trfrag; using ssd::packfrag; using ssd::u32x2;
constexpr int QK = 0, KK = 8192, KW = 16384, VV = 24576, SB = 32768, OS = 40960, TB = 58368;
#define RET_BAR() asm volatile("s_waitcnt lgkmcnt(0)\n\ts_barrier" ::: "memory")
__device__ __forceinline__ f32x4 lo4(const v4u q_) { return (f32x4){bflo(q_.x), bfhi(q_.x), bflo(q_.y), bfhi(q_.y)}; }
__device__ __forceinline__ f32x4 hi4(const v4u q_) { return (f32x4){bflo(q_.z), bfhi(q_.z), bflo(q_.w), bfhi(q_.w)}; }
__device__ __forceinline__ v4u pack8(const f32x4 a, const f32x4 b) { v4u o; o.x = pk2(a.x, a.y); o.y = pk2(a.z, a.w); o.z = pk2(b.x, b.y); o.w = pk2(b.z, b.w); return o; }

__device__ __forceinline__ void ret_m1_unit(Frame& F_, const Args& A, int l, int b, int c, int h) {
    Frame F = refresh(F_);
    const int tid = F.tid, lane = tid & 63, wid = F.wave, r32 = lane & 31, hi = lane >> 5;
    LAS char* L = (LAS char*)F.lds; LAS float* tb = (LAS float*)(L + TB); LAS float* os = (LAS float*)(L + OS);
    const bf16* PROJ = (const bf16*)(F.ws + WS_BIG);
    const float gam = 1.0f - exp2f(-5.0f - (float)h), lg2 = log2f(gam);
    const int tok = tid >> 3, seg = tid & 7;
    const size_t rowb = (size_t)b * SEQ + (size_t)c * 64;
    v4u ld[4];
    { const bf16* rp = PROJ + (rowb + tok) * NPROJ;
      if (seg < 4) { ld[0] = *(const v4u*)(rp + PC_RQ + h * 64 + seg * 8); ld[1] = *(const v4u*)(rp + PC_RQ + h * 64 + 32 + seg * 8); ld[2] = *(const v4u*)(rp + PC_RK + h * 64 + seg * 8); ld[3] = *(const v4u*)(rp + PC_RK + h * 64 + 32 + seg * 8); }
      else { ld[0] = *(const v4u*)(rp + PC_RV + h * 64 + (seg - 4) * 16); ld[1] = *(const v4u*)(rp + PC_RV + h * 64 + (seg - 4) * 16 + 8); ld[2] = ld[0]; ld[3] = ld[0]; } }
    RET_BAR();
    if (tid < 128) tb[tid] = exp2f(lg2 * (float)(tid < 63 ? 63 - tid : tid - 63));
    if (seg < 4) {
        const f32x4 qla = lo4(ld[0]), qlb = hi4(ld[0]), qha = lo4(ld[1]), qhb = hi4(ld[1]), kla = lo4(ld[2]), klb = hi4(ld[2]), kha = lo4(ld[3]), khb = hi4(ld[3]);
        float ql[8] = {qla.x, qla.y, qla.z, qla.w, qlb.x, qlb.y, qlb.z, qlb.w}, qh[8] = {qha.x, qha.y, qha.z, qha.w, qhb.x, qhb.y, qhb.z, qhb.w};
        float kl[8] = {kla.x, kla.y, kla.z, kla.w, klb.x, klb.y, klb.z, klb.w}, kh[8] = {kha.x, kha.y, kha.z, kha.w, khb.x, khb.y, khb.z, khb.w};
        float q1[8], q2[8], k1[8], k2[8];
        const float pos = (float)(c * 64 + tok);
#pragma unroll
        for (int i = 0; i < 8; ++i) { const int fi = seg * 8 + i; const float invf = exp2f(-(float)fi * (13.287712379549449f / 32.0f)); const float ang = pos * invf;
            double rev = (double)ang * 0.15915494309189535; rev -= __builtin_rint(rev); const float fr = (float)rev;
            const float sn = __builtin_amdgcn_sinf(fr), cs = __builtin_amdgcn_cosf(fr);
            q1[i] = ql[i] * cs - qh[i] * sn; q2[i] = ql[i] * sn + qh[i] * cs; k1[i] = kl[i] * cs - kh[i] * sn; k2[i] = kl[i] * sn + kh[i] * cs; }
        const float kd = exp2f(lg2 * (float)(63 - tok));
        const v4u qa = pack8((f32x4){q1[0], q1[1], q1[2], q1[3]}, (f32x4){q1[4], q1[5], q1[6], q1[7]}), qb = pack8((f32x4){q2[0], q2[1], q2[2], q2[3]}, (f32x4){q2[4], q2[5], q2[6], q2[7]});
        *(LAS v4u*)(L + QK + seg * 1024 + tok * 16) = qa; *(LAS v4u*)(L + QK + (seg + 4) * 1024 + tok * 16) = qb;
        { char* qimg = (char*)(F.ws + WS_QR) + ((size_t)((b * 128 + c) * 4 + h)) * 8192; *(v4u*)(qimg + seg * 1024 + tok * 16) = qa; *(v4u*)(qimg + (seg + 4) * 1024 + tok * 16) = qb; }
        *(LAS v4u*)(L + KK + seg * 1024 + tok * 16) = pack8((f32x4){k1[0], k1[1], k1[2], k1[3]}, (f32x4){k1[4], k1[5], k1[6], k1[7]});
        *(LAS v4u*)(L + KK + (seg + 4) * 1024 + tok * 16) = pack8((f32x4){k2[0], k2[1], k2[2], k2[3]}, (f32x4){k2[4], k2[5], k2[6], k2[7]});
        *(LAS v4u*)(L + KW + tok * 64 + seg * 16) = pack8((f32x4){k1[0], k1[1], k1[2], k1[3]} * kd, (f32x4){k1[4], k1[5], k1[6], k1[7]} * kd);
        *(LAS v4u*)(L + KW + 4096 + tok * 64 + seg * 16) = pack8((f32x4){k2[0], k2[1], k2[2], k2[3]} * kd, (f32x4){k2[4], k2[5], k2[6], k2[7]} * kd);
    } else {
        const int s4 = seg - 4;
        *(LAS v4u*)(L + VV + (s4 >> 1) * 4096 + tok * 64 + (s4 & 1) * 32) = ld[0];
        *(LAS v4u*)(L + VV + (s4 >> 1) * 4096 + tok * 64 + (s4 & 1) * 32 + 16) = ld[1];
    }
    RET_BAR();
    const int kfo = hi * 1024 + r32 * 16;
    const int vfo = ((lane >> 4) & 1) * 32 + (lane & 3) * 8 + (4 * hi + ((lane & 15) >> 2)) * 64;
    const int lb = wid & 1, eb = (wid >> 1) & 1;
    if (wid < 4) {
        bf16x8 qf[4];
#pragma unroll
        for (int ks = 0; ks < 4; ++ks) qf[ks] = *(const LAS bf16x8*)(L + QK + kfo + ks * 2048 + lb * 512);
        f32x16 o;
#pragma unroll
        for (int r = 0; r < 16; ++r) o[r] = 0.f;
        const LAS float* rt = tb + (63 + 4 * hi - 32 * lb - r32);
#pragma unroll
        for (int sb = 0; sb < 2; ++sb) {
            f32x16 T;
#pragma unroll
            for (int r = 0; r < 16; ++r) T[r] = 0.f;
#pragma unroll
            for (int ks = 0; ks < 4; ++ks) { const bf16x8 kf = *(const LAS bf16x8*)(L + KK + kfo + ks * 2048 + sb * 512); T = __builtin_amdgcn_mfma_f32_32x32x16_bf16(kf, qf[ks], T, 0, 0, 0); }
#pragma unroll
            for (int r = 0; r < 16; ++r) T[r] *= rt[32 * sb + (r & 3) + 8 * (r >> 2)];
            const bf16x8 pa0 = packfrag(T, 0), pa1 = packfrag(T, 1);
            const LAS char* vb = L + VV + eb * 4096 + vfo + sb * 2048;
            const bf16x8 v0 = trfrag(vb), v1 = trfrag(vb + 1024);
            o = __builtin_amdgcn_mfma_f32_32x32x16_bf16(pa0, v0, o, 0, 0, 0); o = __builtin_amdgcn_mfma_f32_32x32x16_bf16(pa1, v1, o, 0, 0, 0);
        }
#pragma unroll
        for (int r = 0; r < 16; ++r) os[(32 * lb + crow(r, hi)) * 68 + 32 * eb + r32] = o[r];
    } else {
        f32x16 S;
#pragma unroll
        for (int r = 0; r < 16; ++r) S[r] = 0.f;
#pragma unroll
        for (int ks = 0; ks < 4; ++ks) { const bf16x8 ka = trfrag(L + KW + lb * 4096 + vfo + ks * 1024), vbf = trfrag(L + VV + eb * 4096 + vfo + ks * 1024);
            S = __builtin_amdgcn_mfma_f32_32x32x16_bf16(ka, vbf, S, 0, 0, 0); }
        char* simg = (char*)(F.ws + WS_RST) + ((size_t)((b * 128 + c) * 4 + h)) * 8192;
#pragma unroll
        for (int gq = 0; gq < 4; ++gq) { u32x2 w; w.x = pk2(S[4 * gq], S[4 * gq + 1]); w.y = pk2(S[4 * gq + 2], S[4 * gq + 3]);
            *(u32x2*)(simg + (4 * lb + gq) * 1024 + (32 * eb + r32) * 16 + hi * 8) = w; }
    }
    RET_BAR();
    { const int row = wid * 8 + (lane >> 3), ch = lane & 7;
      const f32x4 a0 = *(const LAS f32x4*)(os + row * 68 + ch * 8), a1 = *(const LAS f32x4*)(os + row * 68 + ch * 8 + 4);
      *(v4u*)((bf16*)(F.ws + WS_OI) + (rowb + row) * 256 + h * 64 + ch * 8) = pack8(a0, a1); }
}

__device__ __forceinline__ void ret_m3_unit(Frame& F_, const Args& A, int l, int b, int c, int h) {
    Frame F = refresh(F_);
    const int tid = F.tid, lane = tid & 63, wid = F.wave, r32 = lane & 31, hi = lane >> 5;
    LAS char* L = (LAS char*)F.lds; LAS float* os = (LAS float*)(L + OS);
    const bf16* PROJ = (const bf16*)(F.ws + WS_BIG); bf16* MIXp = (bf16*)(F.ws + WS_MIX);
    const float lg2 = log2f(1.0f - exp2f(-5.0f - (float)h));
    const size_t rowb = (size_t)b * SEQ + (size_t)c * 64;
    const size_t ioff = ((size_t)((b * 128 + c) * 4 + h)) * 8192;
    const v4u q16 = *(const v4u*)((const char*)(F.ws + WS_QR) + ioff + tid * 16);
#if defined(RTEST) && RTEST == 3
    v4u s16; { const unsigned long long* sp = (const unsigned long long*)((const char*)(F.ws + WS_RST) + ioff + tid * 16);
        const unsigned long long a = __hip_atomic_load(sp, __ATOMIC_RELAXED, __HIP_MEMORY_SCOPE_AGENT), b2 = __hip_atomic_load(sp + 1, __ATOMIC_RELAXED, __HIP_MEMORY_SCOPE_AGENT);
        s16.x = (unsigned)a; s16.y = (unsigned)(a >> 32); s16.z = (unsigned)b2; s16.w = (unsigned)(b2 >> 32); }
#else
    const v4u s16 = *(const v4u*)((const char*)(F.ws + WS_RST) + ioff + tid * 16);
#endif
    const size_t erow = rowb + wid * 8 + (lane >> 3); const int ch = lane & 7;
    const v4u gt = *(const v4u*)(PROJ + erow * NPROJ + PC_RG + h * 64 + ch * 8);
    const v4u oi = *(const v4u*)((const bf16*)(F.ws + WS_OI) + erow * 256 + h * 64 + ch * 8);
    RET_BAR();
#if defined(RTEST) && RTEST == 5
    { v4u qq; qq.x = 0x3f803f80u; qq.y = 0x3f803f80u; qq.z = 0x3f803f80u; qq.w = 0x3f803f80u; (void)q16; *(LAS v4u*)(L + QK + tid * 16) = qq; *(LAS v4u*)(L + SB + tid * 16) = s16; }
#elif defined(RTEST) && RTEST == 6
    { v4u qq; qq.x = 0x3f803f80u; qq.y = 0x3f803f80u; qq.z = 0x3f803f80u; qq.w = 0x3f803f80u; (void)s16; *(LAS v4u*)(L + QK + tid * 16) = q16; *(LAS v4u*)(L + SB + tid * 16) = qq; }
#else
    *(LAS v4u*)(L + QK + tid * 16) = q16; *(LAS v4u*)(L + SB + tid * 16) = s16;
#endif
    RET_BAR();
    if (wid < 4) {
        const int kfo = hi * 1024 + r32 * 16, lb = wid & 1, eb = wid >> 1;
        f32x16 o;
#pragma unroll
        for (int r = 0; r < 16; ++r) o[r] = 0.f;
#pragma unroll
        for (int ks = 0; ks < 4; ++ks) { const bf16x8 qf = *(const LAS bf16x8*)(L + QK + kfo + ks * 2048 + lb * 512), sf = *(const LAS bf16x8*)(L + SB + kfo + ks * 2048 + eb * 512);
            o = __builtin_amdgcn_mfma_f32_32x32x16_bf16(qf, sf, o, 0, 0, 0); }
#pragma unroll
        for (int r = 0; r < 16; ++r) { const int lrow = 32 * lb + crow(r, hi); os[lrow * 68 + 32 * eb + r32] = o[r] * exp2f(lg2 * (float)(lrow + 1)); }
    }
    RET_BAR();
    { const int row = wid * 8 + (lane >> 3);
      f32x4 a0 = *(const LAS f32x4*)(os + row * 68 + ch * 8), a1 = *(const LAS f32x4*)(os + row * 68 + ch * 8 + 4);
#if defined(RTEST) && RTEST == 1
      a0 = lo4(oi); a1 = hi4(oi);
#elif defined(RTEST) && RTEST == 2
      (void)oi;
#else
      a0 += lo4(oi); a1 += hi4(oi);
#endif
      float ss = (a0.x * a0.x + a0.y * a0.y) + (a0.z * a0.z + a0.w * a0.w) + (a1.x * a1.x + a1.y * a1.y) + (a1.z * a1.z + a1.w * a1.w);
      ss += __shfl_xor(ss, 1); ss += __shfl_xor(ss, 2); ss += __shfl_xor(ss, 4);
      const float rstd = __builtin_amdgcn_rsqf(ss * (1.f / 64.f) + EPS);
      const f32x4 g0 = *(const f32x4*)(A.in[18] + l * 64 + ch * 8), g1 = *(const f32x4*)(A.in[18] + l * 64 + ch * 8 + 4);
      const f32x4 z0 = lo4(gt), z1 = hi4(gt);
      v4u w; w.x = pk2(silu_f(z0.x) * a0.x * rstd * g0.x, silu_f(z0.y) * a0.y * rstd * g0.y); w.y = pk2(silu_f(z0.z) * a0.z * rstd * g0.z, silu_f(z0.w) * a0.w * rstd * g0.w);
      w.z = pk2(silu_f(z1.x) * a1.x * rstd * g1.x, silu_f(z1.y) * a1.y * rstd * g1.y); w.w = pk2(silu_f(z1.z) * a1.z * rstd * g1.z, silu_f(z1.w) * a1.w * rstd * g1.w);
      *(v4u*)(MIXp + erow * D + 768 + h * 64 + ch * 8) = w; }
}
}
namespace ssds {
using ssd::u32x2;
using att::f32x16; using att::s16x4; using att::vtr; using att::crow;
constexpr int XS = 0, BK = 32768, CK = 40960, BW = 49152, HB = 81920, SM = 114688, CW = 122880;
constexpr int SM_VL = 0, SM_US = 256, SM_EO = 512, SM_WS = 768, SM_DT = 1024, SM_DK = 1028, SM_AK = 1032, SM_DB = 1036, SM_GN = 1040;
#undef SSD_BAR
#define SSD_BAR() asm volatile("s_waitcnt lgkmcnt(0)\n\ts_barrier" ::: "memory")
using ssd::trfrag;
using ssd::packfrag;

__device__ __forceinline__ void ssd_unit(Frame& F_, const Args& A, int l, int b, int g) {
    Frame F = refresh(F_);
    const int tid = F.tid, lane = tid & 63, wid = F.wave, r32 = lane & 31, hi = lane >> 5, hh = wid >> 1, lh = wid & 1;
    LAS char* L = (LAS char*)F.lds; LAS float* sm = (LAS float*)(L + SM); LAS float* cwl = (LAS float*)(L + CW);
    const bf16* PROJ = (const bf16*)(F.ws + WS_BIG); const float* DTg = (const float*)(F.ws + WS_DT); bf16* MIXp = (bf16*)(F.ws + WS_MIX);
    SSD_BAR();
    for (int i = tid; i < 5 * 384; i += 512) { const int w = i / 384, li = i - w * 384; const int ch = li < 256 ? g * 256 + li : li < 320 ? 512 + g * 64 + (li - 256) : 640 + g * 64 + (li - 320);
        cwl[i] = w < 4 ? A.in[12][(size_t)l * 4 * 768 + w * 768 + ch] : A.in[13][l * 768 + ch]; }
    for (int i = tid; i < 32768 / 16; i += 512) *(LAS v4u*)(L + HB + i * 16) = (v4u){0u, 0u, 0u, 0u};
    if (tid < 256) sm[SM_GN + tid] = A.in[17][l * 512 + g * 256 + tid];
    if (tid < 4) { sm[SM_DK + tid] = A.in[16][l * 8 + g * 4 + tid]; sm[SM_AK + tid] = -__expf(A.in[15][l * 8 + g * 4 + tid]); sm[SM_DB + tid] = A.in[14][l * 8 + g * 4 + tid]; }
    const int tg = tid / 48, cc = tid - tg * 48;
    const int gcol = PC_XBC + (cc < 32 ? g * 256 + cc * 8 : cc < 40 ? 512 + g * 64 + (cc - 32) * 8 : 640 + g * 64 + (cc - 40) * 8);
    const int dsto = cc < 32 ? XS + (cc >> 3) * 8192 + ((cc & 7) >> 2) * 4096 + ((cc & 3) * 8) * 2 : cc < 40 ? BK + (cc - 32) * 1024 : CK + (cc - 40) * 1024;
    const int dstr = cc < 32 ? 64 : 16;
    const size_t rb = (size_t)b * SEQ;
    v4u raw[11];
#define SSD_LOADRAW(c) do { _Pragma("unroll") for (int i = 0; i < 11; ++i) { const int trow = (c) * 64 + 8 * tg - 3 + i; \
        raw[i] = (tid < 384 && trow >= 0) ? *(const v4u*)(PROJ + (rb + trow) * NPROJ + gcol) : (v4u){0u, 0u, 0u, 0u}; } } while (0)
    SSD_LOADRAW(0);
    float dtr[4]; u32x2 zr[8];
#define SSD_LOADDT(c) do { if (wid == 7) { const f32x4 d4 = *(const f32x4*)(DTg + (rb + (c) * 64 + lane) * 8 + g * 4); dtr[0] = d4.x; dtr[1] = d4.y; dtr[2] = d4.z; dtr[3] = d4.w; } } while (0)
#define SSD_LOADZ(c) do { _Pragma("unroll") for (int k = 0; k < 8; ++k) zr[k] = *(const u32x2*)(PROJ + (rb + (c) * 64 + wid * 8 + k) * NPROJ + PC_Z + g * 256 + 4 * lane); } while (0)
    SSD_LOADDT(0);
    f32x16 hacc0, hacc1;
#pragma unroll
    for (int r = 0; r < 16; ++r) { hacc0[r] = 0.f; hacc1[r] = 0.f; }
    const int kfo0 = hi * 1024 + r32 * 16;
    const int vfo0 = ((lane >> 4) & 1) * 32 + (lane & 3) * 8 + (4 * hi + ((lane & 15) >> 2)) * 64;
    SSD_BAR();
    for (int c = 0; c < SEQ / 64; ++c) {
        const size_t rowb = rb + (size_t)c * 64;
        int kfo = kfo0, vfo = vfo0; asm volatile("" : "+v"(kfo), "+v"(vfo));
        if (tid < 384) {
            f32x4 w0a = *(const LAS f32x4*)(cwl + cc * 8), w0b = *(const LAS f32x4*)(cwl + cc * 8 + 4), w1a = *(const LAS f32x4*)(cwl + 384 + cc * 8), w1b = *(const LAS f32x4*)(cwl + 384 + cc * 8 + 4);
            f32x4 w2a = *(const LAS f32x4*)(cwl + 768 + cc * 8), w2b = *(const LAS f32x4*)(cwl + 768 + cc * 8 + 4), w3a = *(const LAS f32x4*)(cwl + 1152 + cc * 8), w3b = *(const LAS f32x4*)(cwl + 1152 + cc * 8 + 4);
            const f32x4 cba = *(const LAS f32x4*)(cwl + 1536 + cc * 8), cbb = *(const LAS f32x4*)(cwl + 1536 + cc * 8 + 4);
#define SSD_LO(q_) ((f32x4){bflo((q_).x), bfhi((q_).x), bflo((q_).y), bfhi((q_).y)})
#define SSD_HI(q_) ((f32x4){bflo((q_).z), bfhi((q_).z), bflo((q_).w), bfhi((q_).w)})
#pragma unroll
            for (int j = 0; j < 8; ++j) {
                f32x4 va = cba + SSD_LO(raw[j]) * w0a + SSD_LO(raw[j + 1]) * w1a + SSD_LO(raw[j + 2]) * w2a + SSD_LO(raw[j + 3]) * w3a;
                f32x4 vb = cbb + SSD_HI(raw[j]) * w0b + SSD_HI(raw[j + 1]) * w1b + SSD_HI(raw[j + 2]) * w2b + SSD_HI(raw[j + 3]) * w3b;
                v4u o; o.x = pk2(silu_f(va.x), silu_f(va.y)); o.y = pk2(silu_f(va.z), silu_f(va.w)); o.z = pk2(silu_f(vb.x), silu_f(vb.y)); o.w = pk2(silu_f(vb.z), silu_f(vb.w));
                *(LAS v4u*)(L + dsto + (8 * tg + j) * dstr) = o;
            }
        } else if (wid == 7) {
            float tot[4];
#pragma unroll
            for (int k = 0; k < 4; ++k) { const float Ak = sm[SM_AK + k], dbk = sm[SM_DB + k];
                const float xr = dtr[k] + dbk; const float dt = xr > 20.f ? xr : log1pf(__expf(xr));
                float acs = Ak * dt;
#pragma unroll
                for (int o = 1; o < 64; o <<= 1) { const float u = __shfl_up(acs, o); if (lane >= o) acs += u; }
                tot[k] = __shfl(acs, 63);
                sm[SM_VL + k * 64 + lane] = acs * LOG2E; sm[SM_US + k * 64 + lane] = acs * LOG2E - __log2f(dt);
                sm[SM_EO + k * 64 + lane] = __expf(acs); sm[SM_WS + k * 64 + lane] = __expf(tot[k] - acs) * dt; }
            if (lane == 0) { sm[SM_DT + 0] = __expf(tot[0]); sm[SM_DT + 1] = __expf(tot[1]); sm[SM_DT + 2] = __expf(tot[2]); sm[SM_DT + 3] = __expf(tot[3]); }
        }
        if (c + 1 < SEQ / 64) { SSD_LOADRAW(c + 1); SSD_LOADDT(c + 1); }
        SSD_BAR();
        { const int s = tid >> 3, nc = tid & 7; const v4u b8 = *(const LAS v4u*)(L + BK + nc * 1024 + s * 16);
          const f32x4 ba = SSD_LO(b8), bb = SSD_HI(b8);
#pragma unroll
          for (int k = 0; k < 4; ++k) { const float w = sm[SM_WS + k * 64 + s]; v4u o; o.x = pk2(ba.x * w, ba.y * w); o.y = pk2(ba.z * w, ba.w * w); o.z = pk2(bb.x * w, bb.y * w); o.w = pk2(bb.z * w, bb.w * w);
              *(LAS v4u*)(L + BW + k * 8192 + (nc >> 2) * 4096 + s * 64 + (nc & 3) * 16) = o; } }
        SSD_BAR();
        SSD_LOADZ(c);
        f32x16 y0, y1;
        {
            bf16x8 cf[4];
#pragma unroll
            for (int ks = 0; ks < 4; ++ks) cf[ks] = *(const LAS bf16x8*)(L + CK + kfo + ks * 2048 + lh * 512);
#pragma unroll
            for (int r = 0; r < 16; ++r) { y0[r] = 0.f; y1[r] = 0.f; }
#pragma unroll
            for (int ks = 0; ks < 4; ++ks) { const bf16x8 h0 = *(const LAS bf16x8*)(L + HB + hh * 8192 + kfo + ks * 2048), h1 = *(const LAS bf16x8*)(L + HB + hh * 8192 + kfo + ks * 2048 + 512);
                y0 = __builtin_amdgcn_mfma_f32_32x32x16_bf16(cf[ks], h0, y0, 0, 0, 0); y1 = __builtin_amdgcn_mfma_f32_32x32x16_bf16(cf[ks], h1, y1, 0, 0, 0); }
#pragma unroll
            for (int r = 0; r < 16; ++r) { const float e = sm[SM_EO + hh * 64 + 32 * lh + crow(r, hi)]; y0[r] *= e; y1[r] *= e; }
            const float vl = sm[SM_VL + hh * 64 + 32 * lh + r32];
#pragma unroll
            for (int sb = 0; sb < 2; ++sb) {
                if (sb <= lh) {
                    f32x16 T;
#pragma unroll
                    for (int r = 0; r < 16; ++r) T[r] = 0.f;
#pragma unroll
                    for (int ks = 0; ks < 4; ++ks) { const bf16x8 bfr = *(const LAS bf16x8*)(L + BK + kfo + ks * 2048 + sb * 512); T = __builtin_amdgcn_mfma_f32_32x32x16_bf16(bfr, cf[ks], T, 0, 0, 0); }
#pragma unroll
                    for (int r = 0; r < 16; ++r) { const float us = sm[SM_US + hh * 64 + 32 * sb + crow(r, hi)]; float w = T[r] * __builtin_amdgcn_exp2f(vl - us);
                        if (sb == lh && crow(r, hi) > r32) w = 0.f; T[r] = w; }
                    const bf16x8 pa0 = packfrag(T, 0), pa1 = packfrag(T, 1);
                    const LAS char* xb = L + XS + hh * 8192 + vfo + sb * 2048;
                    const bf16x8 x00 = trfrag(xb), x01 = trfrag(xb + 4096), x10 = trfrag(xb + 1024), x11 = trfrag(xb + 4096 + 1024);
                    y0 = __builtin_amdgcn_mfma_f32_32x32x16_bf16(pa0, x00, y0, 0, 0, 0); y1 = __builtin_amdgcn_mfma_f32_32x32x16_bf16(pa0, x01, y1, 0, 0, 0);
                    y0 = __builtin_amdgcn_mfma_f32_32x32x16_bf16(pa1, x10, y0, 0, 0, 0); y1 = __builtin_amdgcn_mfma_f32_32x32x16_bf16(pa1, x11, y1, 0, 0, 0);
                }
            }
            const float dtot = sm[SM_DT + hh];
#pragma unroll
            for (int r = 0; r < 16; ++r) { hacc0[r] *= dtot; hacc1[r] *= dtot; }
#pragma unroll
            for (int ks = 0; ks < 4; ++ks) { const bf16x8 xa = trfrag(L + XS + hh * 8192 + lh * 4096 + vfo + ks * 1024), b0 = trfrag(L + BW + hh * 8192 + vfo + ks * 1024), b1 = trfrag(L + BW + hh * 8192 + 4096 + vfo + ks * 1024);
                hacc0 = __builtin_amdgcn_mfma_f32_32x32x16_bf16(xa, b0, hacc0, 0, 0, 0); hacc1 = __builtin_amdgcn_mfma_f32_32x32x16_bf16(xa, b1, hacc1, 0, 0, 0); }
        }
        SSD_BAR();
#pragma unroll
        for (int r = 0; r < 16; ++r) { const int p = 32 * lh + crow(r, hi);
            *(LAS unsigned short*)(L + HB + hh * 8192 + (r32 >> 3) * 1024 + p * 16 + (r32 & 7) * 2) = (unsigned short)f2bf(hacc0[r]);
            *(LAS unsigned short*)(L + HB + hh * 8192 + (4 + (r32 >> 3)) * 1024 + p * 16 + (r32 & 7) * 2) = (unsigned short)f2bf(hacc1[r]);
            const int lrow = 32 * lh + crow(r, hi);
            *(LAS unsigned short*)(L + BW + (lrow * 256 + hh * 64 + r32) * 2) = (unsigned short)f2bf(y0[r]);
            *(LAS unsigned short*)(L + BW + (lrow * 256 + hh * 64 + 32 + r32) * 2) = (unsigned short)f2bf(y1[r]); }
        SSD_BAR();
        const float Dk = sm[SM_DK + (lane >> 4)]; const f32x4 gn4 = *(const LAS f32x4*)(sm + SM_GN + 4 * lane);
#pragma unroll
        for (int k = 0; k < 8; ++k) { const int tk = wid * 8 + k; const int hd = lane >> 4, p = (4 * lane) & 63;
            const u32x2 yv = *(const LAS u32x2*)(L + BW + (tk * 256 + 4 * lane) * 2), xv = *(const LAS u32x2*)(L + XS + hd * 8192 + (p >> 5) * 4096 + tk * 64 + (p & 31) * 2);
            f32x4 v; v.x = (bflo(yv.x) + Dk * bflo(xv.x)) * silu_f(bflo(zr[k].x)); v.y = (bfhi(yv.x) + Dk * bfhi(xv.x)) * silu_f(bfhi(zr[k].x));
            v.z = (bflo(yv.y) + Dk * bflo(xv.y)) * silu_f(bflo(zr[k].y)); v.w = (bfhi(yv.y) + Dk * bfhi(xv.y)) * silu_f(bfhi(zr[k].y));
            const float rstd = __builtin_amdgcn_rsqf(wave_sum((v.x * v.x + v.y * v.y) + (v.z * v.z + v.w * v.w)) * (1.f / 256.f) + EPS);
            u32x2 o; o.x = pk2(v.x * rstd * gn4.x, v.y * rstd * gn4.y); o.y = pk2(v.z * rstd * gn4.z, v.w * rstd * gn4.w);
            *(u32x2*)(MIXp + (rowb + tk) * D + 256 + g * 256 + 4 * lane) = o; }
        SSD_BAR();
    }
#undef SSD_LOADRAW
#undef SSD_LOADDT
#undef SSD_LOADZ
#undef SSD_LO
#undef SSD_HI
}
}
namespace rets {
using att::f32x16; using att::crow; using ssd::trfrag; using ssd::packfrag; using ssd::u32x2;
constexpr int QK = 0, KK = 8192, KW = 16384, VV = 24576, SB = 32768, OS = 40960, TB = 58368;
#undef RET_BAR
#define RET_BAR() asm volatile("s_waitcnt lgkmcnt(0)\n\ts_barrier" ::: "memory")
__device__ __forceinline__ f32x4 lo4(const v4u q_) { return (f32x4){bflo(q_.x), bfhi(q_.x), bflo(q_.y), bfhi(q_.y)}; }
__device__ __forceinline__ f32x4 hi4(const v4u q_) { return (f32x4){bflo(q_.z), bfhi(q_.z), bflo(q_.w), bfhi(q_.w)}; }
__device__ __forceinline__ v4u pack8(const f32x4 a, const f32x4 b) { v4u o; o.x = pk2(a.x, a.y); o.y = pk2(a.z, a.w); o.z = pk2(b.x, b.y); o.w = pk2(b.z, b.w); return o; }

__device__ __forceinline__ void ret_unit(Frame& F_, const Args& A, int l, int b, int h) {
    Frame F = refresh(F_);
    const int tid = F.tid, lane = tid & 63, wid = F.wave, r32 = lane & 31, hi = lane >> 5;
    LAS char* L = (LAS char*)F.lds; LAS float* tb = (LAS float*)(L + TB); LAS float* os = (LAS float*)(L + OS);
    const bf16* PROJ = (const bf16*)(F.ws + WS_BIG); bf16* MIXp = (bf16*)(F.ws + WS_MIX);
    const float gam = 1.0f - exp2f(-5.0f - (float)h), lg2 = log2f(gam), g64 = exp2f(lg2 * 64.f);
    RET_BAR();
    if (tid < 128) tb[tid] = exp2f(lg2 * (float)(tid < 63 ? 63 - tid : tid - 63));
    else if (tid < 192) tb[tid] = exp2f(lg2 * (float)(tid - 128 + 1));
    else if (tid < 256) tb[tid] = exp2f(lg2 * (float)(63 - (tid - 192)));
    for (int i = tid; i < 8192 / 16; i += 512) *(LAS v4u*)(L + SB + i * 16) = (v4u){0u, 0u, 0u, 0u};
    const int tok = tid >> 3, seg = tid & 7;
    const size_t rb = (size_t)b * SEQ;
    v4u ld[4];
#define RET_LOAD(c) do { const bf16* rp = PROJ + (rb + (c) * 64 + tok) * NPROJ; \
        if (seg < 4) { ld[0] = *(const v4u*)(rp + PC_RQ + h * 64 + seg * 8); ld[1] = *(const v4u*)(rp + PC_RQ + h * 64 + 32 + seg * 8); ld[2] = *(const v4u*)(rp + PC_RK + h * 64 + seg * 8); ld[3] = *(const v4u*)(rp + PC_RK + h * 64 + 32 + seg * 8); } \
        else { ld[0] = *(const v4u*)(rp + PC_RV + h * 64 + (seg - 4) * 16); ld[1] = *(const v4u*)(rp + PC_RV + h * 64 + (seg - 4) * 16 + 8); } } while (0)
    RET_LOAD(0);
    f32x16 Sacc;
#pragma unroll
    for (int r = 0; r < 16; ++r) Sacc[r] = 0.f;
    const int kfo0 = hi * 1024 + r32 * 16;
    const int vfo0 = ((lane >> 4) & 1) * 32 + (lane & 3) * 8 + (4 * hi + ((lane & 15) >> 2)) * 64;
    const int lb = wid & 1, eb = (wid >> 1) & 1;
    RET_BAR();
    for (int c = 0; c < SEQ / 64; ++c) {
        int kfo = kfo0, vfo = vfo0; asm volatile("" : "+v"(kfo), "+v"(vfo));
        if (seg < 4) {
            const f32x4 qla = lo4(ld[0]), qlb = hi4(ld[0]), qha = lo4(ld[1]), qhb = hi4(ld[1]), kla = lo4(ld[2]), klb = hi4(ld[2]), kha = lo4(ld[3]), khb = hi4(ld[3]);
            float ql[8] = {qla.x, qla.y, qla.z, qla.w, qlb.x, qlb.y, qlb.z, qlb.w}, qh[8] = {qha.x, qha.y, qha.z, qha.w, qhb.x, qhb.y, qhb.z, qhb.w};
            float kl[8] = {kla.x, kla.y, kla.z, kla.w, klb.x, klb.y, klb.z, klb.w}, kh[8] = {kha.x, kha.y, kha.z, kha.w, khb.x, khb.y, khb.z, khb.w};
            float q1[8], q2[8], k1[8], k2[8];
            const float pos = (float)(c * 64 + tok);
#pragma unroll
            for (int i = 0; i < 8; ++i) { const int fi = seg * 8 + i; const float invf = exp2f(-(float)fi * (13.287712379549449f / 32.0f)); const float ang = pos * invf;
                double rev = (double)ang * 0.15915494309189535; rev -= __builtin_rint(rev); const float fr = (float)rev;
                const float sn = __builtin_amdgcn_sinf(fr), cs = __builtin_amdgcn_cosf(fr);
                q1[i] = ql[i] * cs - qh[i] * sn; q2[i] = ql[i] * sn + qh[i] * cs; k1[i] = kl[i] * cs - kh[i] * sn; k2[i] = kl[i] * sn + kh[i] * cs; }
            const float kd = tb[192 + tok];
            *(LAS v4u*)(L + QK + seg * 1024 + tok * 16) = pack8((f32x4){q1[0], q1[1], q1[2], q1[3]}, (f32x4){q1[4], q1[5], q1[6], q1[7]});
            *(LAS v4u*)(L + QK + (seg + 4) * 1024 + tok * 16) = pack8((f32x4){q2[0], q2[1], q2[2], q2[3]}, (f32x4){q2[4], q2[5], q2[6], q2[7]});
            *(LAS v4u*)(L + KK + seg * 1024 + tok * 16) = pack8((f32x4){k1[0], k1[1], k1[2], k1[3]}, (f32x4){k1[4], k1[5], k1[6], k1[7]});
            *(LAS v4u*)(L + KK + (seg + 4) * 1024 + tok * 16) = pack8((f32x4){k2[0], k2[1], k2[2], k2[3]}, (f32x4){k2[4], k2[5], k2[6], k2[7]});
            *(LAS v4u*)(L + KW + tok * 64 + seg * 16) = pack8((f32x4){k1[0], k1[1], k1[2], k1[3]} * kd, (f32x4){k1[4], k1[5], k1[6], k1[7]} * kd);
            *(LAS v4u*)(L + KW + 4096 + tok * 64 + seg * 16) = pack8((f32x4){k2[0], k2[1], k2[2], k2[3]} * kd, (f32x4){k2[4], k2[5], k2[6], k2[7]} * kd);
        } else {
            const int s4 = seg - 4;
            *(LAS v4u*)(L + VV + (s4 >> 1) * 4096 + tok * 64 + (s4 & 1) * 32) = ld[0];
            *(LAS v4u*)(L + VV + (s4 >> 1) * 4096 + tok * 64 + (s4 & 1) * 32 + 16) = ld[1];
        }
        if (c + 1 < SEQ / 64) RET_LOAD(c + 1);
        const size_t erow = rb + (size_t)c * 64 + wid * 8 + (lane >> 3);
        const v4u gt = *(const v4u*)(PROJ + erow * NPROJ + PC_RG + h * 64 + (lane & 7) * 8);
        RET_BAR();
        f32x16 o;
        if (wid < 4) {
            bf16x8 qf[4];
#pragma unroll
            for (int ks = 0; ks < 4; ++ks) qf[ks] = *(const LAS bf16x8*)(L + QK + kfo + ks * 2048 + lb * 512);
#pragma unroll
            for (int r = 0; r < 16; ++r) o[r] = 0.f;
#pragma unroll
            for (int ks = 0; ks < 4; ++ks) { const bf16x8 sf = *(const LAS bf16x8*)(L + SB + kfo + ks * 2048 + eb * 512); o = __builtin_amdgcn_mfma_f32_32x32x16_bf16(qf[ks], sf, o, 0, 0, 0); }
#pragma unroll
            for (int r = 0; r < 16; ++r) o[r] *= tb[128 + 32 * lb + crow(r, hi)];
            const LAS float* rt = tb + (63 + 4 * hi - 32 * lb - r32);
#pragma unroll
            for (int sb = 0; sb < 2; ++sb) {
                f32x16 T;
#pragma unroll
                for (int r = 0; r < 16; ++r) T[r] = 0.f;
#pragma unroll
                for (int ks = 0; ks < 4; ++ks) { const bf16x8 kf = *(const LAS bf16x8*)(L + KK + kfo + ks * 2048 + sb * 512); T = __builtin_amdgcn_mfma_f32_32x32x16_bf16(kf, qf[ks], T, 0, 0, 0); }
#pragma unroll
                for (int r = 0; r < 16; ++r) T[r] *= rt[32 * sb + (r & 3) + 8 * (r >> 2)];
                const bf16x8 pa0 = packfrag(T, 0), pa1 = packfrag(T, 1);
                const LAS char* vb = L + VV + eb * 4096 + vfo + sb * 2048;
                const bf16x8 v0 = trfrag(vb), v1 = trfrag(vb + 1024);
                o = __builtin_amdgcn_mfma_f32_32x32x16_bf16(pa0, v0, o, 0, 0, 0); o = __builtin_amdgcn_mfma_f32_32x32x16_bf16(pa1, v1, o, 0, 0, 0);
            }
        } else {
#pragma unroll
            for (int r = 0; r < 16; ++r) Sacc[r] *= g64;
#pragma unroll
            for (int ks = 0; ks < 4; ++ks) { const bf16x8 ka = trfrag(L + KW + lb * 4096 + vfo + ks * 1024), vbf = trfrag(L + VV + eb * 4096 + vfo + ks * 1024);
                Sacc = __builtin_amdgcn_mfma_f32_32x32x16_bf16(ka, vbf, Sacc, 0, 0, 0); }
        }
        RET_BAR();
        if (wid < 4) {
#pragma unroll
            for (int r = 0; r < 16; ++r) os[(32 * lb + crow(r, hi)) * 68 + 32 * eb + r32] = o[r];
        } else {
#pragma unroll
            for (int gq = 0; gq < 4; ++gq) { u32x2 w; w.x = pk2(Sacc[4 * gq], Sacc[4 * gq + 1]); w.y = pk2(Sacc[4 * gq + 2], Sacc[4 * gq + 3]);
                *(LAS u32x2*)(L + SB + (4 * lb + gq) * 1024 + (32 * eb + r32) * 16 + hi * 8) = w; }
        }
        RET_BAR();
        { const int row = wid * 8 + (lane >> 3), ch = lane & 7;
          const f32x4 a0 = *(const LAS f32x4*)(os + row * 68 + ch * 8), a1 = *(const LAS f32x4*)(os + row * 68 + ch * 8 + 4);
          float ss = (a0.x * a0.x + a0.y * a0.y) + (a0.z * a0.z + a0.w * a0.w) + (a1.x * a1.x + a1.y * a1.y) + (a1.z * a1.z + a1.w * a1.w);
          ss += __shfl_xor(ss, 1); ss += __shfl_xor(ss, 2); ss += __shfl_xor(ss, 4);
          const float rstd = __builtin_amdgcn_rsqf(ss * (1.f / 64.f) + EPS);
          const f32x4 g0 = *(const f32x4*)(A.in[18] + l * 64 + ch * 8), g1 = *(const f32x4*)(A.in[18] + l * 64 + ch * 8 + 4);
          const f32x4 z0 = lo4(gt), z1 = hi4(gt);
          v4u w; w.x = pk2(silu_f(z0.x) * a0.x * rstd * g0.x, silu_f(z0.y) * a0.y * rstd * g0.y); w.y = pk2(silu_f(z0.z) * a0.z * rstd * g0.z, silu_f(z0.w) * a0.w * rstd * g0.w);
          w.z = pk2(silu_f(z1.x) * a1.x * rstd * g1.x, silu_f(z1.y) * a1.y * rstd * g1.y); w.w = pk2(silu_f(z1.z) * a1.z * rstd * g1.z, silu_f(z1.w) * a1.w * rstd * g1.w);
          *(v4u*)(MIXp + erow * D + 768 + h * 64 + ch * 8) = w; }
    }
    RET_BAR();
#undef RET_LOAD
}
}
__device__ __forceinline__ void attn_naive_unit(Frame& F_, const Args& A, int l, int b, int h, int qb, float lam, float lam_init) {
    Frame F = refresh(F_);
    LAS float* Ks = (LAS float*)F.lds;
    LAS float* Vs = Ks + 4096;
    LAS float* Bt = Vs + 4096;
    LAS float* Ob = (LAS float*)(F.lds + 36864);
    const int tid = F.tid, t = tid >> 8, r = tid & 255;
    const int Q0 = qb * 256, row = Q0 + r; const size_t grow = (size_t)b * SEQ + row;
    const bf16* PROJ = (const bf16*)(F.ws + WS_BIG);
    __syncthreads();
    if (tid < 192) Bt[tid] = A.in[6][t5_bucket(tid - 128) * 4 + h] * LOG2E;
    f32x4 q4[8];
    { const v4u* qp = (const v4u*)(PROJ + grow * NPROJ + PC_Q + h * 64 + t * 32);
#pragma unroll
      for (int i = 0; i < 4; ++i) { const v4u w = qp[i]; q4[2 * i] = (f32x4){bflo(w.x), bfhi(w.x), bflo(w.y), bfhi(w.y)}; q4[2 * i + 1] = (f32x4){bflo(w.z), bfhi(w.z), bflo(w.w), bfhi(w.w)}; } }
    f32x4 O4[16];
#pragma unroll
    for (int e = 0; e < 16; ++e) O4[e] = (f32x4){0.f, 0.f, 0.f, 0.f};
    float mrun = -1.0e30f, lsum = 0.f;
    const int cq = row >> 6, nck = (Q0 >> 6) + 4;
    for (int ck = 0; ck < nck; ++ck) {
        __syncthreads();
        { const int key = tid >> 3, seg = tid & 7; const bf16* kp = PROJ + ((size_t)b * SEQ + ck * 64 + key) * NPROJ + PC_K + h * 64 + seg * 8;
          const v4u kw = *(const v4u*)kp, vw = *(const v4u*)(kp + 256);
          LAS f32x4* kd = (LAS f32x4*)(Ks + (seg >> 2) * 2048 + key * 32 + (seg & 3) * 8); LAS f32x4* vd = (LAS f32x4*)(Vs + key * 64 + seg * 8);
          kd[0] = (f32x4){bflo(kw.x), bfhi(kw.x), bflo(kw.y), bfhi(kw.y)}; kd[1] = (f32x4){bflo(kw.z), bfhi(kw.z), bflo(kw.w), bfhi(kw.w)};
          vd[0] = (f32x4){bflo(vw.x), bfhi(vw.x), bflo(vw.y), bfhi(vw.y)}; vd[1] = (f32x4){bflo(vw.z), bfhi(vw.z), bflo(vw.w), bfhi(vw.w)}; }
        __syncthreads();
        if (ck <= cq) {
            const int kbase = ck * 64 - row;
#pragma unroll 1
            for (int j = 0; j < 64; ++j) {
                const LAS f32x4* kr = (const LAS f32x4*)(Ks + t * 2048 + j * 32);
                f32x4 a4 = q4[0] * kr[0];
#pragma unroll
                for (int d = 1; d < 8; ++d) a4 += q4[d] * kr[d];
                int rel = kbase + j; rel = rel < -128 ? -128 : rel;
                const float sj = (a4.x + a4.y) + (a4.z + a4.w) + Bt[rel + 128];
                if (sj > mrun) { const float sc = __builtin_amdgcn_exp2f(mrun - sj); lsum *= sc;
#pragma unroll
                    for (int e = 0; e < 16; ++e) O4[e] *= sc;
                    mrun = sj; }
                const float p = __builtin_amdgcn_exp2f(sj - mrun); lsum += p;
                const LAS f32x4* vr = (const LAS f32x4*)(Vs + j * 64);
#pragma unroll
                for (int e = 0; e < 16; ++e) O4[e] += vr[e] * p;
            }
        }
    }
    __syncthreads();
    const float inv = 1.0f / lsum;
    if (t == 1) {
#pragma unroll
        for (int e = 0; e < 16; ++e) *(LAS f32x4*)(Ob + r * 68 + 4 * e) = O4[e] * inv; }
    __syncthreads();
    if (t == 0) { f32x4 ss4 = (f32x4){0.f, 0.f, 0.f, 0.f};
#pragma unroll
        for (int e = 0; e < 16; ++e) { const f32x4 o = O4[e] * inv - *(const LAS f32x4*)(Ob + r * 68 + 4 * e) * lam; O4[e] = o; ss4 += o * o; }
        const float rstd = __builtin_amdgcn_rsqf(((ss4.x + ss4.y) + (ss4.z + ss4.w)) * (1.f / 64.f) + EPS) * (1.0f - lam_init);
        const f32x4* gn = (const f32x4*)(A.in[11] + l * 64); v4u* op = (v4u*)((bf16*)(F.ws + WS_MIX) + grow * D + h * 64);
#pragma unroll
        for (int e = 0; e < 16; e += 2) { const f32x4 o0 = O4[e] * gn[e] * rstd, o1 = O4[e + 1] * gn[e + 1] * rstd;
            v4u w; w.x = pk2(o0.x, o0.y); w.y = pk2(o0.z, o0.w); w.z = pk2(o1.x, o1.y); w.w = pk2(o1.z, o1.w); op[e >> 1] = w; } }
    __syncthreads();
}

__device__ __forceinline__ void ssd_naive_unit(Frame& F_, const Args& A, int l, int b, int g) {
    Frame F = refresh(F_);
    LAS float* xs = (LAS float*)F.lds;
    LAS float* Bs = xs + 64 * 256;
    LAS float* Cs = Bs + 4096;
    LAS float* dts = Cs + 4096;
    LAS float* dAs = dts + 256;
    const int tid = F.tid, hh = tid >> 7, p = (tid & 127) >> 1, nh = tid & 1, head = g * 4 + hh;
    const float Dk = A.in[16][l * 8 + head];
    float hst[32];
#pragma unroll
    for (int i = 0; i < 32; ++i) hst[i] = 0.f;
    int ch = 0; float w0 = 0.f, w1 = 0.f, w2 = 0.f, w3 = 0.f, cb = 0.f, r0 = 0.f, r1 = 0.f, r2 = 0.f;
    if (tid < 384) { ch = tid < 256 ? g * 256 + tid : tid < 320 ? 512 + g * 64 + (tid - 256) : 640 + g * 64 + (tid - 320);
        const float* cw = A.in[12] + (size_t)l * 4 * 768; w0 = cw[ch]; w1 = cw[768 + ch]; w2 = cw[2 * 768 + ch]; w3 = cw[3 * 768 + ch]; cb = A.in[13][l * 768 + ch]; }
    for (int c = 0; c < SEQ / 64; ++c) {
        __syncthreads();
        const size_t rowb = (size_t)b * SEQ + c * 64;
        if (tid < 384) { const bf16* src = ((bf16*)(F.ws + WS_BIG)) + rowb * NPROJ + PC_XBC + ch; LAS float* dst = tid < 256 ? xs + tid : tid < 320 ? Bs + (tid - 256) : Cs + (tid - 320); const int dstr = tid < 256 ? 256 : 64;
            _Pragma("unroll 16") for (int tt = 0; tt < 64; ++tt) { const float r3 = bf2f(src[(size_t)tt * NPROJ]); const float v = cb + r0 * w0 + r1 * w1 + r2 * w2 + r3 * w3; dst[tt * dstr] = silu_f(v); r0 = r1; r1 = r2; r2 = r3; } }
        else if (tid < 384 + 64) { const int tt = tid - 384;
#pragma unroll
            for (int k = 0; k < 4; ++k) { const int hd = g * 4 + k; const float xr = ((float*)(F.ws + WS_DT))[(rowb + tt) * 8 + hd] + A.in[14][l * 8 + hd]; const float dt = xr > 20.f ? xr : log1pf(__expf(xr));
                dts[tt * 4 + k] = dt; dAs[tt * 4 + k] = __expf(-__expf(A.in[15][l * 8 + hd]) * dt); } }
        __syncthreads();
        for (int tt = 0; tt < 64; ++tt) {
            const float x = xs[tt * 256 + hh * 64 + p], dt = dts[tt * 4 + hh], dA = dAs[tt * 4 + hh], cx = dt * x;
            const LAS float* Br = Bs + tt * 64 + nh * 32; const LAS float* Cr = Cs + tt * 64 + nh * 32; float a = 0.f;
#pragma unroll
            for (int i = 0; i < 32; i += 4) { const f32x4 bb = *(const LAS f32x4*)(Br + i), cc = *(const LAS f32x4*)(Cr + i);
                hst[i] = hst[i] * dA + cx * bb.x; hst[i + 1] = hst[i + 1] * dA + cx * bb.y; hst[i + 2] = hst[i + 2] * dA + cx * bb.z; hst[i + 3] = hst[i + 3] * dA + cx * bb.w;
                a += (hst[i] * cc.x + hst[i + 1] * cc.y) + (hst[i + 2] * cc.z + hst[i + 3] * cc.w); }
            a += __shfl_xor(a, 1);
            if (nh == 0) xs[tt * 256 + hh * 64 + p] = a + Dk * x;
        }
        __syncthreads();
        for (int k = 0; k < 8; ++k) { const int tt = F.wave * 8 + k; const size_t row = rowb + tt;
            const f32x4 y = *(const LAS f32x4*)(xs + tt * 256 + 4 * F.lane); const uint2 zz = *(const uint2*)(((bf16*)(F.ws + WS_BIG)) + row * NPROJ + PC_Z + g * 256 + 4 * F.lane);
            f32x4 v; v.x = y.x * silu_f(bflo(zz.x)); v.y = y.y * silu_f(bfhi(zz.x)); v.z = y.z * silu_f(bflo(zz.y)); v.w = y.w * silu_f(bfhi(zz.y));
            const float rstd = __builtin_amdgcn_rsqf(wave_sum((v.x * v.x + v.y * v.y) + (v.z * v.z + v.w * v.w)) * (1.f / 256.f) + EPS);
            const f32x4 gn = *(const f32x4*)(A.in[17] + l * 512 + g * 256 + 4 * F.lane);
            uint2 o; o.x = pk2(v.x * rstd * gn.x, v.y * rstd * gn.y); o.y = pk2(v.z * rstd * gn.z, v.w * rstd * gn.w);
            *(uint2*)(((bf16*)(F.ws + WS_MIX)) + row * D + 256 + g * 256 + 4 * F.lane) = o; }
    }
    __syncthreads();
}

__device__ __forceinline__ void ret_naive_unit(Frame& F_, const Args& A, int l, int b, int h) {
    Frame F = refresh(F_);
    constexpr int ST = 68;
    LAS float* qs = (LAS float*)F.lds; LAS float* ks = qs + 64 * ST; LAS float* vs = ks + 64 * ST; LAS float* sc = vs + 64 * ST; LAS float* Ss = sc + 64 * ST; LAS float* os = Ss + 64 * ST;
    const int tid = F.tid, ra = tid >> 3, eg = tid & 7;
    const float gam = 1.0f - exp2f(-5.0f - (float)h), lg2 = log2f(gam), g64 = exp2f(lg2 * 64.f);
    float Sreg[8];
#pragma unroll
    for (int i = 0; i < 8; ++i) Sreg[i] = 0.f;
    __syncthreads();
#pragma unroll
    for (int i = 0; i < 8; ++i) Ss[ra * ST + eg * 8 + i] = 0.f;
    for (int c = 0; c < SEQ / 64; ++c) {
        __syncthreads();
        const size_t rowb = (size_t)b * SEQ + c * 64;
        { const int tok = ra, seg = eg; const bf16* rp = ((bf16*)(F.ws + WS_BIG)) + (rowb + tok) * NPROJ;
          if (seg < 4) { float ql[8], qh[8], kl[8], kh[8];
              unpack8(*(const v4u*)(rp + PC_RQ + h * 64 + seg * 8), ql); unpack8(*(const v4u*)(rp + PC_RQ + h * 64 + 32 + seg * 8), qh);
              unpack8(*(const v4u*)(rp + PC_RK + h * 64 + seg * 8), kl); unpack8(*(const v4u*)(rp + PC_RK + h * 64 + 32 + seg * 8), kh);
              const float pos = (float)(c * 64 + tok);
#pragma unroll
              for (int i = 0; i < 8; ++i) { const int fi = seg * 8 + i; const float invf = exp2f(-(float)fi * (13.287712379549449f / 32.0f)); const float ang = pos * invf;
                  double rev = (double)ang * 0.15915494309189535; rev -= __builtin_rint(rev); const float fr = (float)rev;
                  const float sn = __builtin_amdgcn_sinf(fr), cs = __builtin_amdgcn_cosf(fr);
                  qs[tok * ST + fi] = ql[i] * cs - qh[i] * sn; qs[tok * ST + fi + 32] = ql[i] * sn + qh[i] * cs;
                  ks[tok * ST + fi] = kl[i] * cs - kh[i] * sn; ks[tok * ST + fi + 32] = kl[i] * sn + kh[i] * cs; } }
          else { float va[8], vb[8]; const int c0 = (seg - 4) * 16; unpack8(*(const v4u*)(rp + PC_RV + h * 64 + c0), va); unpack8(*(const v4u*)(rp + PC_RV + h * 64 + c0 + 8), vb);
#pragma unroll
              for (int i = 0; i < 8; ++i) { vs[tok * ST + c0 + i] = va[i]; vs[tok * ST + c0 + 8 + i] = vb[i]; } } }
        __syncthreads();
        { float a[8];
#pragma unroll
          for (int jj = 0; jj < 8; ++jj) a[jj] = 0.f;
          for (int d = 0; d < 64; d += 4) { const f32x4 qq = *(const LAS f32x4*)(qs + ra * ST + d);
#pragma unroll
              for (int jj = 0; jj < 8; ++jj) { const f32x4 kk = *(const LAS f32x4*)(ks + (jj * 8 + eg) * ST + d); a[jj] += (qq.x * kk.x + qq.y * kk.y) + (qq.z * kk.z + qq.w * kk.w); } }
#pragma unroll
          for (int jj = 0; jj < 8; ++jj) { const int s = jj * 8 + eg; const int dd = ra > s ? ra - s : s - ra; sc[ra * ST + s] = a[jj] * exp2f(lg2 * (float)dd); } }
        __syncthreads();
        { float a[8];
#pragma unroll
          for (int i = 0; i < 8; ++i) a[i] = 0.f;
          for (int s = 0; s < 64; ++s) { const float w = sc[ra * ST + s]; const f32x4 v0 = *(const LAS f32x4*)(vs + s * ST + eg * 8), v1 = *(const LAS f32x4*)(vs + s * ST + eg * 8 + 4);
              a[0] += w * v0.x; a[1] += w * v0.y; a[2] += w * v0.z; a[3] += w * v0.w; a[4] += w * v1.x; a[5] += w * v1.y; a[6] += w * v1.z; a[7] += w * v1.w; }
          const float qd = exp2f(lg2 * (float)(ra + 1));
          for (int d = 0; d < 64; ++d) { const float w = qs[ra * ST + d] * qd; const f32x4 v0 = *(const LAS f32x4*)(Ss + d * ST + eg * 8), v1 = *(const LAS f32x4*)(Ss + d * ST + eg * 8 + 4);
              a[0] += w * v0.x; a[1] += w * v0.y; a[2] += w * v0.z; a[3] += w * v0.w; a[4] += w * v1.x; a[5] += w * v1.y; a[6] += w * v1.z; a[7] += w * v1.w; }
#pragma unroll
          for (int i = 0; i < 8; ++i) os[ra * ST + eg * 8 + i] = a[i]; }
        __syncthreads();
        { float a[8];
#pragma unroll
          for (int i = 0; i < 8; ++i) a[i] = 0.f;
          for (int s = 0; s < 64; ++s) { const float w = ks[s * ST + ra] * exp2f(lg2 * (float)(63 - s)); const f32x4 v0 = *(const LAS f32x4*)(vs + s * ST + eg * 8), v1 = *(const LAS f32x4*)(vs + s * ST + eg * 8 + 4);
              a[0] += w * v0.x; a[1] += w * v0.y; a[2] += w * v0.z; a[3] += w * v0.w; a[4] += w * v1.x; a[5] += w * v1.y; a[6] += w * v1.z; a[7] += w * v1.w; }
#pragma unroll
          for (int i = 0; i < 8; ++i) { Sreg[i] = Sreg[i] * g64 + a[i]; Ss[ra * ST + eg * 8 + i] = Sreg[i]; } }
        for (int k = 0; k < 8; ++k) { const int tok = F.wave * 8 + k; const size_t row = rowb + tok;
            const float v = os[tok * ST + F.lane]; const float rstd = __builtin_amdgcn_rsqf(wave_sum(v * v) * (1.f / 64.f) + EPS);
            const float gt = bf2f(((bf16*)(F.ws + WS_BIG))[row * NPROJ + PC_RG + h * 64 + F.lane]);
            ((bf16*)(F.ws + WS_MIX))[row * D + 768 + h * 64 + F.lane] = (bf16)f2bf(silu_f(gt) * v * rstd * A.in[18][l * 64 + F.lane]); }
    }
    __syncthreads();
}
__device__ __forceinline__ void mixer_2a(Frame& F, const Args& A, int l) {
    for (int u = F.bx; u < 1536; u += F.G) {
#if !defined(BISECT) || BISECT != 2
        if (u < 512) ssd::ssd_m1_unit(F, A, l, u >> 8, (u >> 1) & 127, u & 1);
#else
        if (u < 512) {}
#endif
#if !defined(BISECT) || BISECT != 1
        else { const int v = u - 512; ret::ret_m1_unit(F, A, l, v >> 9, (v >> 2) & 127, v & 3); }
#endif
    }
}
__device__ __forceinline__ void mixer_2b(Frame& F_, const Args& A, int l) {
    Frame F = refresh(F_);
    const float lam_init = 0.8f - 0.6f * __expf(-0.3f * (float)l);
    float d1 = 0.f, d2 = 0.f;
    for (int i = 0; i < 32; ++i) { d1 += A.in[7][l * 32 + i] * A.in[8][l * 32 + i]; d2 += A.in[9][l * 32 + i] * A.in[10][l * 32 + i]; }
    const float lam = __expf(d1) - __expf(d2) + lam_init;
    if (F.bx < 64) ssd::scan_unit(F, 0, F.bx); else if (F.bx < 96) ssd::scan_unit(F, 1, F.bx - 64);
    const int na = F.G, j = F.bx;
    const int wpos = (F.bx >> 3) % 3;
    for (int rnd = 0; rnd < 3 || rnd * na < 512; ++rnd) {
#ifndef EXPERTS_IN_P0
        if (l == 0 && rnd == wpos) expert_weights(F, A);
#endif
        const int i = (rnd & 1) ? (rnd + 1) * na - 1 - j : rnd * na + j;
        if (i < 512) { const int qb = 63 - (i >> 3), bh = i & 7; att::attn_unit(F, A, l, bh >> 2, bh & 3, qb, lam, 1.0f - lam_init);
#if defined(DBL_PHASE) && DBL_PHASE == 23
            att::attn_unit(F, A, l, bh >> 2, bh & 3, qb, lam, 1.0f - lam_init);
#endif
        }
    }
}
__device__ __forceinline__ void mixer_2c(Frame& F, const Args& A, int l) {
    for (int u = F.bx; u < 1536; u += F.G) {
#if !defined(BISECT) || BISECT != 2
        if (u < 512) ssd::ssd_m3_unit(F, A, l, u >> 8, (u >> 1) & 127, u & 1);
#else
        if (u < 512) {}
#endif
#if !defined(BISECT) || BISECT != 1
        else { const int v = u - 512; ret::ret_m3_unit(F, A, l, v >> 9, (v >> 2) & 127, v & 3); }
#endif
    }
}
__device__ __forceinline__ void gather_phase(Frame& F_) {
    Frame F = refresh(F_);
    const int gw = F.bx * NWAVES + F.wave, NGW = F.G * NWAVES, nrows = F.META[16] * 256;
    const v4u* XN8 = (const v4u*)(F.ws + WS_XN); v4u* XG8 = (v4u*)(F.ws + WS_XG8); const int* LIST = (const int*)(F.ws + WS_LIST);
    const float* XNS = (const float*)(F.ws + WS_XNS); float* XGS = (float*)(F.ws + WS_XGS);
    for (int row0 = gw; row0 < nrows; row0 += 4 * NGW) {
        int tok[4]; bool ok[4];
#pragma unroll
        for (int i = 0; i < 4; ++i) { const int row = row0 + i * NGW; ok[i] = false; tok[i] = 0;
            if (row < nrows) { const int p = row >> 8, r = row & 255; int e = 0;
#pragma unroll
                for (int k = 1; k < 8; ++k) e += (p >= F.META[8 + k]) ? 1 : 0;
                const int pos = (p - F.META[8 + e]) * 256 + r;
                if (pos < F.META[e]) { ok[i] = true; tok[i] = LIST[e * 16384 + pos]; } } }
        v4u a[4]; float s[4];
#pragma unroll
        for (int i = 0; i < 4; ++i) { a[i] = (v4u){0u, 0u, 0u, 0u}; s[i] = 0.f; if (ok[i]) { a[i] = XN8[(size_t)tok[i] * 64 + F.lane]; s[i] = XNS[tok[i]]; } }
#pragma unroll
        for (int i = 0; i < 4; ++i) { const int row = row0 + i * NGW; if (row < nrows) { XG8[(size_t)row * 64 + F.lane] = a[i]; if (F.lane == 0) XGS[row] = s[i]; } }
    }
}
__device__ __forceinline__ void zero_yacc(Frame& F_) {
    Frame F = refresh(F_);
    v4u* za = (v4u*)(F.ws + WS_XN);
    for (size_t i = (size_t)F.bx * 512 + F.tid; i < (size_t)8 * 256 * 1024 / 4; i += (size_t)F.G * 512) za[i] = (v4u){0u, 0u, 0u, 0u};
}
#if defined(DBL_PHASE) && DBL_PHASE == 40
#define GRID_BAR() do { xcd_barrier(bar); xcd_barrier(bar); } while (0)
#else
#define GRID_BAR() xcd_barrier(bar)
#endif
#ifndef DBL_PHASE
#define DBL_PHASE -1
#endif
#ifdef PROBE_A
#define STAMP(i) do { if (F.bx == 0 && threadIdx.x == 0) ((LAS unsigned long long*)(F.lds + LDSCTL_OFF + 2048))[i] = __builtin_amdgcn_s_memrealtime(); } while (0)
#else
#define STAMP(i) do { } while (0)
#endif
#define WSB(off) ((bf16*)(F.ws + (off)))
template <int l>
__device__ __forceinline__ void layer_body(Frame& F, const Args& args, const XcdBarrier& bar) {

        { pg8::Gemm g{WSB(WS_XN), (const bf16*)((const signed char*)(F.ws + WS_WIN) + (size_t)l * NPROJ * D), D / 2}; pg8::StaticOrder S; S.init(M, NPROJ, F.G, F.bx);
          pg8::EpiBf16S E{WSB(WS_BIG), NPROJ, (const float*)(F.ws + WS_XNS), (const float*)(F.ws + WS_SBI) + l * NPROJ};
          pg8::gemm_phase<pg8::EpiBf16S, pg8::StaticOrder, true, true>(F.lds, g, S, E); }
#if DBL_PHASE == 1
        { pg8::Gemm g{WSB(WS_XN), (const bf16*)((const signed char*)(F.ws + WS_WIN) + (size_t)l * NPROJ * D), D / 2}; pg8::StaticOrder S; S.init(M, NPROJ, F.G, F.bx);
          pg8::EpiBf16S E{WSB(WS_BIG), NPROJ, (const float*)(F.ws + WS_XNS), (const float*)(F.ws + WS_SBI) + l * NPROJ};
          pg8::gemm_phase<pg8::EpiBf16S, pg8::StaticOrder, true, true>(F.lds, g, S, E); }
#endif
        GRID_BAR(); STAMP(1 + 1 + (l == 0 ? 0 : 7));
        mixer_2a(F, args, l);
#if DBL_PHASE == 20
        mixer_2a(F, args, l);
#endif
        GRID_BAR();
        mixer_2b(F, args, l);
#if DBL_PHASE == 21
        mixer_2b(F, args, l);
#endif
        GRID_BAR();
        mixer_2c(F, args, l);
#if DBL_PHASE == 22
        mixer_2c(F, args, l);
#endif
        GRID_BAR(); STAMP(1 + 2 + (l == 0 ? 0 : 7));
        { pg8::Gemm g{WSB(WS_MIX), WSB(WS_WOUT) + (size_t)l * D * D, D}; pg8::StaticOrder S; S.init(M, D, F.G, F.bx);
          if constexpr (l == 0) { pg8::EpiResBf<true> E{args.in[0], WSB(WS_XR), D, nullptr}; pg8::gemm_phase<pg8::EpiResBf<true>, pg8::StaticOrder, false>(F.lds, g, S, E); }
          else { pg8::EpiResBf<false> E{WSB(WS_XR), WSB(WS_XR), D, nullptr}; pg8::gemm_phase<pg8::EpiResBf<false>, pg8::StaticOrder, false>(F.lds, g, S, E); } }
#if DBL_PHASE == 41
        if constexpr (l == 0) { pg8::Gemm g{WSB(WS_MIX), WSB(WS_WOUT), D}; pg8::StaticOrder S; S.init(M, D, F.G, F.bx);
          pg8::EpiResBf<true> E{args.in[0], WSB(WS_XR), D, nullptr}; pg8::gemm_phase<pg8::EpiResBf<true>, pg8::StaticOrder, false>(F.lds, g, S, E); }
#endif
        GRID_BAR(); STAMP(1 + 3 + (l == 0 ? 0 : 7));
        if constexpr (l == 0) {
            norm_phase<0, true, true>(F, (const float*)(F.ws + WS_XR), args.in[4], nullptr, 0);
            GRID_BAR(); STAMP(5);
            { pg8::Gemm g{WSB(WS_XN), WSB(WS_WGU), D / 2}; pg8::StaticOrder S; S.init(M, 2 * FDP, F.G, F.bx);
              pg8::EpiSwiGLU8<true> E{WSB(WS_BIG), FDP, (const float*)(F.ws + WS_XNS), (const float*)(F.ws + WS_SBD)};
              pg8::gemm_phase<pg8::EpiSwiGLU8<true>, pg8::StaticOrder, true, true>(F.lds, g, S, E); }
#if DBL_PHASE == 4
        { pg8::Gemm g{WSB(WS_XN), WSB(WS_WGU), D / 2}; pg8::StaticOrder S; S.init(M, 2 * FDP, F.G, F.bx);
              pg8::EpiSwiGLU8<true> E{WSB(WS_BIG), FDP, (const float*)(F.ws + WS_XNS), (const float*)(F.ws + WS_SBD)};
              pg8::gemm_phase<pg8::EpiSwiGLU8<true>, pg8::StaticOrder, true, true>(F.lds, g, S, E); }
#endif
            GRID_BAR(); STAMP(6);
            { pg8::Gemm g{WSB(WS_BIG), WSB(WS_WD), FDP / 2}; pg8::StaticOrder S; S.init(M, D, F.G, F.bx);
              pg8::EpiResBf<false> E{WSB(WS_XR), WSB(WS_XR), D, (const float*)(F.ws + WS_SBWD)};
              pg8::gemm_phase<pg8::EpiResBf<false>, pg8::StaticOrder, false, false, true>(F.lds, g, S, E); }
            GRID_BAR(); STAMP(7);
            norm_phase<1, true, true>(F, (const float*)(F.ws + WS_XR), args.in[3] + D, args.in[1] + (size_t)D * NIN + 2048, NIN);
            GRID_BAR(); STAMP(8);
        } else {
            norm_phase<2, true, true>(F, (const float*)(F.ws + WS_XR), args.in[4] + D, args.in[22], 8);
            GRID_BAR(); STAMP(12);
            if (F.tid == 0) { int acc = 0;
                for (int e = 0; e < 8; ++e) { const int c = (int)__hip_atomic_load(F.ctl + CW_CNT + 64 * e, RLX_AGENT); F.META[e] = c; F.META[8 + e] = acc; acc += (c + 255) >> 8; }
                F.META[16] = acc; }
            __syncthreads();
            gather_phase(F);
            GRID_BAR(); STAMP(13);
            const int ptot = F.META[16];
            {
                const int p0 = 0; int np = ptot; if (np > 136) np = 136; const int slab = 0; (void)slab;
                { pg8::Gemm g{WSB(WS_XG8), WSB(WS_EGU), D / 2}; pg8::GroupedOrder S{2 * FE / 256, p0, np, F.G, F.bx, 0, F.META, 0, 0};
                  pg8::EpiSwiGLU8<true> E{WSB(WS_BIG), FE, (const float*)(F.ws + WS_XGS), (const float*)(F.ws + WS_SBE)};
                  pg8::gemm_phase<pg8::EpiSwiGLU8<true>, pg8::GroupedOrder, true, true>(F.lds, g, S, E); }
#if DBL_PHASE == 5
        { pg8::Gemm g{WSB(WS_XG8), WSB(WS_EGU), D / 2}; pg8::GroupedOrder S{2 * FE / 256, p0, np, F.G, F.bx, 0, F.META, 0, 0};
                  pg8::EpiSwiGLU8<true> E{WSB(WS_BIG), FE, (const float*)(F.ws + WS_XGS), (const float*)(F.ws + WS_SBE)};
                  pg8::gemm_phase<pg8::EpiSwiGLU8<true>, pg8::GroupedOrder, true, true>(F.lds, g, S, E); }
#endif
                GRID_BAR(); STAMP(14 + 2 * slab);
                { pg8::Gemm g{WSB(WS_BIG), WSB(WS_ED), FE / 2}; pg8::GroupedOrder S{D / 256, p0, np, F.G, F.bx, 1, F.META, 512, 4};
                  pg8::EpiYMoE E{WSB(WS_MIX), WSB(WS_XN), D, (const float*)(F.ws + WS_SBED), 512};
                  pg8::gemm_phase<pg8::EpiYMoE, pg8::GroupedOrder, true, false, true>(F.lds, g, S, E); }
#if DBL_PHASE == 6
        { pg8::Gemm g{WSB(WS_BIG), WSB(WS_ED), FE / 2}; pg8::GroupedOrder S{D / 256, p0, np, F.G, F.bx, 1, F.META, 512, 4};
                  pg8::EpiYMoE E{WSB(WS_MIX), WSB(WS_XN), D, (const float*)(F.ws + WS_SBED), 512};
                  pg8::gemm_phase<pg8::EpiYMoE, pg8::GroupedOrder, true, false, true>(F.lds, g, S, E); }
#endif
                GRID_BAR(); STAMP(15 + 2 * slab);
            }
#ifdef PROBE_A
            if (F.bx == 0 && threadIdx.x == 0) { const LAS unsigned long long* ts = (const LAS unsigned long long*)(F.lds + LDSCTL_OFF + 2048);
                float ta = 0.f, tbv = 0.f;
                for (int i = 1; i <= 17; ++i) { const float d = (float)(ts[i] - ts[i - 1]) * 0.01f;
                    if ((PROBE_A >> i) & 1) ta += d; if ((PROBE_B >> i) & 1) tbv += d; }
                ((float*)(F.ws + WS_CTL))[100] = ta / PROBE_SA; ((float*)(F.ws + WS_CTL))[101] = tbv / PROBE_SB * 100.0f; }
            GRID_BAR();
#endif
            combine_phase(F, args);
#ifdef PROBE_A
            GRID_BAR();
            { const float eps = ((const float*)(F.ws + WS_CTL))[100], vv = ((const float*)(F.ws + WS_CTL))[101];
              for (size_t i = (size_t)F.bx * 512 + threadIdx.x; i < (size_t)M * D; i += (size_t)F.G * 512) F.out[i] = (i == 0) ? vv : F.out[i] * (1.0f + eps); }
#endif
        }
}
__global__ void __launch_bounds__(NWAVES * 64, 2) mk_fwd(Args args) {
    extern __shared__ __attribute__((aligned(16))) unsigned char lds[];
    Frame F;
    F.lds = (LAS unsigned char*)lds;
    F.MISC = (volatile LAS unsigned*)(F.lds + MISC_OFF);
    F.META = (LAS int*)(F.lds + MISC_OFF + 64);
    F.tid = threadIdx.x; F.lane = F.tid & 63; F.wave = __builtin_amdgcn_readfirstlane(F.tid >> 6);
    F.G = gridDim.x; F.bx = blockIdx.x;
    F.ws = args.ws; F.out = args.out;
    F.ctl = (gu32*)(F.ws + WS_CTL);
    for (int u = F.tid; u < (LDS_BYTES - LDSCTL_OFF) / 4; u += NWAVES * 64) ((LAS unsigned*)(F.lds + LDSCTL_OFF))[u] = 0u;
    __syncthreads();
    XcdBarrier bar = xcd_barrier_post((unsigned*)(F.ctl + CW_BAR), F.MISC + 8);
    STAMP(0);
    p0_weights(F, args);
    __syncthreads();
#ifdef EXPERTS_IN_P0
    expert_weights(F, args);
#endif
#if DBL_PHASE == 0
    p0_weights(F, args);
    __syncthreads();
#endif
    __syncthreads();
    norm_phase<1, true>(F, args.in[0], args.in[3], args.in[1] + 2048, NIN);
    GRID_BAR(); STAMP(1);
    layer_body<0>(F, args, bar);
    layer_body<1>(F, args, bar);
}

extern "C" void kernel_launch(void* const* d_in, const int* in_sizes, int n_in, void* d_out, int out_size, void* d_ws, size_t ws_size, hipStream_t stream) {
    static int grid = 0;
    if (grid == 0) {
        if (n_in != 26 || in_sizes[0] != M * D || out_size != M * D || ws_size < WS_END) { fprintf(stderr, "kernel_launch: unexpected shapes (n_in %d, in0 %d, out %d, ws %zu); nothing launched\n", n_in, n_in > 0 ? in_sizes[0] : -1, out_size, ws_size); grid = -1; return; }
        int dev = 0, cus = 0, per_cu = 0;
        if (hipGetDevice(&dev) != hipSuccess || hipDeviceGetAttribute(&cus, hipDeviceAttributeMultiprocessorCount, dev) != hipSuccess) { grid = -1; return; }
        if (hipFuncSetAttribute((const void*)mk_fwd, hipFuncAttributeMaxDynamicSharedMemorySize, LDS_BYTES) != hipSuccess) { fprintf(stderr, "kernel_launch: hipFuncSetAttribute failed\n"); grid = -1; return; }
        if (hipOccupancyMaxActiveBlocksPerMultiprocessor(&per_cu, (const void*)mk_fwd, NWAVES * 64, LDS_BYTES) != hipSuccess || per_cu < 1) fprintf(stderr, "kernel_launch: occupancy query reports %d blocks per CU\n", per_cu);
        (void)hipGetLastError();
        grid = cus;
    }
    if (grid < 0) return;
    if (hipMemsetAsync((char*)d_ws + WS_CTL, 0, CTL_ZERO_BYTES, stream) != hipSuccess) return;
    Args a{};
    for (int i = 0; i < 26; ++i) a.in[i] = (const float*)d_in[i];
    a.out = (float*)d_out; a.ws = (unsigned char*)d_ws;
    hipLaunchKernelGGL(mk_fwd, dim3(grid), dim3(NWAVES * 64), LDS_BYTES, stream, a);
}
```

```cpp
#include <hip/hip_runtime.h>
#include <cstdio>
#include <cstdint>
namespace pg8 {
#define PG8_LAS __attribute__((address_space(3)))
typedef unsigned short bf16_t;
typedef short bf16x8 __attribute__((ext_vector_type(8)));
typedef float f32x4 __attribute__((ext_vector_type(4)));
typedef unsigned u32x4 __attribute__((ext_vector_type(4)));
constexpr int BM = 256, BK = 64, HALF = 128, HTB = HALF * BK * 2  , STAGE_BYTES = 8 * HTB, NXCD = 8, WGM = 8;

__host__ __device__ __forceinline__ int lds_byte(int r, int c) { const int st = (r >> 4) * 2 + (c >> 5), rr = r & 15, cc = c & 31, ob = rr * 64 + cc * 2; return st * 1024 + (ob ^ (((ob >> 9) & 1) << 5)); }
__host__ __device__ __forceinline__ void stage_rc(int b, int& R, int& C) { const int st = b / 1024, sb = b % 1024, swz = sb ^ (((sb >> 9) & 1) << 5); R = (st >> 1) * 16 + swz / 64; C = (st & 1) * 32 + (swz % 64) / 2; }
__host__ __device__ __forceinline__ int perm32(int rho) { const int n = rho >> 4, i = rho & 15; return 8 * (i >> 2) + 4 * n + (i & 3); }

struct Unit { int pm, pn, cn, po, e, j, koff, kt, split; };
struct Gemm { const bf16_t* A; const bf16_t* Bt; int K; };

struct StaticOrder {
    int nM, nN, nwg, G, c;
    __host__ __device__ void init(int M, int N, int G_, int c_) { nM = M / BM; nN = N / BM; nwg = nM * nN; G = G_; c = c_; }
    __host__ __device__ bool next(int i, Unit& u) const {
        const long L = (long)i * G + c; if (L >= nwg) return false;
        int wgid = (int)L; { const int q = nwg / NXCD, r = nwg % NXCD, xcd = wgid % NXCD, off = wgid / NXCD; wgid = (xcd < r ? xcd * (q + 1) : r * (q + 1) + (xcd - r) * q) + off; }
        const int nig = WGM * nN, gid = wgid / nig, fm = gid * WGM, gsz = (nM - fm) < WGM ? (nM - fm) : WGM;
        u.pm = fm + ((wgid % nig) % gsz); u.pn = (wgid % nig) / gsz; u.cn = u.pn; u.po = u.pm; u.e = 0; u.j = 0; u.koff = 0; u.kt = 0; u.split = 0; return true;
    }
};
struct GroupedOrder {
    int nN, p0, np, G, c, a_local;
    const PG8_LAS int* meta;
    int ksb, kst;
    int aregion;
    __device__ __forceinline__ bool next(int i, Unit& u) const {
        int pl, n, koff = 0, kt = 0, split = 0;
        if (a_local && nN == 4 && G == 256) {
            {
            const int nfull = np < 128 ? np : 128, pl0 = ((c >> 3) >> 2) * 8 + (c & 7);
            const int nmine = (pl0 < nfull ? 1 : 0) + (64 + pl0 < nfull ? 1 : 0);
            if (i < nmine) { pl = i * 64 + pl0; n = (c >> 3) & 3; }
            else if (i == nmine) { if (c >= (np - nfull) * 28) return false; pl = nfull + c / 28; const int rem = c - (c / 28) * 28; n = rem / 7; koff = (rem - n * 7) * ksb; kt = kst; split = 1; }
            else return false;
            }
        } else { const int L = i * G + c; if (L >= np * nN) return false; pl = L / nN; n = L - pl * nN; }
        const int p = p0 + pl;
        int e = 0;
#pragma unroll
        for (int k = 1; k < 8; ++k) e += (p >= meta[8 + k]) ? 1 : 0;
        e = __builtin_amdgcn_readfirstlane(e);
        u.e = e; u.j = 0; u.pm = a_local ? pl : p; u.po = a_local ? p : pl;
        if (aregion) u.pm = (e < 6 ? (203 + 16 * e) * 4 : (2 + 16 * (e - 6)) * 4) + (p - meta[8 + e]); u.pn = e * nN + n; u.cn = n; u.koff = koff; u.kt = kt; u.split = split; return true;
    }
};

__device__ __forceinline__ unsigned cvt_pk_bf16(float lo, float hi) { unsigned r; asm volatile("v_cvt_pk_bf16_f32 %0, %1, %2" : "=v"(r) : "v"(lo), "v"(hi)); return r; }

#ifdef EPI_NT
#define PG8_ST16(p, v) __builtin_nontemporal_store((v), (u32x4*)(p))
#define PG8_ST16F(p, v) __builtin_nontemporal_store((v), (f32x4*)(p))
#else
#define PG8_ST16(p, v) (*(u32x4*)(p) = (v))
#define PG8_ST16F(p, v) (*(f32x4*)(p) = (v))
#endif
struct EpiBf16 {
    static constexpr bool PERM = true, AFTER_DRAIN = false;
    bf16_t* O; int ldc;
    __device__ __forceinline__ void operator()(const f32x4 (&acc)[2][2][4][2], const Unit& u, int wr, int wc, int fr, int fq) const {
        const int row0 = u.po * BM + wr * 64 + fr, col0 = u.cn * BM + wc * 32 + 8 * fq;
#pragma unroll
        for (int ai = 0; ai < 2; ++ai)
#pragma unroll
            for (int m = 0; m < 4; ++m) { bf16_t* rowp = O + (size_t)(row0 + ai * HALF + m * 16) * ldc + col0;
#pragma unroll
                for (int bj = 0; bj < 2; ++bj) { const f32x4 v0 = acc[ai][bj][m][0], v1 = acc[ai][bj][m][1];
                    u32x4 w; w.x = cvt_pk_bf16(v0[0], v0[1]); w.y = cvt_pk_bf16(v0[2], v0[3]); w.z = cvt_pk_bf16(v1[0], v1[1]); w.w = cvt_pk_bf16(v1[2], v1[3]);
                    PG8_ST16(rowp + bj * HALF, w); } }
    }
};
__device__ __forceinline__ float silu_mul(float g, float u) { return g * u * __builtin_amdgcn_rcpf(1.0f + __builtin_amdgcn_exp2f(-1.4426950408889634f * g)); }
struct EpiSwiGLU {
    static constexpr bool PERM = true, AFTER_DRAIN = false;
    bf16_t* O; int ldc;
    __device__ __forceinline__ void operator()(const f32x4 (&acc)[2][2][4][2], const Unit& u, int wr, int wc, int fr, int fq) const {
        const int row0 = u.po * BM + wr * 64 + fr, col0 = u.cn * HALF + wc * 32 + 8 * fq;
#pragma unroll
        for (int ai = 0; ai < 2; ++ai)
#pragma unroll
            for (int m = 0; m < 4; ++m) { bf16_t* rowp = O + (size_t)(row0 + ai * HALF + m * 16) * ldc + col0;
                const f32x4 g0 = acc[ai][0][m][0], g1 = acc[ai][0][m][1], u0 = acc[ai][1][m][0], u1 = acc[ai][1][m][1];
                u32x4 w; w.x = cvt_pk_bf16(silu_mul(g0[0], u0[0]), silu_mul(g0[1], u0[1])); w.y = cvt_pk_bf16(silu_mul(g0[2], u0[2]), silu_mul(g0[3], u0[3]));
                w.z = cvt_pk_bf16(silu_mul(g1[0], u1[0]), silu_mul(g1[1], u1[1])); w.w = cvt_pk_bf16(silu_mul(g1[2], u1[2]), silu_mul(g1[3], u1[3]));
                PG8_ST16(rowp, w); asm volatile("" ::: "memory"); }
    }
};
struct EpiBf16S {
    static constexpr bool PERM = true, AFTER_DRAIN = false;
    bf16_t* O; int ldc; const float* sa; const float* sb;
    __device__ __forceinline__ void operator()(const int __attribute__((ext_vector_type(4))) (&acc)[2][2][4][2], const Unit& u, int wr, int wc, int fr, int fq) const {
        const int row0 = u.po * BM + wr * 64 + fr, col0 = u.cn * BM + wc * 32 + 8 * fq;
        const float* sbp = sb + (size_t)u.pn * BM + wc * 32 + 8 * fq;
        f32x4 s4[2][2];
#pragma unroll
        for (int bj = 0; bj < 2; ++bj) { s4[bj][0] = *(const f32x4*)(sbp + bj * HALF); s4[bj][1] = *(const f32x4*)(sbp + bj * HALF + 4); }
        float av[2][4];
#pragma unroll
        for (int ai = 0; ai < 2; ++ai)
#pragma unroll
            for (int m = 0; m < 4; ++m) av[ai][m] = sa[(size_t)u.pm * BM + wr * 64 + fr + ai * HALF + m * 16];
#pragma unroll
        for (int ai = 0; ai < 2; ++ai)
#pragma unroll
            for (int m = 0; m < 4; ++m) { bf16_t* rowp = O + (size_t)(row0 + ai * HALF + m * 16) * ldc + col0;
                const float a = av[ai][m];
#pragma unroll
                for (int bj = 0; bj < 2; ++bj) { const f32x4 v0 = __builtin_convertvector(acc[ai][bj][m][0], f32x4) * s4[bj][0] * a, v1 = __builtin_convertvector(acc[ai][bj][m][1], f32x4) * s4[bj][1] * a;
                    u32x4 w; w.x = cvt_pk_bf16(v0[0], v0[1]); w.y = cvt_pk_bf16(v0[2], v0[3]); w.z = cvt_pk_bf16(v1[0], v1[1]); w.w = cvt_pk_bf16(v1[2], v1[3]);
                    PG8_ST16(rowp + bj * HALF, w); }
                asm volatile("" ::: "memory"); }
    }
};
__device__ __forceinline__ unsigned pk4_fp8(float a, float b, float c, float d) {
    a = __builtin_amdgcn_fmed3f(a, -448.f, 448.f); b = __builtin_amdgcn_fmed3f(b, -448.f, 448.f); c = __builtin_amdgcn_fmed3f(c, -448.f, 448.f); d = __builtin_amdgcn_fmed3f(d, -448.f, 448.f);
    int w = __builtin_amdgcn_cvt_pk_fp8_f32(a, b, 0, false); w = __builtin_amdgcn_cvt_pk_fp8_f32(c, d, w, true); return (unsigned)w; }
template <bool F8OUT> struct EpiSwiGLU8 {
    static constexpr bool PERM = true, AFTER_DRAIN = false;
    bf16_t* O; int ldc; const float* sa; const float* sb;
    __device__ __forceinline__ void operator()(const int __attribute__((ext_vector_type(4))) (&acc)[2][2][4][2], const Unit& u, int wr, int wc, int fr, int fq) const {
        const int row0 = u.po * BM + wr * 64 + fr, col0 = u.cn * HALF + wc * 32 + 8 * fq;
        const float* sbp = sb + (size_t)u.pn * BM + wc * 32 + 8 * fq;
        const f32x4 sg0 = *(const f32x4*)(sbp), sg1 = *(const f32x4*)(sbp + 4), su0 = *(const f32x4*)(sbp + HALF), su1 = *(const f32x4*)(sbp + HALF + 4);
        float av[2][4];
#pragma unroll
        for (int ai = 0; ai < 2; ++ai)
#pragma unroll
            for (int m = 0; m < 4; ++m) av[ai][m] = sa[(size_t)u.pm * BM + wr * 64 + fr + ai * HALF + m * 16];
#pragma unroll
        for (int ai = 0; ai < 2; ++ai)
#pragma unroll
            for (int m = 0; m < 4; ++m) {
                const float a = av[ai][m];
                const f32x4 g0 = __builtin_convertvector(acc[ai][0][m][0], f32x4) * sg0 * a, g1 = __builtin_convertvector(acc[ai][0][m][1], f32x4) * sg1 * a;
                const f32x4 u0 = __builtin_convertvector(acc[ai][1][m][0], f32x4) * su0 * a, u1 = __builtin_convertvector(acc[ai][1][m][1], f32x4) * su1 * a;
                if constexpr (F8OUT) { unsigned char* rowp = (unsigned char*)O + (size_t)(row0 + ai * HALF + m * 16) * ldc + col0;
                    typedef unsigned u32x2 __attribute__((ext_vector_type(2))); u32x2 w;
                    w.x = pk4_fp8(silu_mul(g0[0], u0[0]), silu_mul(g0[1], u0[1]), silu_mul(g0[2], u0[2]), silu_mul(g0[3], u0[3]));
                    w.y = pk4_fp8(silu_mul(g1[0], u1[0]), silu_mul(g1[1], u1[1]), silu_mul(g1[2], u1[2]), silu_mul(g1[3], u1[3]));
                    *(u32x2*)rowp = w;
                } else { bf16_t* rowp = O + (size_t)(row0 + ai * HALF + m * 16) * ldc + col0;
                    u32x4 w; w.x = cvt_pk_bf16(silu_mul(g0[0], u0[0]), silu_mul(g0[1], u0[1])); w.y = cvt_pk_bf16(silu_mul(g0[2], u0[2]), silu_mul(g0[3], u0[3]));
                    w.z = cvt_pk_bf16(silu_mul(g1[0], u1[0]), silu_mul(g1[1], u1[1])); w.w = cvt_pk_bf16(silu_mul(g1[2], u1[2]), silu_mul(g1[3], u1[3]));
                    PG8_ST16(rowp, w); }
                asm volatile("" ::: "memory"); }
    }
};
struct EpiYMoE {
    static constexpr bool PERM = true, AFTER_DRAIN = false;
    bf16_t* O; bf16_t* Ypart; int ldc; const float* sb; int ksb;
    __device__ __forceinline__ void operator()(const f32x4 (&acc)[2][2][4][2], const Unit& u, int wr, int wc, int fr, int fq) const {
        const int col0 = u.cn * BM + wc * 32 + 8 * fq;
        bf16_t* base = u.split ? Ypart + ((size_t)(u.koff / ksb) * 2048 + (size_t)(u.po - 128) * BM) * ldc : O + (size_t)u.po * BM * ldc;
        const int row0 = wr * 64 + fr;
        const float* sbp = sb + (size_t)u.pn * BM + wc * 32 + 8 * fq;
        f32x4 s4[2][2];
#pragma unroll
        for (int bj = 0; bj < 2; ++bj) { s4[bj][0] = *(const f32x4*)(sbp + bj * HALF); s4[bj][1] = *(const f32x4*)(sbp + bj * HALF + 4); }
#pragma unroll
        for (int ai = 0; ai < 2; ++ai)
#pragma unroll
            for (int m = 0; m < 4; ++m) { bf16_t* rowp = base + (size_t)(row0 + ai * HALF + m * 16) * ldc + col0;
#pragma unroll
                for (int bj = 0; bj < 2; ++bj) { const f32x4 v0 = acc[ai][bj][m][0] * s4[bj][0], v1 = acc[ai][bj][m][1] * s4[bj][1];
                    u32x4 w; w.x = cvt_pk_bf16(v0[0], v0[1]); w.y = cvt_pk_bf16(v0[2], v0[3]); w.z = cvt_pk_bf16(v1[0], v1[1]); w.w = cvt_pk_bf16(v1[2], v1[3]);
                    PG8_ST16(rowp + bj * HALF, w); }
                asm volatile("" ::: "memory"); }
    }
};
template <bool BASE_F32> struct EpiResBf {
    static constexpr bool PERM = true, AFTER_DRAIN = false;
    const void* base; bf16_t* out; int ldc; const float* sb;
    __device__ __forceinline__ void operator()(const f32x4 (&acc)[2][2][4][2], const Unit& u, int wr, int wc, int fr, int fq) const {
        const int row0 = u.po * BM + wr * 64 + fr, col0 = u.cn * BM + wc * 32 + 8 * fq;
        f32x4 s[2][2];
#pragma unroll
        for (int bj = 0; bj < 2; ++bj) { s[bj][0] = (f32x4){1.f, 1.f, 1.f, 1.f}; s[bj][1] = s[bj][0]; if (sb) { s[bj][0] = *(const f32x4*)(sb + col0 + bj * HALF); s[bj][1] = *(const f32x4*)(sb + col0 + bj * HALF + 4); } }
        if constexpr (BASE_F32) {
#pragma unroll
            for (int ai = 0; ai < 2; ++ai) {
                f32x4 b[4][2][2];
#pragma unroll
                for (int m = 0; m < 4; ++m)
#pragma unroll
                    for (int bj = 0; bj < 2; ++bj) { const float* bp = (const float*)base + (size_t)(row0 + ai * HALF + m * 16) * ldc + col0 + bj * HALF; b[m][bj][0] = *(const f32x4*)bp; b[m][bj][1] = *(const f32x4*)(bp + 4); }
#pragma unroll
                for (int m = 0; m < 4; ++m) { const size_t off = (size_t)(row0 + ai * HALF + m * 16) * ldc + col0;
#pragma unroll
                    for (int bj = 0; bj < 2; ++bj) { const f32x4 v0 = b[m][bj][0] + acc[ai][bj][m][0] * s[bj][0], v1 = b[m][bj][1] + acc[ai][bj][m][1] * s[bj][1];
                        u32x4 w; w.x = cvt_pk_bf16(v0[0], v0[1]); w.y = cvt_pk_bf16(v0[2], v0[3]); w.z = cvt_pk_bf16(v1[0], v1[1]); w.w = cvt_pk_bf16(v1[2], v1[3]);
                        PG8_ST16(out + off + bj * HALF, w); } }
                asm volatile("" ::: "memory"); }
        } else {
            u32x4 b[2][4][2];
#pragma unroll
            for (int ai = 0; ai < 2; ++ai)
#pragma unroll
                for (int m = 0; m < 4; ++m)
#pragma unroll
                    for (int bj = 0; bj < 2; ++bj) b[ai][m][bj] = *(const u32x4*)((const bf16_t*)base + (size_t)(row0 + ai * HALF + m * 16) * ldc + col0 + bj * HALF);
#pragma unroll
            for (int ai = 0; ai < 2; ++ai)
#pragma unroll
                for (int m = 0; m < 4; ++m) { const size_t off = (size_t)(row0 + ai * HALF + m * 16) * ldc + col0;
#pragma unroll
                    for (int bj = 0; bj < 2; ++bj) { const u32x4 w0 = b[ai][m][bj];
                        const f32x4 b0 = (f32x4){__uint_as_float(w0.x << 16), __uint_as_float(w0.x & 0xffff0000u), __uint_as_float(w0.y << 16), __uint_as_float(w0.y & 0xffff0000u)};
                        const f32x4 b1 = (f32x4){__uint_as_float(w0.z << 16), __uint_as_float(w0.z & 0xffff0000u), __uint_as_float(w0.w << 16), __uint_as_float(w0.w & 0xffff0000u)};
                        const f32x4 v0 = b0 + acc[ai][bj][m][0] * s[bj][0], v1 = b1 + acc[ai][bj][m][1] * s[bj][1];
                        u32x4 w; w.x = cvt_pk_bf16(v0[0], v0[1]); w.y = cvt_pk_bf16(v0[2], v0[3]); w.z = cvt_pk_bf16(v1[0], v1[1]); w.w = cvt_pk_bf16(v1[2], v1[3]);
                        PG8_ST16(out + off + bj * HALF, w); }
                    asm volatile("" ::: "memory"); }
        }
    }
};
struct EpiResF32 {
    static constexpr bool PERM = false, AFTER_DRAIN = false;
    const float* base; float* out; int ldc; const float* sb;
    __device__ __forceinline__ void operator()(const f32x4 (&acc)[2][2][4][2], const Unit& u, int wr, int wc, int fr, int fq) const {
        const int row0 = u.po * BM + wr * 64 + fr, col0 = u.cn * BM + wc * 32 + 4 * fq;
#pragma unroll
        for (int ai = 0; ai < 2; ++ai)
#pragma unroll
            for (int m = 0; m < 4; ++m) { const size_t off = (size_t)(row0 + ai * HALF + m * 16) * ldc + col0;
#pragma unroll
                for (int bj = 0; bj < 2; ++bj)
#pragma unroll
                    for (int n = 0; n < 2; ++n) { const f32x4 bs = *(const f32x4*)(base + off + bj * HALF + n * 16);
                        const f32x4 s = sb ? *(const f32x4*)(sb + col0 + bj * HALF + n * 16) : (f32x4){1.f, 1.f, 1.f, 1.f};
                        PG8_ST16F(out + off + bj * HALF + n * 16, bs + acc[ai][bj][m][n] * s); }
                asm volatile("" ::: "memory"); }
    }
};
typedef int i32x4 __attribute__((ext_vector_type(4)));
template <bool I8> struct AccT { typedef f32x4 type; };
template <> struct AccT<true> { typedef i32x4 type; };
template <bool I8> __device__ __forceinline__ typename AccT<I8>::type mma16(const bf16x8 b, const bf16x8 a, const typename AccT<I8>::type c);
template <> __device__ __forceinline__ f32x4 mma16<false>(const bf16x8 b, const bf16x8 a, const f32x4 c) { return __builtin_amdgcn_mfma_f32_16x16x32_bf16(b, a, c, 0, 0, 0); }
template <> __device__ __forceinline__ i32x4 mma16<true>(const bf16x8 b, const bf16x8 a, const i32x4 c) { return __builtin_amdgcn_mfma_i32_16x16x64_i8(__builtin_bit_cast(i32x4, b), __builtin_bit_cast(i32x4, a), c, 0, 0, 0); }
typedef int i32x8 __attribute__((ext_vector_type(8)));
__device__ __forceinline__ void mma_f8(f32x4& c, const i32x8 b, const i32x8 a, const int one) {
    asm volatile("v_mfma_scale_f32_16x16x128_f8f6f4 %0, %1, %2, %0, %3, %3 op_sel_hi:[0,0,0]" : "+v"(c) : "v"(b), "v"(a), "v"(one));
}
template <class Epi, class Sched, bool ALIGN_EPI, bool I8 = false, bool F8 = false>
__device__ __forceinline__ void gemm_phase(PG8_LAS unsigned char* lds, const Gemm g, const Sched& S, const Epi& E) {
    int tid_ = threadIdx.x; asm volatile("" : "+v"(tid_));
    const int tid = tid_, wid = __builtin_amdgcn_readfirstlane(tid >> 6), lane = tid & 63, wr = wid >> 2, wc = wid & 3, fr = lane & 15, fq = lane >> 4;
    const int K = g.K, nt = K / BK;
    unsigned voffA[2], voffB[2];
#pragma unroll
    for (int i = 0; i < 2; ++i) { int R, C; stage_rc(tid * 16 + i * 8192, R, C); const int Rb = Epi::PERM ? ((R & ~31) + perm32(R & 31)) : R;
        voffA[i] = (unsigned)(R * K + C) * 2u; voffB[i] = (unsigned)(Rb * K + C) * 2u; }
    const size_t kstep = (size_t)(BK * 2);
    const size_t hstep = (size_t)HALF * K * 2;
    const size_t tstep = 2 * hstep;
    const unsigned ldsw = (unsigned)wid * 1024u;
    const int aoff = lds_byte(wr * 64 + fr, fq * 8), boff = lds_byte(wc * 32 + fr, fq * 8);
#define PG8_SA(b, h) (((b) * 2 + (h)) * HTB)
#define PG8_SB(b, h) ((4 + (b) * 2 + (h)) * HTB)
#define PG8_STAGE(bufoff, gbase, voff) do { _Pragma("unroll") for (int _i = 0; _i < 2; ++_i) \
        __builtin_amdgcn_global_load_lds((const unsigned*)((const char*)(gbase) + (voff)[_i]), (PG8_LAS unsigned*)(lds + (bufoff) + ldsw + _i * 8192), 16, 0, 0); } while (0)
#define PG8_LDA(dst, b, h) do { if constexpr (F8) { _Pragma("unroll") for (int m = 0; m < 4; ++m) { const i32x4 lo_ = *(const PG8_LAS i32x4*)(lds + PG8_SA(b, h) + aoff + m * 2048), hi_ = *(const PG8_LAS i32x4*)(lds + PG8_SA(b, h) + aoff + m * 2048 + 1024); dst##8[m] = __builtin_shufflevector(lo_, hi_, 0, 1, 2, 3, 4, 5, 6, 7); } } \
        else { _Pragma("unroll") for (int m = 0; m < 4; ++m) _Pragma("unroll") for (int k = 0; k < 2; ++k) dst[m][k] = *(const PG8_LAS bf16x8*)(lds + PG8_SA(b, h) + aoff + m * 2048 + k * 1024); } } while (0)
#define PG8_LDB(dst, b, h) do { if constexpr (F8) { _Pragma("unroll") for (int n = 0; n < 2; ++n) { const i32x4 lo_ = *(const PG8_LAS i32x4*)(lds + PG8_SB(b, h) + boff + n * 2048), hi_ = *(const PG8_LAS i32x4*)(lds + PG8_SB(b, h) + boff + n * 2048 + 1024); dst##8[n] = __builtin_shufflevector(lo_, hi_, 0, 1, 2, 3, 4, 5, 6, 7); } } \
        else { _Pragma("unroll") for (int n = 0; n < 2; ++n) _Pragma("unroll") for (int k = 0; k < 2; ++k) dst[n][k] = *(const PG8_LAS bf16x8*)(lds + PG8_SB(b, h) + boff + n * 2048 + k * 1024); } } while (0)
#define PG8_MMA(ai, bj, At, Bt) do { __builtin_amdgcn_s_setprio(1); \
        if constexpr (F8) { _Pragma("unroll") for (int m = 0; m < 4; ++m) _Pragma("unroll") for (int n = 0; n < 2; ++n) mma_f8(acc[ai][bj][m][n], Bt##8[n], At##8[m], f8one); } \
        else { _Pragma("unroll") for (int m = 0; m < 4; ++m) _Pragma("unroll") for (int n = 0; n < 2; ++n) _Pragma("unroll") for (int k = 0; k < 2; ++k) \
            acc[ai][bj][m][n] = mma16<I8>(Bt[n][k], At[m][k], acc[ai][bj][m][n]); } __builtin_amdgcn_s_setprio(0); } while (0)
#define PG8_WAIT_V(n) asm volatile("s_waitcnt vmcnt(" #n ")" ::: "memory")
#define PG8_WAIT_L(n) asm volatile("s_waitcnt lgkmcnt(" #n ")" ::: "memory")
#define PG8_BAR __builtin_amdgcn_s_barrier()
#define PG8_SCHED __builtin_amdgcn_sched_barrier(0)
    Unit cur, nxt; int ui = 0;
    if (!S.next(0, cur)) return;
    typedef typename AccT<I8>::type acc_t;
    acc_t acc[2][2][4][2];
#pragma unroll
    for (int a = 0; a < 2; ++a)
#pragma unroll
        for (int b = 0; b < 2; ++b)
#pragma unroll
            for (int m = 0; m < 4; ++m)
#pragma unroll
                for (int n = 0; n < 2; ++n) acc[a][b][m][n] = (acc_t){0, 0, 0, 0};
    bf16x8 At[4][2], B0[2][2], B1[2][2];
    int f8one = 0x7f7f7f7f; asm volatile("" : "+v"(f8one));
    i32x8 At8[4], B08[2], B18[2];
    const char* cA = (const char*)g.A + (size_t)cur.pm * tstep + cur.koff; const char* cB = (const char*)g.Bt + (size_t)cur.pn * tstep + cur.koff;
    PG8_STAGE(PG8_SB(0, 0), cB, voffB); PG8_STAGE(PG8_SB(0, 1), cB + hstep, voffB); PG8_STAGE(PG8_SA(0, 0), cA, voffA); PG8_STAGE(PG8_SA(0, 1), cA + hstep, voffA);
    if (wr == 1) PG8_BAR;
    PG8_WAIT_V(2); PG8_BAR;
    PG8_STAGE(PG8_SB(1, 0), cB + kstep, voffB); PG8_STAGE(PG8_SA(1, 0), cA + kstep, voffA); PG8_STAGE(PG8_SB(1, 1), cB + hstep + kstep, voffB);
    PG8_WAIT_V(6); PG8_BAR;
    for (;;) {
        const bool has_next = S.next(ui + 1, nxt);
        const char* nA = has_next ? (const char*)g.A + (size_t)nxt.pm * tstep + nxt.koff : cA; const char* nB = has_next ? (const char*)g.Bt + (size_t)nxt.pn * tstep + nxt.koff : cB;
        const int ntc = cur.kt ? cur.kt : nt;
        for (int t = 0; t < ntc; t += 2) {
            const bool last = (t == ntc - 2);
            const char* a1 = cA + (size_t)(t + 1) * kstep;
            const char* a2 = last ? nA : cA + (size_t)(t + 2) * kstep; const char* b2 = last ? nB : cB + (size_t)(t + 2) * kstep;
            const char* a3 = a2 + kstep; const char* b3 = b2 + kstep;
            PG8_LDB(B0, 0, 0); PG8_LDB(B1, 0, 1); PG8_SCHED; PG8_LDA(At, 0, 0); PG8_STAGE(PG8_SA(1, 1), a1 + hstep, voffA);
            PG8_WAIT_V(8); PG8_WAIT_L(0); PG8_BAR; PG8_MMA(0, 0, At, B0); PG8_MMA(0, 1, At, B1); PG8_BAR; PG8_SCHED;
            PG8_LDA(At, 0, 1); PG8_STAGE(PG8_SB(0, 0), b2, voffB); PG8_STAGE(PG8_SB(0, 1), b2 + hstep, voffB); PG8_STAGE(PG8_SA(0, 0), a2, voffA);
            PG8_WAIT_V(8); PG8_WAIT_L(0); PG8_BAR; PG8_MMA(1, 0, At, B0); PG8_MMA(1, 1, At, B1); PG8_BAR; PG8_SCHED;
            PG8_LDB(B0, 1, 0); PG8_LDB(B1, 1, 1); PG8_SCHED; PG8_LDA(At, 1, 0); PG8_STAGE(PG8_SA(0, 1), a2 + hstep, voffA);
            PG8_WAIT_V(8); PG8_WAIT_L(0); PG8_BAR; PG8_MMA(0, 0, At, B0); PG8_MMA(0, 1, At, B1); PG8_BAR; PG8_SCHED;
            PG8_LDA(At, 1, 1); PG8_STAGE(PG8_SB(1, 0), b3, voffB); PG8_STAGE(PG8_SB(1, 1), b3 + hstep, voffB); PG8_STAGE(PG8_SA(1, 0), a3, voffA);
            PG8_WAIT_V(8); PG8_WAIT_L(0); PG8_BAR; PG8_MMA(1, 0, At, B0); PG8_MMA(1, 1, At, B1); PG8_BAR; PG8_SCHED;
        }
        if constexpr (ALIGN_EPI) { if (wr == 0) PG8_BAR; }
        if constexpr (F8) asm volatile("s_nop 15\n\ts_nop 15" ::: "memory");
        if constexpr (!Epi::AFTER_DRAIN) E(acc, cur, wr, wc, fr, fq);
#if defined(DBL_PHASE) && DBL_PHASE == 30
        if constexpr (I8) { asm volatile("" ::: "memory"); E(acc, cur, wr, wc, fr, fq); }
#endif
        if (!has_next) break;
#pragma unroll
        for (int a = 0; a < 2; ++a)
#pragma unroll
            for (int b = 0; b < 2; ++b)
#pragma unroll
                for (int m = 0; m < 4; ++m)
#pragma unroll
                    for (int n = 0; n < 2; ++n) acc[a][b][m][n] = (acc_t){0, 0, 0, 0};
        cur = nxt; cA = nA; cB = nB; ++ui;
        if constexpr (ALIGN_EPI) { if (wr == 1) PG8_BAR; }
    }
    PG8_WAIT_V(0);
    if constexpr (!ALIGN_EPI) { if (wr == 0) PG8_BAR; }
    PG8_BAR;
    if constexpr (Epi::AFTER_DRAIN) E.fused(acc, cur, wr, wc, fr, fq, lds, wid, lane);
#undef PG8_SA
#undef PG8_SB
#undef PG8_STAGE
#undef PG8_LDA
#undef PG8_LDB
#undef PG8_MMA
#undef PG8_WAIT_V
#undef PG8_WAIT_L
#undef PG8_BAR
#undef PG8_SCHED
}
}
constexpr int NWAVES = 8;
constexpr int SEQ = 8192, M = 16384, D = 1024, NIN = 3080, NPROJ = 3072;
constexpr int FD = 2752, FDP = 2816, FE = 3584, NEXP = 8;
constexpr float EPS = 1e-6f, LOG2E = 1.4426950408889634f;
constexpr int PC_Q = 0, PC_K = 256, PC_V = 512, PC_Z = 768, PC_XBC = 1280, PC_RQ = 2048, PC_RK = 2304, PC_RV = 2560, PC_RG = 2816;
constexpr size_t MiB = 1u << 20;
constexpr size_t WS_CTL = 0, CTL_ZERO_BYTES = 1 * MiB;
constexpr size_t WS_WIN = 2 * MiB;
constexpr size_t WS_WOUT = 14 * MiB;
constexpr size_t WS_WGU = 18 * MiB;
constexpr size_t WS_WD = 29 * MiB;
constexpr size_t WS_EGU = 35 * MiB;
constexpr size_t WS_ED = 147 * MiB;
constexpr size_t WS_XN = 203 * MiB;
constexpr size_t WS_MIX = 235 * MiB;
constexpr size_t WS_BIG = 303 * MiB;
constexpr size_t WS_SMALL = 430 * MiB;
constexpr size_t WS_DT = WS_SMALL, WS_TI = WS_SMALL + 512 * 1024, WS_TG = WS_SMALL + 768 * 1024, WS_LIST = WS_SMALL + 1024 * 1024;
constexpr size_t WS_XCH = 434 * MiB;
constexpr size_t WS_END = 438 * MiB;
constexpr size_t WS_SST = 203 * MiB;
constexpr size_t WS_RST = 219 * MiB;
constexpr size_t WS_QR = 227 * MiB;
constexpr size_t WS_YD = 267 * MiB;
constexpr size_t WS_OI = 283 * MiB;
constexpr size_t WS_XC = 399 * MiB;
constexpr size_t WS_SBD = WS_SMALL + 2176 * 1024, WS_SBE = WS_SMALL + 2240 * 1024;
constexpr size_t WS_SBI = WS_SMALL + 2900 * 1024;
constexpr size_t WS_SBWD = WS_SMALL + 2930 * 1024, WS_SBED = WS_SMALL + 2940 * 1024;
constexpr size_t WS_XR = 91 * MiB;
constexpr size_t WS_XNS = WS_SMALL + 2560 * 1024, WS_XGS = WS_SMALL + 2688 * 1024;
constexpr size_t WS_XGS2 = 299 * MiB;
__host__ __device__ constexpr int xg_panel(int e) { return e < 6 ? (203 + 16 * e) * 4 : (2 + 16 * (e - 6)) * 4; }
constexpr size_t WS_XG8 = 269 * MiB;
constexpr size_t WS_DTOT = WS_SMALL + 1536 * 1024, WS_EOFF = WS_SMALL + 1600 * 1024;
constexpr int SLAB0_PANELS = 64, SLAB1_MAX = 72;
constexpr int CW_BAR = 4096;
constexpr int CW_SEAM = 16384, SEAM_BANK = 64 * 64;
constexpr int CW_CNT = 8192;
constexpr int RING_BYTES = 131072;
constexpr int LDSCTL_OFF = RING_BYTES, MISC_OFF = LDSCTL_OFF + 320;
constexpr int LDS_BYTES = 147456;
#define GAS __attribute__((address_space(1)))
#define LAS __attribute__((address_space(3)))
typedef unsigned short bf16;
typedef unsigned v4u __attribute__((ext_vector_type(4)));
typedef float f32x4 __attribute__((ext_vector_type(4)));
typedef short bf16x8 __attribute__((ext_vector_type(8)));
typedef GAS unsigned gu32;
typedef GAS unsigned long long gu64;
#define RLX_AGENT __ATOMIC_RELAXED, __HIP_MEMORY_SCOPE_AGENT
#define LDS_WAIT() asm volatile("s_waitcnt lgkmcnt(0)" ::: "memory")
#define VM_WAIT() asm volatile("s_waitcnt vmcnt(0)" ::: "memory")
__device__ __forceinline__ unsigned long long rt() { return __builtin_amdgcn_s_memrealtime(); }
__device__ __forceinline__ unsigned f2bf(float f) { unsigned u = __builtin_bit_cast(unsigned, f); return (u + 0x7fffu + ((u >> 16) & 1u)) >> 16; }
typedef float f32x2_t __attribute__((ext_vector_type(2))); typedef __bf16 bf16x2_t __attribute__((ext_vector_type(2)));
__device__ __forceinline__ unsigned pk2(float lo, float hi) { f32x2_t v = {lo, hi}; bf16x2_t b = __builtin_convertvector(v, bf16x2_t); return __builtin_bit_cast(unsigned, b); }

#define XB_TMO      128
#define XB_XCNT(j)  (256  + 64 * (j))
#define XB_XSUB(j)  (1280 + 64 * (j))
#define XB_XGEN(j)  (2304 + 64 * (j))
#define XB_TOP      3328
#define XB_TOPGEN   3392
#define XCD_BAR_WORDS 3456
#define XB_SPIN_CAP (1u << 18)

__device__ __forceinline__ unsigned xb_ld(unsigned* p)              { return __hip_atomic_load(p, __ATOMIC_RELAXED, __HIP_MEMORY_SCOPE_AGENT); }
__device__ __forceinline__ unsigned xb_add(unsigned* p, unsigned v) { return __hip_atomic_fetch_add(p, v, __ATOMIC_RELAXED, __HIP_MEMORY_SCOPE_AGENT); }
__device__ __forceinline__ unsigned xb_xcc_id() { return (unsigned)__builtin_amdgcn_s_getreg((3 << 11) | 20) & 0xFu; }
#define XB_SPIN(cond, bar) do { unsigned _sp = 0; while (cond) { __builtin_amdgcn_s_sleep(1); \
    if ((++_sp & 255u) == 0u) { if (xb_ld(&(bar)[XB_TMO])) break; if (_sp > XB_SPIN_CAP) { atomicAdd(&(bar)[XB_TMO], 1u); break; } } } } while (0)

struct XcdBarrier {
    unsigned* bar; unsigned x;
    volatile LAS unsigned* st;
};

__device__ __forceinline__ XcdBarrier xcd_barrier_post(unsigned* bar, volatile LAS unsigned* st) {
    XcdBarrier b; b.bar = bar; b.x = xb_xcc_id(); b.st = st;
    if (threadIdx.x == 0) (void)xb_add(&bar[XB_XCNT(b.x)], 1u);
    return b;
}
__device__ __forceinline__ void xcd_barrier_complete(unsigned* bar, unsigned x, unsigned& nloc, unsigned& nx) {
    const unsigned G = gridDim.x * gridDim.y * gridDim.z;
    unsigned sum, cnt, mine, sp = 0u;
    for (;;) {
        sum = 0u; cnt = 0u; mine = 0u;
#pragma unroll
        for (unsigned j = 0; j < 16; ++j) { const unsigned c = xb_ld(&bar[XB_XCNT(j)]); sum += c; cnt += (c > 0u) ? 1u : 0u; mine = (j == x) ? c : mine; }
        if (sum == G) break;
        __builtin_amdgcn_s_sleep(1);
        if ((++sp & 255u) == 0u) { if (xb_ld(&bar[XB_TMO])) break; if (sp > XB_SPIN_CAP) { atomicAdd(&bar[XB_TMO], 1u); break; } }
    }
    nloc = mine > 0u ? mine : 1u; nx = cnt > 0u ? cnt : 1u;
}

__device__ __forceinline__ void xcd_barrier(const XcdBarrier& b) {
    asm volatile("s_waitcnt vmcnt(0)" ::: "memory");
    __syncthreads();
    if (threadIdx.x == 0) {
        unsigned* bar = b.bar;
        __builtin_amdgcn_s_waitcnt(0);
        unsigned nloc = b.st[0], nx = b.st[1];
        if (nloc == 0u) { xcd_barrier_complete(bar, b.x, nloc, nx); b.st[0] = nloc; b.st[1] = nx; }
        const unsigned old = xb_add(&bar[XB_XSUB(b.x)], 1u);
        const unsigned gen = old / nloc;
        if (old + 1u == (gen + 1u) * nloc) {
            __builtin_amdgcn_fence(__ATOMIC_RELEASE, "agent");
            asm volatile("s_waitcnt vmcnt(0)" ::: "memory");
            const unsigned og = xb_add(&bar[XB_TOP], 1u);
            const unsigned tg = og / nx;
            if (og + 1u == (tg + 1u) * nx) xb_add(&bar[XB_TOPGEN], 1u);
            else XB_SPIN(xb_ld(&bar[XB_TOPGEN]) == tg, bar);
            __builtin_amdgcn_fence(__ATOMIC_ACQUIRE, "agent");
            xb_add(&bar[XB_XGEN(b.x)], 1u);
            asm volatile("s_waitcnt vmcnt(0)" ::: "memory");
        } else {
            XB_SPIN(xb_ld(&bar[XB_XGEN(b.x)]) == gen, bar);
            __builtin_amdgcn_fence(__ATOMIC_ACQUIRE, "agent");
            asm volatile("s_waitcnt vmcnt(0)" ::: "memory");
        }
    }
    __syncthreads();
}

struct Args { const float* in[26]; float* out; unsigned char* ws; };
struct Frame {
    LAS unsigned char* lds;
    volatile LAS unsigned* MISC;
    LAS int* META;
    gu32* ctl;
    unsigned char* ws; float* out;
    int tid, lane, wave, G, bx;
};
__device__ __forceinline__ Frame refresh(const Frame& f) { Frame r = f; int t = threadIdx.x; asm volatile("" : "+v"(t)); r.tid = t; r.lane = t & 63; r.wave = __builtin_amdgcn_readfirstlane(t >> 6); return r; }
__device__ __forceinline__ float bf2f(unsigned short u) { return __uint_as_float((unsigned)u << 16); }
__device__ __forceinline__ float bflo(unsigned w) { return __uint_as_float(w << 16); }
__device__ __forceinline__ float bfhi(unsigned w) { return __uint_as_float(w & 0xffff0000u); }
__device__ __forceinline__ float wave_sum(float v) {
#pragma unroll
    for (int o = 1; o < 64; o <<= 1) v += __shfl_xor(v, o);
    return v;
}
__device__ __forceinline__ float silu_f(float v) { return v * __builtin_amdgcn_rcpf(1.0f + __builtin_amdgcn_exp2f(-LOG2E * v)); }

__device__ __forceinline__ void tr_item(const float* W, int ldw, int k0, int nsrc0, bool valid, bf16* WT, int ldk, int drow0, float scale, LAS float* scr, int lane) {
    (void)scr;
    const int c4 = lane & 7, r8 = lane >> 3;
    f32x4 v[8];
    if (valid) { const float* wp = W + (size_t)(k0 + 8 * r8) * ldw + nsrc0 + 4 * c4;
#pragma unroll
        for (int i = 0; i < 8; ++i) v[i] = *(const f32x4*)(wp + (size_t)i * ldw) * scale;
    } else {
#pragma unroll
        for (int i = 0; i < 8; ++i) v[i] = (f32x4){0.f, 0.f, 0.f, 0.f};
    }
#pragma unroll
    for (int j = 0; j < 4; ++j) { v4u o; o.x = pk2(v[0][j], v[1][j]); o.y = pk2(v[2][j], v[3][j]); o.z = pk2(v[4][j], v[5][j]); o.w = pk2(v[6][j], v[7][j]);
        *(GAS v4u*)(WT + (size_t)(drow0 + 4 * c4 + j) * ldk + k0 + 8 * r8) = o; }
}
__device__ __forceinline__ void q_item(const float* W, int ldw, int nsrc0, bool valid, signed char* WT8, int drow0, float* sb, float post, LAS unsigned char* lds, int wave, int lane) {
    LAS float* cm = (LAS float*)lds;
    const int c4 = lane & 7, rs = lane >> 3;
    f32x4 v[16]; f32x4 mx = (f32x4){0.f, 0.f, 0.f, 0.f};
    if (valid) { const float* wp = W + (size_t)(wave * 128 + 16 * rs) * ldw + nsrc0 + 4 * c4;
#pragma unroll
        for (int i = 0; i < 16; ++i) v[i] = *(const f32x4*)(wp + (size_t)i * ldw);
#pragma unroll
        for (int i = 0; i < 16; ++i) { mx.x = fmaxf(mx.x, fabsf(v[i].x)); mx.y = fmaxf(mx.y, fabsf(v[i].y)); mx.z = fmaxf(mx.z, fabsf(v[i].z)); mx.w = fmaxf(mx.w, fabsf(v[i].w)); }
    } else {
#pragma unroll
        for (int i = 0; i < 16; ++i) v[i] = (f32x4){0.f, 0.f, 0.f, 0.f};
    }
#pragma unroll
    for (int o = 8; o < 64; o <<= 1) { mx.x = fmaxf(mx.x, __shfl_xor(mx.x, o)); mx.y = fmaxf(mx.y, __shfl_xor(mx.y, o)); mx.z = fmaxf(mx.z, __shfl_xor(mx.z, o)); mx.w = fmaxf(mx.w, __shfl_xor(mx.w, o)); }
    __syncthreads();
    if (rs == 0) *(LAS f32x4*)(cm + wave * 32 + 4 * c4) = mx;
    __syncthreads();
    f32x4 bm = *(const LAS f32x4*)(cm + 4 * c4);
#pragma unroll
    for (int w = 1; w < 8; ++w) { const f32x4 t = *(const LAS f32x4*)(cm + w * 32 + 4 * c4); bm.x = fmaxf(bm.x, t.x); bm.y = fmaxf(bm.y, t.y); bm.z = fmaxf(bm.z, t.z); bm.w = fmaxf(bm.w, t.w); }
    f32x4 sc; sc.x = bm.x > 0.f ? 127.0f / bm.x : 0.f; sc.y = bm.y > 0.f ? 127.0f / bm.y : 0.f; sc.z = bm.z > 0.f ? 127.0f / bm.z : 0.f; sc.w = bm.w > 0.f ? 127.0f / bm.w : 0.f;
#pragma unroll
    for (int j = 0; j < 4; ++j) { v4u o;
#pragma unroll
        for (int g = 0; g < 4; ++g) { const int q0 = (int)rintf(v[4 * g][j] * sc[j]), q1 = (int)rintf(v[4 * g + 1][j] * sc[j]), q2 = (int)rintf(v[4 * g + 2][j] * sc[j]), q3 = (int)rintf(v[4 * g + 3][j] * sc[j]);
            o[g] = (unsigned)(q0 & 255) | ((unsigned)(q1 & 255) << 8) | ((unsigned)(q2 & 255) << 16) | ((unsigned)(q3 & 255) << 24); }
        *(GAS v4u*)(WT8 + (size_t)(drow0 + 4 * c4 + j) * 1024 + wave * 128 + 16 * rs) = o; }
    if (wave == 0 && rs == 0) *(f32x4*)(sb + drow0 + 4 * c4) = bm * ((1.0f / 127.0f) * post);
}
__device__ __forceinline__ void f8_item(const float* W, int Kvalid, int Kdst, int nsrc0, unsigned char* WT8, int drow0, float* sb, LAS unsigned char* lds, int wave, int lane) {
    LAS float* cm = (LAS float*)lds;
    const int c4 = lane & 7, rs = lane >> 3, slot = wave * 8 + rs;
    const float* wp = W + nsrc0 + 4 * c4;
    f32x4 mx = (f32x4){0.f, 0.f, 0.f, 0.f};
#pragma unroll 16
    for (int k = slot; k < Kvalid; k += 64) { const f32x4 v = *(const f32x4*)(wp + (size_t)k * 1024); mx.x = fmaxf(mx.x, fabsf(v.x)); mx.y = fmaxf(mx.y, fabsf(v.y)); mx.z = fmaxf(mx.z, fabsf(v.z)); mx.w = fmaxf(mx.w, fabsf(v.w)); }
#pragma unroll
    for (int o = 8; o < 64; o <<= 1) { mx.x = fmaxf(mx.x, __shfl_xor(mx.x, o)); mx.y = fmaxf(mx.y, __shfl_xor(mx.y, o)); mx.z = fmaxf(mx.z, __shfl_xor(mx.z, o)); mx.w = fmaxf(mx.w, __shfl_xor(mx.w, o)); }
    __syncthreads();
    if (rs == 0) *(LAS f32x4*)(cm + wave * 32 + 4 * c4) = mx;
    __syncthreads();
    f32x4 bm = *(const LAS f32x4*)(cm + 4 * c4);
#pragma unroll
    for (int w = 1; w < 8; ++w) { const f32x4 t = *(const LAS f32x4*)(cm + w * 32 + 4 * c4); bm.x = fmaxf(bm.x, t.x); bm.y = fmaxf(bm.y, t.y); bm.z = fmaxf(bm.z, t.z); bm.w = fmaxf(bm.w, t.w); }
    f32x4 sc; sc.x = bm.x > 0.f ? 384.0f / bm.x : 0.f; sc.y = bm.y > 0.f ? 384.0f / bm.y : 0.f; sc.z = bm.z > 0.f ? 384.0f / bm.z : 0.f; sc.w = bm.w > 0.f ? 384.0f / bm.w : 0.f;
    for (int q = slot; q * 16 < Kdst; q += 64) {
        f32x4 v[16];
#pragma unroll
        for (int i = 0; i < 16; ++i) { const int k = q * 16 + i; v[i] = k < Kvalid ? *(const f32x4*)(wp + (size_t)k * 1024) : (f32x4){0.f, 0.f, 0.f, 0.f}; }
#pragma unroll
        for (int j = 0; j < 4; ++j) { v4u o;
#pragma unroll
            for (int g = 0; g < 4; ++g) o[g] = pg8::pk4_fp8(v[4 * g][j] * sc[j], v[4 * g + 1][j] * sc[j], v[4 * g + 2][j] * sc[j], v[4 * g + 3][j] * sc[j]);
            *(GAS v4u*)(WT8 + (size_t)(drow0 + 4 * c4 + j) * Kdst + q * 16) = o; }
    }
    if (wave == 0 && rs == 0) *(f32x4*)(sb + drow0 + 4 * c4) = bm * (1.0f / 384.0f);
}
constexpr float C2Q = 0.17677669529663687f * LOG2E;
__device__ __forceinline__ void p0_weights(Frame& F_, const Args& A) {
    Frame F = refresh(F_);
    for (int it0 = F.bx; it0 < 192 + 176 + 32; it0 += F.G) { int it = it0;
        if (it >= 192 + 176) { const int nb = it - 368; f8_item(A.in[21], FD, FDP, nb * 32, (unsigned char*)(F.ws + WS_WD), nb * 32, (float*)(F.ws + WS_SBWD), (LAS unsigned char*)F.lds, F.wave, F.lane); continue; }
        if (it < 192) { const int l = it / 96, nb = it - l * 96; const float post = nb < 8 ? C2Q : ((nb >= 72 && nb < 80) ? 0.125f : 1.0f);
            q_item(A.in[1] + (size_t)l * D * NIN, NIN, nb < 64 ? nb * 32 : nb * 32 + 8, true, (signed char*)(F.ws + WS_WIN) + (size_t)l * NPROJ * D, nb * 32, (float*)(F.ws + WS_SBI) + l * NPROJ, post, (LAS unsigned char*)F.lds, F.wave, F.lane); continue; }
        it -= 192;
        { const int nb = it, t = nb >> 3, sub = nb & 7, fcol = t * 128 + (sub & 3) * 32;
            q_item(sub < 4 ? A.in[19] : A.in[20], FD, fcol, fcol < FD, (signed char*)(F.ws + WS_WGU), nb * 32, (float*)(F.ws + WS_SBD), 1.0f, (LAS unsigned char*)F.lds, F.wave, F.lane); }
    }
    __syncthreads();
    LAS float* scr = (LAS float*)(F.lds + F.wave * 16384);
    const int gw = F.bx * NWAVES + F.wave, NGW = F.G * NWAVES;
    constexpr int I_OUT = 32 * 16;
    for (int it = gw; it < 2 * I_OUT; it += NGW) { const int l = it / I_OUT, r = it - l * I_OUT, kb = r / 32, nb = r % 32;
        tr_item(A.in[2] + (size_t)l * D * D, D, kb * 64, nb * 32, true, ((bf16*)(F.ws + WS_WOUT)) + (size_t)l * D * D, D, nb * 32, 1.0f, scr, F.lane); }
}
__device__ __forceinline__ void expert_weights(Frame& F_, const Args& A) {
    Frame F = refresh(F_);
    for (int r = F.bx; r < NEXP * 224; r += F.G) { const int e = r / 224, nb = r - e * 224, t = nb >> 3, sub = nb & 7, fcol = t * 128 + (sub & 3) * 32;
        q_item((sub < 4 ? A.in[23] : A.in[24]) + (size_t)e * D * FE, FE, fcol, true, (signed char*)(F.ws + WS_EGU) + (size_t)e * 2 * FE * D, nb * 32, (float*)(F.ws + WS_SBE) + e * 2 * FE, 1.0f, (LAS unsigned char*)F.lds, F.wave, F.lane); }
    for (int r = F.bx; r < NEXP * 32; r += F.G) { const int e = r >> 5, nb = r & 31;
        f8_item(A.in[25] + (size_t)e * FE * D, FE, FE, nb * 32, (unsigned char*)(F.ws + WS_ED) + (size_t)e * D * FE, nb * 32, (float*)(F.ws + WS_SBED) + e * D, (LAS unsigned char*)F.lds, F.wave, F.lane); }
    __syncthreads();
}

template <int MODE, bool OUT8 = false, bool SRC16 = false>
__device__ __forceinline__ void norm_phase(Frame& F_, const float* src, const float* gain, const float* wx, int ldw) {
    Frame F = refresh(F_);
    LAS float* Wl = (LAS float*)F.lds;
    if (MODE != 0) {
        for (int idx = F.tid; idx < 8 * D; idx += NWAVES * 64) { const int k = idx >> 3, j = idx & 7; Wl[j * D + k] = wx[(size_t)k * ldw + j]; }
        __syncthreads();
    }
    const int hl = F.lane & 31, hw = F.lane >> 5, gw = F.bx * NWAVES + F.wave, NGW = F.G * NWAVES;
    f32x4 g8[4][2];
#pragma unroll
    for (int j = 0; j < 4; ++j) { g8[j][0] = *(const f32x4*)(gain + 8 * (hl + 32 * j)); g8[j][1] = *(const f32x4*)(gain + 8 * (hl + 32 * j) + 4); }
#define NP_HSUM(x) do { _Pragma("unroll") for (int o_ = 1; o_ < 32; o_ <<= 1) x += __shfl_xor(x, o_); } while (0)
    for (int m = 2 * gw + hw; m < M; m += 2 * NGW) {
        f32x4 v[4][2]; float s = 0.f; uint2 q8[4]; float qsc = 0.f; (void)q8; (void)qsc;
        if constexpr (SRC16) { const v4u* xr = (const v4u*)((const bf16*)src + (size_t)m * D) + hl;
#pragma unroll
            for (int j = 0; j < 4; ++j) { const v4u w = xr[32 * j]; v[j][0] = (f32x4){bflo(w.x), bfhi(w.x), bflo(w.y), bfhi(w.y)}; v[j][1] = (f32x4){bflo(w.z), bfhi(w.z), bflo(w.w), bfhi(w.w)}; }
        } else { const f32x4* xr = (const f32x4*)(src + (size_t)m * D) + 2 * hl;
#pragma unroll
            for (int j = 0; j < 4; ++j) { v[j][0] = xr[64 * j]; v[j][1] = xr[64 * j + 1]; } }
#pragma unroll
        for (int j = 0; j < 4; ++j)
#pragma unroll
            for (int t = 0; t < 2; ++t) s += (v[j][t].x * v[j][t].x + v[j][t].y * v[j][t].y) + (v[j][t].z * v[j][t].z + v[j][t].w * v[j][t].w);
        NP_HSUM(s);
        const float rstd = __builtin_amdgcn_rsqf(s * (1.f / D) + EPS);
        float amax = 0.f;
#pragma unroll
        for (int j = 0; j < 4; ++j)
#pragma unroll
            for (int t = 0; t < 2; ++t) { v[j][t] = v[j][t] * rstd * g8[j][t]; amax = fmaxf(amax, fmaxf(fmaxf(fabsf(v[j][t].x), fabsf(v[j][t].y)), fmaxf(fabsf(v[j][t].z), fabsf(v[j][t].w)))); }
        if (!OUT8) {
            v4u* o16 = (v4u*)(((bf16*)(F.ws + WS_XN)) + (size_t)m * D) + hl;
#pragma unroll
            for (int j = 0; j < 4; ++j) { v4u o; o.x = pk2(v[j][0].x, v[j][0].y); o.y = pk2(v[j][0].z, v[j][0].w); o.z = pk2(v[j][1].x, v[j][1].y); o.w = pk2(v[j][1].z, v[j][1].w); o16[32 * j] = o; }
        } else {
#pragma unroll
            for (int o = 1; o < 32; o <<= 1) amax = fmaxf(amax, __shfl_xor(amax, o));
            const float qs = amax > 0.f ? 127.0f / amax : 0.f;
            uint2* o8 = (uint2*)(F.ws + WS_XN + (size_t)m * D) + hl;
            (void)o8;
#pragma unroll
            for (int j = 0; j < 4; ++j) { uint2 o;
                { const int q0 = (int)rintf(v[j][0].x * qs), q1 = (int)rintf(v[j][0].y * qs), q2 = (int)rintf(v[j][0].z * qs), q3 = (int)rintf(v[j][0].w * qs); o.x = (unsigned)(q0 & 255) | ((unsigned)(q1 & 255) << 8) | ((unsigned)(q2 & 255) << 16) | ((unsigned)(q3 & 255) << 24); }
                { const int q0 = (int)rintf(v[j][1].x * qs), q1 = (int)rintf(v[j][1].y * qs), q2 = (int)rintf(v[j][1].z * qs), q3 = (int)rintf(v[j][1].w * qs); o.y = (unsigned)(q0 & 255) | ((unsigned)(q1 & 255) << 8) | ((unsigned)(q2 & 255) << 16) | ((unsigned)(q3 & 255) << 24); }
                if constexpr (MODE == 2) q8[j] = o; else o8[32 * j] = o; }
            if constexpr (MODE == 2) qsc = amax * (1.0f / 127.0f); else if (hl == 0) ((float*)(F.ws + WS_XNS))[m] = amax * (1.0f / 127.0f);
        }
        if (MODE != 0) {
            float ex[8];
#pragma unroll
            for (int e = 0; e < 8; ++e) { float a = 0.f;
#pragma unroll
                for (int j = 0; j < 4; ++j) { const f32x4 w0 = *(const LAS f32x4*)(Wl + e * D + 8 * (hl + 32 * j)), w1 = *(const LAS f32x4*)(Wl + e * D + 8 * (hl + 32 * j) + 4);
                    a += (v[j][0].x * w0.x + v[j][0].y * w0.y) + (v[j][0].z * w0.z + v[j][0].w * w0.w) + (v[j][1].x * w1.x + v[j][1].y * w1.y) + (v[j][1].z * w1.z + v[j][1].w * w1.w); }
                NP_HSUM(a); ex[e] = a; asm volatile("" ::: "memory"); }
            if (MODE == 1) {
                float val = ex[0];
#pragma unroll
                for (int e = 1; e < 8; ++e) val = (hl == e) ? ex[e] : val;
                if (hl < 8) ((float*)(F.ws + WS_DT))[(size_t)m * 8 + hl] = val;
            } else {
                int e0 = 0; float v0 = ex[0];
#pragma unroll
                for (int e = 1; e < 8; ++e) if (ex[e] > v0) { v0 = ex[e]; e0 = e; }
                int e1 = -1; float v1 = -3.0e38f;
#pragma unroll
                for (int e = 0; e < 8; ++e) if (e != e0 && ex[e] > v1) { v1 = ex[e]; e1 = e; }
                int pos0 = 0, pos1 = 0;
                if (hl == 0) {
                    const float g0 = 1.0f / (1.0f + __expf(v1 - v0)), g1 = 1.0f - g0;
                    pos0 = (int)atomicAdd((unsigned*)(F.ctl + CW_CNT + 64 * e0), 1u); pos1 = (int)atomicAdd((unsigned*)(F.ctl + CW_CNT + 64 * e1), 1u);
                    ((int*)(F.ws + WS_TI))[m * 4 + 0] = e0 | (e1 << 8); ((int*)(F.ws + WS_TI))[m * 4 + 1] = pos0; ((int*)(F.ws + WS_TI))[m * 4 + 2] = pos1; ((int*)(F.ws + WS_TI))[m * 4 + 3] = 0;
                    ((float*)(F.ws + WS_TG))[m * 2 + 0] = g0; ((float*)(F.ws + WS_TG))[m * 2 + 1] = g1;
                }
                pos0 = __shfl(pos0, hw * 32); pos1 = __shfl(pos1, hw * 32);
                { const int pa = xg_panel(e0), pb = xg_panel(e1);
                  uint2* d0 = (uint2*)(F.ws + (size_t)pa * 262144 + (size_t)pos0 * 1024) + hl; uint2* d1 = (uint2*)(F.ws + (size_t)pb * 262144 + (size_t)pos1 * 1024) + hl;
#pragma unroll
                  for (int j = 0; j < 4; ++j) { d0[32 * j] = q8[j]; d1[32 * j] = q8[j]; }
                  if (hl == 0) { ((float*)(F.ws + WS_XGS2))[pa * 256 + pos0] = qsc; ((float*)(F.ws + WS_XGS2))[pb * 256 + pos1] = qsc; } }
            }
        }
    }
#undef NP_HSUM
    if (MODE != 0) __syncthreads();
}
__device__ __forceinline__ void combine_phase(Frame& F_, const Args& A) {
    Frame F = refresh(F_);
    const int hl = F.lane & 31, hw = F.lane >> 5, gw = F.bx * NWAVES + F.wave, NGW = F.G * NWAVES;
    f32x4 g8[4][2];
#pragma unroll
    for (int j = 0; j < 4; ++j) { g8[j][0] = *(const f32x4*)(A.in[5] + 8 * (hl + 32 * j)); g8[j][1] = *(const f32x4*)(A.in[5] + 8 * (hl + 32 * j) + 4); }
    for (int m = 2 * gw + hw; m < M; m += 2 * NGW) {
        const int ti = ((int*)(F.ws + WS_TI))[m * 4], e0 = ti & 255, e1 = ti >> 8;
        const size_t r0 = (size_t)F.META[8 + e0] * 256 + ((int*)(F.ws + WS_TI))[m * 4 + 1], r1 = (size_t)F.META[8 + e1] * 256 + ((int*)(F.ws + WS_TI))[m * 4 + 2];
        const float g0 = ((float*)(F.ws + WS_TG))[m * 2], g1 = ((float*)(F.ws + WS_TG))[m * 2 + 1];
        const v4u* xb = (const v4u*)((const bf16*)(F.ws + WS_XR) + (size_t)m * D) + hl;
        const v4u* y0 = (const v4u*)(((const bf16*)(F.ws + WS_MIX)) + r0 * D) + hl; const v4u* y1 = (const v4u*)(((const bf16*)(F.ws + WS_MIX)) + r1 * D) + hl;
        const v4u* z0 = (const v4u*)(((const bf16*)(F.ws + WS_XN)) + (r0 >= 32768 ? r0 - 32768 : 0) * D) + hl; const v4u* z1 = (const v4u*)(((const bf16*)(F.ws + WS_XN)) + (r1 >= 32768 ? r1 - 32768 : 0) * D) + hl;
        f32x4 v[4][2]; float s = 0.f;
#define CB_LO(w_) ((f32x4){bflo((w_).x), bfhi((w_).x), bflo((w_).y), bfhi((w_).y)})
#define CB_HI(w_) ((f32x4){bflo((w_).z), bfhi((w_).z), bflo((w_).w), bfhi((w_).w)})
#pragma unroll
        for (int j = 0; j < 4; ++j) { f32x4 ya0, ya1, yb0, yb1;
            if (r0 >= 32768) { ya0 = (f32x4){0.f, 0.f, 0.f, 0.f}; ya1 = ya0;
#pragma unroll
                for (int ks = 0; ks < 7; ++ks) { const v4u a = z0[(size_t)ks * 2048 * 128 + 32 * j]; ya0 += CB_LO(a); ya1 += CB_HI(a); } }
            else { const v4u a = y0[32 * j]; ya0 = CB_LO(a); ya1 = CB_HI(a); }
            if (r1 >= 32768) { yb0 = (f32x4){0.f, 0.f, 0.f, 0.f}; yb1 = yb0;
#pragma unroll
                for (int ks = 0; ks < 7; ++ks) { const v4u b = z1[(size_t)ks * 2048 * 128 + 32 * j]; yb0 += CB_LO(b); yb1 += CB_HI(b); } }
            else { const v4u b = y1[32 * j]; yb0 = CB_LO(b); yb1 = CB_HI(b); }
            const v4u xw = xb[32 * j];
            v[j][0] = CB_LO(xw) + ya0 * g0 + yb0 * g1; v[j][1] = CB_HI(xw) + ya1 * g0 + yb1 * g1;
            s += (v[j][0].x * v[j][0].x + v[j][0].y * v[j][0].y) + (v[j][0].z * v[j][0].z + v[j][0].w * v[j][0].w) + (v[j][1].x * v[j][1].x + v[j][1].y * v[j][1].y) + (v[j][1].z * v[j][1].z + v[j][1].w * v[j][1].w); }
#undef CB_LO
#undef CB_HI
#pragma unroll
        for (int o = 1; o < 32; o <<= 1) s += __shfl_xor(s, o);
        const float rstd = __builtin_amdgcn_rsqf(s * (1.f / D) + EPS);
        f32x4* xr = (f32x4*)(F.out + (size_t)m * D) + 2 * hl;
#pragma unroll
        for (int j = 0; j < 4; ++j) { xr[64 * j] = v[j][0] * rstd * g8[j][0]; xr[64 * j + 1] = v[j][1] * rstd * g8[j][1]; }
    }
}
__device__ __forceinline__ int t5_bucket(int rel) {
    const int n = rel < 0 ? -rel : rel;
    int b = n < 8 ? n : n < 12 ? 8 : n < 16 ? 9 : n < 23 ? 10 : n < 32 ? 11 : n < 46 ? 12 : n < 64 ? 13 : n < 91 ? 14 : 15;
    return rel > 0 ? b + 16 : b;
}
__device__ __forceinline__ void unpack8(const v4u w, float* f) { f[0] = bflo(w.x); f[1] = bfhi(w.x); f[2] = bflo(w.y); f[3] = bfhi(w.y); f[4] = bflo(w.z); f[5] = bfhi(w.z); f[6] = bflo(w.w); f[7] = bfhi(w.w); }

namespace pg8 {
template <int MODE> struct EpiResNorm {
    static constexpr bool PERM = false, AFTER_DRAIN = true;
    const float* base; float* out; const float* gain; const float* wx; int ldw;
    unsigned char* ws; unsigned* cnt;
    __device__ __forceinline__ void fused(f32x4 (&acc)[2][2][4][2], const Unit& u, int wr, int wc, int fr, int fq, PG8_LAS unsigned char* lds, int wid, int lane) const {
        PG8_LAS float* Wt = (PG8_LAS float*)lds;
        PG8_LAS float* P = (PG8_LAS float*)(lds + 8192);
        PG8_LAS float* S = (PG8_LAS float*)(lds + 8192 + 49152);
        PG8_LAS unsigned* flag = (PG8_LAS unsigned*)(lds + 8192 + 49152 + 1024);
        const int tid = wid * 64 + lane, ldc = 1024;
        if (MODE != 0) { for (int idx = tid; idx < 2048; idx += 512) { const int e = idx >> 8, c = idx & 255; Wt[idx] = wx[(size_t)(u.cn * BM + c) * ldw + e]; } }
        const int col0 = u.cn * BM + wc * 32 + 4 * fq;
        f32x4 g4[2][2];
#pragma unroll
        for (int bj = 0; bj < 2; ++bj)
#pragma unroll
            for (int n = 0; n < 2; ++n) g4[bj][n] = *(const f32x4*)(gain + col0 + bj * HALF + n * 16);
        asm volatile("s_waitcnt lgkmcnt(0)" ::: "memory"); __builtin_amdgcn_s_barrier(); asm volatile("" ::: "memory");
#pragma unroll
        for (int ai = 0; ai < 2; ++ai)
#pragma unroll
            for (int m = 0; m < 4; ++m) { const int r = ai * HALF + wr * 64 + m * 16 + fr; const size_t off = (size_t)(u.po * BM + r) * ldc + col0;
                float st[10];
#pragma unroll
                for (int k = 0; k < 10; ++k) st[k] = 0.f;
#pragma unroll
                for (int bj = 0; bj < 2; ++bj)
#pragma unroll
                    for (int n = 0; n < 2; ++n) { const f32x4 bs = *(const f32x4*)(base + off + bj * HALF + n * 16); const f32x4 x1 = bs + acc[ai][bj][m][n]; acc[ai][bj][m][n] = x1;
                        *(f32x4*)(out + off + bj * HALF + n * 16) = x1;
                        const f32x4 xg = x1 * g4[bj][n];
                        st[0] += (x1.x * x1.x + x1.y * x1.y) + (x1.z * x1.z + x1.w * x1.w);
                        st[1] = fmaxf(st[1], fmaxf(fmaxf(fabsf(xg.x), fabsf(xg.y)), fmaxf(fabsf(xg.z), fabsf(xg.w))));
                        if (MODE != 0) { const int cl = bj * HALF + wc * 32 + n * 16 + 4 * fq;
#pragma unroll
                            for (int e = 0; e < 8; ++e) { const f32x4 w = *(const PG8_LAS f32x4*)(Wt + e * 256 + cl); st[2 + e] += (xg.x * w.x + xg.y * w.y) + (xg.z * w.z + xg.w * w.w); if (e & 1) asm volatile("" ::: "memory"); } } }
                st[0] += __shfl_xor(st[0], 16); st[0] += __shfl_xor(st[0], 32); st[1] = fmaxf(st[1], __shfl_xor(st[1], 16)); st[1] = fmaxf(st[1], __shfl_xor(st[1], 32));
                if (MODE != 0) {
#pragma unroll
                    for (int e = 0; e < 8; ++e) { st[2 + e] += __shfl_xor(st[2 + e], 16); st[2 + e] += __shfl_xor(st[2 + e], 32); } }
                if (fq == 0) { PG8_LAS float* p = P + (r * 4 + wc) * 12;
                    p[0] = st[0]; p[1] = st[1];
                    if (MODE != 0) {
#pragma unroll
                        for (int e = 0; e < 8; ++e) p[2 + e] = st[2 + e]; } }
                asm volatile("" ::: "memory"); }
        asm volatile("s_waitcnt lgkmcnt(0)" ::: "memory"); __builtin_amdgcn_s_barrier(); asm volatile("" ::: "memory");
        const int row = wid * 32 + (lane & 31);
        unsigned long long* slot = (unsigned long long*)((float*)(ws + WS_XCH) + ((size_t)(u.po * BM + row) * 4 + u.cn) * 12);
        if (lane < 32) { float t[10];
#pragma unroll
            for (int k = 0; k < 10; ++k) { const float a = P[(row * 4 + 0) * 12 + k], b = P[(row * 4 + 1) * 12 + k], c = P[(row * 4 + 2) * 12 + k], d = P[(row * 4 + 3) * 12 + k];
                t[k] = (k == 1) ? fmaxf(fmaxf(a, b), fmaxf(c, d)) : (a + b) + (c + d); }
#pragma unroll
            for (int k = 0; k < 5; ++k) __hip_atomic_store(slot + k, ((unsigned long long)__float_as_uint(t[2 * k + 1]) << 32) | __float_as_uint(t[2 * k]), __ATOMIC_RELAXED, __HIP_MEMORY_SCOPE_AGENT); }
        asm volatile("s_waitcnt vmcnt(0)" ::: "memory");
        if (lane == 0) __hip_atomic_fetch_add(cnt + 64 * u.po, 1u, __ATOMIC_RELAXED, __HIP_MEMORY_SCOPE_AGENT);
        if (wid == 0) {
            const unsigned long long t0 = __builtin_amdgcn_s_memrealtime();
            for (;;) {
                if ((unsigned)__builtin_amdgcn_readfirstlane(__hip_atomic_load(cnt + 64 * u.po, __ATOMIC_RELAXED, __HIP_MEMORY_SCOPE_AGENT)) >= 32u) break;
                if (__builtin_amdgcn_s_memrealtime() - t0 > 2000000ull) break;
                __builtin_amdgcn_s_sleep(2);
            }
            __builtin_amdgcn_fence(__ATOMIC_ACQUIRE, "agent");
            if (lane == 0) flag[0] = 1u;
        }
        asm volatile("s_waitcnt vmcnt(0) lgkmcnt(0)" ::: "memory"); __builtin_amdgcn_s_barrier(); asm volatile("" ::: "memory");
        if (lane < 32) { const unsigned long long* sl = (const unsigned long long*)((const float*)(ws + WS_XCH) + (size_t)(u.po * BM + row) * 4 * 12);
            float t[10];
#pragma unroll
            for (int k = 0; k < 10; ++k) t[k] = 0.f;
#pragma unroll
            for (int tl = 0; tl < 4; ++tl)
#pragma unroll
                for (int k = 0; k < 5; ++k) { const unsigned long long w = __hip_atomic_load(sl + tl * 6 + k, __ATOMIC_RELAXED, __HIP_MEMORY_SCOPE_AGENT);
                    const float lo = __uint_as_float((unsigned)w), hi = __uint_as_float((unsigned)(w >> 32));
                    if (k == 0) { t[0] += lo; t[1] = fmaxf(t[1], hi); } else { t[2 * k] += lo; t[2 * k + 1] += hi; } }
            const float rstd = __builtin_amdgcn_rsqf(t[0] * (1.f / 1024.f) + 1e-6f), arow = t[1] * rstd;
            S[row] = arow > 0.f ? rstd * (127.0f / arow) : 0.f;
            if (u.cn == 0) { const size_t grow = (size_t)u.po * BM + row;
                ((float*)(ws + WS_XNS))[grow] = arow * (1.0f / 127.0f);
                if (MODE == 1) { *(f32x4*)((float*)(ws + WS_DT) + grow * 8) = (f32x4){t[2] * rstd, t[3] * rstd, t[4] * rstd, t[5] * rstd}; *(f32x4*)((float*)(ws + WS_DT) + grow * 8 + 4) = (f32x4){t[6] * rstd, t[7] * rstd, t[8] * rstd, t[9] * rstd}; }
                if (MODE == 2) { float ex[8];
#pragma unroll
                    for (int e = 0; e < 8; ++e) ex[e] = t[2 + e] * rstd;
                    int e0 = 0; float v0 = ex[0];
#pragma unroll
                    for (int e = 1; e < 8; ++e) if (ex[e] > v0) { v0 = ex[e]; e0 = e; }
                    int e1 = -1; float v1 = -3.0e38f;
#pragma unroll
                    for (int e = 0; e < 8; ++e) if (e != e0 && ex[e] > v1) { v1 = ex[e]; e1 = e; }
                    const float g0 = 1.0f / (1.0f + __expf(v1 - v0)), g1 = 1.0f - g0; const int mtok = (int)grow;
                    unsigned* ctl = (unsigned*)(ws + WS_CTL);
                    const int pos0 = (int)atomicAdd(ctl + CW_CNT + 64 * e0, 1u), pos1 = (int)atomicAdd(ctl + CW_CNT + 64 * e1, 1u);
                    int* LIST = (int*)(ws + WS_LIST); int* TI = (int*)(ws + WS_TI); float* TG = (float*)(ws + WS_TG);
                    LIST[e0 * 16384 + pos0] = mtok; LIST[e1 * 16384 + pos1] = mtok;
                    TI[mtok * 4 + 0] = e0 | (e1 << 8); TI[mtok * 4 + 1] = pos0; TI[mtok * 4 + 2] = pos1; TI[mtok * 4 + 3] = 0;
                    TG[mtok * 2 + 0] = g0; TG[mtok * 2 + 1] = g1; } } }
        asm volatile("s_waitcnt lgkmcnt(0)" ::: "memory"); __builtin_amdgcn_s_barrier(); asm volatile("" ::: "memory");
        unsigned char* XN8 = ws + WS_XN;
#pragma unroll
        for (int ai = 0; ai < 2; ++ai)
#pragma unroll
            for (int m = 0; m < 4; ++m) { const int r = ai * HALF + wr * 64 + m * 16 + fr; const float s = S[r]; unsigned char* rowp = XN8 + (size_t)(u.po * BM + r) * 1024 + col0;
#pragma unroll
                for (int bj = 0; bj < 2; ++bj)
#pragma unroll
                    for (int n = 0; n < 2; ++n) { const f32x4 q = acc[ai][bj][m][n] * g4[bj][n] * s;
                        const int q0 = (int)rintf(q.x), q1 = (int)rintf(q.y), q2 = (int)rintf(q.z), q3 = (int)rintf(q.w);
                        *(unsigned*)(rowp + bj * HALF + n * 16) = (unsigned)(q0 & 255) | ((unsigned)(q1 & 255) << 8) | ((unsigned)(q2 & 255) << 16) | ((unsigned)(q3 & 255) << 24); } }
    }
};
}
namespace att {
typedef short v4i16_t __attribute__((ext_vector_type(4)));
typedef short s16x4 __attribute__((ext_vector_type(4)));
typedef float f32x16 __attribute__((ext_vector_type(16)));
constexpr int NSLOT = 3, SLOTB = 8192;
constexpr int LDS_K = 0, LDS_V = NSLOT * SLOTB, LDS_BT = 2 * NSLOT * SLOTB, LDS_WS = LDS_BT + 2048, LDS_OST = LDS_WS + 2048, OST_W = 32 * 68, LDS_END = LDS_OST + 8 * OST_W * 4;
static_assert(LDS_END <= RING_BYTES, "attention LDS map");
constexpr float THR = 8.0f;
__device__ __forceinline__ s16x4 vtr(const LAS char* p) { return __builtin_bit_cast(s16x4, __builtin_amdgcn_ds_read_tr16_b64_v4i16((LAS v4i16_t*)p)); }
__device__ __forceinline__ int crow(int r, int hi) { return (r & 3) + 8 * (r >> 2) + 4 * hi; }
__device__ __forceinline__ float xhalf_max(float v) { auto rr = __builtin_amdgcn_permlane32_swap(__float_as_uint(v), __float_as_uint(v), false, false); return fmaxf(__uint_as_float(rr[0]), __uint_as_float(rr[1])); }
__device__ __forceinline__ float xhalf_sum(float v) { auto rr = __builtin_amdgcn_permlane32_swap(__float_as_uint(v), __float_as_uint(v), false, false); return __uint_as_float(rr[0]) + __uint_as_float(rr[1]); }
#define ATT_WAIT_BAR(N) asm volatile("s_waitcnt vmcnt(" #N ") lgkmcnt(0)\n\ts_barrier" ::: "memory")

__device__ __forceinline__ void attn_unit(Frame& F_, const Args& A, int l, int b, int h, int qb, float lam, float oscale) {
    Frame F = refresh(F_);
    const int tid = F.tid, lane = tid & 63, wid = F.wave, r32 = lane & 31, hi = lane >> 5, t = wid >> 2, wq = wid & 3;
    const int Q0 = qb * 128, row0 = Q0 + 32 * wq, NT = 2 * qb + 2, cq = 2 * qb + (wq >> 1);
    const bf16* PROJ = (const bf16*)(F.ws + WS_BIG); const size_t rb = (size_t)b * SEQ;
    LAS char* L = (LAS char*)F.lds;
    LAS float* Bt = (LAS float*)(L + LDS_BT); LAS float* wsf = (LAS float*)(L + LDS_WS) + wid * 64; LAS float* stg = (LAS float*)(L + LDS_OST) + wid * OST_W;
    ATT_WAIT_BAR(0);
    const float cb = A.in[6][15 * 4 + h] * LOG2E;
    if (tid < 320) Bt[tid] = A.in[6][t5_bucket(tid - 255) * 4 + h] * LOG2E - cb;
    bf16x8 qr[2];
#pragma unroll
    for (int s = 0; s < 2; ++s) qr[s] = *(const bf16x8*)(PROJ + (rb + row0 + r32) * NPROJ + PC_Q + h * 64 + t * 32 + s * 16 + hi * 8);
    const int krow = wid * 8 + (lane >> 3);
    const bf16* ksrc = PROJ + (rb + krow) * NPROJ + PC_K + h * 64 + (((lane & 7) ^ (krow & 7)) * 8);
    const bf16* vsrc = PROJ + (rb + 16 * (wid & 3) + (lane >> 2)) * NPROJ + PC_V + h * 64 + (wid >> 2) * 32 + (lane & 3) * 8;
#define ATT_DMA(tile, sl) do { \
        __builtin_amdgcn_global_load_lds((const unsigned*)(ksrc + (size_t)(tile) * 64 * NPROJ), (LAS unsigned*)(L + LDS_K + (sl) * SLOTB + wid * 1024), 16, 0, 0); \
        __builtin_amdgcn_global_load_lds((const unsigned*)(vsrc + (size_t)(tile) * 64 * NPROJ), (LAS unsigned*)(L + LDS_V + (sl) * SLOTB + wid * 1024), 16, 0, 0); } while (0)
    ATT_DMA(0, 0); ATT_DMA(1, 1);
    f32x16 o0, o1, zero16;
#pragma unroll
    for (int r = 0; r < 16; ++r) { o0[r] = 0.f; o1[r] = 0.f; zero16[r] = 0.f; }
    float lsum = 0.f;
    const int kf0 = r32 * 128 + (((t * 4 + hi) ^ (r32 & 7)) * 16), kf1 = r32 * 128 + (((t * 4 + 2 + hi) ^ (r32 & 7)) * 16);
    const int vfo = ((lane >> 4) & 1) * 32 + (lane & 3) * 8 + (4 * hi + ((lane & 15) >> 2)) * 64;
    int slot = 0;
    for (int tile = 0; tile < NT; ++tile) {
        if (tile + 1 < NT) ATT_WAIT_BAR(2); else ATT_WAIT_BAR(0);
        if (tile + 2 < NT) { const int s2 = slot >= 1 ? slot - 1 : 2; ATT_DMA(tile + 2, s2); }
        if (tile <= cq) {
            const LAS char* Ks = L + LDS_K + slot * SLOTB; const LAS char* Vs = L + LDS_V + slot * SLOTB + vfo;
            f32x16 p0, p1;
            { const bf16x8 k00 = *(const LAS bf16x8*)(Ks + kf0), k01 = *(const LAS bf16x8*)(Ks + kf1), k10 = *(const LAS bf16x8*)(Ks + 4096 + kf0), k11 = *(const LAS bf16x8*)(Ks + 4096 + kf1);
              p0 = __builtin_amdgcn_mfma_f32_32x32x16_bf16(k00, qr[0], zero16, 0, 0, 0); p0 = __builtin_amdgcn_mfma_f32_32x32x16_bf16(k01, qr[1], p0, 0, 0, 0);
              p1 = __builtin_amdgcn_mfma_f32_32x32x16_bf16(k10, qr[0], zero16, 0, 0, 0); p1 = __builtin_amdgcn_mfma_f32_32x32x16_bf16(k11, qr[1], p1, 0, 0, 0); }
            const int K0 = tile * 64;
            if (K0 > row0 - 154) {
                const LAS float* bp = Bt + (K0 - row0 + 255 + 4 * hi - r32);
#pragma unroll
                for (int r = 0; r < 16; ++r) { p0[r] += bp[(r & 3) + 8 * (r >> 2)]; p1[r] += bp[32 + (r & 3) + 8 * (r >> 2)]; }
            }
            float sacc = 0.f;
#pragma unroll
            for (int r = 0; r < 16; ++r) { p0[r] = __builtin_amdgcn_exp2f(p0[r]); p1[r] = __builtin_amdgcn_exp2f(p1[r]); sacc += p0[r] + p1[r]; }
            lsum += sacc;
            bf16x8 pa[4];
            { v4u w;
              w.x = pk2(p0[0], p0[1]); w.y = pk2(p0[2], p0[3]); w.z = pk2(p0[4], p0[5]); w.w = pk2(p0[6], p0[7]); pa[0] = __builtin_bit_cast(bf16x8, w);
              w.x = pk2(p0[8], p0[9]); w.y = pk2(p0[10], p0[11]); w.z = pk2(p0[12], p0[13]); w.w = pk2(p0[14], p0[15]); pa[1] = __builtin_bit_cast(bf16x8, w);
              w.x = pk2(p1[0], p1[1]); w.y = pk2(p1[2], p1[3]); w.z = pk2(p1[4], p1[5]); w.w = pk2(p1[6], p1[7]); pa[2] = __builtin_bit_cast(bf16x8, w);
              w.x = pk2(p1[8], p1[9]); w.y = pk2(p1[10], p1[11]); w.z = pk2(p1[12], p1[13]); w.w = pk2(p1[14], p1[15]); pa[3] = __builtin_bit_cast(bf16x8, w); }
#pragma unroll
            for (int k = 0; k < 4; ++k) {
                const s16x4 a0 = vtr(Vs + k * 1024), a1 = vtr(Vs + k * 1024 + 512), c0 = vtr(Vs + 4096 + k * 1024), c1 = vtr(Vs + 4096 + k * 1024 + 512);
                const bf16x8 v0 = (bf16x8){a0[0], a0[1], a0[2], a0[3], a1[0], a1[1], a1[2], a1[3]}, v1 = (bf16x8){c0[0], c0[1], c0[2], c0[3], c1[0], c1[1], c1[2], c1[3]};
                o0 = __builtin_amdgcn_mfma_f32_32x32x16_bf16(pa[k], v0, o0, 0, 0, 0);
                o1 = __builtin_amdgcn_mfma_f32_32x32x16_bf16(pa[k], v1, o1, 0, 0, 0);
            }
        }
        slot = slot == 2 ? 0 : slot + 1;
    }
    lsum = xhalf_sum(lsum);
    if (hi == 0) wsf[32 + r32] = lsum;
    asm volatile("s_waitcnt lgkmcnt(0)" ::: "memory");
#pragma unroll
    for (int r = 0; r < 16; ++r) { const int q = crow(r, hi); const float rl = __builtin_amdgcn_rcpf(wsf[32 + q]); stg[q * 68 + r32] = o0[r] * rl; stg[q * 68 + 32 + r32] = o1[r] * rl; }
    ATT_WAIT_BAR(0);
    if (t == 0) {
        const LAS float* s1 = stg + 4 * OST_W; const float* gn = A.in[11] + l * 64; bf16* MIXp = (bf16*)(F.ws + WS_MIX);
#pragma unroll
        for (int i = 0; i < 4; ++i) { const int row = i * 8 + (lane >> 3), ch = lane & 7;
            const f32x4 a0 = *(const LAS f32x4*)(stg + row * 68 + ch * 8), a1 = *(const LAS f32x4*)(stg + row * 68 + ch * 8 + 4), b0 = *(const LAS f32x4*)(s1 + row * 68 + ch * 8), b1 = *(const LAS f32x4*)(s1 + row * 68 + ch * 8 + 4);
            const f32x4 x0 = a0 - b0 * lam, x1 = a1 - b1 * lam;
            float ss = (x0.x * x0.x + x0.y * x0.y) + (x0.z * x0.z + x0.w * x0.w) + (x1.x * x1.x + x1.y * x1.y) + (x1.z * x1.z + x1.w * x1.w);
            ss += __shfl_xor(ss, 1); ss += __shfl_xor(ss, 2); ss += __shfl_xor(ss, 4);
            const float rstd = __builtin_amdgcn_rsqf(ss * (1.f / 64.f) + EPS) * oscale;
            const f32x4 g0 = *(const f32x4*)(gn + ch * 8), g1 = *(const f32x4*)(gn + ch * 8 + 4);
            v4u w; w.x = pk2(x0.x * rstd * g0.x, x0.y * rstd * g0.y); w.y = pk2(x0.z * rstd * g0.z, x0.w * rstd * g0.w); w.z = pk2(x1.x * rstd * g1.x, x1.y * rstd * g1.y); w.w = pk2(x1.z * rstd * g1.z, x1.w * rstd * g1.w);
            *(v4u*)(MIXp + (rb + row0 + row) * D + h * 64 + ch * 8) = w; }
    }
#undef ATT_DMA
}
}
namespace ssd {
typedef unsigned u32x2 __attribute__((ext_vector_type(2)));
using att::f32x16; using att::s16x4; using att::vtr; using att::crow;
constexpr int XS = 0, BK = 32768, CK = 40960, BW = 49152, HB = 81920, SM = 114688, CW = 122880;
constexpr int SM_VL = 0, SM_US = 256, SM_EO = 512, SM_WS = 768, SM_DT = 1024, SM_DK = 1028, SM_AK = 1032, SM_DB = 1036, SM_GN = 1040;
#define SSD_BAR() asm volatile("s_waitcnt lgkmcnt(0)\n\ts_barrier" ::: "memory")
__device__ __forceinline__ bf16x8 trfrag(const LAS char* p) { const s16x4 a = vtr(p), b = vtr(p + 512); return (bf16x8){a[0], a[1], a[2], a[3], b[0], b[1], b[2], b[3]}; }
__device__ __forceinline__ bf16x8 packfrag(const f32x16& x, int s) { v4u w; w.x = pk2(x[8 * s], x[8 * s + 1]); w.y = pk2(x[8 * s + 2], x[8 * s + 3]); w.z = pk2(x[8 * s + 4], x[8 * s + 5]); w.w = pk2(x[8 * s + 6], x[8 * s + 7]); return __builtin_bit_cast(bf16x8, w); }
#define SSD_LO(q_) ((f32x4){bflo((q_).x), bfhi((q_).x), bflo((q_).y), bfhi((q_).y)})
#define SSD_HI(q_) ((f32x4){bflo((q_).z), bfhi((q_).z), bflo((q_).w), bfhi((q_).w)})

__device__ __forceinline__ void ssd_m1_unit(Frame& F_, const Args& A, int l, int b, int c, int g) {
    Frame F = refresh(F_);
    const int tid = F.tid, lane = tid & 63, wid = F.wave, r32 = lane & 31, hi = lane >> 5, hh = wid >> 1, lh = wid & 1;
    LAS char* L = (LAS char*)F.lds; LAS float* sm = (LAS float*)(L + SM); LAS float* cwl = (LAS float*)(L + CW);
    const bf16* PROJ = (const bf16*)(F.ws + WS_BIG); const float* DTg = (const float*)(F.ws + WS_DT);
    bf16* XC = (bf16*)(F.ws + WS_XC); bf16* YD = (bf16*)(F.ws + WS_YD); bf16* SST = (bf16*)(F.ws + WS_SST);
    const size_t rowb = (size_t)b * SEQ + (size_t)c * 64;
    const int tg = tid / 48, cc = tid - tg * 48;
    const int gcol = PC_XBC + (cc < 32 ? g * 256 + cc * 8 : cc < 40 ? 512 + g * 64 + (cc - 32) * 8 : 640 + g * 64 + (cc - 40) * 8);
    v4u raw[11];
#pragma unroll
    for (int i = 0; i < 11; ++i) { const int trow = c * 64 + 8 * tg - 3 + i; raw[i] = (tid < 384 && trow >= 0) ? *(const v4u*)(PROJ + ((size_t)b * SEQ + trow) * NPROJ + gcol) : (v4u){0u, 0u, 0u, 0u}; }
    f32x4 d4 = (f32x4){0.f, 0.f, 0.f, 0.f};
    if (wid == 7) d4 = *(const f32x4*)(DTg + (rowb + lane) * 8 + g * 4);
    SSD_BAR();
    for (int i = tid; i < 5 * 384; i += 512) { const int w = i / 384, li = i - w * 384; const int ch = li < 256 ? g * 256 + li : li < 320 ? 512 + g * 64 + (li - 256) : 640 + g * 64 + (li - 320);
        cwl[i] = w < 4 ? A.in[12][(size_t)l * 4 * 768 + w * 768 + ch] : A.in[13][l * 768 + ch]; }
    if (tid < 4) { sm[SM_AK + tid] = -__expf(A.in[15][l * 8 + g * 4 + tid]); sm[SM_DB + tid] = A.in[14][l * 8 + g * 4 + tid]; }
    SSD_BAR();
    if (tid < 384) {
        const int dsto = cc < 32 ? XS + (cc >> 3) * 8192 + ((cc & 7) >> 2) * 4096 + ((cc & 3) * 8) * 2 : cc < 40 ? BK + (cc - 32) * 1024 : CK + (cc - 40) * 1024;
        const int dstr = cc < 32 ? 64 : 16;
        const int xcol = cc < 32 ? g * 256 + cc * 8 : 512 + g * 64 + (cc - 40) * 8;
        const f32x4 w0a = *(const LAS f32x4*)(cwl + cc * 8), w0b = *(const LAS f32x4*)(cwl + cc * 8 + 4), w1a = *(const LAS f32x4*)(cwl + 384 + cc * 8), w1b = *(const LAS f32x4*)(cwl + 384 + cc * 8 + 4);
        const f32x4 w2a = *(const LAS f32x4*)(cwl + 768 + cc * 8), w2b = *(const LAS f32x4*)(cwl + 768 + cc * 8 + 4), w3a = *(const LAS f32x4*)(cwl + 1152 + cc * 8), w3b = *(const LAS f32x4*)(cwl + 1152 + cc * 8 + 4);
        const f32x4 cba = *(const LAS f32x4*)(cwl + 1536 + cc * 8), cbb = *(const LAS f32x4*)(cwl + 1536 + cc * 8 + 4);
#pragma unroll
        for (int j = 0; j < 8; ++j) {
            const f32x4 va = cba + SSD_LO(raw[j]) * w0a + SSD_LO(raw[j + 1]) * w1a + SSD_LO(raw[j + 2]) * w2a + SSD_LO(raw[j + 3]) * w3a;
            const f32x4 vb = cbb + SSD_HI(raw[j]) * w0b + SSD_HI(raw[j + 1]) * w1b + SSD_HI(raw[j + 2]) * w2b + SSD_HI(raw[j + 3]) * w3b;
            v4u o; o.x = pk2(silu_f(va.x), silu_f(va.y)); o.y = pk2(silu_f(va.z), silu_f(va.w)); o.z = pk2(silu_f(vb.x), silu_f(vb.y)); o.w = pk2(silu_f(vb.z), silu_f(vb.w));
            *(LAS v4u*)(L + dsto + (8 * tg + j) * dstr) = o;
            if (cc < 32 || cc >= 40) *(v4u*)(XC + (rowb + 8 * tg + j) * 640 + xcol) = o;
        }
    } else if (wid == 7) {
        float dtr[4] = {d4.x, d4.y, d4.z, d4.w}; float tot[4];
#pragma unroll
        for (int k = 0; k < 4; ++k) { const float Ak = sm[SM_AK + k], dbk = sm[SM_DB + k];
            const float xr = dtr[k] + dbk; const float dt = xr > 20.f ? xr : log1pf(__expf(xr));
            float acs = Ak * dt;
#pragma unroll
            for (int o = 1; o < 64; o <<= 1) { const float u = __shfl_up(acs, o); if (lane >= o) acs += u; }
            tot[k] = __shfl(acs, 63);
            sm[SM_VL + k * 64 + lane] = acs * LOG2E; sm[SM_US + k * 64 + lane] = acs * LOG2E - __log2f(dt);
            sm[SM_WS + k * 64 + lane] = __expf(tot[k] - acs) * dt; dtr[k] = __expf(acs); }
        *(f32x4*)((float*)(F.ws + WS_EOFF) + (rowb + lane) * 8 + g * 4) = (f32x4){dtr[0], dtr[1], dtr[2], dtr[3]};
        if (lane == 0) *(f32x4*)((float*)(F.ws + WS_DTOT) + ((size_t)(b * 128 + c)) * 8 + g * 4) = (f32x4){__expf(tot[0]), __expf(tot[1]), __expf(tot[2]), __expf(tot[3])};
    }
    SSD_BAR();
    { const int s = tid >> 3, nc = tid & 7; const v4u b8 = *(const LAS v4u*)(L + BK + nc * 1024 + s * 16);
      const f32x4 ba = SSD_LO(b8), bb = SSD_HI(b8);
#pragma unroll
      for (int k = 0; k < 4; ++k) { const float w = sm[SM_WS + k * 64 + s]; v4u o; o.x = pk2(ba.x * w, ba.y * w); o.y = pk2(ba.z * w, ba.w * w); o.z = pk2(bb.x * w, bb.y * w); o.w = pk2(bb.z * w, bb.w * w);
          *(LAS v4u*)(L + BW + k * 8192 + (nc >> 2) * 4096 + s * 64 + (nc & 3) * 16) = o; } }
    SSD_BAR();
    const int kfo = hi * 1024 + r32 * 16;
    const int vfo = ((lane >> 4) & 1) * 32 + (lane & 3) * 8 + (4 * hi + ((lane & 15) >> 2)) * 64;
    f32x16 y0, y1, h0, h1;
#pragma unroll
    for (int r = 0; r < 16; ++r) { y0[r] = 0.f; y1[r] = 0.f; h0[r] = 0.f; h1[r] = 0.f; }
    {
        bf16x8 cf[4];
#pragma unroll
        for (int ks = 0; ks < 4; ++ks) cf[ks] = *(const LAS bf16x8*)(L + CK + kfo + ks * 2048 + lh * 512);
        const float vl = sm[SM_VL + hh * 64 + 32 * lh + r32];
#pragma unroll
        for (int sb = 0; sb < 2; ++sb) {
            if (sb <= lh) {
                f32x16 T;
#pragma unroll
                for (int r = 0; r < 16; ++r) T[r] = 0.f;
#pragma unroll
                for (int ks = 0; ks < 4; ++ks) { const bf16x8 bfr = *(const LAS bf16x8*)(L + BK + kfo + ks * 2048 + sb * 512); T = __builtin_amdgcn_mfma_f32_32x32x16_bf16(bfr, cf[ks], T, 0, 0, 0); }
#pragma unroll
                for (int r = 0; r < 16; ++r) { const float us = sm[SM_US + hh * 64 + 32 * sb + crow(r, hi)]; float w = T[r] * __builtin_amdgcn_exp2f(vl - us);
                    if (sb == lh && crow(r, hi) > r32) w = 0.f; T[r] = w; }
                const bf16x8 pa0 = packfrag(T, 0), pa1 = packfrag(T, 1);
                const LAS char* xb = L + XS + hh * 8192 + vfo + sb * 2048;
                const bf16x8 x00 = trfrag(xb), x01 = trfrag(xb + 4096), x10 = trfrag(xb + 1024), x11 = trfrag(xb + 4096 + 1024);
                y0 = __builtin_amdgcn_mfma_f32_32x32x16_bf16(pa0, x00, y0, 0, 0, 0); y1 = __builtin_amdgcn_mfma_f32_32x32x16_bf16(pa0, x01, y1, 0, 0, 0);
                y0 = __builtin_amdgcn_mfma_f32_32x32x16_bf16(pa1, x10, y0, 0, 0, 0); y1 = __builtin_amdgcn_mfma_f32_32x32x16_bf16(pa1, x11, y1, 0, 0, 0);
            }
        }
#pragma unroll
        for (int ks = 0; ks < 4; ++ks) { const bf16x8 xa = trfrag(L + XS + hh * 8192 + lh * 4096 + vfo + ks * 1024), b0 = trfrag(L + BW + hh * 8192 + vfo + ks * 1024), b1 = trfrag(L + BW + hh * 8192 + 4096 + vfo + ks * 1024);
            h0 = __builtin_amdgcn_mfma_f32_32x32x16_bf16(xa, b0, h0, 0, 0, 0); h1 = __builtin_amdgcn_mfma_f32_32x32x16_bf16(xa, b1, h1, 0, 0, 0); }
    }
    { bf16* img = SST + ((size_t)((b * 128 + c) * 8 + g * 4 + hh)) * 4096;
#pragma unroll
      for (int r = 0; r < 16; ++r) { const int p = 32 * lh + crow(r, hi);
          img[(r32 >> 3) * 512 + p * 8 + (r32 & 7)] = (bf16)f2bf(h0[r]); img[(4 + (r32 >> 3)) * 512 + p * 8 + (r32 & 7)] = (bf16)f2bf(h1[r]); } }
    SSD_BAR();
#pragma unroll
    for (int r = 0; r < 16; ++r) { const int lrow = 32 * lh + crow(r, hi);
        *(LAS unsigned short*)(L + BW + (lrow * 256 + hh * 64 + r32) * 2) = (unsigned short)f2bf(y0[r]);
        *(LAS unsigned short*)(L + BW + (lrow * 256 + hh * 64 + 32 + r32) * 2) = (unsigned short)f2bf(y1[r]); }
    SSD_BAR();
#pragma unroll
    for (int k = 0; k < 4; ++k) { const int tk = wid * 8 + 2 * k + (lane >> 5), chn = (lane & 31) * 8;
        *(v4u*)(YD + (rowb + tk) * 512 + g * 256 + chn) = *(const LAS v4u*)(L + BW + (tk * 256 + chn) * 2); }
}

__device__ __forceinline__ void ssd_m3_unit(Frame& F_, const Args& A, int l, int b, int c, int g) {
    Frame F = refresh(F_);
    const int tid = F.tid, lane = tid & 63, wid = F.wave, r32 = lane & 31, hi = lane >> 5, hh = wid >> 1, lh = wid & 1;
    LAS char* L = (LAS char*)F.lds; LAS float* sm = (LAS float*)(L + SM);
    const bf16* PROJ = (const bf16*)(F.ws + WS_BIG); const bf16* XC = (const bf16*)(F.ws + WS_XC); const bf16* YD = (const bf16*)(F.ws + WS_YD); const bf16* SST = (const bf16*)(F.ws + WS_SST);
    bf16* MIXp = (bf16*)(F.ws + WS_MIX);
    const size_t rowb = (size_t)b * SEQ + (size_t)c * 64;
    const v4u c8 = *(const v4u*)(XC + (rowb + (tid >> 3)) * 640 + 512 + g * 64 + (tid & 7) * 8);
    v4u hp[4];
    { const v4u* src = (const v4u*)(SST + ((size_t)((b * 128 + c) * 8 + g * 4)) * 4096);
#pragma unroll
      for (int i = 0; i < 4; ++i) hp[i] = src[tid + 512 * i]; }
    float eo = 0.f; if (tid < 256) eo = ((const float*)(F.ws + WS_EOFF))[(rowb + (tid & 63)) * 8 + g * 4 + (tid >> 6)];
    SSD_BAR();
    *(LAS v4u*)(L + CK + (tid & 7) * 1024 + (tid >> 3) * 16) = c8;
#pragma unroll
    for (int i = 0; i < 4; ++i) *(LAS v4u*)(L + HB + (tid + 512 * i) * 16) = hp[i];
    if (tid < 256) { sm[SM_EO + tid] = eo; sm[SM_GN + tid] = A.in[17][l * 512 + g * 256 + tid]; }
    if (tid < 4) sm[SM_DK + tid] = A.in[16][l * 8 + g * 4 + tid];
    SSD_BAR();
    const int kfo = hi * 1024 + r32 * 16;
    f32x16 y0, y1;
#pragma unroll
    for (int r = 0; r < 16; ++r) { y0[r] = 0.f; y1[r] = 0.f; }
#pragma unroll
    for (int ks = 0; ks < 4; ++ks) { const bf16x8 cf = *(const LAS bf16x8*)(L + CK + kfo + ks * 2048 + lh * 512);
        const bf16x8 h0 = *(const LAS bf16x8*)(L + HB + hh * 8192 + kfo + ks * 2048), h1 = *(const LAS bf16x8*)(L + HB + hh * 8192 + kfo + ks * 2048 + 512);
        y0 = __builtin_amdgcn_mfma_f32_32x32x16_bf16(cf, h0, y0, 0, 0, 0); y1 = __builtin_amdgcn_mfma_f32_32x32x16_bf16(cf, h1, y1, 0, 0, 0); }
#pragma unroll
    for (int r = 0; r < 16; ++r) { const int lrow = 32 * lh + crow(r, hi); const float e = sm[SM_EO + hh * 64 + lrow];
        *(LAS unsigned short*)(L + BW + (lrow * 256 + hh * 64 + r32) * 2) = (unsigned short)f2bf(y0[r] * e);
        *(LAS unsigned short*)(L + BW + (lrow * 256 + hh * 64 + 32 + r32) * 2) = (unsigned short)f2bf(y1[r] * e); }
    SSD_BAR();
    const float Dk = sm[SM_DK + (lane >> 4)]; const f32x4 gn4 = *(const LAS f32x4*)(sm + SM_GN + 4 * lane);
    u32x2 zr[8], xr[8], yr[8];
#pragma unroll
    for (int k = 0; k < 8; ++k) { const size_t row = rowb + wid * 8 + k; zr[k] = *(const u32x2*)(PROJ + row * NPROJ + PC_Z + g * 256 + 4 * lane); xr[k] = *(const u32x2*)(XC + row * 640 + g * 256 + 4 * lane); yr[k] = *(const u32x2*)(YD + row * 512 + g * 256 + 4 * lane); }
#pragma unroll
    for (int k = 0; k < 8; ++k) { const int tk = wid * 8 + k;
        const u32x2 yo = *(const LAS u32x2*)(L + BW + (tk * 256 + 4 * lane) * 2);
        f32x4 v; v.x = (bflo(yo.x) + bflo(yr[k].x) + Dk * bflo(xr[k].x)) * silu_f(bflo(zr[k].x)); v.y = (bfhi(yo.x) + bfhi(yr[k].x) + Dk * bfhi(xr[k].x)) * silu_f(bfhi(zr[k].x));
        v.z = (bflo(yo.y) + bflo(yr[k].y) + Dk * bflo(xr[k].y)) * silu_f(bflo(zr[k].y)); v.w = (bfhi(yo.y) + bfhi(yr[k].y) + Dk * bfhi(xr[k].y)) * silu_f(bfhi(zr[k].y));
        const float rstd = __builtin_amdgcn_rsqf(wave_sum((v.x * v.x + v.y * v.y) + (v.z * v.z + v.w * v.w)) * (1.f / 256.f) + EPS);
        u32x2 o; o.x = pk2(v.x * rstd * gn4.x, v.y * rstd * gn4.y); o.y = pk2(v.z * rstd * gn4.z, v.w * rstd * gn4.w);
        *(u32x2*)(MIXp + (rowb + tk) * D + 256 + g * 256 + 4 * lane) = o; }
}

__device__ __forceinline__ void scan_unit(Frame& F_, int kind, int u) {
    Frame F = refresh(F_);
    const int e = u * 1024 + F.tid * 2, nh = kind == 0 ? 8 : 4;
    const int idx = e & 4095, head = (e >> 12) & (nh - 1), b = e >> (kind == 0 ? 15 : 14);
    unsigned* base = (unsigned*)((bf16*)(F.ws + (kind == 0 ? WS_SST : WS_RST)) + ((size_t)(b * 128) * nh + head) * 4096 + idx);
    const size_t cstride = (size_t)nh * 4096 / 2;
    const float* dtot = (const float*)(F.ws + WS_DTOT) + (size_t)(b * 128) * 8 + head;
    const float gdec = exp2f(64.f * log2f(1.0f - exp2f(-5.0f - (float)head)));
    float h0 = 0.f, h1 = 0.f;
    for (int c0 = 0; c0 < 128; c0 += 16) {
        unsigned v[16]; float d[16];
#pragma unroll
        for (int i = 0; i < 16; ++i) { v[i] = base[(size_t)(c0 + i) * cstride]; d[i] = kind == 0 ? dtot[(size_t)(c0 + i) * 8] : gdec; }
#pragma unroll
        for (int i = 0; i < 16; ++i) { base[(size_t)(c0 + i) * cstride] = pk2(h0, h1); h0 = d[i] * h0 + bflo(v[i]); h1 = d[i] * h1 + bfhi(v[i]); }
    }
}
#undef SSD_LO
#undef SSD_HI
}
namespace ret {
using att::f32x16; using att::crow; using ssd::trfrag; using ssd::packfrag; using ssd::u32x2;
constexpr int QK = 0, KK = 8192, KW = 16384, VV = 24576, SB = 32768, OS = 40960, TB = 58368;
#define RET_BAR() asm volatile("s_waitcnt lgkmcnt(0)\n\ts_barrier" ::: "memory")
__device__ __forceinline__ f32x4 lo4(const v4u q_) { return (f32x4){bflo(q_.x), bfhi(q_.x), bflo(q_.y), bfhi(q_.y)}; }
__device__ __forceinline__ f32x4 hi4(const v4u q_) { return (f32x4){bflo(q_.z), bfhi(q_.z), bflo(q_.w), bfhi(q_.w)}; }
__device__ __forceinline__ v4u pack8(const f32x4 a, const f32x4 b) { v4u o; o.x = pk2(a.x, a.y); o.y = pk2(a.z, a.w); o.z = pk2(b.x, b.y); o.w = pk2(b.z, b.w); return o; }

__device__ __forceinline__ void ret_m1_unit(Frame& F_, const Args& A, int l, int b, int c, int h) {
    Frame F = refresh(F_);
    const int tid = F.tid, lane = tid & 63, wid = F.wave, r32 = lane & 31, hi = lane >> 5;
    LAS char* L = (LAS char*)F.lds; LAS float* tb = (LAS float*)(L + TB); LAS float* os = (LAS float*)(L + OS);
    const bf16* PROJ = (const bf16*)(F.ws + WS_BIG);
    const float gam = 1.0f - exp2f(-5.0f - (float)h), lg2 = log2f(gam);
    const int tok = tid >> 3, seg = tid & 7;
    const size_t rowb = (size_t)b * SEQ + (size_t)c * 64;
    v4u ld[4];
    { const bf16* rp = PROJ + (rowb + tok) * NPROJ;
      if (seg < 4) { ld[0] = *(const v4u*)(rp + PC_RQ + h * 64 + seg * 8); ld[1] = *(const v4u*)(rp + PC_RQ + h * 64 + 32 + seg * 8); ld[2] = *(const v4u*)(rp + PC_RK + h * 64 + seg * 8); ld[3] = *(const v4u*)(rp + PC_RK + h * 64 + 32 + seg * 8); }
      else { ld[0] = *(const v4u*)(rp + PC_RV + h * 64 + (seg - 4) * 16); ld[1] = *(const v4u*)(rp + PC_RV + h * 64 + (seg - 4) * 16 + 8); ld[2] = ld[0]; ld[3] = ld[0]; } }
    RET_BAR();
    if (tid < 128) tb[tid] = exp2f(lg2 * (float)(tid < 63 ? 63 - tid : tid - 63));
    if (seg < 4) {
        const f32x4 qla = lo4(ld[0]), qlb = hi4(ld[0]), qha = lo4(ld[1]), qhb = hi4(ld[1]), kla = lo4(ld[2]), klb = hi4(ld[2]), kha = lo4(ld[3]), khb = hi4(ld[3]);
        float ql[8] = {qla.x, qla.y, qla.z, qla.w, qlb.x, qlb.y, qlb.z, qlb.w}, qh[8] = {qha.x, qha.y, qha.z, qha.w, qhb.x, qhb.y, qhb.z, qhb.w};
        float kl[8] = {kla.x, kla.y, kla.z, kla.w, klb.x, klb.y, klb.z, klb.w}, kh[8] = {kha.x, kha.y, kha.z, kha.w, khb.x, khb.y, khb.z, khb.w};
        float q1[8], q2[8], k1[8], k2[8];
        const float pos = (float)(c * 64 + tok);
#pragma unroll
        for (int i = 0; i < 8; ++i) { const int fi = seg * 8 + i; const float invf = exp2f(-(float)fi * (13.287712379549449f / 32.0f)); const float ang = pos * invf;
            double rev = (double)ang * 0.15915494309189535; rev -= __builtin_rint(rev); const float fr = (float)rev;
            const float sn = __builtin_amdgcn_sinf(fr), cs = __builtin_amdgcn_cosf(fr);
            q1[i] = ql[i] * cs - qh[i] * sn; q2[i] = ql[i] * sn + qh[i] * cs; k1[i] = kl[i] * cs - kh[i] * sn; k2[i] = kl[i] * sn + kh[i] * cs; }
        const float kd = exp2f(lg2 * (float)(63 - tok));
        const v4u qa = pack8((f32x4){q1[0], q1[1], q1[2], q1[3]}, (f32x4){q1[4], q1[5], q1[6], q1[7]}), qb = pack8((f32x4){q2[0], q2[1], q2[2], q2[3]}, (f32x4){q2[4], q2[5], q2[6], q2[7]});
        *(LAS v4u*)(L + QK + seg * 1024 + tok * 16) = qa; *(LAS v4u*)(L + QK + (seg + 4) * 1024 + tok * 16) = qb;
        { char* qimg = (char*)(F.ws + WS_QR) + ((size_t)((b * 128 + c) * 4 + h)) * 8192; *(v4u*)(qimg + seg * 1024 + tok * 16) = qa; *(v4u*)(qimg + (seg + 4) * 1024 + tok * 16) = qb; }
        *(LAS v4u*)(L + KK + seg * 1024 + tok * 16) = pack8((f32x4){k1[0], k1[1], k1[2], k1[3]}, (f32x4){k1[4], k1[5], k1[6], k1[7]});
        *(LAS v4u*)(L + KK + (seg + 4) * 1024 + tok * 16) = pack8((f32x4){k2[0], k2[1], k2[2], k2[3]}, (f32x4){k2[4], k2[5], k2[6], k2[7]});
        *(LAS v4u*)(L + KW + tok * 64 + seg * 16) = pack8((f32x4){k1[0], k1[1], k1[2], k1[3]} * kd, (f32x4){k1[4], k1[5], k1[6], k1[7]} * kd);
        *(LAS v4u*)(L + KW + 4096 + tok * 64 + seg * 16) = pack8((f32x4){k2[0], k2[1], k2[2], k2[3]} * kd, (f32x4){k2[4], k2[5], k2[6], k2[7]} * kd);
    } else {
        const int s4 = seg - 4;
        *(LAS v4u*)(L + VV + (s4 >> 1) * 4096 + tok * 64 + (s4 & 1) * 32) = ld[0];
        *(LAS v4u*)(L + VV + (s4 >> 1) * 4096 + tok * 64 + (s4 & 1) * 32 + 16) = ld[1];
    }
    RET_BAR();
    const int kfo = hi * 1024 + r32 * 16;
    const int vfo = ((lane >> 4) & 1) * 32 + (lane & 3) * 8 + (4 * hi + ((lane & 15) >> 2)) * 64;
    const int lb = wid & 1, eb = (wid >> 1) & 1;
    if (wid < 4) {
        bf16x8 qf[4];
#pragma unroll
        for (int ks = 0; ks < 4; ++ks) qf[ks] = *(const LAS bf16x8*)(L + QK + kfo + ks * 2048 + lb * 512);
        f32x16 o;
#pragma unroll
        for (int r = 0; r < 16; ++r) o[r] = 0.f;
        const LAS float* rt = tb + (63 + 4 * hi - 32 * lb - r32);
#pragma unroll
        for (int sb = 0; sb < 2; ++sb) {
            f32x16 T;
#pragma unroll
            for (int r = 0; r < 16; ++r) T[r] = 0.f;
#pragma unroll
            for (int ks = 0; ks < 4; ++ks) { const bf16x8 kf = *(const LAS bf16x8*)(L + KK + kfo + ks * 2048 + sb * 512); T = __builtin_amdgcn_mfma_f32_32x32x16_bf16(kf, qf[ks], T, 0, 0, 0); }
#pragma unroll
            for (int r = 0; r < 16; ++r) T[r] *= rt[32 * sb + (r & 3) + 8 * (r >> 2)];
            const bf16x8 pa0 = packfrag(T, 0), pa1 = packfrag(T, 1);
            const LAS char* vb = L + VV + eb * 4096 + vfo + sb * 2048;
            const bf16x8 v0 = trfrag(vb), v1 = trfrag(vb + 1024);
            o = __builtin_amdgcn_mfma_f32_32x32x16_bf16(pa0, v0, o, 0, 0, 0); o = __builtin_amdgcn_mfma_f32_32x32x16_bf16(pa1, v1, o, 0, 0, 0);
        }
#pragma unroll
        for (int r = 0; r < 16; ++r) os[(32 * lb + crow(r, hi)) * 68 + 32 * eb + r32] = o[r];
    } else {
        f32x16 S;
#pragma unroll
        for (int r = 0; r < 16; ++r) S[r] = 0.f;
#pragma unroll
        for (int ks = 0; ks < 4; ++ks) { const bf16x8 ka = trfrag(L + KW + lb * 4096 + vfo + ks * 1024), vbf = trfrag(L + VV + eb * 4096 + vfo + ks * 1024);
            S = __builtin_amdgcn_mfma_f32_32x32x16_bf16(ka, vbf, S, 0, 0, 0); }
        char* simg = (char*)(F.ws + WS_RST) + ((size_t)((b * 128 + c) * 4 + h)) * 8192;
#pragma unroll
        for (int gq = 0; gq < 4; ++gq) { u32x2 w; w.x = pk2(S[4 * gq], S[4 * gq + 1]); w.y = pk2(S[4 * gq + 2], S[4 * gq + 3]);
            *(u32x2*)(simg + (4 * lb + gq) * 1024 + (32 * eb + r32) * 16 + hi * 8) = w; }
    }
    RET_BAR();
    { const int row = wid * 8 + (lane >> 3), ch = lane & 7;
      const f32x4 a0 = *(const LAS f32x4*)(os + row * 68 + ch * 8), a1 = *(const LAS f32x4*)(os + row * 68 + ch * 8 + 4);
      *(v4u*)((bf16*)(F.ws + WS_OI) + (rowb + row) * 256 + h * 64 + ch * 8) = pack8(a0, a1); }
}

__device__ __forceinline__ void ret_m3_unit(Frame& F_, const Args& A, int l, int b, int c, int h) {
    Frame F = refresh(F_);
    const int tid = F.tid, lane = tid & 63, wid = F.wave, r32 = lane & 31, hi = lane >> 5;
    LAS char* L = (LAS char*)F.lds; LAS float* os = (LAS float*)(L + OS);
    const bf16* PROJ = (const bf16*)(F.ws + WS_BIG); bf16* MIXp = (bf16*)(F.ws + WS_MIX);
    const float lg2 = log2f(1.0f - exp2f(-5.0f - (float)h));
    const size_t rowb = (size_t)b * SEQ + (size_t)c * 64;
    const size_t ioff = ((size_t)((b * 128 + c) * 4 + h)) * 8192;
    const v4u q16 = *(const v4u*)((const char*)(F.ws + WS_QR) + ioff + tid * 16);
#if defined(RTEST) && RTEST == 3
    v4u s16; { const unsigned long long* sp = (const unsigned long long*)((const char*)(F.ws + WS_RST) + ioff + tid * 16);
        const unsigned long long a = __hip_atomic_load(sp, __ATOMIC_RELAXED, __HIP_MEMORY_SCOPE_AGENT), b2 = __hip_atomic_load(sp + 1, __ATOMIC_RELAXED, __HIP_MEMORY_SCOPE_AGENT);
        s16.x = (unsigned)a; s16.y = (unsigned)(a >> 32); s16.z = (unsigned)b2; s16.w = (unsigned)(b2 >> 32); }
#else
    const v4u s16 = *(const v4u*)((const char*)(F.ws + WS_RST) + ioff + tid * 16);
#endif
    const size_t erow = rowb + wid * 8 + (lane >> 3); const int ch = lane & 7;
    const v4u gt = *(const v4u*)(PROJ + erow * NPROJ + PC_RG + h * 64 + ch * 8);
    const v4u oi = *(const v4u*)((const bf16*)(F.ws + WS_OI) + erow * 256 + h * 64 + ch * 8);
    RET_BAR();
#if defined(RTEST) && RTEST == 5
    { v4u qq; qq.x = 0x3f803f80u; qq.y = 0x3f803f80u; qq.z = 0x3f803f80u; qq.w = 0x3f803f80u; (void)q16; *(LAS v4u*)(L + QK + tid * 16) = qq; *(LAS v4u*)(L + SB + tid * 16) = s16; }
#elif defined(RTEST) && RTEST == 6
    { v4u qq; qq.x = 0x3f803f80u; qq.y = 0x3f803f80u; qq.z = 0x3f803f80u; qq.w = 0x3f803f80u; (void)s16; *(LAS v4u*)(L + QK + tid * 16) = q16; *(LAS v4u*)(L + SB + tid * 16) = qq; }
#else
    *(LAS v4u*)(L + QK + tid * 16) = q16; *(LAS v4u*)(L + SB + tid * 16) = s16;
#endif
    RET_BAR();
    if (wid < 4) {
        const int kfo = hi * 1024 + r32 * 16, lb = wid & 1, eb = wid >> 1;
        f32x16 o;
#pragma unroll
        for (int r = 0; r < 16; ++r) o[r] = 0.f;
#pragma unroll
        for (int ks = 0; ks < 4; ++ks) { const bf16x8 qf = *(const LAS bf16x8*)(L + QK + kfo + ks * 2048 + lb * 512), sf = *(const LAS bf16x8*)(L + SB + kfo + ks * 2048 + eb * 512);
            o = __builtin_amdgcn_mfma_f32_32x32x16_bf16(qf, sf, o, 0, 0, 0); }
#pragma unroll
        for (int r = 0; r < 16; ++r) { const int lrow = 32 * lb + crow(r, hi); os[lrow * 68 + 32 * eb + r32] = o[r] * exp2f(lg2 * (float)(lrow + 1)); }
    }
    RET_BAR();
    { const int row = wid * 8 + (lane >> 3);
      f32x4 a0 = *(const LAS f32x4*)(os + row * 68 + ch * 8), a1 = *(const LAS f32x4*)(os + row * 68 + ch * 8 + 4);
#if defined(RTEST) && RTEST == 1
      a0 = lo4(oi); a1 = hi4(oi);
#elif defined(RTEST) && RTEST == 2
      (void)oi;
#else
      a0 += lo4(oi); a1 += hi4(oi);
#endif
      float ss = (a0.x * a0.x + a0.y * a0.y) + (a0.z * a0.z + a0.w * a0.w) + (a1.x * a1.x + a1.y * a1.y) + (a1.z * a1.z + a1.w * a1.w);
      ss += __shfl_xor(ss, 1); ss += __shfl_xor(ss, 2); ss += __shfl_xor(ss, 4);
      const float rstd = __builtin_amdgcn_rsqf(ss * (1.f / 64.f) + EPS);
      const f32x4 g0 = *(const f32x4*)(A.in[18] + l * 64 + ch * 8), g1 = *(const f32x4*)(A.in[18] + l * 64 + ch * 8 + 4);
      const f32x4 z0 = lo4(gt), z1 = hi4(gt);
      v4u w; w.x = pk2(silu_f(z0.x) * a0.x * rstd * g0.x, silu_f(z0.y) * a0.y * rstd * g0.y); w.y = pk2(silu_f(z0.z) * a0.z * rstd * g0.z, silu_f(z0.w) * a0.w * rstd * g0.w);
      w.z = pk2(silu_f(z1.x) * a1.x * rstd * g1.x, silu_f(z1.y) * a1.y * rstd * g1.y); w.w = pk2(silu_f(z1.z) * a1.z * rstd * g1.z, silu_f(z1.w) * a1.w * rstd * g1.w);
      *(v4u*)(MIXp + erow * D + 768 + h * 64 + ch * 8) = w; }
}
}
namespace ssds {
using ssd::u32x2;
using att::f32x16; using att::s16x4; using att::vtr; using att::crow;
constexpr int XS = 0, BK = 32768, CK = 40960, BW = 49152, HB = 81920, SM = 114688, CW = 122880;
constexpr int SM_VL = 0, SM_US = 256, SM_EO = 512, SM_WS = 768, SM_DT = 1024, SM_DK = 1028, SM_AK = 1032, SM_DB = 1036, SM_GN = 1040;
#undef SSD_BAR
#define SSD_BAR() asm volatile("s_waitcnt lgkmcnt(0)\n\ts_barrier" ::: "memory")
using ssd::trfrag;
using ssd::packfrag;

__device__ __forceinline__ void ssd_unit(Frame& F_, const Args& A, int l, int b, int g) {
    Frame F = refresh(F_);
    const int tid = F.tid, lane = tid & 63, wid = F.wave, r32 = lane & 31, hi = lane >> 5, hh = wid >> 1, lh = wid & 1;
    LAS char* L = (LAS char*)F.lds; LAS float* sm = (LAS float*)(L + SM); LAS float* cwl = (LAS float*)(L + CW);
    const bf16* PROJ = (const bf16*)(F.ws + WS_BIG); const float* DTg = (const float*)(F.ws + WS_DT); bf16* MIXp = (bf16*)(F.ws + WS_MIX);
    SSD_BAR();
    for (int i = tid; i < 5 * 384; i += 512) { const int w = i / 384, li = i - w * 384; const int ch = li < 256 ? g * 256 + li : li < 320 ? 512 + g * 64 + (li - 256) : 640 + g * 64 + (li - 320);
        cwl[i] = w < 4 ? A.in[12][(size_t)l * 4 * 768 + w * 768 + ch] : A.in[13][l * 768 + ch]; }
    for (int i = tid; i < 32768 / 16; i += 512) *(LAS v4u*)(L + HB + i * 16) = (v4u){0u, 0u, 0u, 0u};
    if (tid < 256) sm[SM_GN + tid] = A.in[17][l * 512 + g * 256 + tid];
    if (tid < 4) { sm[SM_DK + tid] = A.in[16][l * 8 + g * 4 + tid]; sm[SM_AK + tid] = -__expf(A.in[15][l * 8 + g * 4 + tid]); sm[SM_DB + tid] = A.in[14][l * 8 + g * 4 + tid]; }
    const int tg = tid / 48, cc = tid - tg * 48;
    const int gcol = PC_XBC + (cc < 32 ? g * 256 + cc * 8 : cc < 40 ? 512 + g * 64 + (cc - 32) * 8 : 640 + g * 64 + (cc - 40) * 8);
    const int dsto = cc < 32 ? XS + (cc >> 3) * 8192 + ((cc & 7) >> 2) * 4096 + ((cc & 3) * 8) * 2 : cc < 40 ? BK + (cc - 32) * 1024 : CK + (cc - 40) * 1024;
    const int dstr = cc < 32 ? 64 : 16;
    const size_t rb = (size_t)b * SEQ;
    v4u raw[11];
#define SSD_LOADRAW(c) do { _Pragma("unroll") for (int i = 0; i < 11; ++i) { const int trow = (c) * 64 + 8 * tg - 3 + i; \
        raw[i] = (tid < 384 && trow >= 0) ? *(const v4u*)(PROJ + (rb + trow) * NPROJ + gcol) : (v4u){0u, 0u, 0u, 0u}; } } while (0)
    SSD_LOADRAW(0);
    float dtr[4]; u32x2 zr[8];
#define SSD_LOADDT(c) do { if (wid == 7) { const f32x4 d4 = *(const f32x4*)(DTg + (rb + (c) * 64 + lane) * 8 + g * 4); dtr[0] = d4.x; dtr[1] = d4.y; dtr[2] = d4.z; dtr[3] = d4.w; } } while (0)
#define SSD_LOADZ(c) do { _Pragma("unroll") for (int k = 0; k < 8; ++k) zr[k] = *(const u32x2*)(PROJ + (rb + (c) * 64 + wid * 8 + k) * NPROJ + PC_Z + g * 256 + 4 * lane); } while (0)
    SSD_LOADDT(0);
    f32x16 hacc0, hacc1;
#pragma unroll
    for (int r = 0; r < 16; ++r) { hacc0[r] = 0.f; hacc1[r] = 0.f; }
    const int kfo0 = hi * 1024 + r32 * 16;
    const int vfo0 = ((lane >> 4) & 1) * 32 + (lane & 3) * 8 + (4 * hi + ((lane & 15) >> 2)) * 64;
    SSD_BAR();
    for (int c = 0; c < SEQ / 64; ++c) {
        const size_t rowb = rb + (size_t)c * 64;
        int kfo = kfo0, vfo = vfo0; asm volatile("" : "+v"(kfo), "+v"(vfo));
        if (tid < 384) {
            f32x4 w0a = *(const LAS f32x4*)(cwl + cc * 8), w0b = *(const LAS f32x4*)(cwl + cc * 8 + 4), w1a = *(const LAS f32x4*)(cwl + 384 + cc * 8), w1b = *(const LAS f32x4*)(cwl + 384 + cc * 8 + 4);
            f32x4 w2a = *(const LAS f32x4*)(cwl + 768 + cc * 8), w2b = *(const LAS f32x4*)(cwl + 768 + cc * 8 + 4), w3a = *(const LAS f32x4*)(cwl + 1152 + cc * 8), w3b = *(const LAS f32x4*)(cwl + 1152 + cc * 8 + 4);
            const f32x4 cba = *(const LAS f32x4*)(cwl + 1536 + cc * 8), cbb = *(const LAS f32x4*)(cwl + 1536 + cc * 8 + 4);
#define SSD_LO(q_) ((f32x4){bflo((q_).x), bfhi((q_).x), bflo((q_).y), bfhi((q_).y)})
#define SSD_HI(q_) ((f32x4){bflo((q_).z), bfhi((q_).z), bflo((q_).w), bfhi((q_).w)})
#pragma unroll
            for (int j = 0; j < 8; ++j) {
                f32x4 va = cba + SSD_LO(raw[j]) * w0a + SSD_LO(raw[j + 1]) * w1a + SSD_LO(raw[j + 2]) * w2a + SSD_LO(raw[j + 3]) * w3a;
                f32x4 vb = cbb + SSD_HI(raw[j]) * w0b + SSD_HI(raw[j + 1]) * w1b + SSD_HI(raw[j + 2]) * w2b + SSD_HI(raw[j + 3]) * w3b;
                v4u o; o.x = pk2(silu_f(va.x), silu_f(va.y)); o.y = pk2(silu_f(va.z), silu_f(va.w)); o.z = pk2(silu_f(vb.x), silu_f(vb.y)); o.w = pk2(silu_f(vb.z), silu_f(vb.w));
                *(LAS v4u*)(L + dsto + (8 * tg + j) * dstr) = o;
            }
        } else if (wid == 7) {
            float tot[4];
#pragma unroll
            for (int k = 0; k < 4; ++k) { const float Ak = sm[SM_AK + k], dbk = sm[SM_DB + k];
                const float xr = dtr[k] + dbk; const float dt = xr > 20.f ? xr : log1pf(__expf(xr));
                float acs = Ak * dt;
#pragma unroll
                for (int o = 1; o < 64; o <<= 1) { const float u = __shfl_up(acs, o); if (lane >= o) acs += u; }
                tot[k] = __shfl(acs, 63);
                sm[SM_VL + k * 64 + lane] = acs * LOG2E; sm[SM_US + k * 64 + lane] = acs * LOG2E - __log2f(dt);
                sm[SM_EO + k * 64 + lane] = __expf(acs); sm[SM_WS + k * 64 + lane] = __expf(tot[k] - acs) * dt; }
            if (lane == 0) { sm[SM_DT + 0] = __expf(tot[0]); sm[SM_DT + 1] = __expf(tot[1]); sm[SM_DT + 2] = __expf(tot[2]); sm[SM_DT + 3] = __expf(tot[3]); }
        }
        if (c + 1 < SEQ / 64) { SSD_LOADRAW(c + 1); SSD_LOADDT(c + 1); }
        SSD_BAR();
        { const int s = tid >> 3, nc = tid & 7; const v4u b8 = *(const LAS v4u*)(L + BK + nc * 1024 + s * 16);
          const f32x4 ba = SSD_LO(b8), bb = SSD_HI(b8);
#pragma unroll
          for (int k = 0; k < 4; ++k) { const float w = sm[SM_WS + k * 64 + s]; v4u o; o.x = pk2(ba.x * w, ba.y * w); o.y = pk2(ba.z * w, ba.w * w); o.z = pk2(bb.x * w, bb.y * w); o.w = pk2(bb.z * w, bb.w * w);
              *(LAS v4u*)(L + BW + k * 8192 + (nc >> 2) * 4096 + s * 64 + (nc & 3) * 16) = o; } }
        SSD_BAR();
        SSD_LOADZ(c);
        f32x16 y0, y1;
        {
            bf16x8 cf[4];
#pragma unroll
            for (int ks = 0; ks < 4; ++ks) cf[ks] = *(const LAS bf16x8*)(L + CK + kfo + ks * 2048 + lh * 512);
#pragma unroll
            for (int r = 0; r < 16; ++r) { y0[r] = 0.f; y1[r] = 0.f; }
#pragma unroll
            for (int ks = 0; ks < 4; ++ks) { const bf16x8 h0 = *(const LAS bf16x8*)(L + HB + hh * 8192 + kfo + ks * 2048), h1 = *(const LAS bf16x8*)(L + HB + hh * 8192 + kfo + ks * 2048 + 512);
                y0 = __builtin_amdgcn_mfma_f32_32x32x16_bf16(cf[ks], h0, y0, 0, 0, 0); y1 = __builtin_amdgcn_mfma_f32_32x32x16_bf16(cf[ks], h1, y1, 0, 0, 0); }
#pragma unroll
            for (int r = 0; r < 16; ++r) { const float e = sm[SM_EO + hh * 64 + 32 * lh + crow(r, hi)]; y0[r] *= e; y1[r] *= e; }
            const float vl = sm[SM_VL + hh * 64 + 32 * lh + r32];
#pragma unroll
            for (int sb = 0; sb < 2; ++sb) {
                if (sb <= lh) {
                    f32x16 T;
#pragma unroll
                    for (int r = 0; r < 16; ++r) T[r] = 0.f;
#pragma unroll
                    for (int ks = 0; ks < 4; ++ks) { const bf16x8 bfr = *(const LAS bf16x8*)(L + BK + kfo + ks * 2048 + sb * 512); T = __builtin_amdgcn_mfma_f32_32x32x16_bf16(bfr, cf[ks], T, 0, 0, 0); }
#pragma unroll
                    for (int r = 0; r < 16; ++r) { const float us = sm[SM_US + hh * 64 + 32 * sb + crow(r, hi)]; float w = T[r] * __builtin_amdgcn_exp2f(vl - us);
                        if (sb == lh && crow(r, hi) > r32) w = 0.f; T[r] = w; }
                    const bf16x8 pa0 = packfrag(T, 0), pa1 = packfrag(T, 1);
                    const LAS char* xb = L + XS + hh * 8192 + vfo + sb * 2048;
                    const bf16x8 x00 = trfrag(xb), x01 = trfrag(xb + 4096), x10 = trfrag(xb + 1024), x11 = trfrag(xb + 4096 + 1024);
                    y0 = __builtin_amdgcn_mfma_f32_32x32x16_bf16(pa0, x00, y0, 0, 0, 0); y1 = __builtin_amdgcn_mfma_f32_32x32x16_bf16(pa0, x01, y1, 0, 0, 0);
                    y0 = __builtin_amdgcn_mfma_f32_32x32x16_bf16(pa1, x10, y0, 0, 0, 0); y1 = __builtin_amdgcn_mfma_f32_32x32x16_bf16(pa1, x11, y1, 0, 0, 0);
                }
            }
            const float dtot = sm[SM_DT + hh];
#pragma unroll
            for (int r = 0; r < 16; ++r) { hacc0[r] *= dtot; hacc1[r] *= dtot; }
#pragma unroll
            for (int ks = 0; ks < 4; ++ks) { const bf16x8 xa = trfrag(L + XS + hh * 8192 + lh * 4096 + vfo + ks * 1024), b0 = trfrag(L + BW + hh * 8192 + vfo + ks * 1024), b1 = trfrag(L + BW + hh * 8192 + 4096 + vfo + ks * 1024);
                hacc0 = __builtin_amdgcn_mfma_f32_32x32x16_bf16(xa, b0, hacc0, 0, 0, 0); hacc1 = __builtin_amdgcn_mfma_f32_32x32x16_bf16(xa, b1, hacc1, 0, 0, 0); }
        }
        SSD_BAR();
#pragma unroll
        for (int r = 0; r < 16; ++r) { const int p = 32 * lh + crow(r, hi);
            *(LAS unsigned short*)(L + HB + hh * 8192 + (r32 >> 3) * 1024 + p * 16 + (r32 & 7) * 2) = (unsigned short)f2bf(hacc0[r]);
            *(LAS unsigned short*)(L + HB + hh * 8192 + (4 + (r32 >> 3)) * 1024 + p * 16 + (r32 & 7) * 2) = (unsigned short)f2bf(hacc1[r]);
            const int lrow = 32 * lh + crow(r, hi);
            *(LAS unsigned short*)(L + BW + (lrow * 256 + hh * 64 + r32) * 2) = (unsigned short)f2bf(y0[r]);
            *(LAS unsigned short*)(L + BW + (lrow * 256 + hh * 64 + 32 + r32) * 2) = (unsigned short)f2bf(y1[r]); }
        SSD_BAR();
        const float Dk = sm[SM_DK + (lane >> 4)]; const f32x4 gn4 = *(const LAS f32x4*)(sm + SM_GN + 4 * lane);
#pragma unroll
        for (int k = 0; k < 8; ++k) { const int tk = wid * 8 + k; const int hd = lane >> 4, p = (4 * lane) & 63;
            const u32x2 yv = *(const LAS u32x2*)(L + BW + (tk * 256 + 4 * lane) * 2), xv = *(const LAS u32x2*)(L + XS + hd * 8192 + (p >> 5) * 4096 + tk * 64 + (p & 31) * 2);
            f32x4 v; v.x = (bflo(yv.x) + Dk * bflo(xv.x)) * silu_f(bflo(zr[k].x)); v.y = (bfhi(yv.x) + Dk * bfhi(xv.x)) * silu_f(bfhi(zr[k].x));
            v.z = (bflo(yv.y) + Dk * bflo(xv.y)) * silu_f(bflo(zr[k].y)); v.w = (bfhi(yv.y) + Dk * bfhi(xv.y)) * silu_f(bfhi(zr[k].y));
            const float rstd = __builtin_amdgcn_rsqf(wave_sum((v.x * v.x + v.y * v.y) + (v.z * v.z + v.w * v.w)) * (1.f / 256.f) + EPS);
            u32x2 o; o.x = pk2(v.x * rstd * gn4.x, v.y * rstd * gn4.y); o.y = pk2(v.z * rstd * gn4.z, v.w * rstd * gn4.w);
            *(u32x2*)(MIXp + (rowb + tk) * D + 256 + g * 256 + 4 * lane) = o; }
        SSD_BAR();
    }
#undef SSD_LOADRAW
#undef SSD_LOADDT
#undef SSD_LOADZ
#undef SSD_LO
#undef SSD_HI
}
}
namespace rets {
using att::f32x16; using att::crow; using ssd::trfrag; using ssd::packfrag; using ssd::u32x2;
constexpr int QK = 0, KK = 8192, KW = 16384, VV = 24576, SB = 32768, OS = 40960, TB = 58368;
#undef RET_BAR
#define RET_BAR() asm volatile("s_waitcnt lgkmcnt(0)\n\ts_barrier" ::: "memory")
__device__ __forceinline__ f32x4 lo4(const v4u q_) { return (f32x4){bflo(q_.x), bfhi(q_.x), bflo(q_.y), bfhi(q_.y)}; }
__device__ __forceinline__ f32x4 hi4(const v4u q_) { return (f32x4){bflo(q_.z), bfhi(q_.z), bflo(q_.w), bfhi(q_.w)}; }
__device__ __forceinline__ v4u pack8(const f32x4 a, const f32x4 b) { v4u o; o.x = pk2(a.x, a.y); o.y = pk2(a.z, a.w); o.z = pk2(b.x, b.y); o.w = pk2(b.z, b.w); return o; }

__device__ __forceinline__ void ret_unit(Frame& F_, const Args& A, int l, int b, int h) {
    Frame F = refresh(F_);
    const int tid = F.tid, lane = tid & 63, wid = F.wave, r32 = lane & 31, hi = lane >> 5;
    LAS char* L = (LAS char*)F.lds; LAS float* tb = (LAS float*)(L + TB); LAS float* os = (LAS float*)(L + OS);
    const bf16* PROJ = (const bf16*)(F.ws + WS_BIG); bf16* MIXp = (bf16*)(F.ws + WS_MIX);
    const float gam = 1.0f - exp2f(-5.0f - (float)h), lg2 = log2f(gam), g64 = exp2f(lg2 * 64.f);
    RET_BAR();
    if (tid < 128) tb[tid] = exp2f(lg2 * (float)(tid < 63 ? 63 - tid : tid - 63));
    else if (tid < 192) tb[tid] = exp2f(lg2 * (float)(tid - 128 + 1));
    else if (tid < 256) tb[tid] = exp2f(lg2 * (float)(63 - (tid - 192)));
    for (int i = tid; i < 8192 / 16; i += 512) *(LAS v4u*)(L + SB + i * 16) = (v4u){0u, 0u, 0u, 0u};
    const int tok = tid >> 3, seg = tid & 7;
    const size_t rb = (size_t)b * SEQ;
    v4u ld[4];
#define RET_LOAD(c) do { const bf16* rp = PROJ + (rb + (c) * 64 + tok) * NPROJ; \
        if (seg < 4) { ld[0] = *(const v4u*)(rp + PC_RQ + h * 64 + seg * 8); ld[1] = *(const v4u*)(rp + PC_RQ + h * 64 + 32 + seg * 8); ld[2] = *(const v4u*)(rp + PC_RK + h * 64 + seg * 8); ld[3] = *(const v4u*)(rp + PC_RK + h * 64 + 32 + seg * 8); } \
        else { ld[0] = *(const v4u*)(rp + PC_RV + h * 64 + (seg - 4) * 16); ld[1] = *(const v4u*)(rp + PC_RV + h * 64 + (seg - 4) * 16 + 8); } } while (0)
    RET_LOAD(0);
    f32x16 Sacc;
#pragma unroll
    for (int r = 0; r < 16; ++r) Sacc[r] = 0.f;
    const int kfo0 = hi * 1024 + r32 * 16;
    const int vfo0 = ((lane >> 4) & 1) * 32 + (lane & 3) * 8 + (4 * hi + ((lane & 15) >> 2)) * 64;
    const int lb = wid & 1, eb = (wid >> 1) & 1;
    RET_BAR();
    for (int c = 0; c < SEQ / 64; ++c) {
        int kfo = kfo0, vfo = vfo0; asm volatile("" : "+v"(kfo), "+v"(vfo));
        if (seg < 4) {
            const f32x4 qla = lo4(ld[0]), qlb = hi4(ld[0]), qha = lo4(ld[1]), qhb = hi4(ld[1]), kla = lo4(ld[2]), klb = hi4(ld[2]), kha = lo4(ld[3]), khb = hi4(ld[3]);
            float ql[8] = {qla.x, qla.y, qla.z, qla.w, qlb.x, qlb.y, qlb.z, qlb.w}, qh[8] = {qha.x, qha.y, qha.z, qha.w, qhb.x, qhb.y, qhb.z, qhb.w};
            float kl[8] = {kla.x, kla.y, kla.z, kla.w, klb.x, klb.y, klb.z, klb.w}, kh[8] = {kha.x, kha.y, kha.z, kha.w, khb.x, khb.y, khb.z, khb.w};
            float q1[8], q2[8], k1[8], k2[8];
            const float pos = (float)(c * 64 + tok);
#pragma unroll
            for (int i = 0; i < 8; ++i) { const int fi = seg * 8 + i; const float invf = exp2f(-(float)fi * (13.287712379549449f / 32.0f)); const float ang = pos * invf;
                double rev = (double)ang * 0.15915494309189535; rev -= __builtin_rint(rev); const float fr = (float)rev;
                const float sn = __builtin_amdgcn_sinf(fr), cs = __builtin_amdgcn_cosf(fr);
                q1[i] = ql[i] * cs - qh[i] * sn; q2[i] = ql[i] * sn + qh[i] * cs; k1[i] = kl[i] * cs - kh[i] * sn; k2[i] = kl[i] * sn + kh[i] * cs; }
            const float kd = tb[192 + tok];
            *(LAS v4u*)(L + QK + seg * 1024 + tok * 16) = pack8((f32x4){q1[0], q1[1], q1[2], q1[3]}, (f32x4){q1[4], q1[5], q1[6], q1[7]});
            *(LAS v4u*)(L + QK + (seg + 4) * 1024 + tok * 16) = pack8((f32x4){q2[0], q2[1], q2[2], q2[3]}, (f32x4){q2[4], q2[5], q2[6], q2[7]});
            *(LAS v4u*)(L + KK + seg * 1024 + tok * 16) = pack8((f32x4){k1[0], k1[1], k1[2], k1[3]}, (f32x4){k1[4], k1[5], k1[6], k1[7]});
            *(LAS v4u*)(L + KK + (seg + 4) * 1024 + tok * 16) = pack8((f32x4){k2[0], k2[1], k2[2], k2[3]}, (f32x4){k2[4], k2[5], k2[6], k2[7]});
            *(LAS v4u*)(L + KW + tok * 64 + seg * 16) = pack8((f32x4){k1[0], k1[1], k1[2], k1[3]} * kd, (f32x4){k1[4], k1[5], k1[6], k1[7]} * kd);
            *(LAS v4u*)(L + KW + 4096 + tok * 64 + seg * 16) = pack8((f32x4){k2[0], k2[1], k2[2], k2[3]} * kd, (f32x4){k2[4], k2[5], k2[6], k2[7]} * kd);
        } else {
            const int s4 = seg - 4;
            *(LAS v4u*)(L + VV + (s4 >> 1) * 4096 + tok * 64 + (s4 & 1) * 32) = ld[0];
            *(LAS v4u*)(L + VV + (s4 >> 1) * 4096 + tok * 64 + (s4 & 1) * 32 + 16) = ld[1];
        }
        if (c + 1 < SEQ / 64) RET_LOAD(c + 1);
        const size_t erow = rb + (size_t)c * 64 + wid * 8 + (lane >> 3);
        const v4u gt = *(const v4u*)(PROJ + erow * NPROJ + PC_RG + h * 64 + (lane & 7) * 8);
        RET_BAR();
        f32x16 o;
        if (wid < 4) {
            bf16x8 qf[4];
#pragma unroll
            for (int ks = 0; ks < 4; ++ks) qf[ks] = *(const LAS bf16x8*)(L + QK + kfo + ks * 2048 + lb * 512);
#pragma unroll
            for (int r = 0; r < 16; ++r) o[r] = 0.f;
#pragma unroll
            for (int ks = 0; ks < 4; ++ks) { const bf16x8 sf = *(const LAS bf16x8*)(L + SB + kfo + ks * 2048 + eb * 512); o = __builtin_amdgcn_mfma_f32_32x32x16_bf16(qf[ks], sf, o, 0, 0, 0); }
#pragma unroll
            for (int r = 0; r < 16; ++r) o[r] *= tb[128 + 32 * lb + crow(r, hi)];
            const LAS float* rt = tb + (63 + 4 * hi - 32 * lb - r32);
#pragma unroll
            for (int sb = 0; sb < 2; ++sb) {
                f32x16 T;
#pragma unroll
                for (int r = 0; r < 16; ++r) T[r] = 0.f;
#pragma unroll
                for (int ks = 0; ks < 4; ++ks) { const bf16x8 kf = *(const LAS bf16x8*)(L + KK + kfo + ks * 2048 + sb * 512); T = __builtin_amdgcn_mfma_f32_32x32x16_bf16(kf, qf[ks], T, 0, 0, 0); }
#pragma unroll
                for (int r = 0; r < 16; ++r) T[r] *= rt[32 * sb + (r & 3) + 8 * (r >> 2)];
                const bf16x8 pa0 = packfrag(T, 0), pa1 = packfrag(T, 1);
                const LAS char* vb = L + VV + eb * 4096 + vfo + sb * 2048;
                const bf16x8 v0 = trfrag(vb), v1 = trfrag(vb + 1024);
                o = __builtin_amdgcn_mfma_f32_32x32x16_bf16(pa0, v0, o, 0, 0, 0); o = __builtin_amdgcn_mfma_f32_32x32x16_bf16(pa1, v1, o, 0, 0, 0);
            }
        } else {
#pragma unroll
            for (int r = 0; r < 16; ++r) Sacc[r] *= g64;
#pragma unroll
            for (int ks = 0; ks < 4; ++ks) { const bf16x8 ka = trfrag(L + KW + lb * 4096 + vfo + ks * 1024), vbf = trfrag(L + VV + eb * 4096 + vfo + ks * 1024);
                Sacc = __builtin_amdgcn_mfma_f32_32x32x16_bf16(ka, vbf, Sacc, 0, 0, 0); }
        }
        RET_BAR();
        if (wid < 4) {
#pragma unroll
            for (int r = 0; r < 16; ++r) os[(32 * lb + crow(r, hi)) * 68 + 32 * eb + r32] = o[r];
        } else {
#pragma unroll
            for (int gq = 0; gq < 4; ++gq) { u32x2 w; w.x = pk2(Sacc[4 * gq], Sacc[4 * gq + 1]); w.y = pk2(Sacc[4 * gq + 2], Sacc[4 * gq + 3]);
                *(LAS u32x2*)(L + SB + (4 * lb + gq) * 1024 + (32 * eb + r32) * 16 + hi * 8) = w; }
        }
        RET_BAR();
        { const int row = wid * 8 + (lane >> 3), ch = lane & 7;
          const f32x4 a0 = *(const LAS f32x4*)(os + row * 68 + ch * 8), a1 = *(const LAS f32x4*)(os + row * 68 + ch * 8 + 4);
          float ss = (a0.x * a0.x + a0.y * a0.y) + (a0.z * a0.z + a0.w * a0.w) + (a1.x * a1.x + a1.y * a1.y) + (a1.z * a1.z + a1.w * a1.w);
          ss += __shfl_xor(ss, 1); ss += __shfl_xor(ss, 2); ss += __shfl_xor(ss, 4);
          const float rstd = __builtin_amdgcn_rsqf(ss * (1.f / 64.f) + EPS);
          const f32x4 g0 = *(const f32x4*)(A.in[18] + l * 64 + ch * 8), g1 = *(const f32x4*)(A.in[18] + l * 64 + ch * 8 + 4);
          const f32x4 z0 = lo4(gt), z1 = hi4(gt);
          v4u w; w.x = pk2(silu_f(z0.x) * a0.x * rstd * g0.x, silu_f(z0.y) * a0.y * rstd * g0.y); w.y = pk2(silu_f(z0.z) * a0.z * rstd * g0.z, silu_f(z0.w) * a0.w * rstd * g0.w);
          w.z = pk2(silu_f(z1.x) * a1.x * rstd * g1.x, silu_f(z1.y) * a1.y * rstd * g1.y); w.w = pk2(silu_f(z1.z) * a1.z * rstd * g1.z, silu_f(z1.w) * a1.w * rstd * g1.w);
          *(v4u*)(MIXp + erow * D + 768 + h * 64 + ch * 8) = w; }
    }
    RET_BAR();
#undef RET_LOAD
}
}
__device__ __forceinline__ void attn_naive_unit(Frame& F_, const Args& A, int l, int b, int h, int qb, float lam, float lam_init) {
    Frame F = refresh(F_);
    LAS float* Ks = (LAS float*)F.lds;
    LAS float* Vs = Ks + 4096;
    LAS float* Bt = Vs + 4096;
    LAS float* Ob = (LAS float*)(F.lds + 36864);
    const int tid = F.tid, t = tid >> 8, r = tid & 255;
    const int Q0 = qb * 256, row = Q0 + r; const size_t grow = (size_t)b * SEQ + row;
    const bf16* PROJ = (const bf16*)(F.ws + WS_BIG);
    __syncthreads();
    if (tid < 192) Bt[tid] = A.in[6][t5_bucket(tid - 128) * 4 + h] * LOG2E;
    f32x4 q4[8];
    { const v4u* qp = (const v4u*)(PROJ + grow * NPROJ + PC_Q + h * 64 + t * 32);
#pragma unroll
      for (int i = 0; i < 4; ++i) { const v4u w = qp[i]; q4[2 * i] = (f32x4){bflo(w.x), bfhi(w.x), bflo(w.y), bfhi(w.y)}; q4[2 * i + 1] = (f32x4){bflo(w.z), bfhi(w.z), bflo(w.w), bfhi(w.w)}; } }
    f32x4 O4[16];
#pragma unroll
    for (int e = 0; e < 16; ++e) O4[e] = (f32x4){0.f, 0.f, 0.f, 0.f};
    float mrun = -1.0e30f, lsum = 0.f;
    const int cq = row >> 6, nck = (Q0 >> 6) + 4;
    for (int ck = 0; ck < nck; ++ck) {
        __syncthreads();
        { const int key = tid >> 3, seg = tid & 7; const bf16* kp = PROJ + ((size_t)b * SEQ + ck * 64 + key) * NPROJ + PC_K + h * 64 + seg * 8;
          const v4u kw = *(const v4u*)kp, vw = *(const v4u*)(kp + 256);
          LAS f32x4* kd = (LAS f32x4*)(Ks + (seg >> 2) * 2048 + key * 32 + (seg & 3) * 8); LAS f32x4* vd = (LAS f32x4*)(Vs + key * 64 + seg * 8);
          kd[0] = (f32x4){bflo(kw.x), bfhi(kw.x), bflo(kw.y), bfhi(kw.y)}; kd[1] = (f32x4){bflo(kw.z), bfhi(kw.z), bflo(kw.w), bfhi(kw.w)};
          vd[0] = (f32x4){bflo(vw.x), bfhi(vw.x), bflo(vw.y), bfhi(vw.y)}; vd[1] = (f32x4){bflo(vw.z), bfhi(vw.z), bflo(vw.w), bfhi(vw.w)}; }
        __syncthreads();
        if (ck <= cq) {
            const int kbase = ck * 64 - row;
#pragma unroll 1
            for (int j = 0; j < 64; ++j) {
                const LAS f32x4* kr = (const LAS f32x4*)(Ks + t * 2048 + j * 32);
                f32x4 a4 = q4[0] * kr[0];
#pragma unroll
                for (int d = 1; d < 8; ++d) a4 += q4[d] * kr[d];
                int rel = kbase + j; rel = rel < -128 ? -128 : rel;
                const float sj = (a4.x + a4.y) + (a4.z + a4.w) + Bt[rel + 128];
                if (sj > mrun) { const float sc = __builtin_amdgcn_exp2f(mrun - sj); lsum *= sc;
#pragma unroll
                    for (int e = 0; e < 16; ++e) O4[e] *= sc;
                    mrun = sj; }
                const float p = __builtin_amdgcn_exp2f(sj - mrun); lsum += p;
                const LAS f32x4* vr = (const LAS f32x4*)(Vs + j * 64);
#pragma unroll
                for (int e = 0; e < 16; ++e) O4[e] += vr[e] * p;
            }
        }
    }
    __syncthreads();
    const float inv = 1.0f / lsum;
    if (t == 1) {
#pragma unroll
        for (int e = 0; e < 16; ++e) *(LAS f32x4*)(Ob + r * 68 + 4 * e) = O4[e] * inv; }
    __syncthreads();
    if (t == 0) { f32x4 ss4 = (f32x4){0.f, 0.f, 0.f, 0.f};
#pragma unroll
        for (int e = 0; e < 16; ++e) { const f32x4 o = O4[e] * inv - *(const LAS f32x4*)(Ob + r * 68 + 4 * e) * lam; O4[e] = o; ss4 += o * o; }
        const float rstd = __builtin_amdgcn_rsqf(((ss4.x + ss4.y) + (ss4.z + ss4.w)) * (1.f / 64.f) + EPS) * (1.0f - lam_init);
        const f32x4* gn = (const f32x4*)(A.in[11] + l * 64); v4u* op = (v4u*)((bf16*)(F.ws + WS_MIX) + grow * D + h * 64);
#pragma unroll
        for (int e = 0; e < 16; e += 2) { const f32x4 o0 = O4[e] * gn[e] * rstd, o1 = O4[e + 1] * gn[e + 1] * rstd;
            v4u w; w.x = pk2(o0.x, o0.y); w.y = pk2(o0.z, o0.w); w.z = pk2(o1.x, o1.y); w.w = pk2(o1.z, o1.w); op[e >> 1] = w; } }
    __syncthreads();
}

__device__ __forceinline__ void ssd_naive_unit(Frame& F_, const Args& A, int l, int b, int g) {
    Frame F = refresh(F_);
    LAS float* xs = (LAS float*)F.lds;
    LAS float* Bs = xs + 64 * 256;
    LAS float* Cs = Bs + 4096;
    LAS float* dts = Cs + 4096;
    LAS float* dAs = dts + 256;
    const int tid = F.tid, hh = tid >> 7, p = (tid & 127) >> 1, nh = tid & 1, head = g * 4 + hh;
    const float Dk = A.in[16][l * 8 + head];
    float hst[32];
#pragma unroll
    for (int i = 0; i < 32; ++i) hst[i] = 0.f;
    int ch = 0; float w0 = 0.f, w1 = 0.f, w2 = 0.f, w3 = 0.f, cb = 0.f, r0 = 0.f, r1 = 0.f, r2 = 0.f;
    if (tid < 384) { ch = tid < 256 ? g * 256 + tid : tid < 320 ? 512 + g * 64 + (tid - 256) : 640 + g * 64 + (tid - 320);
        const float* cw = A.in[12] + (size_t)l * 4 * 768; w0 = cw[ch]; w1 = cw[768 + ch]; w2 = cw[2 * 768 + ch]; w3 = cw[3 * 768 + ch]; cb = A.in[13][l * 768 + ch]; }
    for (int c = 0; c < SEQ / 64; ++c) {
        __syncthreads();
        const size_t rowb = (size_t)b * SEQ + c * 64;
        if (tid < 384) { const bf16* src = ((bf16*)(F.ws + WS_BIG)) + rowb * NPROJ + PC_XBC + ch; LAS float* dst = tid < 256 ? xs + tid : tid < 320 ? Bs + (tid - 256) : Cs + (tid - 320); const int dstr = tid < 256 ? 256 : 64;
            _Pragma("unroll 16") for (int tt = 0; tt < 64; ++tt) { const float r3 = bf2f(src[(size_t)tt * NPROJ]); const float v = cb + r0 * w0 + r1 * w1 + r2 * w2 + r3 * w3; dst[tt * dstr] = silu_f(v); r0 = r1; r1 = r2; r2 = r3; } }
        else if (tid < 384 + 64) { const int tt = tid - 384;
#pragma unroll
            for (int k = 0; k < 4; ++k) { const int hd = g * 4 + k; const float xr = ((float*)(F.ws + WS_DT))[(rowb + tt) * 8 + hd] + A.in[14][l * 8 + hd]; const float dt = xr > 20.f ? xr : log1pf(__expf(xr));
                dts[tt * 4 + k] = dt; dAs[tt * 4 + k] = __expf(-__expf(A.in[15][l * 8 + hd]) * dt); } }
        __syncthreads();
        for (int tt = 0; tt < 64; ++tt) {
            const float x = xs[tt * 256 + hh * 64 + p], dt = dts[tt * 4 + hh], dA = dAs[tt * 4 + hh], cx = dt * x;
            const LAS float* Br = Bs + tt * 64 + nh * 32; const LAS float* Cr = Cs + tt * 64 + nh * 32; float a = 0.f;
#pragma unroll
            for (int i = 0; i < 32; i += 4) { const f32x4 bb = *(const LAS f32x4*)(Br + i), cc = *(const LAS f32x4*)(Cr + i);
                hst[i] = hst[i] * dA + cx * bb.x; hst[i + 1] = hst[i + 1] * dA + cx * bb.y; hst[i + 2] = hst[i + 2] * dA + cx * bb.z; hst[i + 3] = hst[i + 3] * dA + cx * bb.w;
                a += (hst[i] * cc.x + hst[i + 1] * cc.y) + (hst[i + 2] * cc.z + hst[i + 3] * cc.w); }
            a += __shfl_xor(a, 1);
            if (nh == 0) xs[tt * 256 + hh * 64 + p] = a + Dk * x;
        }
        __syncthreads();
        for (int k = 0; k < 8; ++k) { const int tt = F.wave * 8 + k; const size_t row = rowb + tt;
            const f32x4 y = *(const LAS f32x4*)(xs + tt * 256 + 4 * F.lane); const uint2 zz = *(const uint2*)(((bf16*)(F.ws + WS_BIG)) + row * NPROJ + PC_Z + g * 256 + 4 * F.lane);
            f32x4 v; v.x = y.x * silu_f(bflo(zz.x)); v.y = y.y * silu_f(bfhi(zz.x)); v.z = y.z * silu_f(bflo(zz.y)); v.w = y.w * silu_f(bfhi(zz.y));
            const float rstd = __builtin_amdgcn_rsqf(wave_sum((v.x * v.x + v.y * v.y) + (v.z * v.z + v.w * v.w)) * (1.f / 256.f) + EPS);
            const f32x4 gn = *(const f32x4*)(A.in[17] + l * 512 + g * 256 + 4 * F.lane);
            uint2 o; o.x = pk2(v.x * rstd * gn.x, v.y * rstd * gn.y); o.y = pk2(v.z * rstd * gn.z, v.w * rstd * gn.w);
            *(uint2*)(((bf16*)(F.ws + WS_MIX)) + row * D + 256 + g * 256 + 4 * F.lane) = o; }
    }
    __syncthreads();
}

__device__ __forceinline__ void ret_naive_unit(Frame& F_, const Args& A, int l, int b, int h) {
    Frame F = refresh(F_);
    constexpr int ST = 68;
    LAS float* qs = (LAS float*)F.lds; LAS float* ks = qs + 64 * ST; LAS float* vs = ks + 64 * ST; LAS float* sc = vs + 64 * ST; LAS float* Ss = sc + 64 * ST; LAS float* os = Ss + 64 * ST;
    const int tid = F.tid, ra = tid >> 3, eg = tid & 7;
    const float gam = 1.0f - exp2f(-5.0f - (float)h), lg2 = log2f(gam), g64 = exp2f(lg2 * 64.f);
    float Sreg[8];
#pragma unroll
    for (int i = 0; i < 8; ++i) Sreg[i] = 0.f;
    __syncthreads();
#pragma unroll
    for (int i = 0; i < 8; ++i) Ss[ra * ST + eg * 8 + i] = 0.f;
    for (int c = 0; c < SEQ / 64; ++c) {
        __syncthreads();
        const size_t rowb = (size_t)b * SEQ + c * 64;
        { const int tok = ra, seg = eg; const bf16* rp = ((bf16*)(F.ws + WS_BIG)) + (rowb + tok) * NPROJ;
          if (seg < 4) { float ql[8], qh[8], kl[8], kh[8];
              unpack8(*(const v4u*)(rp + PC_RQ + h * 64 + seg * 8), ql); unpack8(*(const v4u*)(rp + PC_RQ + h * 64 + 32 + seg * 8), qh);
              unpack8(*(const v4u*)(rp + PC_RK + h * 64 + seg * 8), kl); unpack8(*(const v4u*)(rp + PC_RK + h * 64 + 32 + seg * 8), kh);
              const float pos = (float)(c * 64 + tok);
#pragma unroll
              for (int i = 0; i < 8; ++i) { const int fi = seg * 8 + i; const float invf = exp2f(-(float)fi * (13.287712379549449f / 32.0f)); const float ang = pos * invf;
                  double rev = (double)ang * 0.15915494309189535; rev -= __builtin_rint(rev); const float fr = (float)rev;
                  const float sn = __builtin_amdgcn_sinf(fr), cs = __builtin_amdgcn_cosf(fr);
                  qs[tok * ST + fi] = ql[i] * cs - qh[i] * sn; qs[tok * ST + fi + 32] = ql[i] * sn + qh[i] * cs;
                  ks[tok * ST + fi] = kl[i] * cs - kh[i] * sn; ks[tok * ST + fi + 32] = kl[i] * sn + kh[i] * cs; } }
          else { float va[8], vb[8]; const int c0 = (seg - 4) * 16; unpack8(*(const v4u*)(rp + PC_RV + h * 64 + c0), va); unpack8(*(const v4u*)(rp + PC_RV + h * 64 + c0 + 8), vb);
#pragma unroll
              for (int i = 0; i < 8; ++i) { vs[tok * ST + c0 + i] = va[i]; vs[tok * ST + c0 + 8 + i] = vb[i]; } } }
        __syncthreads();
        { float a[8];
#pragma unroll
          for (int jj = 0; jj < 8; ++jj) a[jj] = 0.f;
          for (int d = 0; d < 64; d += 4) { const f32x4 qq = *(const LAS f32x4*)(qs + ra * ST + d);
#pragma unroll
              for (int jj = 0; jj < 8; ++jj) { const f32x4 kk = *(const LAS f32x4*)(ks + (jj * 8 + eg) * ST + d); a[jj] += (qq.x * kk.x + qq.y * kk.y) + (qq.z * kk.z + qq.w * kk.w); } }
#pragma unroll
          for (int jj = 0; jj < 8; ++jj) { const int s = jj * 8 + eg; const int dd = ra > s ? ra - s : s - ra; sc[ra * ST + s] = a[jj] * exp2f(lg2 * (float)dd); } }
        __syncthreads();
        { float a[8];
#pragma unroll
          for (int i = 0; i < 8; ++i) a[i] = 0.f;
          for (int s = 0; s < 64; ++s) { const float w = sc[ra * ST + s]; const f32x4 v0 = *(const LAS f32x4*)(vs + s * ST + eg * 8), v1 = *(const LAS f32x4*)(vs + s * ST + eg * 8 + 4);
              a[0] += w * v0.x; a[1] += w * v0.y; a[2] += w * v0.z; a[3] += w * v0.w; a[4] += w * v1.x; a[5] += w * v1.y; a[6] += w * v1.z; a[7] += w * v1.w; }
          const float qd = exp2f(lg2 * (float)(ra + 1));
          for (int d = 0; d < 64; ++d) { const float w = qs[ra * ST + d] * qd; const f32x4 v0 = *(const LAS f32x4*)(Ss + d * ST + eg * 8), v1 = *(const LAS f32x4*)(Ss + d * ST + eg * 8 + 4);
              a[0] += w * v0.x; a[1] += w * v0.y; a[2] += w * v0.z; a[3] += w * v0.w; a[4] += w * v1.x; a[5] += w * v1.y; a[6] += w * v1.z; a[7] += w * v1.w; }
#pragma unroll
          for (int i = 0; i < 8; ++i) os[ra * ST + eg * 8 + i] = a[i]; }
        __syncthreads();
        { float a[8];
#pragma unroll
          for (int i = 0; i < 8; ++i) a[i] = 0.f;
          for (int s = 0; s < 64; ++s) { const float w = ks[s * ST + ra] * exp2f(lg2 * (float)(63 - s)); const f32x4 v0 = *(const LAS f32x4*)(vs + s * ST + eg * 8), v1 = *(const LAS f32x4*)(vs + s * ST + eg * 8 + 4);
              a[0] += w * v0.x; a[1] += w * v0.y; a[2] += w * v0.z; a[3] += w * v0.w; a[4] += w * v1.x; a[5] += w * v1.y; a[6] += w * v1.z; a[7] += w * v1.w; }
#pragma unroll
          for (int i = 0; i < 8; ++i) { Sreg[i] = Sreg[i] * g64 + a[i]; Ss[ra * ST + eg * 8 + i] = Sreg[i]; } }
        for (int k = 0; k < 8; ++k) { const int tok = F.wave * 8 + k; const size_t row = rowb + tok;
            const float v = os[tok * ST + F.lane]; const float rstd = __builtin_amdgcn_rsqf(wave_sum(v * v) * (1.f / 64.f) + EPS);
            const float gt = bf2f(((bf16*)(F.ws + WS_BIG))[row * NPROJ + PC_RG + h * 64 + F.lane]);
            ((bf16*)(F.ws + WS_MIX))[row * D + 768 + h * 64 + F.lane] = (bf16)f2bf(silu_f(gt) * v * rstd * A.in[18][l * 64 + F.lane]); }
    }
    __syncthreads();
}
__device__ __forceinline__ void mixer_2a(Frame& F, const Args& A, int l) {
    for (int u = F.bx; u < 1536; u += F.G) {
#if !defined(BISECT) || BISECT != 2
        if (u < 512) ssd::ssd_m1_unit(F, A, l, u >> 8, (u >> 1) & 127, u & 1);
#else
        if (u < 512) {}
#endif
#if !defined(BISECT) || BISECT != 1
        else { const int v = u - 512; ret::ret_m1_unit(F, A, l, v >> 9, (v >> 2) & 127, v & 3); }
#endif
    }
}
__device__ __forceinline__ void mixer_2b(Frame& F_, const Args& A, int l) {
    Frame F = refresh(F_);
    const float lam_init = 0.8f - 0.6f * __expf(-0.3f * (float)l);
    float d1 = 0.f, d2 = 0.f;
    for (int i = 0; i < 32; ++i) { d1 += A.in[7][l * 32 + i] * A.in[8][l * 32 + i]; d2 += A.in[9][l * 32 + i] * A.in[10][l * 32 + i]; }
    const float lam = __expf(d1) - __expf(d2) + lam_init;
    if (F.bx < 64) ssd::scan_unit(F, 0, F.bx); else if (F.bx < 96) ssd::scan_unit(F, 1, F.bx - 64);
    const int na = F.G, j = F.bx;
    const int wpos = (F.bx >> 3) % 3;
    for (int rnd = 0; rnd < 3 || rnd * na < 512; ++rnd) {
#ifndef EXPERTS_IN_P0
        if (l == 0 && rnd == wpos) expert_weights(F, A);
#endif
        const int i = (rnd & 1) ? (rnd + 1) * na - 1 - j : rnd * na + j;
        if (i < 512) { const int qb = 63 - (i >> 3), bh = i & 7; att::attn_unit(F, A, l, bh >> 2, bh & 3, qb, lam, 1.0f - lam_init);
#if defined(DBL_PHASE) && DBL_PHASE == 23
            att::attn_unit(F, A, l, bh >> 2, bh & 3, qb, lam, 1.0f - lam_init);
#endif
        }
    }
}
__device__ __forceinline__ void mixer_2c(Frame& F, const Args& A, int l) {
    for (int u = F.bx; u < 1536; u += F.G) {
#if !defined(BISECT) || BISECT != 2
        if (u < 512) ssd::ssd_m3_unit(F, A, l, u >> 8, (u >> 1) & 127, u & 1);
#else
        if (u < 512) {}
#endif
#if !defined(BISECT) || BISECT != 1
        else { const int v = u - 512; ret::ret_m3_unit(F, A, l, v >> 9, (v >> 2) & 127, v & 3); }
#endif
    }
}
__device__ __forceinline__ void gather_phase(Frame& F_) {
    Frame F = refresh(F_);
    const int gw = F.bx * NWAVES + F.wave, NGW = F.G * NWAVES, nrows = F.META[16] * 256;
    const v4u* XN8 = (const v4u*)(F.ws + WS_XN); v4u* XG8 = (v4u*)(F.ws + WS_XG8); const int* LIST = (const int*)(F.ws + WS_LIST);
    const float* XNS = (const float*)(F.ws + WS_XNS); float* XGS = (float*)(F.ws + WS_XGS);
    for (int row0 = gw; row0 < nrows; row0 += 4 * NGW) {
        int tok[4]; bool ok[4];
#pragma unroll
        for (int i = 0; i < 4; ++i) { const int row = row0 + i * NGW; ok[i] = false; tok[i] = 0;
            if (row < nrows) { const int p = row >> 8, r = row & 255; int e = 0;
#pragma unroll
                for (int k = 1; k < 8; ++k) e += (p >= F.META[8 + k]) ? 1 : 0;
                const int pos = (p - F.META[8 + e]) * 256 + r;
                if (pos < F.META[e]) { ok[i] = true; tok[i] = LIST[e * 16384 + pos]; } } }
        v4u a[4]; float s[4];
#pragma unroll
        for (int i = 0; i < 4; ++i) { a[i] = (v4u){0u, 0u, 0u, 0u}; s[i] = 0.f; if (ok[i]) { a[i] = XN8[(size_t)tok[i] * 64 + F.lane]; s[i] = XNS[tok[i]]; } }
#pragma unroll
        for (int i = 0; i < 4; ++i) { const int row = row0 + i * NGW; if (row < nrows) { XG8[(size_t)row * 64 + F.lane] = a[i]; if (F.lane == 0) XGS[row] = s[i]; } }
    }
}
__device__ __forceinline__ void zero_yacc(Frame& F_) {
    Frame F = refresh(F_);
    v4u* za = (v4u*)(F.ws + WS_XN);
    for (size_t i = (size_t)F.bx * 512 + F.tid; i < (size_t)8 * 256 * 1024 / 4; i += (size_t)F.G * 512) za[i] = (v4u){0u, 0u, 0u, 0u};
}
#if defined(DBL_PHASE) && DBL_PHASE == 40
#define GRID_BAR() do { xcd_barrier(bar); xcd_barrier(bar); } while (0)
#else
#define GRID_BAR() xcd_barrier(bar)
#endif
#ifndef DBL_PHASE
#define DBL_PHASE -1
#endif
#ifdef PROBE_A
#define STAMP(i) do { if (F.bx == 0 && threadIdx.x == 0) ((LAS unsigned long long*)(F.lds + LDSCTL_OFF + 2048))[i] = __builtin_amdgcn_s_memrealtime(); } while (0)
#else
#define STAMP(i) do { } while (0)
#endif
#define WSB(off) ((bf16*)(F.ws + (off)))
template <int l>
__device__ __forceinline__ void layer_body(Frame& F, const Args& args, const XcdBarrier& bar) {

        { pg8::Gemm g{WSB(WS_XN), (const bf16*)((const signed char*)(F.ws + WS_WIN) + (size_t)l * NPROJ * D), D / 2}; pg8::StaticOrder S; S.init(M, NPROJ, F.G, F.bx);
          pg8::EpiBf16S E{WSB(WS_BIG), NPROJ, (const float*)(F.ws + WS_XNS), (const float*)(F.ws + WS_SBI) + l * NPROJ};
          pg8::gemm_phase<pg8::EpiBf16S, pg8::StaticOrder, true, true>(F.lds, g, S, E); }
#if DBL_PHASE == 1
        { pg8::Gemm g{WSB(WS_XN), (const bf16*)((const signed char*)(F.ws + WS_WIN) + (size_t)l * NPROJ * D), D / 2}; pg8::StaticOrder S; S.init(M, NPROJ, F.G, F.bx);
          pg8::EpiBf16S E{WSB(WS_BIG), NPROJ, (const float*)(F.ws + WS_XNS), (const float*)(F.ws + WS_SBI) + l * NPROJ};
          pg8::gemm_phase<pg8::EpiBf16S, pg8::StaticOrder, true, true>(F.lds, g, S, E); }
#endif
        GRID_BAR(); STAMP(1 + 1 + (l == 0 ? 0 : 7));
        mixer_2a(F, args, l);
#if DBL_PHASE == 20
        mixer_2a(F, args, l);
#endif
        GRID_BAR();
        mixer_2b(F, args, l);
#if DBL_PHASE == 21
        mixer_2b(F, args, l);
#endif
        GRID_BAR();
        mixer_2c(F, args, l);
#if DBL_PHASE == 22
        mixer_2c(F, args, l);
#endif
        GRID_BAR(); STAMP(1 + 2 + (l == 0 ? 0 : 7));
        { pg8::Gemm g{WSB(WS_MIX), WSB(WS_WOUT) + (size_t)l * D * D, D}; pg8::StaticOrder S; S.init(M, D, F.G, F.bx);
          if constexpr (l == 0) { pg8::EpiResBf<true> E{args.in[0], WSB(WS_XR), D, nullptr}; pg8::gemm_phase<pg8::EpiResBf<true>, pg8::StaticOrder, false>(F.lds, g, S, E); }
          else { pg8::EpiResBf<false> E{WSB(WS_XR), WSB(WS_XR), D, nullptr}; pg8::gemm_phase<pg8::EpiResBf<false>, pg8::StaticOrder, false>(F.lds, g, S, E); } }
#if DBL_PHASE == 41
        if constexpr (l == 0) { pg8::Gemm g{WSB(WS_MIX), WSB(WS_WOUT), D}; pg8::StaticOrder S; S.init(M, D, F.G, F.bx);
          pg8::EpiResBf<true> E{args.in[0], WSB(WS_XR), D, nullptr}; pg8::gemm_phase<pg8::EpiResBf<true>, pg8::StaticOrder, false>(F.lds, g, S, E); }
#endif
        GRID_BAR(); STAMP(1 + 3 + (l == 0 ? 0 : 7));
        if constexpr (l == 0) {
            norm_phase<0, true, true>(F, (const float*)(F.ws + WS_XR), args.in[4], nullptr, 0);
            GRID_BAR(); STAMP(5);
            { pg8::Gemm g{WSB(WS_XN), WSB(WS_WGU), D / 2}; pg8::StaticOrder S; S.init(M, 2 * FDP, F.G, F.bx);
              pg8::EpiSwiGLU8<true> E{WSB(WS_BIG), FDP, (const float*)(F.ws + WS_XNS), (const float*)(F.ws + WS_SBD)};
              pg8::gemm_phase<pg8::EpiSwiGLU8<true>, pg8::StaticOrder, true, true>(F.lds, g, S, E); }
#if DBL_PHASE == 4
        { pg8::Gemm g{WSB(WS_XN), WSB(WS_WGU), D / 2}; pg8::StaticOrder S; S.init(M, 2 * FDP, F.G, F.bx);
              pg8::EpiSwiGLU8<true> E{WSB(WS_BIG), FDP, (const float*)(F.ws + WS_XNS), (const float*)(F.ws + WS_SBD)};
              pg8::gemm_phase<pg8::EpiSwiGLU8<true>, pg8::StaticOrder, true, true>(F.lds, g, S, E); }
#endif
            GRID_BAR(); STAMP(6);
            { pg8::Gemm g{WSB(WS_BIG), WSB(WS_WD), FDP / 2}; pg8::StaticOrder S; S.init(M, D, F.G, F.bx);
              pg8::EpiResBf<false> E{WSB(WS_XR), WSB(WS_XR), D, (const float*)(F.ws + WS_SBWD)};
              pg8::gemm_phase<pg8::EpiResBf<false>, pg8::StaticOrder, false, false, true>(F.lds, g, S, E); }
            GRID_BAR(); STAMP(7);
            norm_phase<1, true, true>(F, (const float*)(F.ws + WS_XR), args.in[3] + D, args.in[1] + (size_t)D * NIN + 2048, NIN);
            GRID_BAR(); STAMP(8);
        } else {
            norm_phase<2, true, true>(F, (const float*)(F.ws + WS_XR), args.in[4] + D, args.in[22], 8);
            GRID_BAR(); STAMP(12);
            if (F.tid == 0) { int acc = 0;
                for (int e = 0; e < 8; ++e) { const int c = (int)__hip_atomic_load(F.ctl + CW_CNT + 64 * e, RLX_AGENT); F.META[e] = c; F.META[8 + e] = acc; acc += (c + 255) >> 8; }
                F.META[16] = acc; }
            __syncthreads();
            const int ptot = F.META[16];
            {
                const int p0 = 0; int np = ptot; if (np > 136) np = 136; const int slab = 0; (void)slab;
                { pg8::Gemm g{WSB(0), WSB(WS_EGU), D / 2}; pg8::GroupedOrder S{2 * FE / 256, p0, np, F.G, F.bx, 0, F.META, 0, 0, 1};
                  pg8::EpiSwiGLU8<true> E{WSB(WS_BIG), FE, (const float*)(F.ws + WS_XGS2), (const float*)(F.ws + WS_SBE)};
                  pg8::gemm_phase<pg8::EpiSwiGLU8<true>, pg8::GroupedOrder, true, true>(F.lds, g, S, E); }
#if DBL_PHASE == 5
        { pg8::Gemm g{WSB(0), WSB(WS_EGU), D / 2}; pg8::GroupedOrder S{2 * FE / 256, p0, np, F.G, F.bx, 0, F.META, 0, 0, 1};
                  pg8::EpiSwiGLU8<true> E{WSB(WS_BIG), FE, (const float*)(F.ws + WS_XGS2), (const float*)(F.ws + WS_SBE)};
                  pg8::gemm_phase<pg8::EpiSwiGLU8<true>, pg8::GroupedOrder, true, true>(F.lds, g, S, E); }
#endif
                GRID_BAR(); STAMP(14 + 2 * slab);
                { pg8::Gemm g{WSB(WS_BIG), WSB(WS_ED), FE / 2}; pg8::GroupedOrder S{D / 256, p0, np, F.G, F.bx, 1, F.META, 512, 4};
                  pg8::EpiYMoE E{WSB(WS_MIX), WSB(WS_XN), D, (const float*)(F.ws + WS_SBED), 512};
                  pg8::gemm_phase<pg8::EpiYMoE, pg8::GroupedOrder, true, false, true>(F.lds, g, S, E); }
#if DBL_PHASE == 6
        { pg8::Gemm g{WSB(WS_BIG), WSB(WS_ED), FE / 2}; pg8::GroupedOrder S{D / 256, p0, np, F.G, F.bx, 1, F.META, 512, 4};
                  pg8::EpiYMoE E{WSB(WS_MIX), WSB(WS_XN), D, (const float*)(F.ws + WS_SBED), 512};
                  pg8::gemm_phase<pg8::EpiYMoE, pg8::GroupedOrder, true, false, true>(F.lds, g, S, E); }
#endif
                GRID_BAR(); STAMP(15 + 2 * slab);
            }
#ifdef PROBE_A
            if (F.bx == 0 && threadIdx.x == 0) { const LAS unsigned long long* ts = (const LAS unsigned long long*)(F.lds + LDSCTL_OFF + 2048);
                float ta = 0.f, tbv = 0.f;
                for (int i = 1; i <= 17; ++i) { const float d = (float)(ts[i] - ts[i - 1]) * 0.01f;
                    if ((PROBE_A >> i) & 1) ta += d; if ((PROBE_B >> i) & 1) tbv += d; }
                ((float*)(F.ws + WS_CTL))[100] = ta / PROBE_SA; ((float*)(F.ws + WS_CTL))[101] = tbv / PROBE_SB * 100.0f; }
            GRID_BAR();
#endif
            combine_phase(F, args);
#ifdef PROBE_A
            GRID_BAR();
            { const float eps = ((const float*)(F.ws + WS_CTL))[100], vv = ((const float*)(F.ws + WS_CTL))[101];
              for (size_t i = (size_t)F.bx * 512 + threadIdx.x; i < (size_t)M * D; i += (size_t)F.G * 512) F.out[i] = (i == 0) ? vv : F.out[i] * (1.0f + eps); }
#endif
        }
}
__global__ void __launch_bounds__(NWAVES * 64, 2) mk_fwd(Args args) {
    extern __shared__ __attribute__((aligned(16))) unsigned char lds[];
    Frame F;
    F.lds = (LAS unsigned char*)lds;
    F.MISC = (volatile LAS unsigned*)(F.lds + MISC_OFF);
    F.META = (LAS int*)(F.lds + MISC_OFF + 64);
    F.tid = threadIdx.x; F.lane = F.tid & 63; F.wave = __builtin_amdgcn_readfirstlane(F.tid >> 6);
    F.G = gridDim.x; F.bx = blockIdx.x;
    F.ws = args.ws; F.out = args.out;
    F.ctl = (gu32*)(F.ws + WS_CTL);
    for (int u = F.tid; u < (LDS_BYTES - LDSCTL_OFF) / 4; u += NWAVES * 64) ((LAS unsigned*)(F.lds + LDSCTL_OFF))[u] = 0u;
    __syncthreads();
    XcdBarrier bar = xcd_barrier_post((unsigned*)(F.ctl + CW_BAR), F.MISC + 8);
    STAMP(0);
    p0_weights(F, args);
    __syncthreads();
#ifdef EXPERTS_IN_P0
    expert_weights(F, args);
#endif
#if DBL_PHASE == 0
    p0_weights(F, args);
    __syncthreads();
#endif
    __syncthreads();
    norm_phase<1, true>(F, args.in[0], args.in[3], args.in[1] + 2048, NIN);
    GRID_BAR(); STAMP(1);
    layer_body<0>(F, args, bar);
    layer_body<1>(F, args, bar);
}

extern "C" void kernel_launch(void* const* d_in, const int* in_sizes, int n_in, void* d_out, int out_size, void* d_ws, size_t ws_size, hipStream_t stream) {
    static int grid = 0;
    if (grid == 0) {
        if (n_in != 26 || in_sizes[0] != M * D || out_size != M * D || ws_size < WS_END) { fprintf(stderr, "kernel_launch: unexpected shapes (n_in %d, in0 %d, out %d, ws %zu); nothing launched\n", n_in, n_in > 0 ? in_sizes[0] : -1, out_size, ws_size); grid = -1; return; }
        int dev = 0, cus = 0, per_cu = 0;
        if (hipGetDevice(&dev) != hipSuccess || hipDeviceGetAttribute(&cus, hipDeviceAttributeMultiprocessorCount, dev) != hipSuccess) { grid = -1; return; }
        if (hipFuncSetAttribute((const void*)mk_fwd, hipFuncAttributeMaxDynamicSharedMemorySize, LDS_BYTES) != hipSuccess) { fprintf(stderr, "kernel_launch: hipFuncSetAttribute failed\n"); grid = -1; return; }
        if (hipOccupancyMaxActiveBlocksPerMultiprocessor(&per_cu, (const void*)mk_fwd, NWAVES * 64, LDS_BYTES) != hipSuccess || per_cu < 1) fprintf(stderr, "kernel_launch: occupancy query reports %d blocks per CU\n", per_cu);
        (void)hipGetLastError();
        grid = cus;
    }
    if (grid < 0) return;
    if (hipMemsetAsync((char*)d_ws + WS_CTL, 0, CTL_ZERO_BYTES, stream) != hipSuccess) return;
    Args a{};
    for (int i = 0; i < 26; ++i) a.in[i] = (const float*)d_in[i];
    a.out = (float*)d_out; a.ws = (unsigned char*)d_ws;
    hipLaunchKernelGGL(mk_fwd, dim3(grid), dim3(NWAVES * 64), LDS_BYTES, stream, a);
}
```

```cpp
#include <hip/hip_runtime.h>
#include <cstdio>
#include <cstdint>
namespace pg8 {
#define PG8_LAS __attribute__((address_space(3)))
typedef unsigned short bf16_t;
typedef short bf16x8 __attribute__((ext_vector_type(8)));
typedef float f32x4 __attribute__((ext_vector_type(4)));
typedef unsigned u32x4 __attribute__((ext_vector_type(4)));
constexpr int BM = 256, BK = 64, HALF = 128, HTB = HALF * BK * 2  , STAGE_BYTES = 8 * HTB, NXCD = 8, WGM = 8;

__host__ __device__ __forceinline__ int lds_byte(int r, int c) { const int st = (r >> 4) * 2 + (c >> 5), rr = r & 15, cc = c & 31, ob = rr * 64 + cc * 2; return st * 1024 + (ob ^ (((ob >> 9) & 1) << 5)); }
__host__ __device__ __forceinline__ void stage_rc(int b, int& R, int& C) { const int st = b / 1024, sb = b % 1024, swz = sb ^ (((sb >> 9) & 1) << 5); R = (st >> 1) * 16 + swz / 64; C = (st & 1) * 32 + (swz % 64) / 2; }
__host__ __device__ __forceinline__ int perm32(int rho) { const int n = rho >> 4, i = rho & 15; return 8 * (i >> 2) + 4 * n + (i & 3); }

struct Unit { int pm, pn, cn, po, e, j, koff, kt, split; };
struct Gemm { const bf16_t* A; const bf16_t* Bt; int K; };

struct StaticOrder {
    int nM, nN, nwg, G, c;
    __host__ __device__ void init(int M, int N, int G_, int c_) { nM = M / BM; nN = N / BM; nwg = nM * nN; G = G_; c = c_; }
    __host__ __device__ bool next(int i, Unit& u) const {
        const long L = (long)i * G + c; if (L >= nwg) return false;
        int wgid = (int)L; { const int q = nwg / NXCD, r = nwg % NXCD, xcd = wgid % NXCD, off = wgid / NXCD; wgid = (xcd < r ? xcd * (q + 1) : r * (q + 1) + (xcd - r) * q) + off; }
        const int nig = WGM * nN, gid = wgid / nig, fm = gid * WGM, gsz = (nM - fm) < WGM ? (nM - fm) : WGM;
        u.pm = fm + ((wgid % nig) % gsz); u.pn = (wgid % nig) / gsz; u.cn = u.pn; u.po = u.pm; u.e = 0; u.j = 0; u.koff = 0; u.kt = 0; u.split = 0; return true;
    }
};
struct GroupedOrder {
    int nN, p0, np, G, c, a_local;
    const PG8_LAS int* meta;
    int ksb, kst;
    int aregion;
    __device__ __forceinline__ bool next(int i, Unit& u) const {
        int pl, n, koff = 0, kt = 0, split = 0;
        if (a_local && nN == 4 && G == 256) {
            {
            const int nfull = np < 128 ? np : 128, pl0 = ((c >> 3) >> 2) * 8 + (c & 7);
            const int nmine = (pl0 < nfull ? 1 : 0) + (64 + pl0 < nfull ? 1 : 0);
            if (i < nmine) { pl = i * 64 + pl0; n = (c >> 3) & 3; }
            else if (i == nmine) { if (c >= (np - nfull) * 28) return false; pl = nfull + c / 28; const int rem = c - (c / 28) * 28; n = rem / 7; koff = (rem - n * 7) * ksb; kt = kst; split = 1; }
            else return false;
            }
        } else { const int L = i * G + c; if (L >= np * nN) return false; pl = L / nN; n = L - pl * nN; }
        const int p = p0 + pl;
        int e = 0;
#pragma unroll
        for (int k = 1; k < 8; ++k) e += (p >= meta[8 + k]) ? 1 : 0;
        e = __builtin_amdgcn_readfirstlane(e);
        u.e = e; u.j = 0; u.pm = a_local ? pl : p; u.po = a_local ? p : pl;
        if (aregion) u.pm = (e < 6 ? (203 + 16 * e) * 4 : (2 + 16 * (e - 6)) * 4) + (p - meta[8 + e]); u.pn = e * nN + n; u.cn = n; u.koff = koff; u.kt = kt; u.split = split; return true;
    }
};

__device__ __forceinline__ unsigned cvt_pk_bf16(float lo, float hi) { unsigned r; asm volatile("v_cvt_pk_bf16_f32 %0, %1, %2" : "=v"(r) : "v"(lo), "v"(hi)); return r; }

#ifdef EPI_NT
#define PG8_ST16(p, v) __builtin_nontemporal_store((v), (u32x4*)(p))
#define PG8_ST16F(p, v) __builtin_nontemporal_store((v), (f32x4*)(p))
#else
#define PG8_ST16(p, v) (*(u32x4*)(p) = (v))
#define PG8_ST16F(p, v) (*(f32x4*)(p) = (v))
#endif
struct EpiBf16 {
    static constexpr bool PERM = true, AFTER_DRAIN = false;
    bf16_t* O; int ldc;
    __device__ __forceinline__ void operator()(const f32x4 (&acc)[2][2][4][2], const Unit& u, int wr, int wc, int fr, int fq) const {
        const int row0 = u.po * BM + wr * 64 + fr, col0 = u.cn * BM + wc * 32 + 8 * fq;
#pragma unroll
        for (int ai = 0; ai < 2; ++ai)
#pragma unroll
            for (int m = 0; m < 4; ++m) { bf16_t* rowp = O + (size_t)(row0 + ai * HALF + m * 16) * ldc + col0;
#pragma unroll
                for (int bj = 0; bj < 2; ++bj) { const f32x4 v0 = acc[ai][bj][m][0], v1 = acc[ai][bj][m][1];
                    u32x4 w; w.x = cvt_pk_bf16(v0[0], v0[1]); w.y = cvt_pk_bf16(v0[2], v0[3]); w.z = cvt_pk_bf16(v1[0], v1[1]); w.w = cvt_pk_bf16(v1[2], v1[3]);
                    PG8_ST16(rowp + bj * HALF, w); } }
    }
};
__device__ __forceinline__ float silu_mul(float g, float u) { return g * u * __builtin_amdgcn_rcpf(1.0f + __builtin_amdgcn_exp2f(-1.4426950408889634f * g)); }
struct EpiSwiGLU {
    static constexpr bool PERM = true, AFTER_DRAIN = false;
    bf16_t* O; int ldc;
    __device__ __forceinline__ void operator()(const f32x4 (&acc)[2][2][4][2], const Unit& u, int wr, int wc, int fr, int fq) const {
        const int row0 = u.po * BM + wr * 64 + fr, col0 = u.cn * HALF + wc * 32 + 8 * fq;
#pragma unroll
        for (int ai = 0; ai < 2; ++ai)
#pragma unroll
            for (int m = 0; m < 4; ++m) { bf16_t* rowp = O + (size_t)(row0 + ai * HALF + m * 16) * ldc + col0;
                const f32x4 g0 = acc[ai][0][m][0], g1 = acc[ai][0][m][1], u0 = acc[ai][1][m][0], u1 = acc[ai][1][m][1];
                u32x4 w; w.x = cvt_pk_bf16(silu_mul(g0[0], u0[0]), silu_mul(g0[1], u0[1])); w.y = cvt_pk_bf16(silu_mul(g0[2], u0[2]), silu_mul(g0[3], u0[3]));
                w.z = cvt_pk_bf16(silu_mul(g1[0], u1[0]), silu_mul(g1[1], u1[1])); w.w = cvt_pk_bf16(silu_mul(g1[2], u1[2]), silu_mul(g1[3], u1[3]));
                PG8_ST16(rowp, w); asm volatile("" ::: "memory"); }
    }
};
struct EpiBf16S {
    static constexpr bool PERM = true, AFTER_DRAIN = false;
    bf16_t* O; int ldc; const float* sa; const float* sb;
    __device__ __forceinline__ void operator()(const int __attribute__((ext_vector_type(4))) (&acc)[2][2][4][2], const Unit& u, int wr, int wc, int fr, int fq) const {
        const int row0 = u.po * BM + wr * 64 + fr, col0 = u.cn * BM + wc * 32 + 8 * fq;
        const float* sbp = sb + (size_t)u.pn * BM + wc * 32 + 8 * fq;
        f32x4 s4[2][2];
#pragma unroll
        for (int bj = 0; bj < 2; ++bj) { s4[bj][0] = *(const f32x4*)(sbp + bj * HALF); s4[bj][1] = *(const f32x4*)(sbp + bj * HALF + 4); }
        float av[2][4];
#pragma unroll
        for (int ai = 0; ai < 2; ++ai)
#pragma unroll
            for (int m = 0; m < 4; ++m) av[ai][m] = sa[(size_t)u.pm * BM + wr * 64 + fr + ai * HALF + m * 16];
#pragma unroll
        for (int ai = 0; ai < 2; ++ai)
#pragma unroll
            for (int m = 0; m < 4; ++m) { bf16_t* rowp = O + (size_t)(row0 + ai * HALF + m * 16) * ldc + col0;
                const float a = av[ai][m];
#pragma unroll
                for (int bj = 0; bj < 2; ++bj) { const f32x4 v0 = __builtin_convertvector(acc[ai][bj][m][0], f32x4) * s4[bj][0] * a, v1 = __builtin_convertvector(acc[ai][bj][m][1], f32x4) * s4[bj][1] * a;
                    u32x4 w; w.x = cvt_pk_bf16(v0[0], v0[1]); w.y = cvt_pk_bf16(v0[2], v0[3]); w.z = cvt_pk_bf16(v1[0], v1[1]); w.w = cvt_pk_bf16(v1[2], v1[3]);
                    PG8_ST16(rowp + bj * HALF, w); }
                asm volatile("" ::: "memory"); }
    }
};
__device__ __forceinline__ unsigned pk4_fp8(float a, float b, float c, float d) {
    a = __builtin_amdgcn_fmed3f(a, -448.f, 448.f); b = __builtin_amdgcn_fmed3f(b, -448.f, 448.f); c = __builtin_amdgcn_fmed3f(c, -448.f, 448.f); d = __builtin_amdgcn_fmed3f(d, -448.f, 448.f);
    int w = __builtin_amdgcn_cvt_pk_fp8_f32(a, b, 0, false); w = __builtin_amdgcn_cvt_pk_fp8_f32(c, d, w, true); return (unsigned)w; }
template <bool F8OUT> struct EpiSwiGLU8 {
    static constexpr bool PERM = true, AFTER_DRAIN = false;
    bf16_t* O; int ldc; const float* sa; const float* sb;
    __device__ __forceinline__ void operator()(const int __attribute__((ext_vector_type(4))) (&acc)[2][2][4][2], const Unit& u, int wr, int wc, int fr, int fq) const {
        const int row0 = u.po * BM + wr * 64 + fr, col0 = u.cn * HALF + wc * 32 + 8 * fq;
        const float* sbp = sb + (size_t)u.pn * BM + wc * 32 + 8 * fq;
        const f32x4 sg0 = *(const f32x4*)(sbp), sg1 = *(const f32x4*)(sbp + 4), su0 = *(const f32x4*)(sbp + HALF), su1 = *(const f32x4*)(sbp + HALF + 4);
        float av[2][4];
#pragma unroll
        for (int ai = 0; ai < 2; ++ai)
#pragma unroll
            for (int m = 0; m < 4; ++m) av[ai][m] = sa[(size_t)u.pm * BM + wr * 64 + fr + ai * HALF + m * 16];
#pragma unroll
        for (int ai = 0; ai < 2; ++ai)
#pragma unroll
            for (int m = 0; m < 4; ++m) {
                const float a = av[ai][m];
                const f32x4 g0 = __builtin_convertvector(acc[ai][0][m][0], f32x4) * sg0 * a, g1 = __builtin_convertvector(acc[ai][0][m][1], f32x4) * sg1 * a;
                const f32x4 u0 = __builtin_convertvector(acc[ai][1][m][0], f32x4) * su0 * a, u1 = __builtin_convertvector(acc[ai][1][m][1], f32x4) * su1 * a;
                if constexpr (F8OUT) { unsigned char* rowp = (unsigned char*)O + (size_t)(row0 + ai * HALF + m * 16) * ldc + col0;
                    typedef unsigned u32x2 __attribute__((ext_vector_type(2))); u32x2 w;
                    w.x = pk4_fp8(silu_mul(g0[0], u0[0]), silu_mul(g0[1], u0[1]), silu_mul(g0[2], u0[2]), silu_mul(g0[3], u0[3]));
                    w.y = pk4_fp8(silu_mul(g1[0], u1[0]), silu_mul(g1[1], u1[1]), silu_mul(g1[2], u1[2]), silu_mul(g1[3], u1[3]));
                    *(u32x2*)rowp = w;
                } else { bf16_t* rowp = O + (size_t)(row0 + ai * HALF + m * 16) * ldc + col0;
                    u32x4 w; w.x = cvt_pk_bf16(silu_mul(g0[0], u0[0]), silu_mul(g0[1], u0[1])); w.y = cvt_pk_bf16(silu_mul(g0[2], u0[2]), silu_mul(g0[3], u0[3]));
                    w.z = cvt_pk_bf16(silu_mul(g1[0], u1[0]), silu_mul(g1[1], u1[1])); w.w = cvt_pk_bf16(silu_mul(g1[2], u1[2]), silu_mul(g1[3], u1[3]));
                    PG8_ST16(rowp, w); }
                asm volatile("" ::: "memory"); }
    }
};
struct EpiYMoE {
    static constexpr bool PERM = true, AFTER_DRAIN = false;
    bf16_t* O; bf16_t* Ypart; int ldc; const float* sb; int ksb;
    __device__ __forceinline__ void operator()(const f32x4 (&acc)[2][2][4][2], const Unit& u, int wr, int wc, int fr, int fq) const {
        const int col0 = u.cn * BM + wc * 32 + 8 * fq;
        bf16_t* base = u.split ? Ypart + ((size_t)(u.koff / ksb) * 2048 + (size_t)(u.po - 128) * BM) * ldc : O + (size_t)u.po * BM * ldc;
        const int row0 = wr * 64 + fr;
        const float* sbp = sb + (size_t)u.pn * BM + wc * 32 + 8 * fq;
        f32x4 s4[2][2];
#pragma unroll
        for (int bj = 0; bj < 2; ++bj) { s4[bj][0] = *(const f32x4*)(sbp + bj * HALF); s4[bj][1] = *(const f32x4*)(sbp + bj * HALF + 4); }
#pragma unroll
        for (int ai = 0; ai < 2; ++ai)
#pragma unroll
            for (int m = 0; m < 4; ++m) { bf16_t* rowp = base + (size_t)(row0 + ai * HALF + m * 16) * ldc + col0;
#pragma unroll
                for (int bj = 0; bj < 2; ++bj) { const f32x4 v0 = acc[ai][bj][m][0] * s4[bj][0], v1 = acc[ai][bj][m][1] * s4[bj][1];
                    u32x4 w; w.x = cvt_pk_bf16(v0[0], v0[1]); w.y = cvt_pk_bf16(v0[2], v0[3]); w.z = cvt_pk_bf16(v1[0], v1[1]); w.w = cvt_pk_bf16(v1[2], v1[3]);
                    PG8_ST16(rowp + bj * HALF, w); }
                asm volatile("" ::: "memory"); }
    }
};
template <bool BASE_F32> struct EpiResBf {
    static constexpr bool PERM = true, AFTER_DRAIN = false;
    const void* base; bf16_t* out; int ldc; const float* sb;
    __device__ __forceinline__ void operator()(const f32x4 (&acc)[2][2][4][2], const Unit& u, int wr, int wc, int fr, int fq) const {
        const int row0 = u.po * BM + wr * 64 + fr, col0 = u.cn * BM + wc * 32 + 8 * fq;
        f32x4 s[2][2];
#pragma unroll
        for (int bj = 0; bj < 2; ++bj) { s[bj][0] = (f32x4){1.f, 1.f, 1.f, 1.f}; s[bj][1] = s[bj][0]; if (sb) { s[bj][0] = *(const f32x4*)(sb + col0 + bj * HALF); s[bj][1] = *(const f32x4*)(sb + col0 + bj * HALF + 4); } }
        if constexpr (BASE_F32) {
#pragma unroll
            for (int ai = 0; ai < 2; ++ai) {
                f32x4 b[4][2][2];
#pragma unroll
                for (int m = 0; m < 4; ++m)
#pragma unroll
                    for (int bj = 0; bj < 2; ++bj) { const float* bp = (const float*)base + (size_t)(row0 + ai * HALF + m * 16) * ldc + col0 + bj * HALF; b[m][bj][0] = *(const f32x4*)bp; b[m][bj][1] = *(const f32x4*)(bp + 4); }
#pragma unroll
                for (int m = 0; m < 4; ++m) { const size_t off = (size_t)(row0 + ai * HALF + m * 16) * ldc + col0;
#pragma unroll
                    for (int bj = 0; bj < 2; ++bj) { const f32x4 v0 = b[m][bj][0] + acc[ai][bj][m][0] * s[bj][0], v1 = b[m][bj][1] + acc[ai][bj][m][1] * s[bj][1];
                        u32x4 w; w.x = cvt_pk_bf16(v0[0], v0[1]); w.y = cvt_pk_bf16(v0[2], v0[3]); w.z = cvt_pk_bf16(v1[0], v1[1]); w.w = cvt_pk_bf16(v1[2], v1[3]);
                        PG8_ST16(out + off + bj * HALF, w); } }
                asm volatile("" ::: "memory"); }
        } else {
            u32x4 b[2][4][2];
#pragma unroll
            for (int ai = 0; ai < 2; ++ai)
#pragma unroll
                for (int m = 0; m < 4; ++m)
#pragma unroll
                    for (int bj = 0; bj < 2; ++bj) b[ai][m][bj] = *(const u32x4*)((const bf16_t*)base + (size_t)(row0 + ai * HALF + m * 16) * ldc + col0 + bj * HALF);
#pragma unroll
            for (int ai = 0; ai < 2; ++ai)
#pragma unroll
                for (int m = 0; m < 4; ++m) { const size_t off = (size_t)(row0 + ai * HALF + m * 16) * ldc + col0;
#pragma unroll
                    for (int bj = 0; bj < 2; ++bj) { const u32x4 w0 = b[ai][m][bj];
                        const f32x4 b0 = (f32x4){__uint_as_float(w0.x << 16), __uint_as_float(w0.x & 0xffff0000u), __uint_as_float(w0.y << 16), __uint_as_float(w0.y & 0xffff0000u)};
                        const f32x4 b1 = (f32x4){__uint_as_float(w0.z << 16), __uint_as_float(w0.z & 0xffff0000u), __uint_as_float(w0.w << 16), __uint_as_float(w0.w & 0xffff0000u)};
                        const f32x4 v0 = b0 + acc[ai][bj][m][0] * s[bj][0], v1 = b1 + acc[ai][bj][m][1] * s[bj][1];
                        u32x4 w; w.x = cvt_pk_bf16(v0[0], v0[1]); w.y = cvt_pk_bf16(v0[2], v0[3]); w.z = cvt_pk_bf16(v1[0], v1[1]); w.w = cvt_pk_bf16(v1[2], v1[3]);
                        PG8_ST16(out + off + bj * HALF, w); }
                    asm volatile("" ::: "memory"); }
        }
    }
};
struct EpiResF32 {
    static constexpr bool PERM = false, AFTER_DRAIN = false;
    const float* base; float* out; int ldc; const float* sb;
    __device__ __forceinline__ void operator()(const f32x4 (&acc)[2][2][4][2], const Unit& u, int wr, int wc, int fr, int fq) const {
        const int row0 = u.po * BM + wr * 64 + fr, col0 = u.cn * BM + wc * 32 + 4 * fq;
#pragma unroll
        for (int ai = 0; ai < 2; ++ai)
#pragma unroll
            for (int m = 0; m < 4; ++m) { const size_t off = (size_t)(row0 + ai * HALF + m * 16) * ldc + col0;
#pragma unroll
                for (int bj = 0; bj < 2; ++bj)
#pragma unroll
                    for (int n = 0; n < 2; ++n) { const f32x4 bs = *(const f32x4*)(base + off + bj * HALF + n * 16);
                        const f32x4 s = sb ? *(const f32x4*)(sb + col0 + bj * HALF + n * 16) : (f32x4){1.f, 1.f, 1.f, 1.f};
                        PG8_ST16F(out + off + bj * HALF + n * 16, bs + acc[ai][bj][m][n] * s); }
                asm volatile("" ::: "memory"); }
    }
};
typedef int i32x4 __attribute__((ext_vector_type(4)));
template <bool I8> struct AccT { typedef f32x4 type; };
template <> struct AccT<true> { typedef i32x4 type; };
template <bool I8> __device__ __forceinline__ typename AccT<I8>::type mma16(const bf16x8 b, const bf16x8 a, const typename AccT<I8>::type c);
template <> __device__ __forceinline__ f32x4 mma16<false>(const bf16x8 b, const bf16x8 a, const f32x4 c) { return __builtin_amdgcn_mfma_f32_16x16x32_bf16(b, a, c, 0, 0, 0); }
template <> __device__ __forceinline__ i32x4 mma16<true>(const bf16x8 b, const bf16x8 a, const i32x4 c) { return __builtin_amdgcn_mfma_i32_16x16x64_i8(__builtin_bit_cast(i32x4, b), __builtin_bit_cast(i32x4, a), c, 0, 0, 0); }
typedef int i32x8 __attribute__((ext_vector_type(8)));
__device__ __forceinline__ void mma_f8(f32x4& c, const i32x8 b, const i32x8 a, const int one) {
    asm volatile("v_mfma_scale_f32_16x16x128_f8f6f4 %0, %1, %2, %0, %3, %3 op_sel_hi:[0,0,0]" : "+v"(c) : "v"(b), "v"(a), "v"(one));
}
template <class Epi, class Sched, bool ALIGN_EPI, bool I8 = false, bool F8 = false>
__device__ __forceinline__ void gemm_phase(PG8_LAS unsigned char* lds, const Gemm g, const Sched& S, const Epi& E) {
    int tid_ = threadIdx.x; asm volatile("" : "+v"(tid_));
    const int tid = tid_, wid = __builtin_amdgcn_readfirstlane(tid >> 6), lane = tid & 63, wr = wid >> 2, wc = wid & 3, fr = lane & 15, fq = lane >> 4;
    const int K = g.K, nt = K / BK;
    unsigned voffA[2], voffB[2];
#pragma unroll
    for (int i = 0; i < 2; ++i) { int R, C; stage_rc(tid * 16 + i * 8192, R, C); const int Rb = Epi::PERM ? ((R & ~31) + perm32(R & 31)) : R;
        voffA[i] = (unsigned)(R * K + C) * 2u; voffB[i] = (unsigned)(Rb * K + C) * 2u; }
    const size_t kstep = (size_t)(BK * 2);
    const size_t hstep = (size_t)HALF * K * 2;
    const size_t tstep = 2 * hstep;
    const unsigned ldsw = (unsigned)wid * 1024u;
    const int aoff = lds_byte(wr * 64 + fr, fq * 8), boff = lds_byte(wc * 32 + fr, fq * 8);
#define PG8_SA(b, h) (((b) * 2 + (h)) * HTB)
#define PG8_SB(b, h) ((4 + (b) * 2 + (h)) * HTB)
#define PG8_STAGE(bufoff, gbase, voff) do { _Pragma("unroll") for (int _i = 0; _i < 2; ++_i) \
        __builtin_amdgcn_global_load_lds((const unsigned*)((const char*)(gbase) + (voff)[_i]), (PG8_LAS unsigned*)(lds + (bufoff) + ldsw + _i * 8192), 16, 0, 0); } while (0)
#define PG8_LDA(dst, b, h) do { if constexpr (F8) { _Pragma("unroll") for (int m = 0; m < 4; ++m) { const i32x4 lo_ = *(const PG8_LAS i32x4*)(lds + PG8_SA(b, h) + aoff + m * 2048), hi_ = *(const PG8_LAS i32x4*)(lds + PG8_SA(b, h) + aoff + m * 2048 + 1024); dst##8[m] = __builtin_shufflevector(lo_, hi_, 0, 1, 2, 3, 4, 5, 6, 7); } } \
        else { _Pragma("unroll") for (int m = 0; m < 4; ++m) _Pragma("unroll") for (int k = 0; k < 2; ++k) dst[m][k] = *(const PG8_LAS bf16x8*)(lds + PG8_SA(b, h) + aoff + m * 2048 + k * 1024); } } while (0)
#define PG8_LDB(dst, b, h) do { if constexpr (F8) { _Pragma("unroll") for (int n = 0; n < 2; ++n) { const i32x4 lo_ = *(const PG8_LAS i32x4*)(lds + PG8_SB(b, h) + boff + n * 2048), hi_ = *(const PG8_LAS i32x4*)(lds + PG8_SB(b, h) + boff + n * 2048 + 1024); dst##8[n] = __builtin_shufflevector(lo_, hi_, 0, 1, 2, 3, 4, 5, 6, 7); } } \
        else { _Pragma("unroll") for (int n = 0; n < 2; ++n) _Pragma("unroll") for (int k = 0; k < 2; ++k) dst[n][k] = *(const PG8_LAS bf16x8*)(lds + PG8_SB(b, h) + boff + n * 2048 + k * 1024); } } while (0)
#define PG8_MMA(ai, bj, At, Bt) do { __builtin_amdgcn_s_setprio(1); \
        if constexpr (F8) { _Pragma("unroll") for (int m = 0; m < 4; ++m) _Pragma("unroll") for (int n = 0; n < 2; ++n) mma_f8(acc[ai][bj][m][n], Bt##8[n], At##8[m], f8one); } \
        else { _Pragma("unroll") for (int m = 0; m < 4; ++m) _Pragma("unroll") for (int n = 0; n < 2; ++n) _Pragma("unroll") for (int k = 0; k < 2; ++k) \
            acc[ai][bj][m][n] = mma16<I8>(Bt[n][k], At[m][k], acc[ai][bj][m][n]); } __builtin_amdgcn_s_setprio(0); } while (0)
#define PG8_WAIT_V(n) asm volatile("s_waitcnt vmcnt(" #n ")" ::: "memory")
#define PG8_WAIT_L(n) asm volatile("s_waitcnt lgkmcnt(" #n ")" ::: "memory")
#define PG8_BAR __builtin_amdgcn_s_barrier()
#define PG8_SCHED __builtin_amdgcn_sched_barrier(0)
    Unit cur, nxt; int ui = 0;
    if (!S.next(0, cur)) return;
    typedef typename AccT<I8>::type acc_t;
    acc_t acc[2][2][4][2];
#pragma unroll
    for (int a = 0; a < 2; ++a)
#pragma unroll
        for (int b = 0; b < 2; ++b)
#pragma unroll
            for (int m = 0; m < 4; ++m)
#pragma unroll
                for (int n = 0; n < 2; ++n) acc[a][b][m][n] = (acc_t){0, 0, 0, 0};
    bf16x8 At[4][2], B0[2][2], B1[2][2];
    int f8one = 0x7f7f7f7f; asm volatile("" : "+v"(f8one));
    i32x8 At8[4], B08[2], B18[2];
    const char* cA = (const char*)g.A + (size_t)cur.pm * tstep + cur.koff; const char* cB = (const char*)g.Bt + (size_t)cur.pn * tstep + cur.koff;
    PG8_STAGE(PG8_SB(0, 0), cB, voffB); PG8_STAGE(PG8_SB(0, 1), cB + hstep, voffB); PG8_STAGE(PG8_SA(0, 0), cA, voffA); PG8_STAGE(PG8_SA(0, 1), cA + hstep, voffA);
    if (wr == 1) PG8_BAR;
    PG8_WAIT_V(2); PG8_BAR;
    PG8_STAGE(PG8_SB(1, 0), cB + kstep, voffB); PG8_STAGE(PG8_SA(1, 0), cA + kstep, voffA); PG8_STAGE(PG8_SB(1, 1), cB + hstep + kstep, voffB);
    PG8_WAIT_V(6); PG8_BAR;
    for (;;) {
        const bool has_next = S.next(ui + 1, nxt);
        const char* nA = has_next ? (const char*)g.A + (size_t)nxt.pm * tstep + nxt.koff : cA; const char* nB = has_next ? (const char*)g.Bt + (size_t)nxt.pn * tstep + nxt.koff : cB;
        const int ntc = cur.kt ? cur.kt : nt;
        for (int t = 0; t < ntc; t += 2) {
            const bool last = (t == ntc - 2);
            const char* a1 = cA + (size_t)(t + 1) * kstep;
            const char* a2 = last ? nA : cA + (size_t)(t + 2) * kstep; const char* b2 = last ? nB : cB + (size_t)(t + 2) * kstep;
            const char* a3 = a2 + kstep; const char* b3 = b2 + kstep;
            PG8_LDB(B0, 0, 0); PG8_LDB(B1, 0, 1); PG8_SCHED; PG8_LDA(At, 0, 0); PG8_STAGE(PG8_SA(1, 1), a1 + hstep, voffA);
            PG8_WAIT_V(8); PG8_WAIT_L(0); PG8_BAR; PG8_MMA(0, 0, At, B0); PG8_MMA(0, 1, At, B1); PG8_BAR; PG8_SCHED;
            PG8_LDA(At, 0, 1); PG8_STAGE(PG8_SB(0, 0), b2, voffB); PG8_STAGE(PG8_SB(0, 1), b2 + hstep, voffB); PG8_STAGE(PG8_SA(0, 0), a2, voffA);
            PG8_WAIT_V(8); PG8_WAIT_L(0); PG8_BAR; PG8_MMA(1, 0, At, B0); PG8_MMA(1, 1, At, B1); PG8_BAR; PG8_SCHED;
            PG8_LDB(B0, 1, 0); PG8_LDB(B1, 1, 1); PG8_SCHED; PG8_LDA(At, 1, 0); PG8_STAGE(PG8_SA(0, 1), a2 + hstep, voffA);
            PG8_WAIT_V(8); PG8_WAIT_L(0); PG8_BAR; PG8_MMA(0, 0, At, B0); PG8_MMA(0, 1, At, B1); PG8_BAR; PG8_SCHED;
            PG8_LDA(At, 1, 1); PG8_STAGE(PG8_SB(1, 0), b3, voffB); PG8_STAGE(PG8_SB(1, 1), b3 + hstep, voffB); PG8_STAGE(PG8_SA(1, 0), a3, voffA);
            PG8_WAIT_V(8); PG8_WAIT_L(0); PG8_BAR; PG8_MMA(1, 0, At, B0); PG8_MMA(1, 1, At, B1); PG8_BAR; PG8_SCHED;
        }
        if constexpr (ALIGN_EPI) { if (wr == 0) PG8_BAR; }
        if constexpr (F8) asm volatile("s_nop 15\n\ts_nop 15" ::: "memory");
        if constexpr (!Epi::AFTER_DRAIN) E(acc, cur, wr, wc, fr, fq);
#if defined(DBL_PHASE) && DBL_PHASE == 30
        if constexpr (I8) { asm volatile("" ::: "memory"); E(acc, cur, wr, wc, fr, fq); }
#endif
        if (!has_next) break;
#pragma unroll
        for (int a = 0; a < 2; ++a)
#pragma unroll
            for (int b = 0; b < 2; ++b)
#pragma unroll
                for (int m = 0; m < 4; ++m)
#pragma unroll
                    for (int n = 0; n < 2; ++n) acc[a][b][m][n] = (acc_t){0, 0, 0, 0};
        cur = nxt; cA = nA; cB = nB; ++ui;
        if constexpr (ALIGN_EPI) { if (wr == 1) PG8_BAR; }
    }
    PG8_WAIT_V(0);
    if constexpr (!ALIGN_EPI) { if (wr == 0) PG8_BAR; }
    PG8_BAR;
    if constexpr (Epi::AFTER_DRAIN) E.fused(acc, cur, wr, wc, fr, fq, lds, wid, lane);
#undef PG8_SA
#undef PG8_SB
#undef PG8_STAGE
#undef PG8_LDA
#undef PG8_LDB
#undef PG8_MMA
#undef PG8_WAIT_V
#undef PG8_WAIT_L
#undef PG8_BAR
#undef PG8_SCHED
}
}
constexpr int NWAVES = 8;
constexpr int SEQ = 8192, M = 16384, D = 1024, NIN = 3080, NPROJ = 3072;
constexpr int FD = 2752, FDP = 2816, FE = 3584, NEXP = 8;
constexpr float EPS = 1e-6f, LOG2E = 1.4426950408889634f;
constexpr int PC_Q = 0, PC_K = 256, PC_V = 512, PC_Z = 768, PC_XBC = 1280, PC_RQ = 2048, PC_RK = 2304, PC_RV = 2560, PC_RG = 2816;
constexpr size_t MiB = 1u << 20;
constexpr size_t WS_CTL = 0, CTL_ZERO_BYTES = 1 * MiB;
constexpr size_t WS_WIN = 2 * MiB;
constexpr size_t WS_WOUT = 14 * MiB;
constexpr size_t WS_WGU = 18 * MiB;
constexpr size_t WS_WD = 29 * MiB;
constexpr size_t WS_EGU = 35 * MiB;
constexpr size_t WS_ED = 147 * MiB;
constexpr size_t WS_XN = 203 * MiB;
constexpr size_t WS_MIX = 235 * MiB;
constexpr size_t WS_BIG = 303 * MiB;
constexpr size_t WS_SMALL = 430 * MiB;
constexpr size_t WS_DT = WS_SMALL, WS_TI = WS_SMALL + 512 * 1024, WS_TG = WS_SMALL + 768 * 1024, WS_LIST = WS_SMALL + 1024 * 1024;
constexpr size_t WS_XCH = 434 * MiB;
constexpr size_t WS_END = 438 * MiB;
constexpr size_t WS_SST = 203 * MiB;
constexpr size_t WS_RST = 219 * MiB;
constexpr size_t WS_QR = 227 * MiB;
constexpr size_t WS_YD = 267 * MiB;
constexpr size_t WS_OI = 283 * MiB;
constexpr size_t WS_XC = 399 * MiB;
constexpr size_t WS_SBD = WS_SMALL + 2176 * 1024, WS_SBE = WS_SMALL + 2240 * 1024;
constexpr size_t WS_SBI = WS_SMALL + 2900 * 1024;
constexpr size_t WS_SBWD = WS_SMALL + 2930 * 1024, WS_SBED = WS_SMALL + 2940 * 1024;
constexpr size_t WS_XR = 91 * MiB;
constexpr size_t WS_XNS = WS_SMALL + 2560 * 1024, WS_XGS = WS_SMALL + 2688 * 1024;
constexpr size_t WS_XGS2 = 299 * MiB;
__host__ __device__ constexpr int xg_panel(int e) { return e < 6 ? (203 + 16 * e) * 4 : (2 + 16 * (e - 6)) * 4; }
constexpr size_t WS_XG8 = 269 * MiB;
constexpr size_t WS_DTOT = WS_SMALL + 1536 * 1024, WS_EOFF = WS_SMALL + 1600 * 1024;
constexpr int SLAB0_PANELS = 64, SLAB1_MAX = 72;
constexpr int CW_BAR = 4096;
constexpr int CW_SEAM = 16384, SEAM_BANK = 64 * 64;
constexpr int CW_SCAN = 20480;
constexpr int CW_CNT = 8192;
constexpr int RING_BYTES = 131072;
constexpr int LDSCTL_OFF = RING_BYTES, MISC_OFF = LDSCTL_OFF + 320;
constexpr int LDS_BYTES = 147456;
#define GAS __attribute__((address_space(1)))
#define LAS __attribute__((address_space(3)))
typedef unsigned short bf16;
typedef unsigned v4u __attribute__((ext_vector_type(4)));
typedef float f32x4 __attribute__((ext_vector_type(4)));
typedef short bf16x8 __attribute__((ext_vector_type(8)));
typedef GAS unsigned gu32;
typedef GAS unsigned long long gu64;
#define RLX_AGENT __ATOMIC_RELAXED, __HIP_MEMORY_SCOPE_AGENT
#define LDS_WAIT() asm volatile("s_waitcnt lgkmcnt(0)" ::: "memory")
#define VM_WAIT() asm volatile("s_waitcnt vmcnt(0)" ::: "memory")
__device__ __forceinline__ unsigned long long rt() { return __builtin_amdgcn_s_memrealtime(); }
__device__ __forceinline__ unsigned f2bf(float f) { unsigned u = __builtin_bit_cast(unsigned, f); return (u + 0x7fffu + ((u >> 16) & 1u)) >> 16; }
typedef float f32x2_t __attribute__((ext_vector_type(2))); typedef __bf16 bf16x2_t __attribute__((ext_vector_type(2)));
__device__ __forceinline__ unsigned pk2(float lo, float hi) { f32x2_t v = {lo, hi}; bf16x2_t b = __builtin_convertvector(v, bf16x2_t); return __builtin_bit_cast(unsigned, b); }

#define XB_TMO      128
#define XB_XCNT(j)  (256  + 64 * (j))
#define XB_XSUB(j)  (1280 + 64 * (j))
#define XB_XGEN(j)  (2304 + 64 * (j))
#define XB_TOP      3328
#define XB_TOPGEN   3392
#define XCD_BAR_WORDS 3456
#define XB_SPIN_CAP (1u << 18)

__device__ __forceinline__ unsigned xb_ld(unsigned* p)              { return __hip_atomic_load(p, __ATOMIC_RELAXED, __HIP_MEMORY_SCOPE_AGENT); }
__device__ __forceinline__ unsigned xb_add(unsigned* p, unsigned v) { return __hip_atomic_fetch_add(p, v, __ATOMIC_RELAXED, __HIP_MEMORY_SCOPE_AGENT); }
__device__ __forceinline__ unsigned xb_xcc_id() { return (unsigned)__builtin_amdgcn_s_getreg((3 << 11) | 20) & 0xFu; }
#define XB_SPIN(cond, bar) do { unsigned _sp = 0; while (cond) { __builtin_amdgcn_s_sleep(1); \
    if ((++_sp & 255u) == 0u) { if (xb_ld(&(bar)[XB_TMO])) break; if (_sp > XB_SPIN_CAP) { atomicAdd(&(bar)[XB_TMO], 1u); break; } } } } while (0)

struct XcdBarrier {
    unsigned* bar; unsigned x;
    volatile LAS unsigned* st;
};

__device__ __forceinline__ XcdBarrier xcd_barrier_post(unsigned* bar, volatile LAS unsigned* st) {
    XcdBarrier b; b.bar = bar; b.x = xb_xcc_id(); b.st = st;
    if (threadIdx.x == 0) (void)xb_add(&bar[XB_XCNT(b.x)], 1u);
    return b;
}
__device__ __forceinline__ void xcd_barrier_complete(unsigned* bar, unsigned x, unsigned& nloc, unsigned& nx) {
    const unsigned G = gridDim.x * gridDim.y * gridDim.z;
    unsigned sum, cnt, mine, sp = 0u;
    for (;;) {
        sum = 0u; cnt = 0u; mine = 0u;
#pragma unroll
        for (unsigned j = 0; j < 16; ++j) { const unsigned c = xb_ld(&bar[XB_XCNT(j)]); sum += c; cnt += (c > 0u) ? 1u : 0u; mine = (j == x) ? c : mine; }
        if (sum == G) break;
        __builtin_amdgcn_s_sleep(1);
        if ((++sp & 255u) == 0u) { if (xb_ld(&bar[XB_TMO])) break; if (sp > XB_SPIN_CAP) { atomicAdd(&bar[XB_TMO], 1u); break; } }
    }
    nloc = mine > 0u ? mine : 1u; nx = cnt > 0u ? cnt : 1u;
}

__device__ __forceinline__ void xcd_barrier(const XcdBarrier& b) {
    asm volatile("s_waitcnt vmcnt(0)" ::: "memory");
    __syncthreads();
    if (threadIdx.x == 0) {
        unsigned* bar = b.bar;
        __builtin_amdgcn_s_waitcnt(0);
        unsigned nloc = b.st[0], nx = b.st[1];
        if (nloc == 0u) { xcd_barrier_complete(bar, b.x, nloc, nx); b.st[0] = nloc; b.st[1] = nx; }
        const unsigned old = xb_add(&bar[XB_XSUB(b.x)], 1u);
        const unsigned gen = old / nloc;
        if (old + 1u == (gen + 1u) * nloc) {
            __builtin_amdgcn_fence(__ATOMIC_RELEASE, "agent");
            asm volatile("s_waitcnt vmcnt(0)" ::: "memory");
            const unsigned og = xb_add(&bar[XB_TOP], 1u);
            const unsigned tg = og / nx;
            if (og + 1u == (tg + 1u) * nx) xb_add(&bar[XB_TOPGEN], 1u);
            else XB_SPIN(xb_ld(&bar[XB_TOPGEN]) == tg, bar);
            __builtin_amdgcn_fence(__ATOMIC_ACQUIRE, "agent");
            xb_add(&bar[XB_XGEN(b.x)], 1u);
            asm volatile("s_waitcnt vmcnt(0)" ::: "memory");
        } else {
            XB_SPIN(xb_ld(&bar[XB_XGEN(b.x)]) == gen, bar);
            __builtin_amdgcn_fence(__ATOMIC_ACQUIRE, "agent");
            asm volatile("s_waitcnt vmcnt(0)" ::: "memory");
        }
    }
    __syncthreads();
}

struct Args { const float* in[26]; float* out; unsigned char* ws; };
struct Frame {
    LAS unsigned char* lds;
    volatile LAS unsigned* MISC;
    LAS int* META;
    gu32* ctl;
    unsigned char* ws; float* out;
    int tid, lane, wave, G, bx;
};
__device__ __forceinline__ Frame refresh(const Frame& f) { Frame r = f; int t = threadIdx.x; asm volatile("" : "+v"(t)); r.tid = t; r.lane = t & 63; r.wave = __builtin_amdgcn_readfirstlane(t >> 6); return r; }
__device__ __forceinline__ float bf2f(unsigned short u) { return __uint_as_float((unsigned)u << 16); }
__device__ __forceinline__ float bflo(unsigned w) { return __uint_as_float(w << 16); }
__device__ __forceinline__ float bfhi(unsigned w) { return __uint_as_float(w & 0xffff0000u); }
__device__ __forceinline__ float wave_sum(float v) {
#pragma unroll
    for (int o = 1; o < 64; o <<= 1) v += __shfl_xor(v, o);
    return v;
}
__device__ __forceinline__ float silu_f(float v) { return v * __builtin_amdgcn_rcpf(1.0f + __builtin_amdgcn_exp2f(-LOG2E * v)); }

__device__ __forceinline__ void tr_item(const float* W, int ldw, int k0, int nsrc0, bool valid, bf16* WT, int ldk, int drow0, float scale, LAS float* scr, int lane) {
    (void)scr;
    const int c4 = lane & 7, r8 = lane >> 3;
    f32x4 v[8];
    if (valid) { const float* wp = W + (size_t)(k0 + 8 * r8) * ldw + nsrc0 + 4 * c4;
#pragma unroll
        for (int i = 0; i < 8; ++i) v[i] = *(const f32x4*)(wp + (size_t)i * ldw) * scale;
    } else {
#pragma unroll
        for (int i = 0; i < 8; ++i) v[i] = (f32x4){0.f, 0.f, 0.f, 0.f};
    }
#pragma unroll
    for (int j = 0; j < 4; ++j) { v4u o; o.x = pk2(v[0][j], v[1][j]); o.y = pk2(v[2][j], v[3][j]); o.z = pk2(v[4][j], v[5][j]); o.w = pk2(v[6][j], v[7][j]);
        *(GAS v4u*)(WT + (size_t)(drow0 + 4 * c4 + j) * ldk + k0 + 8 * r8) = o; }
}
__device__ __forceinline__ void q_item(const float* W, int ldw, int nsrc0, bool valid, signed char* WT8, int drow0, float* sb, float post, LAS unsigned char* lds, int wave, int lane) {
    LAS float* cm = (LAS float*)lds;
    const int c4 = lane & 7, rs = lane >> 3;
    f32x4 v[16]; f32x4 mx = (f32x4){0.f, 0.f, 0.f, 0.f};
    if (valid) { const float* wp = W + (size_t)(wave * 128 + 16 * rs) * ldw + nsrc0 + 4 * c4;
#pragma unroll
        for (int i = 0; i < 16; ++i) v[i] = *(const f32x4*)(wp + (size_t)i * ldw);
#pragma unroll
        for (int i = 0; i < 16; ++i) { mx.x = fmaxf(mx.x, fabsf(v[i].x)); mx.y = fmaxf(mx.y, fabsf(v[i].y)); mx.z = fmaxf(mx.z, fabsf(v[i].z)); mx.w = fmaxf(mx.w, fabsf(v[i].w)); }
    } else {
#pragma unroll
        for (int i = 0; i < 16; ++i) v[i] = (f32x4){0.f, 0.f, 0.f, 0.f};
    }
#pragma unroll
    for (int o = 8; o < 64; o <<= 1) { mx.x = fmaxf(mx.x, __shfl_xor(mx.x, o)); mx.y = fmaxf(mx.y, __shfl_xor(mx.y, o)); mx.z = fmaxf(mx.z, __shfl_xor(mx.z, o)); mx.w = fmaxf(mx.w, __shfl_xor(mx.w, o)); }
    __syncthreads();
    if (rs == 0) *(LAS f32x4*)(cm + wave * 32 + 4 * c4) = mx;
    __syncthreads();
    f32x4 bm = *(const LAS f32x4*)(cm + 4 * c4);
#pragma unroll
    for (int w = 1; w < 8; ++w) { const f32x4 t = *(const LAS f32x4*)(cm + w * 32 + 4 * c4); bm.x = fmaxf(bm.x, t.x); bm.y = fmaxf(bm.y, t.y); bm.z = fmaxf(bm.z, t.z); bm.w = fmaxf(bm.w, t.w); }
    f32x4 sc; sc.x = bm.x > 0.f ? 127.0f / bm.x : 0.f; sc.y = bm.y > 0.f ? 127.0f / bm.y : 0.f; sc.z = bm.z > 0.f ? 127.0f / bm.z : 0.f; sc.w = bm.w > 0.f ? 127.0f / bm.w : 0.f;
#pragma unroll
    for (int j = 0; j < 4; ++j) { v4u o;
#pragma unroll
        for (int g = 0; g < 4; ++g) { const int q0 = (int)rintf(v[4 * g][j] * sc[j]), q1 = (int)rintf(v[4 * g + 1][j] * sc[j]), q2 = (int)rintf(v[4 * g + 2][j] * sc[j]), q3 = (int)rintf(v[4 * g + 3][j] * sc[j]);
            o[g] = (unsigned)(q0 & 255) | ((unsigned)(q1 & 255) << 8) | ((unsigned)(q2 & 255) << 16) | ((unsigned)(q3 & 255) << 24); }
        *(GAS v4u*)(WT8 + (size_t)(drow0 + 4 * c4 + j) * 1024 + wave * 128 + 16 * rs) = o; }
    if (wave == 0 && rs == 0) *(f32x4*)(sb + drow0 + 4 * c4) = bm * ((1.0f / 127.0f) * post);
}
__device__ __forceinline__ void f8_item(const float* W, int Kvalid, int Kdst, int nsrc0, unsigned char* WT8, int drow0, float* sb, LAS unsigned char* lds, int wave, int lane) {
    LAS float* cm = (LAS float*)lds;
    const int c4 = lane & 7, rs = lane >> 3, slot = wave * 8 + rs;
    const float* wp = W + nsrc0 + 4 * c4;
    f32x4 mx = (f32x4){0.f, 0.f, 0.f, 0.f};
#pragma unroll 16
    for (int k = slot; k < Kvalid; k += 64) { const f32x4 v = *(const f32x4*)(wp + (size_t)k * 1024); mx.x = fmaxf(mx.x, fabsf(v.x)); mx.y = fmaxf(mx.y, fabsf(v.y)); mx.z = fmaxf(mx.z, fabsf(v.z)); mx.w = fmaxf(mx.w, fabsf(v.w)); }
#pragma unroll
    for (int o = 8; o < 64; o <<= 1) { mx.x = fmaxf(mx.x, __shfl_xor(mx.x, o)); mx.y = fmaxf(mx.y, __shfl_xor(mx.y, o)); mx.z = fmaxf(mx.z, __shfl_xor(mx.z, o)); mx.w = fmaxf(mx.w, __shfl_xor(mx.w, o)); }
    __syncthreads();
    if (rs == 0) *(LAS f32x4*)(cm + wave * 32 + 4 * c4) = mx;
    __syncthreads();
    f32x4 bm = *(const LAS f32x4*)(cm + 4 * c4);
#pragma unroll
    for (int w = 1; w < 8; ++w) { const f32x4 t = *(const LAS f32x4*)(cm + w * 32 + 4 * c4); bm.x = fmaxf(bm.x, t.x); bm.y = fmaxf(bm.y, t.y); bm.z = fmaxf(bm.z, t.z); bm.w = fmaxf(bm.w, t.w); }
    f32x4 sc; sc.x = bm.x > 0.f ? 384.0f / bm.x : 0.f; sc.y = bm.y > 0.f ? 384.0f / bm.y : 0.f; sc.z = bm.z > 0.f ? 384.0f / bm.z : 0.f; sc.w = bm.w > 0.f ? 384.0f / bm.w : 0.f;
    for (int q = slot; q * 16 < Kdst; q += 64) {
        f32x4 v[16];
#pragma unroll
        for (int i = 0; i < 16; ++i) { const int k = q * 16 + i; v[i] = k < Kvalid ? *(const f32x4*)(wp + (size_t)k * 1024) : (f32x4){0.f, 0.f, 0.f, 0.f}; }
#pragma unroll
        for (int j = 0; j < 4; ++j) { v4u o;
#pragma unroll
            for (int g = 0; g < 4; ++g) o[g] = pg8::pk4_fp8(v[4 * g][j] * sc[j], v[4 * g + 1][j] * sc[j], v[4 * g + 2][j] * sc[j], v[4 * g + 3][j] * sc[j]);
            *(GAS v4u*)(WT8 + (size_t)(drow0 + 4 * c4 + j) * Kdst + q * 16) = o; }
    }
    if (wave == 0 && rs == 0) *(f32x4*)(sb + drow0 + 4 * c4) = bm * (1.0f / 384.0f);
}
constexpr float C2Q = 0.17677669529663687f * LOG2E;
__device__ __forceinline__ void p0_weights(Frame& F_, const Args& A) {
    Frame F = refresh(F_);
    for (int it0 = F.bx; it0 < 192 + 176 + 32; it0 += F.G) { int it = it0;
        if (it >= 192 + 176) { const int nb = it - 368; f8_item(A.in[21], FD, FDP, nb * 32, (unsigned char*)(F.ws + WS_WD), nb * 32, (float*)(F.ws + WS_SBWD), (LAS unsigned char*)F.lds, F.wave, F.lane); continue; }
        if (it < 192) { const int l = it / 96, nb = it - l * 96; const float post = nb < 8 ? C2Q : ((nb >= 72 && nb < 80) ? 0.125f : 1.0f);
            q_item(A.in[1] + (size_t)l * D * NIN, NIN, nb < 64 ? nb * 32 : nb * 32 + 8, true, (signed char*)(F.ws + WS_WIN) + (size_t)l * NPROJ * D, nb * 32, (float*)(F.ws + WS_SBI) + l * NPROJ, post, (LAS unsigned char*)F.lds, F.wave, F.lane); continue; }
        it -= 192;
        { const int nb = it, t = nb >> 3, sub = nb & 7, fcol = t * 128 + (sub & 3) * 32;
            q_item(sub < 4 ? A.in[19] : A.in[20], FD, fcol, fcol < FD, (signed char*)(F.ws + WS_WGU), nb * 32, (float*)(F.ws + WS_SBD), 1.0f, (LAS unsigned char*)F.lds, F.wave, F.lane); }
    }
    __syncthreads();
    LAS float* scr = (LAS float*)(F.lds + F.wave * 16384);
    const int gw = F.bx * NWAVES + F.wave, NGW = F.G * NWAVES;
    constexpr int I_OUT = 32 * 16;
    for (int it = gw; it < 2 * I_OUT; it += NGW) { const int l = it / I_OUT, r = it - l * I_OUT, kb = r / 32, nb = r % 32;
        tr_item(A.in[2] + (size_t)l * D * D, D, kb * 64, nb * 32, true, ((bf16*)(F.ws + WS_WOUT)) + (size_t)l * D * D, D, nb * 32, 1.0f, scr, F.lane); }
}
__device__ __forceinline__ void expert_weights(Frame& F_, const Args& A) {
    Frame F = refresh(F_);
    for (int r = F.bx; r < NEXP * 224; r += F.G) { const int e = r / 224, nb = r - e * 224, t = nb >> 3, sub = nb & 7, fcol = t * 128 + (sub & 3) * 32;
        q_item((sub < 4 ? A.in[23] : A.in[24]) + (size_t)e * D * FE, FE, fcol, true, (signed char*)(F.ws + WS_EGU) + (size_t)e * 2 * FE * D, nb * 32, (float*)(F.ws + WS_SBE) + e * 2 * FE, 1.0f, (LAS unsigned char*)F.lds, F.wave, F.lane); }
    for (int r = F.bx; r < NEXP * 32; r += F.G) { const int e = r >> 5, nb = r & 31;
        f8_item(A.in[25] + (size_t)e * FE * D, FE, FE, nb * 32, (unsigned char*)(F.ws + WS_ED) + (size_t)e * D * FE, nb * 32, (float*)(F.ws + WS_SBED) + e * D, (LAS unsigned char*)F.lds, F.wave, F.lane); }
    __syncthreads();
}

template <int MODE, bool OUT8 = false, bool SRC16 = false>
__device__ __forceinline__ void norm_phase(Frame& F_, const float* src, const float* gain, const float* wx, int ldw) {
    Frame F = refresh(F_);
    LAS float* Wl = (LAS float*)F.lds;
    if (MODE != 0) {
        for (int idx = F.tid; idx < 8 * D; idx += NWAVES * 64) { const int k = idx >> 3, j = idx & 7; Wl[j * D + k] = wx[(size_t)k * ldw + j]; }
        __syncthreads();
    }
    const int hl = F.lane & 31, hw = F.lane >> 5, gw = F.bx * NWAVES + F.wave, NGW = F.G * NWAVES;
    f32x4 g8[4][2];
#pragma unroll
    for (int j = 0; j < 4; ++j) { g8[j][0] = *(const f32x4*)(gain + 8 * (hl + 32 * j)); g8[j][1] = *(const f32x4*)(gain + 8 * (hl + 32 * j) + 4); }
#define NP_HSUM(x) do { _Pragma("unroll") for (int o_ = 1; o_ < 32; o_ <<= 1) x += __shfl_xor(x, o_); } while (0)
    for (int m = 2 * gw + hw; m < M; m += 2 * NGW) {
        f32x4 v[4][2]; float s = 0.f; uint2 q8[4]; float qsc = 0.f; (void)q8; (void)qsc;
        if constexpr (SRC16) { const v4u* xr = (const v4u*)((const bf16*)src + (size_t)m * D) + hl;
#pragma unroll
            for (int j = 0; j < 4; ++j) { const v4u w = xr[32 * j]; v[j][0] = (f32x4){bflo(w.x), bfhi(w.x), bflo(w.y), bfhi(w.y)}; v[j][1] = (f32x4){bflo(w.z), bfhi(w.z), bflo(w.w), bfhi(w.w)}; }
        } else { const f32x4* xr = (const f32x4*)(src + (size_t)m * D) + 2 * hl;
#pragma unroll
            for (int j = 0; j < 4; ++j) { v[j][0] = xr[64 * j]; v[j][1] = xr[64 * j + 1]; } }
#pragma unroll
        for (int j = 0; j < 4; ++j)
#pragma unroll
            for (int t = 0; t < 2; ++t) s += (v[j][t].x * v[j][t].x + v[j][t].y * v[j][t].y) + (v[j][t].z * v[j][t].z + v[j][t].w * v[j][t].w);
        NP_HSUM(s);
        const float rstd = __builtin_amdgcn_rsqf(s * (1.f / D) + EPS);
        float amax = 0.f;
#pragma unroll
        for (int j = 0; j < 4; ++j)
#pragma unroll
            for (int t = 0; t < 2; ++t) { v[j][t] = v[j][t] * rstd * g8[j][t]; amax = fmaxf(amax, fmaxf(fmaxf(fabsf(v[j][t].x), fabsf(v[j][t].y)), fmaxf(fabsf(v[j][t].z), fabsf(v[j][t].w)))); }
        if (!OUT8) {
            v4u* o16 = (v4u*)(((bf16*)(F.ws + WS_XN)) + (size_t)m * D) + hl;
#pragma unroll
            for (int j = 0; j < 4; ++j) { v4u o; o.x = pk2(v[j][0].x, v[j][0].y); o.y = pk2(v[j][0].z, v[j][0].w); o.z = pk2(v[j][1].x, v[j][1].y); o.w = pk2(v[j][1].z, v[j][1].w); o16[32 * j] = o; }
        } else {
#pragma unroll
            for (int o = 1; o < 32; o <<= 1) amax = fmaxf(amax, __shfl_xor(amax, o));
            const float qs = amax > 0.f ? 127.0f / amax : 0.f;
            uint2* o8 = (uint2*)(F.ws + WS_XN + (size_t)m * D) + hl;
            (void)o8;
#pragma unroll
            for (int j = 0; j < 4; ++j) { uint2 o;
                { const int q0 = (int)rintf(v[j][0].x * qs), q1 = (int)rintf(v[j][0].y * qs), q2 = (int)rintf(v[j][0].z * qs), q3 = (int)rintf(v[j][0].w * qs); o.x = (unsigned)(q0 & 255) | ((unsigned)(q1 & 255) << 8) | ((unsigned)(q2 & 255) << 16) | ((unsigned)(q3 & 255) << 24); }
                { const int q0 = (int)rintf(v[j][1].x * qs), q1 = (int)rintf(v[j][1].y * qs), q2 = (int)rintf(v[j][1].z * qs), q3 = (int)rintf(v[j][1].w * qs); o.y = (unsigned)(q0 & 255) | ((unsigned)(q1 & 255) << 8) | ((unsigned)(q2 & 255) << 16) | ((unsigned)(q3 & 255) << 24); }
                if constexpr (MODE == 2) q8[j] = o; else o8[32 * j] = o; }
            if constexpr (MODE == 2) qsc = amax * (1.0f / 127.0f); else if (hl == 0) ((float*)(F.ws + WS_XNS))[m] = amax * (1.0f / 127.0f);
        }
        if (MODE != 0) {
            float ex[8];
#pragma unroll
            for (int e = 0; e < 8; ++e) { float a = 0.f;
#pragma unroll
                for (int j = 0; j < 4; ++j) { const f32x4 w0 = *(const LAS f32x4*)(Wl + e * D + 8 * (hl + 32 * j)), w1 = *(const LAS f32x4*)(Wl + e * D + 8 * (hl + 32 * j) + 4);
                    a += (v[j][0].x * w0.x + v[j][0].y * w0.y) + (v[j][0].z * w0.z + v[j][0].w * w0.w) + (v[j][1].x * w1.x + v[j][1].y * w1.y) + (v[j][1].z * w1.z + v[j][1].w * w1.w); }
                NP_HSUM(a); ex[e] = a; asm volatile("" ::: "memory"); }
            if (MODE == 1) {
                float val = ex[0];
#pragma unroll
                for (int e = 1; e < 8; ++e) val = (hl == e) ? ex[e] : val;
                if (hl < 8) ((float*)(F.ws + WS_DT))[(size_t)m * 8 + hl] = val;
            } else {
                int e0 = 0; float v0 = ex[0];
#pragma unroll
                for (int e = 1; e < 8; ++e) if (ex[e] > v0) { v0 = ex[e]; e0 = e; }
                int e1 = -1; float v1 = -3.0e38f;
#pragma unroll
                for (int e = 0; e < 8; ++e) if (e != e0 && ex[e] > v1) { v1 = ex[e]; e1 = e; }
                int pos0 = 0, pos1 = 0;
                if (hl == 0) {
                    const float g0 = 1.0f / (1.0f + __expf(v1 - v0)), g1 = 1.0f - g0;
                    pos0 = (int)atomicAdd((unsigned*)(F.ctl + CW_CNT + 64 * e0), 1u); pos1 = (int)atomicAdd((unsigned*)(F.ctl + CW_CNT + 64 * e1), 1u);
                    ((int*)(F.ws + WS_TI))[m * 4 + 0] = e0 | (e1 << 8); ((int*)(F.ws + WS_TI))[m * 4 + 1] = pos0; ((int*)(F.ws + WS_TI))[m * 4 + 2] = pos1; ((int*)(F.ws + WS_TI))[m * 4 + 3] = 0;
                    ((float*)(F.ws + WS_TG))[m * 2 + 0] = g0; ((float*)(F.ws + WS_TG))[m * 2 + 1] = g1;
                }
                pos0 = __shfl(pos0, hw * 32); pos1 = __shfl(pos1, hw * 32);
                { const int pa = xg_panel(e0), pb = xg_panel(e1);
                  uint2* d0 = (uint2*)(F.ws + (size_t)pa * 262144 + (size_t)pos0 * 1024) + hl; uint2* d1 = (uint2*)(F.ws + (size_t)pb * 262144 + (size_t)pos1 * 1024) + hl;
#pragma unroll
                  for (int j = 0; j < 4; ++j) { d0[32 * j] = q8[j]; d1[32 * j] = q8[j]; }
                  if (hl == 0) { ((float*)(F.ws + WS_XGS2))[pa * 256 + pos0] = qsc; ((float*)(F.ws + WS_XGS2))[pb * 256 + pos1] = qsc; } }
            }
        }
    }
#undef NP_HSUM
    if (MODE != 0) __syncthreads();
}
__device__ __forceinline__ void combine_phase(Frame& F_, const Args& A) {
    Frame F = refresh(F_);
    const int hl = F.lane & 31, hw = F.lane >> 5, gw = F.bx * NWAVES + F.wave, NGW = F.G * NWAVES;
    f32x4 g8[4][2];
#pragma unroll
    for (int j = 0; j < 4; ++j) { g8[j][0] = *(const f32x4*)(A.in[5] + 8 * (hl + 32 * j)); g8[j][1] = *(const f32x4*)(A.in[5] + 8 * (hl + 32 * j) + 4); }
    for (int m = 2 * gw + hw; m < M; m += 2 * NGW) {
        const int ti = ((int*)(F.ws + WS_TI))[m * 4], e0 = ti & 255, e1 = ti >> 8;
        const size_t r0 = (size_t)F.META[8 + e0] * 256 + ((int*)(F.ws + WS_TI))[m * 4 + 1], r1 = (size_t)F.META[8 + e1] * 256 + ((int*)(F.ws + WS_TI))[m * 4 + 2];
        const float g0 = ((float*)(F.ws + WS_TG))[m * 2], g1 = ((float*)(F.ws + WS_TG))[m * 2 + 1];
        const v4u* xb = (const v4u*)((const bf16*)(F.ws + WS_XR) + (size_t)m * D) + hl;
        const v4u* y0 = (const v4u*)(((const bf16*)(F.ws + WS_MIX)) + r0 * D) + hl; const v4u* y1 = (const v4u*)(((const bf16*)(F.ws + WS_MIX)) + r1 * D) + hl;
        const v4u* z0 = (const v4u*)(((const bf16*)(F.ws + WS_XN)) + (r0 >= 32768 ? r0 - 32768 : 0) * D) + hl; const v4u* z1 = (const v4u*)(((const bf16*)(F.ws + WS_XN)) + (r1 >= 32768 ? r1 - 32768 : 0) * D) + hl;
        f32x4 v[4][2]; float s = 0.f;
#define CB_LO(w_) ((f32x4){bflo((w_).x), bfhi((w_).x), bflo((w_).y), bfhi((w_).y)})
#define CB_HI(w_) ((f32x4){bflo((w_).z), bfhi((w_).z), bflo((w_).w), bfhi((w_).w)})
#pragma unroll
        for (int j = 0; j < 4; ++j) { f32x4 ya0, ya1, yb0, yb1;
            if (r0 >= 32768) { ya0 = (f32x4){0.f, 0.f, 0.f, 0.f}; ya1 = ya0;
#pragma unroll
                for (int ks = 0; ks < 7; ++ks) { const v4u a = z0[(size_t)ks * 2048 * 128 + 32 * j]; ya0 += CB_LO(a); ya1 += CB_HI(a); } }
            else { const v4u a = y0[32 * j]; ya0 = CB_LO(a); ya1 = CB_HI(a); }
            if (r1 >= 32768) { yb0 = (f32x4){0.f, 0.f, 0.f, 0.f}; yb1 = yb0;
#pragma unroll
                for (int ks = 0; ks < 7; ++ks) { const v4u b = z1[(size_t)ks * 2048 * 128 + 32 * j]; yb0 += CB_LO(b); yb1 += CB_HI(b); } }
            else { const v4u b = y1[32 * j]; yb0 = CB_LO(b); yb1 = CB_HI(b); }
            const v4u xw = xb[32 * j];
            v[j][0] = CB_LO(xw) + ya0 * g0 + yb0 * g1; v[j][1] = CB_HI(xw) + ya1 * g0 + yb1 * g1;
            s += (v[j][0].x * v[j][0].x + v[j][0].y * v[j][0].y) + (v[j][0].z * v[j][0].z + v[j][0].w * v[j][0].w) + (v[j][1].x * v[j][1].x + v[j][1].y * v[j][1].y) + (v[j][1].z * v[j][1].z + v[j][1].w * v[j][1].w); }
#undef CB_LO
#undef CB_HI
#pragma unroll
        for (int o = 1; o < 32; o <<= 1) s += __shfl_xor(s, o);
        const float rstd = __builtin_amdgcn_rsqf(s * (1.f / D) + EPS);
        f32x4* xr = (f32x4*)(F.out + (size_t)m * D) + 2 * hl;
#pragma unroll
        for (int j = 0; j < 4; ++j) { xr[64 * j] = v[j][0] * rstd * g8[j][0]; xr[64 * j + 1] = v[j][1] * rstd * g8[j][1]; }
    }
}
__device__ __forceinline__ int t5_bucket(int rel) {
    const int n = rel < 0 ? -rel : rel;
    int b = n < 8 ? n : n < 12 ? 8 : n < 16 ? 9 : n < 23 ? 10 : n < 32 ? 11 : n < 46 ? 12 : n < 64 ? 13 : n < 91 ? 14 : 15;
    return rel > 0 ? b + 16 : b;
}
__device__ __forceinline__ void unpack8(const v4u w, float* f) { f[0] = bflo(w.x); f[1] = bfhi(w.x); f[2] = bflo(w.y); f[3] = bfhi(w.y); f[4] = bflo(w.z); f[5] = bfhi(w.z); f[6] = bflo(w.w); f[7] = bfhi(w.w); }

namespace pg8 {
template <int MODE> struct EpiResNorm {
    static constexpr bool PERM = false, AFTER_DRAIN = true;
    const float* base; float* out; const float* gain; const float* wx; int ldw;
    unsigned char* ws; unsigned* cnt;
    __device__ __forceinline__ void fused(f32x4 (&acc)[2][2][4][2], const Unit& u, int wr, int wc, int fr, int fq, PG8_LAS unsigned char* lds, int wid, int lane) const {
        PG8_LAS float* Wt = (PG8_LAS float*)lds;
        PG8_LAS float* P = (PG8_LAS float*)(lds + 8192);
        PG8_LAS float* S = (PG8_LAS float*)(lds + 8192 + 49152);
        PG8_LAS unsigned* flag = (PG8_LAS unsigned*)(lds + 8192 + 49152 + 1024);
        const int tid = wid * 64 + lane, ldc = 1024;
        if (MODE != 0) { for (int idx = tid; idx < 2048; idx += 512) { const int e = idx >> 8, c = idx & 255; Wt[idx] = wx[(size_t)(u.cn * BM + c) * ldw + e]; } }
        const int col0 = u.cn * BM + wc * 32 + 4 * fq;
        f32x4 g4[2][2];
#pragma unroll
        for (int bj = 0; bj < 2; ++bj)
#pragma unroll
            for (int n = 0; n < 2; ++n) g4[bj][n] = *(const f32x4*)(gain + col0 + bj * HALF + n * 16);
        asm volatile("s_waitcnt lgkmcnt(0)" ::: "memory"); __builtin_amdgcn_s_barrier(); asm volatile("" ::: "memory");
#pragma unroll
        for (int ai = 0; ai < 2; ++ai)
#pragma unroll
            for (int m = 0; m < 4; ++m) { const int r = ai * HALF + wr * 64 + m * 16 + fr; const size_t off = (size_t)(u.po * BM + r) * ldc + col0;
                float st[10];
#pragma unroll
                for (int k = 0; k < 10; ++k) st[k] = 0.f;
#pragma unroll
                for (int bj = 0; bj < 2; ++bj)
#pragma unroll
                    for (int n = 0; n < 2; ++n) { const f32x4 bs = *(const f32x4*)(base + off + bj * HALF + n * 16); const f32x4 x1 = bs + acc[ai][bj][m][n]; acc[ai][bj][m][n] = x1;
                        *(f32x4*)(out + off + bj * HALF + n * 16) = x1;
                        const f32x4 xg = x1 * g4[bj][n];
                        st[0] += (x1.x * x1.x + x1.y * x1.y) + (x1.z * x1.z + x1.w * x1.w);
                        st[1] = fmaxf(st[1], fmaxf(fmaxf(fabsf(xg.x), fabsf(xg.y)), fmaxf(fabsf(xg.z), fabsf(xg.w))));
                        if (MODE != 0) { const int cl = bj * HALF + wc * 32 + n * 16 + 4 * fq;
#pragma unroll
                            for (int e = 0; e < 8; ++e) { const f32x4 w = *(const PG8_LAS f32x4*)(Wt + e * 256 + cl); st[2 + e] += (xg.x * w.x + xg.y * w.y) + (xg.z * w.z + xg.w * w.w); if (e & 1) asm volatile("" ::: "memory"); } } }
                st[0] += __shfl_xor(st[0], 16); st[0] += __shfl_xor(st[0], 32); st[1] = fmaxf(st[1], __shfl_xor(st[1], 16)); st[1] = fmaxf(st[1], __shfl_xor(st[1], 32));
                if (MODE != 0) {
#pragma unroll
                    for (int e = 0; e < 8; ++e) { st[2 + e] += __shfl_xor(st[2 + e], 16); st[2 + e] += __shfl_xor(st[2 + e], 32); } }
                if (fq == 0) { PG8_LAS float* p = P + (r * 4 + wc) * 12;
                    p[0] = st[0]; p[1] = st[1];
                    if (MODE != 0) {
#pragma unroll
                        for (int e = 0; e < 8; ++e) p[2 + e] = st[2 + e]; } }
                asm volatile("" ::: "memory"); }
        asm volatile("s_waitcnt lgkmcnt(0)" ::: "memory"); __builtin_amdgcn_s_barrier(); asm volatile("" ::: "memory");
        const int row = wid * 32 + (lane & 31);
        unsigned long long* slot = (unsigned long long*)((float*)(ws + WS_XCH) + ((size_t)(u.po * BM + row) * 4 + u.cn) * 12);
        if (lane < 32) { float t[10];
#pragma unroll
            for (int k = 0; k < 10; ++k) { const float a = P[(row * 4 + 0) * 12 + k], b = P[(row * 4 + 1) * 12 + k], c = P[(row * 4 + 2) * 12 + k], d = P[(row * 4 + 3) * 12 + k];
                t[k] = (k == 1) ? fmaxf(fmaxf(a, b), fmaxf(c, d)) : (a + b) + (c + d); }
#pragma unroll
            for (int k = 0; k < 5; ++k) __hip_atomic_store(slot + k, ((unsigned long long)__float_as_uint(t[2 * k + 1]) << 32) | __float_as_uint(t[2 * k]), __ATOMIC_RELAXED, __HIP_MEMORY_SCOPE_AGENT); }
        asm volatile("s_waitcnt vmcnt(0)" ::: "memory");
        if (lane == 0) __hip_atomic_fetch_add(cnt + 64 * u.po, 1u, __ATOMIC_RELAXED, __HIP_MEMORY_SCOPE_AGENT);
        if (wid == 0) {
            const unsigned long long t0 = __builtin_amdgcn_s_memrealtime();
            for (;;) {
                if ((unsigned)__builtin_amdgcn_readfirstlane(__hip_atomic_load(cnt + 64 * u.po, __ATOMIC_RELAXED, __HIP_MEMORY_SCOPE_AGENT)) >= 32u) break;
                if (__builtin_amdgcn_s_memrealtime() - t0 > 2000000ull) break;
                __builtin_amdgcn_s_sleep(2);
            }
            __builtin_amdgcn_fence(__ATOMIC_ACQUIRE, "agent");
            if (lane == 0) flag[0] = 1u;
        }
        asm volatile("s_waitcnt vmcnt(0) lgkmcnt(0)" ::: "memory"); __builtin_amdgcn_s_barrier(); asm volatile("" ::: "memory");
        if (lane < 32) { const unsigned long long* sl = (const unsigned long long*)((const float*)(ws + WS_XCH) + (size_t)(u.po * BM + row) * 4 * 12);
            float t[10];
#pragma unroll
            for (int k = 0; k < 10; ++k) t[k] = 0.f;
#pragma unroll
            for (int tl = 0; tl < 4; ++tl)
#pragma unroll
                for (int k = 0; k < 5; ++k) { const unsigned long long w = __hip_atomic_load(sl + tl * 6 + k, __ATOMIC_RELAXED, __HIP_MEMORY_SCOPE_AGENT);
                    const float lo = __uint_as_float((unsigned)w), hi = __uint_as_float((unsigned)(w >> 32));
                    if (k == 0) { t[0] += lo; t[1] = fmaxf(t[1], hi); } else { t[2 * k] += lo; t[2 * k + 1] += hi; } }
            const float rstd = __builtin_amdgcn_rsqf(t[0] * (1.f / 1024.f) + 1e-6f), arow = t[1] * rstd;
            S[row] = arow > 0.f ? rstd * (127.0f / arow) : 0.f;
            if (u.cn == 0) { const size_t grow = (size_t)u.po * BM + row;
                ((float*)(ws + WS_XNS))[grow] = arow * (1.0f / 127.0f);
                if (MODE == 1) { *(f32x4*)((float*)(ws + WS_DT) + grow * 8) = (f32x4){t[2] * rstd, t[3] * rstd, t[4] * rstd, t[5] * rstd}; *(f32x4*)((float*)(ws + WS_DT) + grow * 8 + 4) = (f32x4){t[6] * rstd, t[7] * rstd, t[8] * rstd, t[9] * rstd}; }
                if (MODE == 2) { float ex[8];
#pragma unroll
                    for (int e = 0; e < 8; ++e) ex[e] = t[2 + e] * rstd;
                    int e0 = 0; float v0 = ex[0];
#pragma unroll
                    for (int e = 1; e < 8; ++e) if (ex[e] > v0) { v0 = ex[e]; e0 = e; }
                    int e1 = -1; float v1 = -3.0e38f;
#pragma unroll
                    for (int e = 0; e < 8; ++e) if (e != e0 && ex[e] > v1) { v1 = ex[e]; e1 = e; }
                    const float g0 = 1.0f / (1.0f + __expf(v1 - v0)), g1 = 1.0f - g0; const int mtok = (int)grow;
                    unsigned* ctl = (unsigned*)(ws + WS_CTL);
                    const int pos0 = (int)atomicAdd(ctl + CW_CNT + 64 * e0, 1u), pos1 = (int)atomicAdd(ctl + CW_CNT + 64 * e1, 1u);
                    int* LIST = (int*)(ws + WS_LIST); int* TI = (int*)(ws + WS_TI); float* TG = (float*)(ws + WS_TG);
                    LIST[e0 * 16384 + pos0] = mtok; LIST[e1 * 16384 + pos1] = mtok;
                    TI[mtok * 4 + 0] = e0 | (e1 << 8); TI[mtok * 4 + 1] = pos0; TI[mtok * 4 + 2] = pos1; TI[mtok * 4 + 3] = 0;
                    TG[mtok * 2 + 0] = g0; TG[mtok * 2 + 1] = g1; } } }
        asm volatile("s_waitcnt lgkmcnt(0)" ::: "memory"); __builtin_amdgcn_s_barrier(); asm volatile("" ::: "memory");
        unsigned char* XN8 = ws + WS_XN;
#pragma unroll
        for (int ai = 0; ai < 2; ++ai)
#pragma unroll
            for (int m = 0; m < 4; ++m) { const int r = ai * HALF + wr * 64 + m * 16 + fr; const float s = S[r]; unsigned char* rowp = XN8 + (size_t)(u.po * BM + r) * 1024 + col0;
#pragma unroll
                for (int bj = 0; bj < 2; ++bj)
#pragma unroll
                    for (int n = 0; n < 2; ++n) { const f32x4 q = acc[ai][bj][m][n] * g4[bj][n] * s;
                        const int q0 = (int)rintf(q.x), q1 = (int)rintf(q.y), q2 = (int)rintf(q.z), q3 = (int)rintf(q.w);
                        *(unsigned*)(rowp + bj * HALF + n * 16) = (unsigned)(q0 & 255) | ((unsigned)(q1 & 255) << 8) | ((unsigned)(q2 & 255) << 16) | ((unsigned)(q3 & 255) << 24); } }
    }
};
}
namespace att {
typedef short v4i16_t __attribute__((ext_vector_type(4)));
typedef short s16x4 __attribute__((ext_vector_type(4)));
typedef float f32x16 __attribute__((ext_vector_type(16)));
constexpr int NSLOT = 3, SLOTB = 8192;
constexpr int LDS_K = 0, LDS_V = NSLOT * SLOTB, LDS_BT = 2 * NSLOT * SLOTB, LDS_WS = LDS_BT + 2048, LDS_OST = LDS_WS + 2048, OST_W = 32 * 68, LDS_END = LDS_OST + 8 * OST_W * 4;
static_assert(LDS_END <= RING_BYTES, "attention LDS map");
constexpr float THR = 8.0f;
__device__ __forceinline__ s16x4 vtr(const LAS char* p) { return __builtin_bit_cast(s16x4, __builtin_amdgcn_ds_read_tr16_b64_v4i16((LAS v4i16_t*)p)); }
__device__ __forceinline__ int crow(int r, int hi) { return (r & 3) + 8 * (r >> 2) + 4 * hi; }
__device__ __forceinline__ float xhalf_max(float v) { auto rr = __builtin_amdgcn_permlane32_swap(__float_as_uint(v), __float_as_uint(v), false, false); return fmaxf(__uint_as_float(rr[0]), __uint_as_float(rr[1])); }
__device__ __forceinline__ float xhalf_sum(float v) { auto rr = __builtin_amdgcn_permlane32_swap(__float_as_uint(v), __float_as_uint(v), false, false); return __uint_as_float(rr[0]) + __uint_as_float(rr[1]); }
#define ATT_WAIT_BAR(N) asm volatile("s_waitcnt vmcnt(" #N ") lgkmcnt(0)\n\ts_barrier" ::: "memory")

__device__ __forceinline__ void attn_unit(Frame& F_, const Args& A, int l, int b, int h, int qb, float lam, float oscale) {
    Frame F = refresh(F_);
    const int tid = F.tid, lane = tid & 63, wid = F.wave, r32 = lane & 31, hi = lane >> 5, t = wid >> 2, wq = wid & 3;
    const int Q0 = qb * 128, row0 = Q0 + 32 * wq, NT = 2 * qb + 2, cq = 2 * qb + (wq >> 1);
    const bf16* PROJ = (const bf16*)(F.ws + WS_BIG); const size_t rb = (size_t)b * SEQ;
    LAS char* L = (LAS char*)F.lds;
    LAS float* Bt = (LAS float*)(L + LDS_BT); LAS float* wsf = (LAS float*)(L + LDS_WS) + wid * 64; LAS float* stg = (LAS float*)(L + LDS_OST) + wid * OST_W;
    ATT_WAIT_BAR(0);
    const float cb = A.in[6][15 * 4 + h] * LOG2E;
    if (tid < 320) Bt[tid] = A.in[6][t5_bucket(tid - 255) * 4 + h] * LOG2E - cb;
    bf16x8 qr[2];
#pragma unroll
    for (int s = 0; s < 2; ++s) qr[s] = *(const bf16x8*)(PROJ + (rb + row0 + r32) * NPROJ + PC_Q + h * 64 + t * 32 + s * 16 + hi * 8);
    const int krow = wid * 8 + (lane >> 3);
    const bf16* ksrc = PROJ + (rb + krow) * NPROJ + PC_K + h * 64 + (((lane & 7) ^ (krow & 7)) * 8);
    const bf16* vsrc = PROJ + (rb + 16 * (wid & 3) + (lane >> 2)) * NPROJ + PC_V + h * 64 + (wid >> 2) * 32 + (lane & 3) * 8;
#define ATT_DMA(tile, sl) do { \
        __builtin_amdgcn_global_load_lds((const unsigned*)(ksrc + (size_t)(tile) * 64 * NPROJ), (LAS unsigned*)(L + LDS_K + (sl) * SLOTB + wid * 1024), 16, 0, 0); \
        __builtin_amdgcn_global_load_lds((const unsigned*)(vsrc + (size_t)(tile) * 64 * NPROJ), (LAS unsigned*)(L + LDS_V + (sl) * SLOTB + wid * 1024), 16, 0, 0); } while (0)
    ATT_DMA(0, 0); ATT_DMA(1, 1);
    f32x16 o0, o1, zero16;
#pragma unroll
    for (int r = 0; r < 16; ++r) { o0[r] = 0.f; o1[r] = 0.f; zero16[r] = 0.f; }
    float lsum = 0.f;
    const int kf0 = r32 * 128 + (((t * 4 + hi) ^ (r32 & 7)) * 16), kf1 = r32 * 128 + (((t * 4 + 2 + hi) ^ (r32 & 7)) * 16);
    const int vfo = ((lane >> 4) & 1) * 32 + (lane & 3) * 8 + (4 * hi + ((lane & 15) >> 2)) * 64;
    int slot = 0;
    for (int tile = 0; tile < NT; ++tile) {
        if (tile + 1 < NT) ATT_WAIT_BAR(2); else ATT_WAIT_BAR(0);
        if (tile + 2 < NT) { const int s2 = slot >= 1 ? slot - 1 : 2; ATT_DMA(tile + 2, s2); }
        if (tile <= cq) {
            const LAS char* Ks = L + LDS_K + slot * SLOTB; const LAS char* Vs = L + LDS_V + slot * SLOTB + vfo;
            f32x16 p0, p1;
            { const bf16x8 k00 = *(const LAS bf16x8*)(Ks + kf0), k01 = *(const LAS bf16x8*)(Ks + kf1), k10 = *(const LAS bf16x8*)(Ks + 4096 + kf0), k11 = *(const LAS bf16x8*)(Ks + 4096 + kf1);
              p0 = __builtin_amdgcn_mfma_f32_32x32x16_bf16(k00, qr[0], zero16, 0, 0, 0); p0 = __builtin_amdgcn_mfma_f32_32x32x16_bf16(k01, qr[1], p0, 0, 0, 0);
              p1 = __builtin_amdgcn_mfma_f32_32x32x16_bf16(k10, qr[0], zero16, 0, 0, 0); p1 = __builtin_amdgcn_mfma_f32_32x32x16_bf16(k11, qr[1], p1, 0, 0, 0); }
            const int K0 = tile * 64;
            if (K0 > row0 - 154) {
                const LAS float* bp = Bt + (K0 - row0 + 255 + 4 * hi - r32);
#pragma unroll
                for (int r = 0; r < 16; ++r) { p0[r] += bp[(r & 3) + 8 * (r >> 2)]; p1[r] += bp[32 + (r & 3) + 8 * (r >> 2)]; }
            }
            float sacc = 0.f;
#pragma unroll
            for (int r = 0; r < 16; ++r) { p0[r] = __builtin_amdgcn_exp2f(p0[r]); p1[r] = __builtin_amdgcn_exp2f(p1[r]); sacc += p0[r] + p1[r]; }
            lsum += sacc;
            bf16x8 pa[4];
            { v4u w;
              w.x = pk2(p0[0], p0[1]); w.y = pk2(p0[2], p0[3]); w.z = pk2(p0[4], p0[5]); w.w = pk2(p0[6], p0[7]); pa[0] = __builtin_bit_cast(bf16x8, w);
              w.x = pk2(p0[8], p0[9]); w.y = pk2(p0[10], p0[11]); w.z = pk2(p0[12], p0[13]); w.w = pk2(p0[14], p0[15]); pa[1] = __builtin_bit_cast(bf16x8, w);
              w.x = pk2(p1[0], p1[1]); w.y = pk2(p1[2], p1[3]); w.z = pk2(p1[4], p1[5]); w.w = pk2(p1[6], p1[7]); pa[2] = __builtin_bit_cast(bf16x8, w);
              w.x = pk2(p1[8], p1[9]); w.y = pk2(p1[10], p1[11]); w.z = pk2(p1[12], p1[13]); w.w = pk2(p1[14], p1[15]); pa[3] = __builtin_bit_cast(bf16x8, w); }
#pragma unroll
            for (int k = 0; k < 4; ++k) {
                const s16x4 a0 = vtr(Vs + k * 1024), a1 = vtr(Vs + k * 1024 + 512), c0 = vtr(Vs + 4096 + k * 1024), c1 = vtr(Vs + 4096 + k * 1024 + 512);
                const bf16x8 v0 = (bf16x8){a0[0], a0[1], a0[2], a0[3], a1[0], a1[1], a1[2], a1[3]}, v1 = (bf16x8){c0[0], c0[1], c0[2], c0[3], c1[0], c1[1], c1[2], c1[3]};
                o0 = __builtin_amdgcn_mfma_f32_32x32x16_bf16(pa[k], v0, o0, 0, 0, 0);
                o1 = __builtin_amdgcn_mfma_f32_32x32x16_bf16(pa[k], v1, o1, 0, 0, 0);
            }
        }
        slot = slot == 2 ? 0 : slot + 1;
    }
    lsum = xhalf_sum(lsum);
    if (hi == 0) wsf[32 + r32] = lsum;
    asm volatile("s_waitcnt lgkmcnt(0)" ::: "memory");
#pragma unroll
    for (int r = 0; r < 16; ++r) { const int q = crow(r, hi); const float rl = __builtin_amdgcn_rcpf(wsf[32 + q]); stg[q * 68 + r32] = o0[r] * rl; stg[q * 68 + 32 + r32] = o1[r] * rl; }
    ATT_WAIT_BAR(0);
    if (t == 0) {
        const LAS float* s1 = stg + 4 * OST_W; const float* gn = A.in[11] + l * 64; bf16* MIXp = (bf16*)(F.ws + WS_MIX);
#pragma unroll
        for (int i = 0; i < 4; ++i) { const int row = i * 8 + (lane >> 3), ch = lane & 7;
            const f32x4 a0 = *(const LAS f32x4*)(stg + row * 68 + ch * 8), a1 = *(const LAS f32x4*)(stg + row * 68 + ch * 8 + 4), b0 = *(const LAS f32x4*)(s1 + row * 68 + ch * 8), b1 = *(const LAS f32x4*)(s1 + row * 68 + ch * 8 + 4);
            const f32x4 x0 = a0 - b0 * lam, x1 = a1 - b1 * lam;
            float ss = (x0.x * x0.x + x0.y * x0.y) + (x0.z * x0.z + x0.w * x0.w) + (x1.x * x1.x + x1.y * x1.y) + (x1.z * x1.z + x1.w * x1.w);
            ss += __shfl_xor(ss, 1); ss += __shfl_xor(ss, 2); ss += __shfl_xor(ss, 4);
            const float rstd = __builtin_amdgcn_rsqf(ss * (1.f / 64.f) + EPS) * oscale;
            const f32x4 g0 = *(const f32x4*)(gn + ch * 8), g1 = *(const f32x4*)(gn + ch * 8 + 4);
            v4u w; w.x = pk2(x0.x * rstd * g0.x, x0.y * rstd * g0.y); w.y = pk2(x0.z * rstd * g0.z, x0.w * rstd * g0.w); w.z = pk2(x1.x * rstd * g1.x, x1.y * rstd * g1.y); w.w = pk2(x1.z * rstd * g1.z, x1.w * rstd * g1.w);
            *(v4u*)(MIXp + (rb + row0 + row) * D + h * 64 + ch * 8) = w; }
    }
#undef ATT_DMA
}
}
namespace ssd {
typedef unsigned u32x2 __attribute__((ext_vector_type(2)));
using att::f32x16; using att::s16x4; using att::vtr; using att::crow;
constexpr int XS = 0, BK = 32768, CK = 40960, BW = 49152, HB = 81920, SM = 114688, CW = 122880;
constexpr int SM_VL = 0, SM_US = 256, SM_EO = 512, SM_WS = 768, SM_DT = 1024, SM_DK = 1028, SM_AK = 1032, SM_DB = 1036, SM_GN = 1040;
#define SSD_BAR() asm volatile("s_waitcnt lgkmcnt(0)\n\ts_barrier" ::: "memory")
__device__ __forceinline__ bf16x8 trfrag(const LAS char* p) { const s16x4 a = vtr(p), b = vtr(p + 512); return (bf16x8){a[0], a[1], a[2], a[3], b[0], b[1], b[2], b[3]}; }
__device__ __forceinline__ bf16x8 packfrag(const f32x16& x, int s) { v4u w; w.x = pk2(x[8 * s], x[8 * s + 1]); w.y = pk2(x[8 * s + 2], x[8 * s + 3]); w.z = pk2(x[8 * s + 4], x[8 * s + 5]); w.w = pk2(x[8 * s + 6], x[8 * s + 7]); return __builtin_bit_cast(bf16x8, w); }
#define SSD_LO(q_) ((f32x4){bflo((q_).x), bfhi((q_).x), bflo((q_).y), bfhi((q_).y)})
#define SSD_HI(q_) ((f32x4){bflo((q_).z), bfhi((q_).z), bflo((q_).w), bfhi((q_).w)})

__device__ __forceinline__ void ssd_m1_unit(Frame& F_, const Args& A, int l, int b, int c, int g) {
    Frame F = refresh(F_);
    const int tid = F.tid, lane = tid & 63, wid = F.wave, r32 = lane & 31, hi = lane >> 5, hh = wid >> 1, lh = wid & 1;
    LAS char* L = (LAS char*)F.lds; LAS float* sm = (LAS float*)(L + SM); LAS float* cwl = (LAS float*)(L + CW);
    const bf16* PROJ = (const bf16*)(F.ws + WS_BIG); const float* DTg = (const float*)(F.ws + WS_DT);
    bf16* XC = (bf16*)(F.ws + WS_XC); bf16* YD = (bf16*)(F.ws + WS_YD); bf16* SST = (bf16*)(F.ws + WS_SST);
    const size_t rowb = (size_t)b * SEQ + (size_t)c * 64;
    const int tg = tid / 48, cc = tid - tg * 48;
    const int gcol = PC_XBC + (cc < 32 ? g * 256 + cc * 8 : cc < 40 ? 512 + g * 64 + (cc - 32) * 8 : 640 + g * 64 + (cc - 40) * 8);
    v4u raw[11];
#pragma unroll
    for (int i = 0; i < 11; ++i) { const int trow = c * 64 + 8 * tg - 3 + i; raw[i] = (tid < 384 && trow >= 0) ? *(const v4u*)(PROJ + ((size_t)b * SEQ + trow) * NPROJ + gcol) : (v4u){0u, 0u, 0u, 0u}; }
    f32x4 d4 = (f32x4){0.f, 0.f, 0.f, 0.f};
    if (wid == 7) d4 = *(const f32x4*)(DTg + (rowb + lane) * 8 + g * 4);
    SSD_BAR();
    for (int i = tid; i < 5 * 384; i += 512) { const int w = i / 384, li = i - w * 384; const int ch = li < 256 ? g * 256 + li : li < 320 ? 512 + g * 64 + (li - 256) : 640 + g * 64 + (li - 320);
        cwl[i] = w < 4 ? A.in[12][(size_t)l * 4 * 768 + w * 768 + ch] : A.in[13][l * 768 + ch]; }
    if (tid < 4) { sm[SM_AK + tid] = -__expf(A.in[15][l * 8 + g * 4 + tid]); sm[SM_DB + tid] = A.in[14][l * 8 + g * 4 + tid]; }
    SSD_BAR();
    if (tid < 384) {
        const int dsto = cc < 32 ? XS + (cc >> 3) * 8192 + ((cc & 7) >> 2) * 4096 + ((cc & 3) * 8) * 2 : cc < 40 ? BK + (cc - 32) * 1024 : CK + (cc - 40) * 1024;
        const int dstr = cc < 32 ? 64 : 16;
        const int xcol = cc < 32 ? g * 256 + cc * 8 : 512 + g * 64 + (cc - 40) * 8;
        const f32x4 w0a = *(const LAS f32x4*)(cwl + cc * 8), w0b = *(const LAS f32x4*)(cwl + cc * 8 + 4), w1a = *(const LAS f32x4*)(cwl + 384 + cc * 8), w1b = *(const LAS f32x4*)(cwl + 384 + cc * 8 + 4);
        const f32x4 w2a = *(const LAS f32x4*)(cwl + 768 + cc * 8), w2b = *(const LAS f32x4*)(cwl + 768 + cc * 8 + 4), w3a = *(const LAS f32x4*)(cwl + 1152 + cc * 8), w3b = *(const LAS f32x4*)(cwl + 1152 + cc * 8 + 4);
        const f32x4 cba = *(const LAS f32x4*)(cwl + 1536 + cc * 8), cbb = *(const LAS f32x4*)(cwl + 1536 + cc * 8 + 4);
#pragma unroll
        for (int j = 0; j < 8; ++j) {
            const f32x4 va = cba + SSD_LO(raw[j]) * w0a + SSD_LO(raw[j + 1]) * w1a + SSD_LO(raw[j + 2]) * w2a + SSD_LO(raw[j + 3]) * w3a;
            const f32x4 vb = cbb + SSD_HI(raw[j]) * w0b + SSD_HI(raw[j + 1]) * w1b + SSD_HI(raw[j + 2]) * w2b + SSD_HI(raw[j + 3]) * w3b;
            v4u o; o.x = pk2(silu_f(va.x), silu_f(va.y)); o.y = pk2(silu_f(va.z), silu_f(va.w)); o.z = pk2(silu_f(vb.x), silu_f(vb.y)); o.w = pk2(silu_f(vb.z), silu_f(vb.w));
            *(LAS v4u*)(L + dsto + (8 * tg + j) * dstr) = o;
            if (cc < 32 || cc >= 40) *(v4u*)(XC + (rowb + 8 * tg + j) * 640 + xcol) = o;
        }
    } else if (wid == 7) {
        float dtr[4] = {d4.x, d4.y, d4.z, d4.w}; float tot[4];
#pragma unroll
        for (int k = 0; k < 4; ++k) { const float Ak = sm[SM_AK + k], dbk = sm[SM_DB + k];
            const float xr = dtr[k] + dbk; const float dt = xr > 20.f ? xr : log1pf(__expf(xr));
            float acs = Ak * dt;
#pragma unroll
            for (int o = 1; o < 64; o <<= 1) { const float u = __shfl_up(acs, o); if (lane >= o) acs += u; }
            tot[k] = __shfl(acs, 63);
            sm[SM_VL + k * 64 + lane] = acs * LOG2E; sm[SM_US + k * 64 + lane] = acs * LOG2E - __log2f(dt);
            sm[SM_WS + k * 64 + lane] = __expf(tot[k] - acs) * dt; dtr[k] = __expf(acs); }
        *(f32x4*)((float*)(F.ws + WS_EOFF) + (rowb + lane) * 8 + g * 4) = (f32x4){dtr[0], dtr[1], dtr[2], dtr[3]};
        if (lane == 0) *(f32x4*)((float*)(F.ws + WS_DTOT) + ((size_t)(b * 128 + c)) * 8 + g * 4) = (f32x4){__expf(tot[0]), __expf(tot[1]), __expf(tot[2]), __expf(tot[3])};
    }
    SSD_BAR();
    { const int s = tid >> 3, nc = tid & 7; const v4u b8 = *(const LAS v4u*)(L + BK + nc * 1024 + s * 16);
      const f32x4 ba = SSD_LO(b8), bb = SSD_HI(b8);
#pragma unroll
      for (int k = 0; k < 4; ++k) { const float w = sm[SM_WS + k * 64 + s]; v4u o; o.x = pk2(ba.x * w, ba.y * w); o.y = pk2(ba.z * w, ba.w * w); o.z = pk2(bb.x * w, bb.y * w); o.w = pk2(bb.z * w, bb.w * w);
          *(LAS v4u*)(L + BW + k * 8192 + (nc >> 2) * 4096 + s * 64 + (nc & 3) * 16) = o; } }
    SSD_BAR();
    const int kfo = hi * 1024 + r32 * 16;
    const int vfo = ((lane >> 4) & 1) * 32 + (lane & 3) * 8 + (4 * hi + ((lane & 15) >> 2)) * 64;
    f32x16 y0, y1, h0, h1;
#pragma unroll
    for (int r = 0; r < 16; ++r) { y0[r] = 0.f; y1[r] = 0.f; h0[r] = 0.f; h1[r] = 0.f; }
    {
        bf16x8 cf[4];
#pragma unroll
        for (int ks = 0; ks < 4; ++ks) cf[ks] = *(const LAS bf16x8*)(L + CK + kfo + ks * 2048 + lh * 512);
        const float vl = sm[SM_VL + hh * 64 + 32 * lh + r32];
#pragma unroll
        for (int sb = 0; sb < 2; ++sb) {
            if (sb <= lh) {
                f32x16 T;
#pragma unroll
                for (int r = 0; r < 16; ++r) T[r] = 0.f;
#pragma unroll
                for (int ks = 0; ks < 4; ++ks) { const bf16x8 bfr = *(const LAS bf16x8*)(L + BK + kfo + ks * 2048 + sb * 512); T = __builtin_amdgcn_mfma_f32_32x32x16_bf16(bfr, cf[ks], T, 0, 0, 0); }
#pragma unroll
                for (int r = 0; r < 16; ++r) { const float us = sm[SM_US + hh * 64 + 32 * sb + crow(r, hi)]; float w = T[r] * __builtin_amdgcn_exp2f(vl - us);
                    if (sb == lh && crow(r, hi) > r32) w = 0.f; T[r] = w; }
                const bf16x8 pa0 = packfrag(T, 0), pa1 = packfrag(T, 1);
                const LAS char* xb = L + XS + hh * 8192 + vfo + sb * 2048;
                const bf16x8 x00 = trfrag(xb), x01 = trfrag(xb + 4096), x10 = trfrag(xb + 1024), x11 = trfrag(xb + 4096 + 1024);
                y0 = __builtin_amdgcn_mfma_f32_32x32x16_bf16(pa0, x00, y0, 0, 0, 0); y1 = __builtin_amdgcn_mfma_f32_32x32x16_bf16(pa0, x01, y1, 0, 0, 0);
                y0 = __builtin_amdgcn_mfma_f32_32x32x16_bf16(pa1, x10, y0, 0, 0, 0); y1 = __builtin_amdgcn_mfma_f32_32x32x16_bf16(pa1, x11, y1, 0, 0, 0);
            }
        }
#pragma unroll
        for (int ks = 0; ks < 4; ++ks) { const bf16x8 xa = trfrag(L + XS + hh * 8192 + lh * 4096 + vfo + ks * 1024), b0 = trfrag(L + BW + hh * 8192 + vfo + ks * 1024), b1 = trfrag(L + BW + hh * 8192 + 4096 + vfo + ks * 1024);
            h0 = __builtin_amdgcn_mfma_f32_32x32x16_bf16(xa, b0, h0, 0, 0, 0); h1 = __builtin_amdgcn_mfma_f32_32x32x16_bf16(xa, b1, h1, 0, 0, 0); }
    }
    { bf16* img = SST + ((size_t)((b * 128 + c) * 8 + g * 4 + hh)) * 4096;
#pragma unroll
      for (int r = 0; r < 16; ++r) { const int p = 32 * lh + crow(r, hi);
          img[(r32 >> 3) * 512 + p * 8 + (r32 & 7)] = (bf16)f2bf(h0[r]); img[(4 + (r32 >> 3)) * 512 + p * 8 + (r32 & 7)] = (bf16)f2bf(h1[r]); } }
    SSD_BAR();
#pragma unroll
    for (int r = 0; r < 16; ++r) { const int lrow = 32 * lh + crow(r, hi);
        *(LAS unsigned short*)(L + BW + (lrow * 256 + hh * 64 + r32) * 2) = (unsigned short)f2bf(y0[r]);
        *(LAS unsigned short*)(L + BW + (lrow * 256 + hh * 64 + 32 + r32) * 2) = (unsigned short)f2bf(y1[r]); }
    SSD_BAR();
#pragma unroll
    for (int k = 0; k < 4; ++k) { const int tk = wid * 8 + 2 * k + (lane >> 5), chn = (lane & 31) * 8;
        *(v4u*)(YD + (rowb + tk) * 512 + g * 256 + chn) = *(const LAS v4u*)(L + BW + (tk * 256 + chn) * 2); }
}

__device__ __forceinline__ void ssd_m3_unit(Frame& F_, const Args& A, int l, int b, int c, int g) {
    Frame F = refresh(F_);
    const int tid = F.tid, lane = tid & 63, wid = F.wave, r32 = lane & 31, hi = lane >> 5, hh = wid >> 1, lh = wid & 1;
    LAS char* L = (LAS char*)F.lds; LAS float* sm = (LAS float*)(L + SM);
    const bf16* PROJ = (const bf16*)(F.ws + WS_BIG); const bf16* XC = (const bf16*)(F.ws + WS_XC); const bf16* YD = (const bf16*)(F.ws + WS_YD); const bf16* SST = (const bf16*)(F.ws + WS_SST);
    bf16* MIXp = (bf16*)(F.ws + WS_MIX);
    const size_t rowb = (size_t)b * SEQ + (size_t)c * 64;
    const v4u c8 = *(const v4u*)(XC + (rowb + (tid >> 3)) * 640 + 512 + g * 64 + (tid & 7) * 8);
    v4u hp[4];
    { const v4u* src = (const v4u*)(SST + ((size_t)((b * 128 + c) * 8 + g * 4)) * 4096);
#pragma unroll
      for (int i = 0; i < 4; ++i) hp[i] = src[tid + 512 * i]; }
    float eo = 0.f; if (tid < 256) eo = ((const float*)(F.ws + WS_EOFF))[(rowb + (tid & 63)) * 8 + g * 4 + (tid >> 6)];
    SSD_BAR();
    *(LAS v4u*)(L + CK + (tid & 7) * 1024 + (tid >> 3) * 16) = c8;
#pragma unroll
    for (int i = 0; i < 4; ++i) *(LAS v4u*)(L + HB + (tid + 512 * i) * 16) = hp[i];
    if (tid < 256) { sm[SM_EO + tid] = eo; sm[SM_GN + tid] = A.in[17][l * 512 + g * 256 + tid]; }
    if (tid < 4) sm[SM_DK + tid] = A.in[16][l * 8 + g * 4 + tid];
    SSD_BAR();
    const int kfo = hi * 1024 + r32 * 16;
    f32x16 y0, y1;
#pragma unroll
    for (int r = 0; r < 16; ++r) { y0[r] = 0.f; y1[r] = 0.f; }
#pragma unroll
    for (int ks = 0; ks < 4; ++ks) { const bf16x8 cf = *(const LAS bf16x8*)(L + CK + kfo + ks * 2048 + lh * 512);
        const bf16x8 h0 = *(const LAS bf16x8*)(L + HB + hh * 8192 + kfo + ks * 2048), h1 = *(const LAS bf16x8*)(L + HB + hh * 8192 + kfo + ks * 2048 + 512);
        y0 = __builtin_amdgcn_mfma_f32_32x32x16_bf16(cf, h0, y0, 0, 0, 0); y1 = __builtin_amdgcn_mfma_f32_32x32x16_bf16(cf, h1, y1, 0, 0, 0); }
#pragma unroll
    for (int r = 0; r < 16; ++r) { const int lrow = 32 * lh + crow(r, hi); const float e = sm[SM_EO + hh * 64 + lrow];
        *(LAS unsigned short*)(L + BW + (lrow * 256 + hh * 64 + r32) * 2) = (unsigned short)f2bf(y0[r] * e);
        *(LAS unsigned short*)(L + BW + (lrow * 256 + hh * 64 + 32 + r32) * 2) = (unsigned short)f2bf(y1[r] * e); }
    SSD_BAR();
    const float Dk = sm[SM_DK + (lane >> 4)]; const f32x4 gn4 = *(const LAS f32x4*)(sm + SM_GN + 4 * lane);
    u32x2 zr[8], xr[8], yr[8];
#pragma unroll
    for (int k = 0; k < 8; ++k) { const size_t row = rowb + wid * 8 + k; zr[k] = *(const u32x2*)(PROJ + row * NPROJ + PC_Z + g * 256 + 4 * lane); xr[k] = *(const u32x2*)(XC + row * 640 + g * 256 + 4 * lane); yr[k] = *(const u32x2*)(YD + row * 512 + g * 256 + 4 * lane); }
#pragma unroll
    for (int k = 0; k < 8; ++k) { const int tk = wid * 8 + k;
        const u32x2 yo = *(const LAS u32x2*)(L + BW + (tk * 256 + 4 * lane) * 2);
        f32x4 v; v.x = (bflo(yo.x) + bflo(yr[k].x) + Dk * bflo(xr[k].x)) * silu_f(bflo(zr[k].x)); v.y = (bfhi(yo.x) + bfhi(yr[k].x) + Dk * bfhi(xr[k].x)) * silu_f(bfhi(zr[k].x));
        v.z = (bflo(yo.y) + bflo(yr[k].y) + Dk * bflo(xr[k].y)) * silu_f(bflo(zr[k].y)); v.w = (bfhi(yo.y) + bfhi(yr[k].y) + Dk * bfhi(xr[k].y)) * silu_f(bfhi(zr[k].y));
        const float rstd = __builtin_amdgcn_rsqf(wave_sum((v.x * v.x + v.y * v.y) + (v.z * v.z + v.w * v.w)) * (1.f / 256.f) + EPS);
        u32x2 o; o.x = pk2(v.x * rstd * gn4.x, v.y * rstd * gn4.y); o.y = pk2(v.z * rstd * gn4.z, v.w * rstd * gn4.w);
        *(u32x2*)(MIXp + (rowb + tk) * D + 256 + g * 256 + 4 * lane) = o; }
}

__device__ __forceinline__ void scan_unit(Frame& F_, int kind, int u) {
    Frame F = refresh(F_);
    const int e = u * 1024 + F.tid * 2, nh = kind == 0 ? 8 : 4;
    const int idx = e & 4095, head = (e >> 12) & (nh - 1), b = e >> (kind == 0 ? 15 : 14);
    unsigned* base = (unsigned*)((bf16*)(F.ws + (kind == 0 ? WS_SST : WS_RST)) + ((size_t)(b * 128) * nh + head) * 4096 + idx);
    const size_t cstride = (size_t)nh * 4096 / 2;
    const float* dtot = (const float*)(F.ws + WS_DTOT) + (size_t)(b * 128) * 8 + head;
    const float gdec = exp2f(64.f * log2f(1.0f - exp2f(-5.0f - (float)head)));
    float h0 = 0.f, h1 = 0.f;
    for (int c0 = 0; c0 < 128; c0 += 16) {
        unsigned v[16]; float d[16];
#pragma unroll
        for (int i = 0; i < 16; ++i) { v[i] = base[(size_t)(c0 + i) * cstride]; d[i] = kind == 0 ? dtot[(size_t)(c0 + i) * 8] : gdec; }
#pragma unroll
        for (int i = 0; i < 16; ++i) { base[(size_t)(c0 + i) * cstride] = pk2(h0, h1); h0 = d[i] * h0 + bflo(v[i]); h1 = d[i] * h1 + bfhi(v[i]); }
    }
}
#undef SSD_LO
#undef SSD_HI
}
namespace ret {
using att::f32x16; using att::crow; using ssd::trfrag; using ssd::packfrag; using ssd::u32x2;
constexpr int QK = 0, KK = 8192, KW = 16384, VV = 24576, SB = 32768, OS = 40960, TB = 58368;
#define RET_BAR() asm volatile("s_waitcnt lgkmcnt(0)\n\ts_barrier" ::: "memory")
__device__ __forceinline__ f32x4 lo4(const v4u q_) { return (f32x4){bflo(q_.x), bfhi(q_.x), bflo(q_.y), bfhi(q_.y)}; }
__device__ __forceinline__ f32x4 hi4(const v4u q_) { return (f32x4){bflo(q_.z), bfhi(q_.z), bflo(q_.w), bfhi(q_.w)}; }
__device__ __forceinline__ v4u pack8(const f32x4 a, const f32x4 b) { v4u o; o.x = pk2(a.x, a.y); o.y = pk2(a.z, a.w); o.z = pk2(b.x, b.y); o.w = pk2(b.z, b.w); return o; }

__device__ __forceinline__ void ret_m1_unit(Frame& F_, const Args& A, int l, int b, int c, int h) {
    Frame F = refresh(F_);
    const int tid = F.tid, lane = tid & 63, wid = F.wave, r32 = lane & 31, hi = lane >> 5;
    LAS char* L = (LAS char*)F.lds; LAS float* tb = (LAS float*)(L + TB); LAS float* os = (LAS float*)(L + OS);
    const bf16* PROJ = (const bf16*)(F.ws + WS_BIG);
    const float gam = 1.0f - exp2f(-5.0f - (float)h), lg2 = log2f(gam);
    const int tok = tid >> 3, seg = tid & 7;
    const size_t rowb = (size_t)b * SEQ + (size_t)c * 64;
    v4u ld[4];
    { const bf16* rp = PROJ + (rowb + tok) * NPROJ;
      if (seg < 4) { ld[0] = *(const v4u*)(rp + PC_RQ + h * 64 + seg * 8); ld[1] = *(const v4u*)(rp + PC_RQ + h * 64 + 32 + seg * 8); ld[2] = *(const v4u*)(rp + PC_RK + h * 64 + seg * 8); ld[3] = *(const v4u*)(rp + PC_RK + h * 64 + 32 + seg * 8); }
      else { ld[0] = *(const v4u*)(rp + PC_RV + h * 64 + (seg - 4) * 16); ld[1] = *(const v4u*)(rp + PC_RV + h * 64 + (seg - 4) * 16 + 8); ld[2] = ld[0]; ld[3] = ld[0]; } }
    RET_BAR();
    if (tid < 128) tb[tid] = exp2f(lg2 * (float)(tid < 63 ? 63 - tid : tid - 63));
    if (seg < 4) {
        const f32x4 qla = lo4(ld[0]), qlb = hi4(ld[0]), qha = lo4(ld[1]), qhb = hi4(ld[1]), kla = lo4(ld[2]), klb = hi4(ld[2]), kha = lo4(ld[3]), khb = hi4(ld[3]);
        float ql[8] = {qla.x, qla.y, qla.z, qla.w, qlb.x, qlb.y, qlb.z, qlb.w}, qh[8] = {qha.x, qha.y, qha.z, qha.w, qhb.x, qhb.y, qhb.z, qhb.w};
        float kl[8] = {kla.x, kla.y, kla.z, kla.w, klb.x, klb.y, klb.z, klb.w}, kh[8] = {kha.x, kha.y, kha.z, kha.w, khb.x, khb.y, khb.z, khb.w};
        float q1[8], q2[8], k1[8], k2[8];
        const float pos = (float)(c * 64 + tok);
#pragma unroll
        for (int i = 0; i < 8; ++i) { const int fi = seg * 8 + i; const float invf = exp2f(-(float)fi * (13.287712379549449f / 32.0f)); const float ang = pos * invf;
            double rev = (double)ang * 0.15915494309189535; rev -= __builtin_rint(rev); const float fr = (float)rev;
            const float sn = __builtin_amdgcn_sinf(fr), cs = __builtin_amdgcn_cosf(fr);
            q1[i] = ql[i] * cs - qh[i] * sn; q2[i] = ql[i] * sn + qh[i] * cs; k1[i] = kl[i] * cs - kh[i] * sn; k2[i] = kl[i] * sn + kh[i] * cs; }
        const float kd = exp2f(lg2 * (float)(63 - tok));
        const v4u qa = pack8((f32x4){q1[0], q1[1], q1[2], q1[3]}, (f32x4){q1[4], q1[5], q1[6], q1[7]}), qb = pack8((f32x4){q2[0], q2[1], q2[2], q2[3]}, (f32x4){q2[4], q2[5], q2[6], q2[7]});
        *(LAS v4u*)(L + QK + seg * 1024 + tok * 16) = qa; *(LAS v4u*)(L + QK + (seg + 4) * 1024 + tok * 16) = qb;
        { char* qimg = (char*)(F.ws + WS_QR) + ((size_t)((b * 128 + c) * 4 + h)) * 8192; *(v4u*)(qimg + seg * 1024 + tok * 16) = qa; *(v4u*)(qimg + (seg + 4) * 1024 + tok * 16) = qb; }
        *(LAS v4u*)(L + KK + seg * 1024 + tok * 16) = pack8((f32x4){k1[0], k1[1], k1[2], k1[3]}, (f32x4){k1[4], k1[5], k1[6], k1[7]});
        *(LAS v4u*)(L + KK + (seg + 4) * 1024 + tok * 16) = pack8((f32x4){k2[0], k2[1], k2[2], k2[3]}, (f32x4){k2[4], k2[5], k2[6], k2[7]});
        *(LAS v4u*)(L + KW + tok * 64 + seg * 16) = pack8((f32x4){k1[0], k1[1], k1[2], k1[3]} * kd, (f32x4){k1[4], k1[5], k1[6], k1[7]} * kd);
        *(LAS v4u*)(L + KW + 4096 + tok * 64 + seg * 16) = pack8((f32x4){k2[0], k2[1], k2[2], k2[3]} * kd, (f32x4){k2[4], k2[5], k2[6], k2[7]} * kd);
    } else {
        const int s4 = seg - 4;
        *(LAS v4u*)(L + VV + (s4 >> 1) * 4096 + tok * 64 + (s4 & 1) * 32) = ld[0];
        *(LAS v4u*)(L + VV + (s4 >> 1) * 4096 + tok * 64 + (s4 & 1) * 32 + 16) = ld[1];
    }
    RET_BAR();
    const int kfo = hi * 1024 + r32 * 16;
    const int vfo = ((lane >> 4) & 1) * 32 + (lane & 3) * 8 + (4 * hi + ((lane & 15) >> 2)) * 64;
    const int lb = wid & 1, eb = (wid >> 1) & 1;
    if (wid < 4) {
        bf16x8 qf[4];
#pragma unroll
        for (int ks = 0; ks < 4; ++ks) qf[ks] = *(const LAS bf16x8*)(L + QK + kfo + ks * 2048 + lb * 512);
        f32x16 o;
#pragma unroll
        for (int r = 0; r < 16; ++r) o[r] = 0.f;
        const LAS float* rt = tb + (63 + 4 * hi - 32 * lb - r32);
#pragma unroll
        for (int sb = 0; sb < 2; ++sb) {
            f32x16 T;
#pragma unroll
            for (int r = 0; r < 16; ++r) T[r] = 0.f;
#pragma unroll
            for (int ks = 0; ks < 4; ++ks) { const bf16x8 kf = *(const LAS bf16x8*)(L + KK + kfo + ks * 2048 + sb * 512); T = __builtin_amdgcn_mfma_f32_32x32x16_bf16(kf, qf[ks], T, 0, 0, 0); }
#pragma unroll
            for (int r = 0; r < 16; ++r) T[r] *= rt[32 * sb + (r & 3) + 8 * (r >> 2)];
            const bf16x8 pa0 = packfrag(T, 0), pa1 = packfrag(T, 1);
            const LAS char* vb = L + VV + eb * 4096 + vfo + sb * 2048;
            const bf16x8 v0 = trfrag(vb), v1 = trfrag(vb + 1024);
            o = __builtin_amdgcn_mfma_f32_32x32x16_bf16(pa0, v0, o, 0, 0, 0); o = __builtin_amdgcn_mfma_f32_32x32x16_bf16(pa1, v1, o, 0, 0, 0);
        }
#pragma unroll
        for (int r = 0; r < 16; ++r) os[(32 * lb + crow(r, hi)) * 68 + 32 * eb + r32] = o[r];
    } else {
        f32x16 S;
#pragma unroll
        for (int r = 0; r < 16; ++r) S[r] = 0.f;
#pragma unroll
        for (int ks = 0; ks < 4; ++ks) { const bf16x8 ka = trfrag(L + KW + lb * 4096 + vfo + ks * 1024), vbf = trfrag(L + VV + eb * 4096 + vfo + ks * 1024);
            S = __builtin_amdgcn_mfma_f32_32x32x16_bf16(ka, vbf, S, 0, 0, 0); }
        char* simg = (char*)(F.ws + WS_RST) + ((size_t)((b * 128 + c) * 4 + h)) * 8192;
#pragma unroll
        for (int gq = 0; gq < 4; ++gq) { u32x2 w; w.x = pk2(S[4 * gq], S[4 * gq + 1]); w.y = pk2(S[4 * gq + 2], S[4 * gq + 3]);
            *(u32x2*)(simg + (4 * lb + gq) * 1024 + (32 * eb + r32) * 16 + hi * 8) = w; }
    }
    RET_BAR();
    { const int row = wid * 8 + (lane >> 3), ch = lane & 7;
      const f32x4 a0 = *(const LAS f32x4*)(os + row * 68 + ch * 8), a1 = *(const LAS f32x4*)(os + row * 68 + ch * 8 + 4);
      *(v4u*)((bf16*)(F.ws + WS_OI) + (rowb + row) * 256 + h * 64 + ch * 8) = pack8(a0, a1); }
}

__device__ __forceinline__ void ret_m3_unit(Frame& F_, const Args& A, int l, int b, int c, int h) {
    Frame F = refresh(F_);
    const int tid = F.tid, lane = tid & 63, wid = F.wave, r32 = lane & 31, hi = lane >> 5;
    LAS char* L = (LAS char*)F.lds; LAS float* os = (LAS float*)(L + OS);
    const bf16* PROJ = (const bf16*)(F.ws + WS_BIG); bf16* MIXp = (bf16*)(F.ws + WS_MIX);
    const float lg2 = log2f(1.0f - exp2f(-5.0f - (float)h));
    const size_t rowb = (size_t)b * SEQ + (size_t)c * 64;
    const size_t ioff = ((size_t)((b * 128 + c) * 4 + h)) * 8192;
    const v4u q16 = *(const v4u*)((const char*)(F.ws + WS_QR) + ioff + tid * 16);
#if defined(RTEST) && RTEST == 3
    v4u s16; { const unsigned long long* sp = (const unsigned long long*)((const char*)(F.ws + WS_RST) + ioff + tid * 16);
        const unsigned long long a = __hip_atomic_load(sp, __ATOMIC_RELAXED, __HIP_MEMORY_SCOPE_AGENT), b2 = __hip_atomic_load(sp + 1, __ATOMIC_RELAXED, __HIP_MEMORY_SCOPE_AGENT);
        s16.x = (unsigned)a; s16.y = (unsigned)(a >> 32); s16.z = (unsigned)b2; s16.w = (unsigned)(b2 >> 32); }
#else
    const v4u s16 = *(const v4u*)((const char*)(F.ws + WS_RST) + ioff + tid * 16);
#endif
    const size_t erow = rowb + wid * 8 + (lane >> 3); const int ch = lane & 7;
    const v4u gt = *(const v4u*)(PROJ + erow * NPROJ + PC_RG + h * 64 + ch * 8);
    const v4u oi = *(const v4u*)((const bf16*)(F.ws + WS_OI) + erow * 256 + h * 64 + ch * 8);
    RET_BAR();
#if defined(RTEST) && RTEST == 5
    { v4u qq; qq.x = 0x3f803f80u; qq.y = 0x3f803f80u; qq.z = 0x3f803f80u; qq.w = 0x3f803f80u; (void)q16; *(LAS v4u*)(L + QK + tid * 16) = qq; *(LAS v4u*)(L + SB + tid * 16) = s16; }
#elif defined(RTEST) && RTEST == 6
    { v4u qq; qq.x = 0x3f803f80u; qq.y = 0x3f803f80u; qq.z = 0x3f803f80u; qq.w = 0x3f803f80u; (void)s16; *(LAS v4u*)(L + QK + tid * 16) = q16; *(LAS v4u*)(L + SB + tid * 16) = qq; }
#else
    *(LAS v4u*)(L + QK + tid * 16) = q16; *(LAS v4u*)(L + SB + tid * 16) = s16;
#endif
    RET_BAR();
    if (wid < 4) {
        const int kfo = hi * 1024 + r32 * 16, lb = wid & 1, eb = wid >> 1;
        f32x16 o;
#pragma unroll
        for (int r = 0; r < 16; ++r) o[r] = 0.f;
#pragma unroll
        for (int ks = 0; ks < 4; ++ks) { const bf16x8 qf = *(const LAS bf16x8*)(L + QK + kfo + ks * 2048 + lb * 512), sf = *(const LAS bf16x8*)(L + SB + kfo + ks * 2048 + eb * 512);
            o = __builtin_amdgcn_mfma_f32_32x32x16_bf16(qf, sf, o, 0, 0, 0); }
#pragma unroll
        for (int r = 0; r < 16; ++r) { const int lrow = 32 * lb + crow(r, hi); os[lrow * 68 + 32 * eb + r32] = o[r] * exp2f(lg2 * (float)(lrow + 1)); }
    }
    RET_BAR();
    { const int row = wid * 8 + (lane >> 3);
      f32x4 a0 = *(const LAS f32x4*)(os + row * 68 + ch * 8), a1 = *(const LAS f32x4*)(os + row * 68 + ch * 8 + 4);
#if defined(RTEST) && RTEST == 1
      a0 = lo4(oi); a1 = hi4(oi);
#elif defined(RTEST) && RTEST == 2
      (void)oi;
#else
      a0 += lo4(oi); a1 += hi4(oi);
#endif
      float ss = (a0.x * a0.x + a0.y * a0.y) + (a0.z * a0.z + a0.w * a0.w) + (a1.x * a1.x + a1.y * a1.y) + (a1.z * a1.z + a1.w * a1.w);
      ss += __shfl_xor(ss, 1); ss += __shfl_xor(ss, 2); ss += __shfl_xor(ss, 4);
      const float rstd = __builtin_amdgcn_rsqf(ss * (1.f / 64.f) + EPS);
      const f32x4 g0 = *(const f32x4*)(A.in[18] + l * 64 + ch * 8), g1 = *(const f32x4*)(A.in[18] + l * 64 + ch * 8 + 4);
      const f32x4 z0 = lo4(gt), z1 = hi4(gt);
      v4u w; w.x = pk2(silu_f(z0.x) * a0.x * rstd * g0.x, silu_f(z0.y) * a0.y * rstd * g0.y); w.y = pk2(silu_f(z0.z) * a0.z * rstd * g0.z, silu_f(z0.w) * a0.w * rstd * g0.w);
      w.z = pk2(silu_f(z1.x) * a1.x * rstd * g1.x, silu_f(z1.y) * a1.y * rstd * g1.y); w.w = pk2(silu_f(z1.z) * a1.z * rstd * g1.z, silu_f(z1.w) * a1.w * rstd * g1.w);
      *(v4u*)(MIXp + erow * D + 768 + h * 64 + ch * 8) = w; }
}
}
namespace ssds {
using ssd::u32x2;
using att::f32x16; using att::s16x4; using att::vtr; using att::crow;
constexpr int XS = 0, BK = 32768, CK = 40960, BW = 49152, HB = 81920, SM = 114688, CW = 122880;
constexpr int SM_VL = 0, SM_US = 256, SM_EO = 512, SM_WS = 768, SM_DT = 1024, SM_DK = 1028, SM_AK = 1032, SM_DB = 1036, SM_GN = 1040;
#undef SSD_BAR
#define SSD_BAR() asm volatile("s_waitcnt lgkmcnt(0)\n\ts_barrier" ::: "memory")
using ssd::trfrag;
using ssd::packfrag;

__device__ __forceinline__ void ssd_unit(Frame& F_, const Args& A, int l, int b, int g) {
    Frame F = refresh(F_);
    const int tid = F.tid, lane = tid & 63, wid = F.wave, r32 = lane & 31, hi = lane >> 5, hh = wid >> 1, lh = wid & 1;
    LAS char* L = (LAS char*)F.lds; LAS float* sm = (LAS float*)(L + SM); LAS float* cwl = (LAS float*)(L + CW);
    const bf16* PROJ = (const bf16*)(F.ws + WS_BIG); const float* DTg = (const float*)(F.ws + WS_DT); bf16* MIXp = (bf16*)(F.ws + WS_MIX);
    SSD_BAR();
    for (int i = tid; i < 5 * 384; i += 512) { const int w = i / 384, li = i - w * 384; const int ch = li < 256 ? g * 256 + li : li < 320 ? 512 + g * 64 + (li - 256) : 640 + g * 64 + (li - 320);
        cwl[i] = w < 4 ? A.in[12][(size_t)l * 4 * 768 + w * 768 + ch] : A.in[13][l * 768 + ch]; }
    for (int i = tid; i < 32768 / 16; i += 512) *(LAS v4u*)(L + HB + i * 16) = (v4u){0u, 0u, 0u, 0u};
    if (tid < 256) sm[SM_GN + tid] = A.in[17][l * 512 + g * 256 + tid];
    if (tid < 4) { sm[SM_DK + tid] = A.in[16][l * 8 + g * 4 + tid]; sm[SM_AK + tid] = -__expf(A.in[15][l * 8 + g * 4 + tid]); sm[SM_DB + tid] = A.in[14][l * 8 + g * 4 + tid]; }
    const int tg = tid / 48, cc = tid - tg * 48;
    const int gcol = PC_XBC + (cc < 32 ? g * 256 + cc * 8 : cc < 40 ? 512 + g * 64 + (cc - 32) * 8 : 640 + g * 64 + (cc - 40) * 8);
    const int dsto = cc < 32 ? XS + (cc >> 3) * 8192 + ((cc & 7) >> 2) * 4096 + ((cc & 3) * 8) * 2 : cc < 40 ? BK + (cc - 32) * 1024 : CK + (cc - 40) * 1024;
    const int dstr = cc < 32 ? 64 : 16;
    const size_t rb = (size_t)b * SEQ;
    v4u raw[11];
#define SSD_LOADRAW(c) do { _Pragma("unroll") for (int i = 0; i < 11; ++i) { const int trow = (c) * 64 + 8 * tg - 3 + i; \
        raw[i] = (tid < 384 && trow >= 0) ? *(const v4u*)(PROJ + (rb + trow) * NPROJ + gcol) : (v4u){0u, 0u, 0u, 0u}; } } while (0)
    SSD_LOADRAW(0);
    float dtr[4]; u32x2 zr[8];
#define SSD_LOADDT(c) do { if (wid == 7) { const f32x4 d4 = *(const f32x4*)(DTg + (rb + (c) * 64 + lane) * 8 + g * 4); dtr[0] = d4.x; dtr[1] = d4.y; dtr[2] = d4.z; dtr[3] = d4.w; } } while (0)
#define SSD_LOADZ(c) do { _Pragma("unroll") for (int k = 0; k < 8; ++k) zr[k] = *(const u32x2*)(PROJ + (rb + (c) * 64 + wid * 8 + k) * NPROJ + PC_Z + g * 256 + 4 * lane); } while (0)
    SSD_LOADDT(0);
    f32x16 hacc0, hacc1;
#pragma unroll
    for (int r = 0; r < 16; ++r) { hacc0[r] = 0.f; hacc1[r] = 0.f; }
    const int kfo0 = hi * 1024 + r32 * 16;
    const int vfo0 = ((lane >> 4) & 1) * 32 + (lane & 3) * 8 + (4 * hi + ((lane & 15) >> 2)) * 64;
    SSD_BAR();
    for (int c = 0; c < SEQ / 64; ++c) {
        const size_t rowb = rb + (size_t)c * 64;
        int kfo = kfo0, vfo = vfo0; asm volatile("" : "+v"(kfo), "+v"(vfo));
        if (tid < 384) {
            f32x4 w0a = *(const LAS f32x4*)(cwl + cc * 8), w0b = *(const LAS f32x4*)(cwl + cc * 8 + 4), w1a = *(const LAS f32x4*)(cwl + 384 + cc * 8), w1b = *(const LAS f32x4*)(cwl + 384 + cc * 8 + 4);
            f32x4 w2a = *(const LAS f32x4*)(cwl + 768 + cc * 8), w2b = *(const LAS f32x4*)(cwl + 768 + cc * 8 + 4), w3a = *(const LAS f32x4*)(cwl + 1152 + cc * 8), w3b = *(const LAS f32x4*)(cwl + 1152 + cc * 8 + 4);
            const f32x4 cba = *(const LAS f32x4*)(cwl + 1536 + cc * 8), cbb = *(const LAS f32x4*)(cwl + 1536 + cc * 8 + 4);
#define SSD_LO(q_) ((f32x4){bflo((q_).x), bfhi((q_).x), bflo((q_).y), bfhi((q_).y)})
#define SSD_HI(q_) ((f32x4){bflo((q_).z), bfhi((q_).z), bflo((q_).w), bfhi((q_).w)})
#pragma unroll
            for (int j = 0; j < 8; ++j) {
                f32x4 va = cba + SSD_LO(raw[j]) * w0a + SSD_LO(raw[j + 1]) * w1a + SSD_LO(raw[j + 2]) * w2a + SSD_LO(raw[j + 3]) * w3a;
                f32x4 vb = cbb + SSD_HI(raw[j]) * w0b + SSD_HI(raw[j + 1]) * w1b + SSD_HI(raw[j + 2]) * w2b + SSD_HI(raw[j + 3]) * w3b;
                v4u o; o.x = pk2(silu_f(va.x), silu_f(va.y)); o.y = pk2(silu_f(va.z), silu_f(va.w)); o.z = pk2(silu_f(vb.x), silu_f(vb.y)); o.w = pk2(silu_f(vb.z), silu_f(vb.w));
                *(LAS v4u*)(L + dsto + (8 * tg + j) * dstr) = o;
            }
        } else if (wid == 7) {
            float tot[4];
#pragma unroll
            for (int k = 0; k < 4; ++k) { const float Ak = sm[SM_AK + k], dbk = sm[SM_DB + k];
                const float xr = dtr[k] + dbk; const float dt = xr > 20.f ? xr : log1pf(__expf(xr));
                float acs = Ak * dt;
#pragma unroll
                for (int o = 1; o < 64; o <<= 1) { const float u = __shfl_up(acs, o); if (lane >= o) acs += u; }
                tot[k] = __shfl(acs, 63);
                sm[SM_VL + k * 64 + lane] = acs * LOG2E; sm[SM_US + k * 64 + lane] = acs * LOG2E - __log2f(dt);
                sm[SM_EO + k * 64 + lane] = __expf(acs); sm[SM_WS + k * 64 + lane] = __expf(tot[k] - acs) * dt; }
            if (lane == 0) { sm[SM_DT + 0] = __expf(tot[0]); sm[SM_DT + 1] = __expf(tot[1]); sm[SM_DT + 2] = __expf(tot[2]); sm[SM_DT + 3] = __expf(tot[3]); }
        }
        if (c + 1 < SEQ / 64) { SSD_LOADRAW(c + 1); SSD_LOADDT(c + 1); }
        SSD_BAR();
        { const int s = tid >> 3, nc = tid & 7; const v4u b8 = *(const LAS v4u*)(L + BK + nc * 1024 + s * 16);
          const f32x4 ba = SSD_LO(b8), bb = SSD_HI(b8);
#pragma unroll
          for (int k = 0; k < 4; ++k) { const float w = sm[SM_WS + k * 64 + s]; v4u o; o.x = pk2(ba.x * w, ba.y * w); o.y = pk2(ba.z * w, ba.w * w); o.z = pk2(bb.x * w, bb.y * w); o.w = pk2(bb.z * w, bb.w * w);
              *(LAS v4u*)(L + BW + k * 8192 + (nc >> 2) * 4096 + s * 64 + (nc & 3) * 16) = o; } }
        SSD_BAR();
        SSD_LOADZ(c);
        f32x16 y0, y1;
        {
            bf16x8 cf[4];
#pragma unroll
            for (int ks = 0; ks < 4; ++ks) cf[ks] = *(const LAS bf16x8*)(L + CK + kfo + ks * 2048 + lh * 512);
#pragma unroll
            for (int r = 0; r < 16; ++r) { y0[r] = 0.f; y1[r] = 0.f; }
#pragma unroll
            for (int ks = 0; ks < 4; ++ks) { const bf16x8 h0 = *(const LAS bf16x8*)(L + HB + hh * 8192 + kfo + ks * 2048), h1 = *(const LAS bf16x8*)(L + HB + hh * 8192 + kfo + ks * 2048 + 512);
                y0 = __builtin_amdgcn_mfma_f32_32x32x16_bf16(cf[ks], h0, y0, 0, 0, 0); y1 = __builtin_amdgcn_mfma_f32_32x32x16_bf16(cf[ks], h1, y1, 0, 0, 0); }
#pragma unroll
            for (int r = 0; r < 16; ++r) { const float e = sm[SM_EO + hh * 64 + 32 * lh + crow(r, hi)]; y0[r] *= e; y1[r] *= e; }
            const float vl = sm[SM_VL + hh * 64 + 32 * lh + r32];
#pragma unroll
            for (int sb = 0; sb < 2; ++sb) {
                if (sb <= lh) {
                    f32x16 T;
#pragma unroll
                    for (int r = 0; r < 16; ++r) T[r] = 0.f;
#pragma unroll
                    for (int ks = 0; ks < 4; ++ks) { const bf16x8 bfr = *(const LAS bf16x8*)(L + BK + kfo + ks * 2048 + sb * 512); T = __builtin_amdgcn_mfma_f32_32x32x16_bf16(bfr, cf[ks], T, 0, 0, 0); }
#pragma unroll
                    for (int r = 0; r < 16; ++r) { const float us = sm[SM_US + hh * 64 + 32 * sb + crow(r, hi)]; float w = T[r] * __builtin_amdgcn_exp2f(vl - us);
                        if (sb == lh && crow(r, hi) > r32) w = 0.f; T[r] = w; }
                    const bf16x8 pa0 = packfrag(T, 0), pa1 = packfrag(T, 1);
                    const LAS char* xb = L + XS + hh * 8192 + vfo + sb * 2048;
                    const bf16x8 x00 = trfrag(xb), x01 = trfrag(xb + 4096), x10 = trfrag(xb + 1024), x11 = trfrag(xb + 4096 + 1024);
                    y0 = __builtin_amdgcn_mfma_f32_32x32x16_bf16(pa0, x00, y0, 0, 0, 0); y1 = __builtin_amdgcn_mfma_f32_32x32x16_bf16(pa0, x01, y1, 0, 0, 0);
                    y0 = __builtin_amdgcn_mfma_f32_32x32x16_bf16(pa1, x10, y0, 0, 0, 0); y1 = __builtin_amdgcn_mfma_f32_32x32x16_bf16(pa1, x11, y1, 0, 0, 0);
                }
            }
            const float dtot = sm[SM_DT + hh];
#pragma unroll
            for (int r = 0; r < 16; ++r) { hacc0[r] *= dtot; hacc1[r] *= dtot; }
#pragma unroll
            for (int ks = 0; ks < 4; ++ks) { const bf16x8 xa = trfrag(L + XS + hh * 8192 + lh * 4096 + vfo + ks * 1024), b0 = trfrag(L + BW + hh * 8192 + vfo + ks * 1024), b1 = trfrag(L + BW + hh * 8192 + 4096 + vfo + ks * 1024);
                hacc0 = __builtin_amdgcn_mfma_f32_32x32x16_bf16(xa, b0, hacc0, 0, 0, 0); hacc1 = __builtin_amdgcn_mfma_f32_32x32x16_bf16(xa, b1, hacc1, 0, 0, 0); }
        }
        SSD_BAR();
#pragma unroll
        for (int r = 0; r < 16; ++r) { const int p = 32 * lh + crow(r, hi);
            *(LAS unsigned short*)(L + HB + hh * 8192 + (r32 >> 3) * 1024 + p * 16 + (r32 & 7) * 2) = (unsigned short)f2bf(hacc0[r]);
            *(LAS unsigned short*)(L + HB + hh * 8192 + (4 + (r32 >> 3)) * 1024 + p * 16 + (r32 & 7) * 2) = (unsigned short)f2bf(hacc1[r]);
            const int lrow = 32 * lh + crow(r, hi);
            *(LAS unsigned short*)(L + BW + (lrow * 256 + hh * 64 + r32) * 2) = (unsigned short)f2bf(y0[r]);
            *(LAS unsigned short*)(L + BW + (lrow * 256 + hh * 64 + 32 + r32) * 2) = (unsigned short)f2bf(y1[r]); }
        SSD_BAR();
        const float Dk = sm[SM_DK + (lane >> 4)]; const f32x4 gn4 = *(const LAS f32x4*)(sm + SM_GN + 4 * lane);
#pragma unroll
        for (int k = 0; k < 8; ++k) { const int tk = wid * 8 + k; const int hd = lane >> 4, p = (4 * lane) & 63;
            const u32x2 yv = *(const LAS u32x2*)(L + BW + (tk * 256 + 4 * lane) * 2), xv = *(const LAS u32x2*)(L + XS + hd * 8192 + (p >> 5) * 4096 + tk * 64 + (p & 31) * 2);
            f32x4 v; v.x = (bflo(yv.x) + Dk * bflo(xv.x)) * silu_f(bflo(zr[k].x)); v.y = (bfhi(yv.x) + Dk * bfhi(xv.x)) * silu_f(bfhi(zr[k].x));
            v.z = (bflo(yv.y) + Dk * bflo(xv.y)) * silu_f(bflo(zr[k].y)); v.w = (bfhi(yv.y) + Dk * bfhi(xv.y)) * silu_f(bfhi(zr[k].y));
            const float rstd = __builtin_amdgcn_rsqf(wave_sum((v.x * v.x + v.y * v.y) + (v.z * v.z + v.w * v.w)) * (1.f / 256.f) + EPS);
            u32x2 o; o.x = pk2(v.x * rstd * gn4.x, v.y * rstd * gn4.y); o.y = pk2(v.z * rstd * gn4.z, v.w * rstd * gn4.w);
            *(u32x2*)(MIXp + (rowb + tk) * D + 256 + g * 256 + 4 * lane) = o; }
        SSD_BAR();
    }
#undef SSD_LOADRAW
#undef SSD_LOADDT
#undef SSD_LOADZ
#undef SSD_LO
#undef SSD_HI
}
}
namespace rets {
using att::f32x16; using att::crow; using ssd::trfrag; using ssd::packfrag; using ssd::u32x2;
constexpr int QK = 0, KK = 8192, KW = 16384, VV = 24576, SB = 32768, OS = 40960, TB = 58368;
#undef RET_BAR
#define RET_BAR() asm volatile("s_waitcnt lgkmcnt(0)\n\ts_barrier" ::: "memory")
__device__ __forceinline__ f32x4 lo4(const v4u q_) { return (f32x4){bflo(q_.x), bfhi(q_.x), bflo(q_.y), bfhi(q_.y)}; }
__device__ __forceinline__ f32x4 hi4(const v4u q_) { return (f32x4){bflo(q_.z), bfhi(q_.z), bflo(q_.w), bfhi(q_.w)}; }
__device__ __forceinline__ v4u pack8(const f32x4 a, const f32x4 b) { v4u o; o.x = pk2(a.x, a.y); o.y = pk2(a.z, a.w); o.z = pk2(b.x, b.y); o.w = pk2(b.z, b.w); return o; }

__device__ __forceinline__ void ret_unit(Frame& F_, const Args& A, int l, int b, int h) {
    Frame F = refresh(F_);
    const int tid = F.tid, lane = tid & 63, wid = F.wave, r32 = lane & 31, hi = lane >> 5;
    LAS char* L = (LAS char*)F.lds; LAS float* tb = (LAS float*)(L + TB); LAS float* os = (LAS float*)(L + OS);
    const bf16* PROJ = (const bf16*)(F.ws + WS_BIG); bf16* MIXp = (bf16*)(F.ws + WS_MIX);
    const float gam = 1.0f - exp2f(-5.0f - (float)h), lg2 = log2f(gam), g64 = exp2f(lg2 * 64.f);
    RET_BAR();
    if (tid < 128) tb[tid] = exp2f(lg2 * (float)(tid < 63 ? 63 - tid : tid - 63));
    else if (tid < 192) tb[tid] = exp2f(lg2 * (float)(tid - 128 + 1));
    else if (tid < 256) tb[tid] = exp2f(lg2 * (float)(63 - (tid - 192)));
    for (int i = tid; i < 8192 / 16; i += 512) *(LAS v4u*)(L + SB + i * 16) = (v4u){0u, 0u, 0u, 0u};
    const int tok = tid >> 3, seg = tid & 7;
    const size_t rb = (size_t)b * SEQ;
    v4u ld[4];
#define RET_LOAD(c) do { const bf16* rp = PROJ + (rb + (c) * 64 + tok) * NPROJ; \
        if (seg < 4) { ld[0] = *(const v4u*)(rp + PC_RQ + h * 64 + seg * 8); ld[1] = *(const v4u*)(rp + PC_RQ + h * 64 + 32 + seg * 8); ld[2] = *(const v4u*)(rp + PC_RK + h * 64 + seg * 8); ld[3] = *(const v4u*)(rp + PC_RK + h * 64 + 32 + seg * 8); } \
        else { ld[0] = *(const v4u*)(rp + PC_RV + h * 64 + (seg - 4) * 16); ld[1] = *(const v4u*)(rp + PC_RV + h * 64 + (seg - 4) * 16 + 8); } } while (0)
    RET_LOAD(0);
    f32x16 Sacc;
#pragma unroll
    for (int r = 0; r < 16; ++r) Sacc[r] = 0.f;
    const int kfo0 = hi * 1024 + r32 * 16;
    const int vfo0 = ((lane >> 4) & 1) * 32 + (lane & 3) * 8 + (4 * hi + ((lane & 15) >> 2)) * 64;
    const int lb = wid & 1, eb = (wid >> 1) & 1;
    RET_BAR();
    for (int c = 0; c < SEQ / 64; ++c) {
        int kfo = kfo0, vfo = vfo0; asm volatile("" : "+v"(kfo), "+v"(vfo));
        if (seg < 4) {
            const f32x4 qla = lo4(ld[0]), qlb = hi4(ld[0]), qha = lo4(ld[1]), qhb = hi4(ld[1]), kla = lo4(ld[2]), klb = hi4(ld[2]), kha = lo4(ld[3]), khb = hi4(ld[3]);
            float ql[8] = {qla.x, qla.y, qla.z, qla.w, qlb.x, qlb.y, qlb.z, qlb.w}, qh[8] = {qha.x, qha.y, qha.z, qha.w, qhb.x, qhb.y, qhb.z, qhb.w};
            float kl[8] = {kla.x, kla.y, kla.z, kla.w, klb.x, klb.y, klb.z, klb.w}, kh[8] = {kha.x, kha.y, kha.z, kha.w, khb.x, khb.y, khb.z, khb.w};
            float q1[8], q2[8], k1[8], k2[8];
            const float pos = (float)(c * 64 + tok);
#pragma unroll
            for (int i = 0; i < 8; ++i) { const int fi = seg * 8 + i; const float invf = exp2f(-(float)fi * (13.287712379549449f / 32.0f)); const float ang = pos * invf;
                double rev = (double)ang * 0.15915494309189535; rev -= __builtin_rint(rev); const float fr = (float)rev;
                const float sn = __builtin_amdgcn_sinf(fr), cs = __builtin_amdgcn_cosf(fr);
                q1[i] = ql[i] * cs - qh[i] * sn; q2[i] = ql[i] * sn + qh[i] * cs; k1[i] = kl[i] * cs - kh[i] * sn; k2[i] = kl[i] * sn + kh[i] * cs; }
            const float kd = tb[192 + tok];
            *(LAS v4u*)(L + QK + seg * 1024 + tok * 16) = pack8((f32x4){q1[0], q1[1], q1[2], q1[3]}, (f32x4){q1[4], q1[5], q1[6], q1[7]});
            *(LAS v4u*)(L + QK + (seg + 4) * 1024 + tok * 16) = pack8((f32x4){q2[0], q2[1], q2[2], q2[3]}, (f32x4){q2[4], q2[5], q2[6], q2[7]});
            *(LAS v4u*)(L + KK + seg * 1024 + tok * 16) = pack8((f32x4){k1[0], k1[1], k1[2], k1[3]}, (f32x4){k1[4], k1[5], k1[6], k1[7]});
            *(LAS v4u*)(L + KK + (seg + 4) * 1024 + tok * 16) = pack8((f32x4){k2[0], k2[1], k2[2], k2[3]}, (f32x4){k2[4], k2[5], k2[6], k2[7]});
            *(LAS v4u*)(L + KW + tok * 64 + seg * 16) = pack8((f32x4){k1[0], k1[1], k1[2], k1[3]} * kd, (f32x4){k1[4], k1[5], k1[6], k1[7]} * kd);
            *(LAS v4u*)(L + KW + 4096 + tok * 64 + seg * 16) = pack8((f32x4){k2[0], k2[1], k2[2], k2[3]} * kd, (f32x4){k2[4], k2[5], k2[6], k2[7]} * kd);
        } else {
            const int s4 = seg - 4;
            *(LAS v4u*)(L + VV + (s4 >> 1) * 4096 + tok * 64 + (s4 & 1) * 32) = ld[0];
            *(LAS v4u*)(L + VV + (s4 >> 1) * 4096 + tok * 64 + (s4 & 1) * 32 + 16) = ld[1];
        }
        if (c + 1 < SEQ / 64) RET_LOAD(c + 1);
        const size_t erow = rb + (size_t)c * 64 + wid * 8 + (lane >> 3);
        const v4u gt = *(const v4u*)(PROJ + erow * NPROJ + PC_RG + h * 64 + (lane & 7) * 8);
        RET_BAR();
        f32x16 o;
        if (wid < 4) {
            bf16x8 qf[4];
#pragma unroll
            for (int ks = 0; ks < 4; ++ks) qf[ks] = *(const LAS bf16x8*)(L + QK + kfo + ks * 2048 + lb * 512);
#pragma unroll
            for (int r = 0; r < 16; ++r) o[r] = 0.f;
#pragma unroll
            for (int ks = 0; ks < 4; ++ks) { const bf16x8 sf = *(const LAS bf16x8*)(L + SB + kfo + ks * 2048 + eb * 512); o = __builtin_amdgcn_mfma_f32_32x32x16_bf16(qf[ks], sf, o, 0, 0, 0); }
#pragma unroll
            for (int r = 0; r < 16; ++r) o[r] *= tb[128 + 32 * lb + crow(r, hi)];
            const LAS float* rt = tb + (63 + 4 * hi - 32 * lb - r32);
#pragma unroll
            for (int sb = 0; sb < 2; ++sb) {
                f32x16 T;
#pragma unroll
                for (int r = 0; r < 16; ++r) T[r] = 0.f;
#pragma unroll
                for (int ks = 0; ks < 4; ++ks) { const bf16x8 kf = *(const LAS bf16x8*)(L + KK + kfo + ks * 2048 + sb * 512); T = __builtin_amdgcn_mfma_f32_32x32x16_bf16(kf, qf[ks], T, 0, 0, 0); }
#pragma unroll
                for (int r = 0; r < 16; ++r) T[r] *= rt[32 * sb + (r & 3) + 8 * (r >> 2)];
                const bf16x8 pa0 = packfrag(T, 0), pa1 = packfrag(T, 1);
                const LAS char* vb = L + VV + eb * 4096 + vfo + sb * 2048;
                const bf16x8 v0 = trfrag(vb), v1 = trfrag(vb + 1024);
                o = __builtin_amdgcn_mfma_f32_32x32x16_bf16(pa0, v0, o, 0, 0, 0); o = __builtin_amdgcn_mfma_f32_32x32x16_bf16(pa1, v1, o, 0, 0, 0);
            }
        } else {
#pragma unroll
            for (int r = 0; r < 16; ++r) Sacc[r] *= g64;
#pragma unroll
            for (int ks = 0; ks < 4; ++ks) { const bf16x8 ka = trfrag(L + KW + lb * 4096 + vfo + ks * 1024), vbf = trfrag(L + VV + eb * 4096 + vfo + ks * 1024);
                Sacc = __builtin_amdgcn_mfma_f32_32x32x16_bf16(ka, vbf, Sacc, 0, 0, 0); }
        }
        RET_BAR();
        if (wid < 4) {
#pragma unroll
            for (int r = 0; r < 16; ++r) os[(32 * lb + crow(r, hi)) * 68 + 32 * eb + r32] = o[r];
        } else {
#pragma unroll
            for (int gq = 0; gq < 4; ++gq) { u32x2 w; w.x = pk2(Sacc[4 * gq], Sacc[4 * gq + 1]); w.y = pk2(Sacc[4 * gq + 2], Sacc[4 * gq + 3]);
                *(LAS u32x2*)(L + SB + (4 * lb + gq) * 1024 + (32 * eb + r32) * 16 + hi * 8) = w; }
        }
        RET_BAR();
        { const int row = wid * 8 + (lane >> 3), ch = lane & 7;
          const f32x4 a0 = *(const LAS f32x4*)(os + row * 68 + ch * 8), a1 = *(const LAS f32x4*)(os + row * 68 + ch * 8 + 4);
          float ss = (a0.x * a0.x + a0.y * a0.y) + (a0.z * a0.z + a0.w * a0.w) + (a1.x * a1.x + a1.y * a1.y) + (a1.z * a1.z + a1.w * a1.w);
          ss += __shfl_xor(ss, 1); ss += __shfl_xor(ss, 2); ss += __shfl_xor(ss, 4);
          const float rstd = __builtin_amdgcn_rsqf(ss * (1.f / 64.f) + EPS);
          const f32x4 g0 = *(const f32x4*)(A.in[18] + l * 64 + ch * 8), g1 = *(const f32x4*)(A.in[18] + l * 64 + ch * 8 + 4);
          const f32x4 z0 = lo4(gt), z1 = hi4(gt);
          v4u w; w.x = pk2(silu_f(z0.x) * a0.x * rstd * g0.x, silu_f(z0.y) * a0.y * rstd * g0.y); w.y = pk2(silu_f(z0.z) * a0.z * rstd * g0.z, silu_f(z0.w) * a0.w * rstd * g0.w);
          w.z = pk2(silu_f(z1.x) * a1.x * rstd * g1.x, silu_f(z1.y) * a1.y * rstd * g1.y); w.w = pk2(silu_f(z1.z) * a1.z * rstd * g1.z, silu_f(z1.w) * a1.w * rstd * g1.w);
          *(v4u*)(MIXp + erow * D + 768 + h * 64 + ch * 8) = w; }
    }
    RET_BAR();
#undef RET_LOAD
}
}
__device__ __forceinline__ void attn_naive_unit(Frame& F_, const Args& A, int l, int b, int h, int qb, float lam, float lam_init) {
    Frame F = refresh(F_);
    LAS float* Ks = (LAS float*)F.lds;
    LAS float* Vs = Ks + 4096;
    LAS float* Bt = Vs + 4096;
    LAS float* Ob = (LAS float*)(F.lds + 36864);
    const int tid = F.tid, t = tid >> 8, r = tid & 255;
    const int Q0 = qb * 256, row = Q0 + r; const size_t grow = (size_t)b * SEQ + row;
    const bf16* PROJ = (const bf16*)(F.ws + WS_BIG);
    __syncthreads();
    if (tid < 192) Bt[tid] = A.in[6][t5_bucket(tid - 128) * 4 + h] * LOG2E;
    f32x4 q4[8];
    { const v4u* qp = (const v4u*)(PROJ + grow * NPROJ + PC_Q + h * 64 + t * 32);
#pragma unroll
      for (int i = 0; i < 4; ++i) { const v4u w = qp[i]; q4[2 * i] = (f32x4){bflo(w.x), bfhi(w.x), bflo(w.y), bfhi(w.y)}; q4[2 * i + 1] = (f32x4){bflo(w.z), bfhi(w.z), bflo(w.w), bfhi(w.w)}; } }
    f32x4 O4[16];
#pragma unroll
    for (int e = 0; e < 16; ++e) O4[e] = (f32x4){0.f, 0.f, 0.f, 0.f};
    float mrun = -1.0e30f, lsum = 0.f;
    const int cq = row >> 6, nck = (Q0 >> 6) + 4;
    for (int ck = 0; ck < nck; ++ck) {
        __syncthreads();
        { const int key = tid >> 3, seg = tid & 7; const bf16* kp = PROJ + ((size_t)b * SEQ + ck * 64 + key) * NPROJ + PC_K + h * 64 + seg * 8;
          const v4u kw = *(const v4u*)kp, vw = *(const v4u*)(kp + 256);
          LAS f32x4* kd = (LAS f32x4*)(Ks + (seg >> 2) * 2048 + key * 32 + (seg & 3) * 8); LAS f32x4* vd = (LAS f32x4*)(Vs + key * 64 + seg * 8);
          kd[0] = (f32x4){bflo(kw.x), bfhi(kw.x), bflo(kw.y), bfhi(kw.y)}; kd[1] = (f32x4){bflo(kw.z), bfhi(kw.z), bflo(kw.w), bfhi(kw.w)};
          vd[0] = (f32x4){bflo(vw.x), bfhi(vw.x), bflo(vw.y), bfhi(vw.y)}; vd[1] = (f32x4){bflo(vw.z), bfhi(vw.z), bflo(vw.w), bfhi(vw.w)}; }
        __syncthreads();
        if (ck <= cq) {
            const int kbase = ck * 64 - row;
#pragma unroll 1
            for (int j = 0; j < 64; ++j) {
                const LAS f32x4* kr = (const LAS f32x4*)(Ks + t * 2048 + j * 32);
                f32x4 a4 = q4[0] * kr[0];
#pragma unroll
                for (int d = 1; d < 8; ++d) a4 += q4[d] * kr[d];
                int rel = kbase + j; rel = rel < -128 ? -128 : rel;
                const float sj = (a4.x + a4.y) + (a4.z + a4.w) + Bt[rel + 128];
                if (sj > mrun) { const float sc = __builtin_amdgcn_exp2f(mrun - sj); lsum *= sc;
#pragma unroll
                    for (int e = 0; e < 16; ++e) O4[e] *= sc;
                    mrun = sj; }
                const float p = __builtin_amdgcn_exp2f(sj - mrun); lsum += p;
                const LAS f32x4* vr = (const LAS f32x4*)(Vs + j * 64);
#pragma unroll
                for (int e = 0; e < 16; ++e) O4[e] += vr[e] * p;
            }
        }
    }
    __syncthreads();
    const float inv = 1.0f / lsum;
    if (t == 1) {
#pragma unroll
        for (int e = 0; e < 16; ++e) *(LAS f32x4*)(Ob + r * 68 + 4 * e) = O4[e] * inv; }
    __syncthreads();
    if (t == 0) { f32x4 ss4 = (f32x4){0.f, 0.f, 0.f, 0.f};
#pragma unroll
        for (int e = 0; e < 16; ++e) { const f32x4 o = O4[e] * inv - *(const LAS f32x4*)(Ob + r * 68 + 4 * e) * lam; O4[e] = o; ss4 += o * o; }
        const float rstd = __builtin_amdgcn_rsqf(((ss4.x + ss4.y) + (ss4.z + ss4.w)) * (1.f / 64.f) + EPS) * (1.0f - lam_init);
        const f32x4* gn = (const f32x4*)(A.in[11] + l * 64); v4u* op = (v4u*)((bf16*)(F.ws + WS_MIX) + grow * D + h * 64);
#pragma unroll
        for (int e = 0; e < 16; e += 2) { const f32x4 o0 = O4[e] * gn[e] * rstd, o1 = O4[e + 1] * gn[e + 1] * rstd;
            v4u w; w.x = pk2(o0.x, o0.y); w.y = pk2(o0.z, o0.w); w.z = pk2(o1.x, o1.y); w.w = pk2(o1.z, o1.w); op[e >> 1] = w; } }
    __syncthreads();
}

__device__ __forceinline__ void ssd_naive_unit(Frame& F_, const Args& A, int l, int b, int g) {
    Frame F = refresh(F_);
    LAS float* xs = (LAS float*)F.lds;
    LAS float* Bs = xs + 64 * 256;
    LAS float* Cs = Bs + 4096;
    LAS float* dts = Cs + 4096;
    LAS float* dAs = dts + 256;
    const int tid = F.tid, hh = tid >> 7, p = (tid & 127) >> 1, nh = tid & 1, head = g * 4 + hh;
    const float Dk = A.in[16][l * 8 + head];
    float hst[32];
#pragma unroll
    for (int i = 0; i < 32; ++i) hst[i] = 0.f;
    int ch = 0; float w0 = 0.f, w1 = 0.f, w2 = 0.f, w3 = 0.f, cb = 0.f, r0 = 0.f, r1 = 0.f, r2 = 0.f;
    if (tid < 384) { ch = tid < 256 ? g * 256 + tid : tid < 320 ? 512 + g * 64 + (tid - 256) : 640 + g * 64 + (tid - 320);
        const float* cw = A.in[12] + (size_t)l * 4 * 768; w0 = cw[ch]; w1 = cw[768 + ch]; w2 = cw[2 * 768 + ch]; w3 = cw[3 * 768 + ch]; cb = A.in[13][l * 768 + ch]; }
    for (int c = 0; c < SEQ / 64; ++c) {
        __syncthreads();
        const size_t rowb = (size_t)b * SEQ + c * 64;
        if (tid < 384) { const bf16* src = ((bf16*)(F.ws + WS_BIG)) + rowb * NPROJ + PC_XBC + ch; LAS float* dst = tid < 256 ? xs + tid : tid < 320 ? Bs + (tid - 256) : Cs + (tid - 320); const int dstr = tid < 256 ? 256 : 64;
            _Pragma("unroll 16") for (int tt = 0; tt < 64; ++tt) { const float r3 = bf2f(src[(size_t)tt * NPROJ]); const float v = cb + r0 * w0 + r1 * w1 + r2 * w2 + r3 * w3; dst[tt * dstr] = silu_f(v); r0 = r1; r1 = r2; r2 = r3; } }
        else if (tid < 384 + 64) { const int tt = tid - 384;
#pragma unroll
            for (int k = 0; k < 4; ++k) { const int hd = g * 4 + k; const float xr = ((float*)(F.ws + WS_DT))[(rowb + tt) * 8 + hd] + A.in[14][l * 8 + hd]; const float dt = xr > 20.f ? xr : log1pf(__expf(xr));
                dts[tt * 4 + k] = dt; dAs[tt * 4 + k] = __expf(-__expf(A.in[15][l * 8 + hd]) * dt); } }
        __syncthreads();
        for (int tt = 0; tt < 64; ++tt) {
            const float x = xs[tt * 256 + hh * 64 + p], dt = dts[tt * 4 + hh], dA = dAs[tt * 4 + hh], cx = dt * x;
            const LAS float* Br = Bs + tt * 64 + nh * 32; const LAS float* Cr = Cs + tt * 64 + nh * 32; float a = 0.f;
#pragma unroll
            for (int i = 0; i < 32; i += 4) { const f32x4 bb = *(const LAS f32x4*)(Br + i), cc = *(const LAS f32x4*)(Cr + i);
                hst[i] = hst[i] * dA + cx * bb.x; hst[i + 1] = hst[i + 1] * dA + cx * bb.y; hst[i + 2] = hst[i + 2] * dA + cx * bb.z; hst[i + 3] = hst[i + 3] * dA + cx * bb.w;
                a += (hst[i] * cc.x + hst[i + 1] * cc.y) + (hst[i + 2] * cc.z + hst[i + 3] * cc.w); }
            a += __shfl_xor(a, 1);
            if (nh == 0) xs[tt * 256 + hh * 64 + p] = a + Dk * x;
        }
        __syncthreads();
        for (int k = 0; k < 8; ++k) { const int tt = F.wave * 8 + k; const size_t row = rowb + tt;
            const f32x4 y = *(const LAS f32x4*)(xs + tt * 256 + 4 * F.lane); const uint2 zz = *(const uint2*)(((bf16*)(F.ws + WS_BIG)) + row * NPROJ + PC_Z + g * 256 + 4 * F.lane);
            f32x4 v; v.x = y.x * silu_f(bflo(zz.x)); v.y = y.y * silu_f(bfhi(zz.x)); v.z = y.z * silu_f(bflo(zz.y)); v.w = y.w * silu_f(bfhi(zz.y));
            const float rstd = __builtin_amdgcn_rsqf(wave_sum((v.x * v.x + v.y * v.y) + (v.z * v.z + v.w * v.w)) * (1.f / 256.f) + EPS);
            const f32x4 gn = *(const f32x4*)(A.in[17] + l * 512 + g * 256 + 4 * F.lane);
            uint2 o; o.x = pk2(v.x * rstd * gn.x, v.y * rstd * gn.y); o.y = pk2(v.z * rstd * gn.z, v.w * rstd * gn.w);
            *(uint2*)(((bf16*)(F.ws + WS_MIX)) + row * D + 256 + g * 256 + 4 * F.lane) = o; }
    }
    __syncthreads();
}

__device__ __forceinline__ void ret_naive_unit(Frame& F_, const Args& A, int l, int b, int h) {
    Frame F = refresh(F_);
    constexpr int ST = 68;
    LAS float* qs = (LAS float*)F.lds; LAS float* ks = qs + 64 * ST; LAS float* vs = ks + 64 * ST; LAS float* sc = vs + 64 * ST; LAS float* Ss = sc + 64 * ST; LAS float* os = Ss + 64 * ST;
    const int tid = F.tid, ra = tid >> 3, eg = tid & 7;
    const float gam = 1.0f - exp2f(-5.0f - (float)h), lg2 = log2f(gam), g64 = exp2f(lg2 * 64.f);
    float Sreg[8];
#pragma unroll
    for (int i = 0; i < 8; ++i) Sreg[i] = 0.f;
    __syncthreads();
#pragma unroll
    for (int i = 0; i < 8; ++i) Ss[ra * ST + eg * 8 + i] = 0.f;
    for (int c = 0; c < SEQ / 64; ++c) {
        __syncthreads();
        const size_t rowb = (size_t)b * SEQ + c * 64;
        { const int tok = ra, seg = eg; const bf16* rp = ((bf16*)(F.ws + WS_BIG)) + (rowb + tok) * NPROJ;
          if (seg < 4) { float ql[8], qh[8], kl[8], kh[8];
              unpack8(*(const v4u*)(rp + PC_RQ + h * 64 + seg * 8), ql); unpack8(*(const v4u*)(rp + PC_RQ + h * 64 + 32 + seg * 8), qh);
              unpack8(*(const v4u*)(rp + PC_RK + h * 64 + seg * 8), kl); unpack8(*(const v4u*)(rp + PC_RK + h * 64 + 32 + seg * 8), kh);
              const float pos = (float)(c * 64 + tok);
#pragma unroll
              for (int i = 0; i < 8; ++i) { const int fi = seg * 8 + i; const float invf = exp2f(-(float)fi * (13.287712379549449f / 32.0f)); const float ang = pos * invf;
                  double rev = (double)ang * 0.15915494309189535; rev -= __builtin_rint(rev); const float fr = (float)rev;
                  const float sn = __builtin_amdgcn_sinf(fr), cs = __builtin_amdgcn_cosf(fr);
                  qs[tok * ST + fi] = ql[i] * cs - qh[i] * sn; qs[tok * ST + fi + 32] = ql[i] * sn + qh[i] * cs;
                  ks[tok * ST + fi] = kl[i] * cs - kh[i] * sn; ks[tok * ST + fi + 32] = kl[i] * sn + kh[i] * cs; } }
          else { float va[8], vb[8]; const int c0 = (seg - 4) * 16; unpack8(*(const v4u*)(rp + PC_RV + h * 64 + c0), va); unpack8(*(const v4u*)(rp + PC_RV + h * 64 + c0 + 8), vb);
#pragma unroll
              for (int i = 0; i < 8; ++i) { vs[tok * ST + c0 + i] = va[i]; vs[tok * ST + c0 + 8 + i] = vb[i]; } } }
        __syncthreads();
        { float a[8];
#pragma unroll
          for (int jj = 0; jj < 8; ++jj) a[jj] = 0.f;
          for (int d = 0; d < 64; d += 4) { const f32x4 qq = *(const LAS f32x4*)(qs + ra * ST + d);
#pragma unroll
              for (int jj = 0; jj < 8; ++jj) { const f32x4 kk = *(const LAS f32x4*)(ks + (jj * 8 + eg) * ST + d); a[jj] += (qq.x * kk.x + qq.y * kk.y) + (qq.z * kk.z + qq.w * kk.w); } }
#pragma unroll
          for (int jj = 0; jj < 8; ++jj) { const int s = jj * 8 + eg; const int dd = ra > s ? ra - s : s - ra; sc[ra * ST + s] = a[jj] * exp2f(lg2 * (float)dd); } }
        __syncthreads();
        { float a[8];
#pragma unroll
          for (int i = 0; i < 8; ++i) a[i] = 0.f;
          for (int s = 0; s < 64; ++s) { const float w = sc[ra * ST + s]; const f32x4 v0 = *(const LAS f32x4*)(vs + s * ST + eg * 8), v1 = *(const LAS f32x4*)(vs + s * ST + eg * 8 + 4);
              a[0] += w * v0.x; a[1] += w * v0.y; a[2] += w * v0.z; a[3] += w * v0.w; a[4] += w * v1.x; a[5] += w * v1.y; a[6] += w * v1.z; a[7] += w * v1.w; }
          const float qd = exp2f(lg2 * (float)(ra + 1));
          for (int d = 0; d < 64; ++d) { const float w = qs[ra * ST + d] * qd; const f32x4 v0 = *(const LAS f32x4*)(Ss + d * ST + eg * 8), v1 = *(const LAS f32x4*)(Ss + d * ST + eg * 8 + 4);
              a[0] += w * v0.x; a[1] += w * v0.y; a[2] += w * v0.z; a[3] += w * v0.w; a[4] += w * v1.x; a[5] += w * v1.y; a[6] += w * v1.z; a[7] += w * v1.w; }
#pragma unroll
          for (int i = 0; i < 8; ++i) os[ra * ST + eg * 8 + i] = a[i]; }
        __syncthreads();
        { float a[8];
#pragma unroll
          for (int i = 0; i < 8; ++i) a[i] = 0.f;
          for (int s = 0; s < 64; ++s) { const float w = ks[s * ST + ra] * exp2f(lg2 * (float)(63 - s)); const f32x4 v0 = *(const LAS f32x4*)(vs + s * ST + eg * 8), v1 = *(const LAS f32x4*)(vs + s * ST + eg * 8 + 4);
              a[0] += w * v0.x; a[1] += w * v0.y; a[2] += w * v0.z; a[3] += w * v0.w; a[4] += w * v1.x; a[5] += w * v1.y; a[6] += w * v1.z; a[7] += w * v1.w; }
#pragma unroll
          for (int i = 0; i < 8; ++i) { Sreg[i] = Sreg[i] * g64 + a[i]; Ss[ra * ST + eg * 8 + i] = Sreg[i]; } }
        for (int k = 0; k < 8; ++k) { const int tok = F.wave * 8 + k; const size_t row = rowb + tok;
            const float v = os[tok * ST + F.lane]; const float rstd = __builtin_amdgcn_rsqf(wave_sum(v * v) * (1.f / 64.f) + EPS);
            const float gt = bf2f(((bf16*)(F.ws + WS_BIG))[row * NPROJ + PC_RG + h * 64 + F.lane]);
            ((bf16*)(F.ws + WS_MIX))[row * D + 768 + h * 64 + F.lane] = (bf16)f2bf(silu_f(gt) * v * rstd * A.in[18][l * 64 + F.lane]); }
    }
    __syncthreads();
}
__device__ __forceinline__ void mixer_2a(Frame& F, const Args& A, int l) {
    for (int u = F.bx; u < 1536; u += F.G) {
#if !defined(BISECT) || BISECT != 2
        if (u < 512) ssd::ssd_m1_unit(F, A, l, u >> 8, (u >> 1) & 127, u & 1);
#else
        if (u < 512) {}
#endif
#if !defined(BISECT) || BISECT != 1
        else { const int v = u - 512; ret::ret_m1_unit(F, A, l, v >> 9, (v >> 2) & 127, v & 3); }
#endif
    }
}
__device__ __forceinline__ void mixer_2b(Frame& F_, const Args& A, int l) {
    Frame F = refresh(F_);
    const float lam_init = 0.8f - 0.6f * __expf(-0.3f * (float)l);
    float d1 = 0.f, d2 = 0.f;
    for (int i = 0; i < 32; ++i) { d1 += A.in[7][l * 32 + i] * A.in[8][l * 32 + i]; d2 += A.in[9][l * 32 + i] * A.in[10][l * 32 + i]; }
    const float lam = __expf(d1) - __expf(d2) + lam_init;
    if (F.bx < 64) ssd::scan_unit(F, 0, F.bx); else if (F.bx < 96) ssd::scan_unit(F, 1, F.bx - 64);
    if (F.bx < 96) {
        asm volatile("s_waitcnt vmcnt(0)" ::: "memory");
        __syncthreads();
        if (F.tid == 0) { __builtin_amdgcn_fence(__ATOMIC_RELEASE, "agent"); asm volatile("s_waitcnt vmcnt(0)" ::: "memory");
            (void)__hip_atomic_fetch_add((unsigned*)(F.ctl + CW_SCAN + 64 * l), 1u, __ATOMIC_RELAXED, __HIP_MEMORY_SCOPE_AGENT); }
    }
    const int na = F.G, j = F.bx;
    const int wpos = (F.bx >> 3) % 3;
    for (int rnd = 0; rnd < 3 || rnd * na < 512; ++rnd) {
#ifndef EXPERTS_IN_P0
        if (l == 0 && rnd == wpos) expert_weights(F, A);
#endif
        const int i = (rnd & 1) ? (rnd + 1) * na - 1 - j : rnd * na + j;
        if (i < 512) { const int qb = 63 - (i >> 3), bh = i & 7; att::attn_unit(F, A, l, bh >> 2, bh & 3, qb, lam, 1.0f - lam_init);
#if defined(DBL_PHASE) && DBL_PHASE == 23
            att::attn_unit(F, A, l, bh >> 2, bh & 3, qb, lam, 1.0f - lam_init);
#endif
        }
    }
}
__device__ __forceinline__ void mixer_2bc_seam(Frame& F, int l) {
    asm volatile("s_waitcnt vmcnt(0)" ::: "memory");
    __syncthreads();
    if (F.tid == 0) {
        unsigned* fl = (unsigned*)(F.ctl + CW_SCAN + 64 * l); unsigned sp = 0;
        while (__hip_atomic_load(fl, __ATOMIC_RELAXED, __HIP_MEMORY_SCOPE_AGENT) < 96u) { __builtin_amdgcn_s_sleep(1); if (++sp > (1u << 20)) break; }
        __builtin_amdgcn_fence(__ATOMIC_ACQUIRE, "agent");
        asm volatile("s_waitcnt vmcnt(0)" ::: "memory");
    }
    __syncthreads();
}
__device__ __forceinline__ void mixer_2c(Frame& F, const Args& A, int l) {
    for (int u = F.bx; u < 1536; u += F.G) {
#if !defined(BISECT) || BISECT != 2
        if (u < 512) ssd::ssd_m3_unit(F, A, l, u >> 8, (u >> 1) & 127, u & 1);
#else
        if (u < 512) {}
#endif
#if !defined(BISECT) || BISECT != 1
        else { const int v = u - 512; ret::ret_m3_unit(F, A, l, v >> 9, (v >> 2) & 127, v & 3); }
#endif
    }
}
__device__ __forceinline__ void gather_phase(Frame& F_) {
    Frame F = refresh(F_);
    const int gw = F.bx * NWAVES + F.wave, NGW = F.G * NWAVES, nrows = F.META[16] * 256;
    const v4u* XN8 = (const v4u*)(F.ws + WS_XN); v4u* XG8 = (v4u*)(F.ws + WS_XG8); const int* LIST = (const int*)(F.ws + WS_LIST);
    const float* XNS = (const float*)(F.ws + WS_XNS); float* XGS = (float*)(F.ws + WS_XGS);
    for (int row0 = gw; row0 < nrows; row0 += 4 * NGW) {
        int tok[4]; bool ok[4];
#pragma unroll
        for (int i = 0; i < 4; ++i) { const int row = row0 + i * NGW; ok[i] = false; tok[i] = 0;
            if (row < nrows) { const int p = row >> 8, r = row & 255; int e = 0;
#pragma unroll
                for (int k = 1; k < 8; ++k) e += (p >= F.META[8 + k]) ? 1 : 0;
                const int pos = (p - F.META[8 + e]) * 256 + r;
                if (pos < F.META[e]) { ok[i] = true; tok[i] = LIST[e * 16384 + pos]; } } }
        v4u a[4]; float s[4];
#pragma unroll
        for (int i = 0; i < 4; ++i) { a[i] = (v4u){0u, 0u, 0u, 0u}; s[i] = 0.f; if (ok[i]) { a[i] = XN8[(size_t)tok[i] * 64 + F.lane]; s[i] = XNS[tok[i]]; } }
#pragma unroll
        for (int i = 0; i < 4; ++i) { const int row = row0 + i * NGW; if (row < nrows) { XG8[(size_t)row * 64 + F.lane] = a[i]; if (F.lane == 0) XGS[row] = s[i]; } }
    }
}
__device__ __forceinline__ void zero_yacc(Frame& F_) {
    Frame F = refresh(F_);
    v4u* za = (v4u*)(F.ws + WS_XN);
    for (size_t i = (size_t)F.bx * 512 + F.tid; i < (size_t)8 * 256 * 1024 / 4; i += (size_t)F.G * 512) za[i] = (v4u){0u, 0u, 0u, 0u};
}
#if defined(DBL_PHASE) && DBL_PHASE == 40
#define GRID_BAR() do { xcd_barrier(bar); xcd_barrier(bar); } while (0)
#else
#define GRID_BAR() xcd_barrier(bar)
#endif
#ifndef DBL_PHASE
#define DBL_PHASE -1
#endif
#ifdef PROBE_A
#define STAMP(i) do { if (F.bx == 0 && threadIdx.x == 0) ((LAS unsigned long long*)(F.lds + LDSCTL_OFF + 2048))[i] = __builtin_amdgcn_s_memrealtime(); } while (0)
#else
#define STAMP(i) do { } while (0)
#endif
#define WSB(off) ((bf16*)(F.ws + (off)))
template <int l>
__device__ __forceinline__ void layer_body(Frame& F, const Args& args, const XcdBarrier& bar) {

        { pg8::Gemm g{WSB(WS_XN), (const bf16*)((const signed char*)(F.ws + WS_WIN) + (size_t)l * NPROJ * D), D / 2}; pg8::StaticOrder S; S.init(M, NPROJ, F.G, F.bx);
          pg8::EpiBf16S E{WSB(WS_BIG), NPROJ, (const float*)(F.ws + WS_XNS), (const float*)(F.ws + WS_SBI) + l * NPROJ};
          pg8::gemm_phase<pg8::EpiBf16S, pg8::StaticOrder, true, true>(F.lds, g, S, E); }
#if DBL_PHASE == 1
        { pg8::Gemm g{WSB(WS_XN), (const bf16*)((const signed char*)(F.ws + WS_WIN) + (size_t)l * NPROJ * D), D / 2}; pg8::StaticOrder S; S.init(M, NPROJ, F.G, F.bx);
          pg8::EpiBf16S E{WSB(WS_BIG), NPROJ, (const float*)(F.ws + WS_XNS), (const float*)(F.ws + WS_SBI) + l * NPROJ};
          pg8::gemm_phase<pg8::EpiBf16S, pg8::StaticOrder, true, true>(F.lds, g, S, E); }
#endif
        GRID_BAR(); STAMP(1 + 1 + (l == 0 ? 0 : 7));
        mixer_2a(F, args, l);
#if DBL_PHASE == 20
        mixer_2a(F, args, l);
#endif
        GRID_BAR();
        mixer_2b(F, args, l);
#if DBL_PHASE == 21
        mixer_2b(F, args, l);
#endif
        mixer_2bc_seam(F, l);
        mixer_2c(F, args, l);
#if DBL_PHASE == 22
        mixer_2c(F, args, l);
#endif
        GRID_BAR(); STAMP(1 + 2 + (l == 0 ? 0 : 7));
        { pg8::Gemm g{WSB(WS_MIX), WSB(WS_WOUT) + (size_t)l * D * D, D}; pg8::StaticOrder S; S.init(M, D, F.G, F.bx);
          if constexpr (l == 0) { pg8::EpiResBf<true> E{args.in[0], WSB(WS_XR), D, nullptr}; pg8::gemm_phase<pg8::EpiResBf<true>, pg8::StaticOrder, false>(F.lds, g, S, E); }
          else { pg8::EpiResBf<false> E{WSB(WS_XR), WSB(WS_XR), D, nullptr}; pg8::gemm_phase<pg8::EpiResBf<false>, pg8::StaticOrder, false>(F.lds, g, S, E); } }
#if DBL_PHASE == 41
        if constexpr (l == 0) { pg8::Gemm g{WSB(WS_MIX), WSB(WS_WOUT), D}; pg8::StaticOrder S; S.init(M, D, F.G, F.bx);
          pg8::EpiResBf<true> E{args.in[0], WSB(WS_XR), D, nullptr}; pg8::gemm_phase<pg8::EpiResBf<true>, pg8::StaticOrder, false>(F.lds, g, S, E); }
#endif
        GRID_BAR(); STAMP(1 + 3 + (l == 0 ? 0 : 7));
        if constexpr (l == 0) {
            norm_phase<0, true, true>(F, (const float*)(F.ws + WS_XR), args.in[4], nullptr, 0);
            GRID_BAR(); STAMP(5);
            { pg8::Gemm g{WSB(WS_XN), WSB(WS_WGU), D / 2}; pg8::StaticOrder S; S.init(M, 2 * FDP, F.G, F.bx);
              pg8::EpiSwiGLU8<true> E{WSB(WS_BIG), FDP, (const float*)(F.ws + WS_XNS), (const float*)(F.ws + WS_SBD)};
              pg8::gemm_phase<pg8::EpiSwiGLU8<true>, pg8::StaticOrder, true, true>(F.lds, g, S, E); }
#if DBL_PHASE == 4
        { pg8::Gemm g{WSB(WS_XN), WSB(WS_WGU), D / 2}; pg8::StaticOrder S; S.init(M, 2 * FDP, F.G, F.bx);
              pg8::EpiSwiGLU8<true> E{WSB(WS_BIG), FDP, (const float*)(F.ws + WS_XNS), (const float*)(F.ws + WS_SBD)};
              pg8::gemm_phase<pg8::EpiSwiGLU8<true>, pg8::StaticOrder, true, true>(F.lds, g, S, E); }
#endif
            GRID_BAR(); STAMP(6);
            { pg8::Gemm g{WSB(WS_BIG), WSB(WS_WD), FDP / 2}; pg8::StaticOrder S; S.init(M, D, F.G, F.bx);
              pg8::EpiResBf<false> E{WSB(WS_XR), WSB(WS_XR), D, (const float*)(F.ws + WS_SBWD)};
              pg8::gemm_phase<pg8::EpiResBf<false>, pg8::StaticOrder, false, false, true>(F.lds, g, S, E); }
            GRID_BAR(); STAMP(7);
            norm_phase<1, true, true>(F, (const float*)(F.ws + WS_XR), args.in[3] + D, args.in[1] + (size_t)D * NIN + 2048, NIN);
            GRID_BAR(); STAMP(8);
        } else {
            norm_phase<2, true, true>(F, (const float*)(F.ws + WS_XR), args.in[4] + D, args.in[22], 8);
            GRID_BAR(); STAMP(12);
            if (F.tid == 0) { int acc = 0;
                for (int e = 0; e < 8; ++e) { const int c = (int)__hip_atomic_load(F.ctl + CW_CNT + 64 * e, RLX_AGENT); F.META[e] = c; F.META[8 + e] = acc; acc += (c + 255) >> 8; }
                F.META[16] = acc; }
            __syncthreads();
            const int ptot = F.META[16];
            {
                const int p0 = 0; int np = ptot; if (np > 136) np = 136; const int slab = 0; (void)slab;
                { pg8::Gemm g{WSB(0), WSB(WS_EGU), D / 2}; pg8::GroupedOrder S{2 * FE / 256, p0, np, F.G, F.bx, 0, F.META, 0, 0, 1};
                  pg8::EpiSwiGLU8<true> E{WSB(WS_BIG), FE, (const float*)(F.ws + WS_XGS2), (const float*)(F.ws + WS_SBE)};
                  pg8::gemm_phase<pg8::EpiSwiGLU8<true>, pg8::GroupedOrder, true, true>(F.lds, g, S, E); }
#if DBL_PHASE == 5
        { pg8::Gemm g{WSB(0), WSB(WS_EGU), D / 2}; pg8::GroupedOrder S{2 * FE / 256, p0, np, F.G, F.bx, 0, F.META, 0, 0, 1};
                  pg8::EpiSwiGLU8<true> E{WSB(WS_BIG), FE, (const float*)(F.ws + WS_XGS2), (const float*)(F.ws + WS_SBE)};
                  pg8::gemm_phase<pg8::EpiSwiGLU8<true>, pg8::GroupedOrder, true, true>(F.lds, g, S, E); }
#endif
                GRID_BAR(); STAMP(14 + 2 * slab);
                { pg8::Gemm g{WSB(WS_BIG), WSB(WS_ED), FE / 2}; pg8::GroupedOrder S{D / 256, p0, np, F.G, F.bx, 1, F.META, 512, 4};
                  pg8::EpiYMoE E{WSB(WS_MIX), WSB(WS_XN), D, (const float*)(F.ws + WS_SBED), 512};
                  pg8::gemm_phase<pg8::EpiYMoE, pg8::GroupedOrder, true, false, true>(F.lds, g, S, E); }
#if DBL_PHASE == 6
        { pg8::Gemm g{WSB(WS_BIG), WSB(WS_ED), FE / 2}; pg8::GroupedOrder S{D / 256, p0, np, F.G, F.bx, 1, F.META, 512, 4};
                  pg8::EpiYMoE E{WSB(WS_MIX), WSB(WS_XN), D, (const float*)(F.ws + WS_SBED), 512};
                  pg8::gemm_phase<pg8::EpiYMoE, pg8::GroupedOrder, true, false, true>(F.lds, g, S, E); }
#endif
                GRID_BAR(); STAMP(15 + 2 * slab);
            }
#ifdef PROBE_A
            if (F.bx == 0 && threadIdx.x == 0) { const LAS unsigned long long* ts = (const LAS unsigned long long*)(F.lds + LDSCTL_OFF + 2048);
                float ta = 0.f, tbv = 0.f;
                for (int i = 1; i <= 17; ++i) { const float d = (float)(ts[i] - ts[i - 1]) * 0.01f;
                    if ((PROBE_A >> i) & 1) ta += d; if ((PROBE_B >> i) & 1) tbv += d; }
                ((float*)(F.ws + WS_CTL))[100] = ta / PROBE_SA; ((float*)(F.ws + WS_CTL))[101] = tbv / PROBE_SB * 100.0f; }
            GRID_BAR();
#endif
            combine_phase(F, args);
#ifdef PROBE_A
            GRID_BAR();
            { const float eps = ((const float*)(F.ws + WS_CTL))[100], vv = ((const float*)(F.ws + WS_CTL))[101];
              for (size_t i = (size_t)F.bx * 512 + threadIdx.x; i < (size_t)M * D; i += (size_t)F.G * 512) F.out[i] = (i == 0) ? vv : F.out[i] * (1.0f + eps); }
#endif
        }
}
__global__ void __launch_bounds__(NWAVES * 64, 2) mk_fwd(Args args) {
    extern __shared__ __attribute__((aligned(16))) unsigned char lds[];
    Frame F;
    F.lds = (LAS unsigned char*)lds;
    F.MISC = (volatile LAS unsigned*)(F.lds + MISC_OFF);
    F.META = (LAS int*)(F.lds + MISC_OFF + 64);
    F.tid = threadIdx.x; F.lane = F.tid & 63; F.wave = __builtin_amdgcn_readfirstlane(F.tid >> 6);
    F.G = gridDim.x; F.bx = blockIdx.x;
    F.ws = args.ws; F.out = args.out;
    F.ctl = (gu32*)(F.ws + WS_CTL);
    for (int u = F.tid; u < (LDS_BYTES - LDSCTL_OFF) / 4; u += NWAVES * 64) ((LAS unsigned*)(F.lds + LDSCTL_OFF))[u] = 0u;
    __syncthreads();
    XcdBarrier bar = xcd_barrier_post((unsigned*)(F.ctl + CW_BAR), F.MISC + 8);
    STAMP(0);
    p0_weights(F, args);
    __syncthreads();
#ifdef EXPERTS_IN_P0
    expert_weights(F, args);
#endif
#if DBL_PHASE == 0
    p0_weights(F, args);
    __syncthreads();
#endif
    __syncthreads();
    norm_phase<1, true>(F, args.in[0], args.in[3], args.in[1] + 2048, NIN);
    GRID_BAR(); STAMP(1);
    layer_body<0>(F, args, bar);
    layer_body<1>(F, args, bar);
}

extern "C" void kernel_launch(void* const* d_in, const int* in_sizes, int n_in, void* d_out, int out_size, void* d_ws, size_t ws_size, hipStream_t stream) {
    static int grid = 0;
    if (grid == 0) {
        if (n_in != 26 || in_sizes[0] != M * D || out_size != M * D || ws_size < WS_END) { fprintf(stderr, "kernel_launch: unexpected shapes (n_in %d, in0 %d, out %d, ws %zu); nothing launched\n", n_in, n_in > 0 ? in_sizes[0] : -1, out_size, ws_size); grid = -1; return; }
        int dev = 0, cus = 0, per_cu = 0;
        if (hipGetDevice(&dev) != hipSuccess || hipDeviceGetAttribute(&cus, hipDeviceAttributeMultiprocessorCount, dev) != hipSuccess) { grid = -1; return; }
        if (hipFuncSetAttribute((const void*)mk_fwd, hipFuncAttributeMaxDynamicSharedMemorySize, LDS_BYTES) != hipSuccess) { fprintf(stderr, "kernel_launch: hipFuncSetAttribute failed\n"); grid = -1; return; }
        if (hipOccupancyMaxActiveBlocksPerMultiprocessor(&per_cu, (const void*)mk_fwd, NWAVES * 64, LDS_BYTES) != hipSuccess || per_cu < 1) fprintf(stderr, "kernel_launch: occupancy query reports %d blocks per CU\n", per_cu);
        (void)hipGetLastError();
        grid = cus;
    }
    if (grid < 0) return;
    if (hipMemsetAsync((char*)d_ws + WS_CTL, 0, CTL_ZERO_BYTES, stream) != hipSuccess) return;
    Args a{};
    for (int i = 0; i < 26; ++i) a.in[i] = (const float*)d_in[i];
    a.out = (float*)d_out; a.ws = (unsigned char*)d_ws;
    hipLaunchKernelGGL(mk_fwd, dim3(grid), dim3(NWAVES * 64), LDS_BYTES, stream, a);
}
```

```cpp
#include <hip/hip_runtime.h>
#include <cstdio>
#include <cstdint>
namespace pg8 {
#define PG8_LAS __attribute__((address_space(3)))
typedef unsigned short bf16_t;
typedef short bf16x8 __attribute__((ext_vector_type(8)));
typedef float f32x4 __attribute__((ext_vector_type(4)));
typedef unsigned u32x4 __attribute__((ext_vector_type(4)));
constexpr int BM = 256, BK = 64, HALF = 128, HTB = HALF * BK * 2  , STAGE_BYTES = 8 * HTB, NXCD = 8, WGM = 8;

__host__ __device__ __forceinline__ int lds_byte(int r, int c) { const int st = (r >> 4) * 2 + (c >> 5), rr = r & 15, cc = c & 31, ob = rr * 64 + cc * 2; return st * 1024 + (ob ^ (((ob >> 9) & 1) << 5)); }
__host__ __device__ __forceinline__ void stage_rc(int b, int& R, int& C) { const int st = b / 1024, sb = b % 1024, swz = sb ^ (((sb >> 9) & 1) << 5); R = (st >> 1) * 16 + swz / 64; C = (st & 1) * 32 + (swz % 64) / 2; }
__host__ __device__ __forceinline__ int perm32(int rho) { const int n = rho >> 4, i = rho & 15; return 8 * (i >> 2) + 4 * n + (i & 3); }

struct Unit { int pm, pn, cn, po, e, j, koff, kt, split; };
struct Gemm { const bf16_t* A; const bf16_t* Bt; int K; };

struct StaticOrder {
    int nM, nN, nwg, G, c;
    __host__ __device__ void init(int M, int N, int G_, int c_) { nM = M / BM; nN = N / BM; nwg = nM * nN; G = G_; c = c_; }
    __host__ __device__ bool next(int i, Unit& u) const {
        const long L = (long)i * G + c; if (L >= nwg) return false;
        int wgid = (int)L; { const int q = nwg / NXCD, r = nwg % NXCD, xcd = wgid % NXCD, off = wgid / NXCD; wgid = (xcd < r ? xcd * (q + 1) : r * (q + 1) + (xcd - r) * q) + off; }
        const int nig = WGM * nN, gid = wgid / nig, fm = gid * WGM, gsz = (nM - fm) < WGM ? (nM - fm) : WGM;
        u.pm = fm + ((wgid % nig) % gsz); u.pn = (wgid % nig) / gsz; u.cn = u.pn; u.po = u.pm; u.e = 0; u.j = 0; u.koff = 0; u.kt = 0; u.split = 0; return true;
    }
};
struct GroupedOrder {
    int nN, p0, np, G, c, a_local;
    const PG8_LAS int* meta;
    int ksb, kst;
    int aregion;
    __device__ __forceinline__ bool next(int i, Unit& u) const {
        int pl, n, koff = 0, kt = 0, split = 0;
        if (a_local && nN == 4 && G == 256) {
            {
            const int nfull = np < 128 ? np : 128, pl0 = ((c >> 3) >> 2) * 8 + (c & 7);
            const int nmine = (pl0 < nfull ? 1 : 0) + (64 + pl0 < nfull ? 1 : 0);
            if (i < nmine) { pl = i * 64 + pl0; n = (c >> 3) & 3; }
            else if (i == nmine) { if (c >= (np - nfull) * 28) return false; pl = nfull + c / 28; const int rem = c - (c / 28) * 28; n = rem / 7; koff = (rem - n * 7) * ksb; kt = kst; split = 1; }
            else return false;
            }
        } else { const int L = i * G + c; if (L >= np * nN) return false; pl = L / nN; n = L - pl * nN; }
        const int p = p0 + pl;
        int e = 0;
#pragma unroll
        for (int k = 1; k < 8; ++k) e += (p >= meta[8 + k]) ? 1 : 0;
        e = __builtin_amdgcn_readfirstlane(e);
        u.e = e; u.j = 0; u.pm = a_local ? pl : p; u.po = a_local ? p : pl;
        if (aregion) u.pm = (e < 6 ? (203 + 16 * e) * 4 : (2 + 16 * (e - 6)) * 4) + (p - meta[8 + e]); u.pn = e * nN + n; u.cn = n; u.koff = koff; u.kt = kt; u.split = split; return true;
    }
};

__device__ __forceinline__ unsigned cvt_pk_bf16(float lo, float hi) { unsigned r; asm volatile("v_cvt_pk_bf16_f32 %0, %1, %2" : "=v"(r) : "v"(lo), "v"(hi)); return r; }

#ifdef EPI_NT
#define PG8_ST16(p, v) __builtin_nontemporal_store((v), (u32x4*)(p))
#define PG8_ST16F(p, v) __builtin_nontemporal_store((v), (f32x4*)(p))
#else
#define PG8_ST16(p, v) (*(u32x4*)(p) = (v))
#define PG8_ST16F(p, v) (*(f32x4*)(p) = (v))
#endif
struct EpiBf16 {
    static constexpr bool PERM = true, AFTER_DRAIN = false;
    bf16_t* O; int ldc;
    __device__ __forceinline__ void operator()(const f32x4 (&acc)[2][2][4][2], const Unit& u, int wr, int wc, int fr, int fq) const {
        const int row0 = u.po * BM + wr * 64 + fr, col0 = u.cn * BM + wc * 32 + 8 * fq;
#pragma unroll
        for (int ai = 0; ai < 2; ++ai)
#pragma unroll
            for (int m = 0; m < 4; ++m) { bf16_t* rowp = O + (size_t)(row0 + ai * HALF + m * 16) * ldc + col0;
#pragma unroll
                for (int bj = 0; bj < 2; ++bj) { const f32x4 v0 = acc[ai][bj][m][0], v1 = acc[ai][bj][m][1];
                    u32x4 w; w.x = cvt_pk_bf16(v0[0], v0[1]); w.y = cvt_pk_bf16(v0[2], v0[3]); w.z = cvt_pk_bf16(v1[0], v1[1]); w.w = cvt_pk_bf16(v1[2], v1[3]);
                    PG8_ST16(rowp + bj * HALF, w); } }
    }
};
__device__ __forceinline__ float silu_mul(float g, float u) { return g * u * __builtin_amdgcn_rcpf(1.0f + __builtin_amdgcn_exp2f(-1.4426950408889634f * g)); }
struct EpiSwiGLU {
    static constexpr bool PERM = true, AFTER_DRAIN = false;
    bf16_t* O; int ldc;
    __device__ __forceinline__ void operator()(const f32x4 (&acc)[2][2][4][2], const Unit& u, int wr, int wc, int fr, int fq) const {
        const int row0 = u.po * BM + wr * 64 + fr, col0 = u.cn * HALF + wc * 32 + 8 * fq;
#pragma unroll
        for (int ai = 0; ai < 2; ++ai)
#pragma unroll
            for (int m = 0; m < 4; ++m) { bf16_t* rowp = O + (size_t)(row0 + ai * HALF + m * 16) * ldc + col0;
                const f32x4 g0 = acc[ai][0][m][0], g1 = acc[ai][0][m][1], u0 = acc[ai][1][m][0], u1 = acc[ai][1][m][1];
                u32x4 w; w.x = cvt_pk_bf16(silu_mul(g0[0], u0[0]), silu_mul(g0[1], u0[1])); w.y = cvt_pk_bf16(silu_mul(g0[2], u0[2]), silu_mul(g0[3], u0[3]));
                w.z = cvt_pk_bf16(silu_mul(g1[0], u1[0]), silu_mul(g1[1], u1[1])); w.w = cvt_pk_bf16(silu_mul(g1[2], u1[2]), silu_mul(g1[3], u1[3]));
                PG8_ST16(rowp, w); asm volatile("" ::: "memory"); }
    }
};
struct EpiBf16S {
    static constexpr bool PERM = true, AFTER_DRAIN = false;
    bf16_t* O; int ldc; const float* sa; const float* sb;
    __device__ __forceinline__ void operator()(const int __attribute__((ext_vector_type(4))) (&acc)[2][2][4][2], const Unit& u, int wr, int wc, int fr, int fq) const {
        const int row0 = u.po * BM + wr * 64 + fr, col0 = u.cn * BM + wc * 32 + 8 * fq;
        const float* sbp = sb + (size_t)u.pn * BM + wc * 32 + 8 * fq;
        f32x4 s4[2][2];
#pragma unroll
        for (int bj = 0; bj < 2; ++bj) { s4[bj][0] = *(const f32x4*)(sbp + bj * HALF); s4[bj][1] = *(const f32x4*)(sbp + bj * HALF + 4); }
        float av[2][4];
#pragma unroll
        for (int ai = 0; ai < 2; ++ai)
#pragma unroll
            for (int m = 0; m < 4; ++m) av[ai][m] = sa[(size_t)u.pm * BM + wr * 64 + fr + ai * HALF + m * 16];
#pragma unroll
        for (int ai = 0; ai < 2; ++ai)
#pragma unroll
            for (int m = 0; m < 4; ++m) { bf16_t* rowp = O + (size_t)(row0 + ai * HALF + m * 16) * ldc + col0;
                const float a = av[ai][m];
#pragma unroll
                for (int bj = 0; bj < 2; ++bj) { const f32x4 v0 = __builtin_convertvector(acc[ai][bj][m][0], f32x4) * s4[bj][0] * a, v1 = __builtin_convertvector(acc[ai][bj][m][1], f32x4) * s4[bj][1] * a;
                    u32x4 w; w.x = cvt_pk_bf16(v0[0], v0[1]); w.y = cvt_pk_bf16(v0[2], v0[3]); w.z = cvt_pk_bf16(v1[0], v1[1]); w.w = cvt_pk_bf16(v1[2], v1[3]);
                    PG8_ST16(rowp + bj * HALF, w); }
                asm volatile("" ::: "memory"); }
    }
};
__device__ __forceinline__ unsigned pk4_fp8(float a, float b, float c, float d) {
    a = __builtin_amdgcn_fmed3f(a, -448.f, 448.f); b = __builtin_amdgcn_fmed3f(b, -448.f, 448.f); c = __builtin_amdgcn_fmed3f(c, -448.f, 448.f); d = __builtin_amdgcn_fmed3f(d, -448.f, 448.f);
    int w = __builtin_amdgcn_cvt_pk_fp8_f32(a, b, 0, false); w = __builtin_amdgcn_cvt_pk_fp8_f32(c, d, w, true); return (unsigned)w; }
template <bool F8OUT> struct EpiSwiGLU8 {
    static constexpr bool PERM = true, AFTER_DRAIN = false;
    bf16_t* O; int ldc; const float* sa; const float* sb;
    __device__ __forceinline__ void operator()(const int __attribute__((ext_vector_type(4))) (&acc)[2][2][4][2], const Unit& u, int wr, int wc, int fr, int fq) const {
        const int row0 = u.po * BM + wr * 64 + fr, col0 = u.cn * HALF + wc * 32 + 8 * fq;
        const float* sbp = sb + (size_t)u.pn * BM + wc * 32 + 8 * fq;
        const f32x4 sg0 = *(const f32x4*)(sbp), sg1 = *(const f32x4*)(sbp + 4), su0 = *(const f32x4*)(sbp + HALF), su1 = *(const f32x4*)(sbp + HALF + 4);
        float av[2][4];
#pragma unroll
        for (int ai = 0; ai < 2; ++ai)
#pragma unroll
            for (int m = 0; m < 4; ++m) av[ai][m] = sa[(size_t)u.pm * BM + wr * 64 + fr + ai * HALF + m * 16];
#pragma unroll
        for (int ai = 0; ai < 2; ++ai)
#pragma unroll
            for (int m = 0; m < 4; ++m) {
                const float a = av[ai][m];
                const f32x4 g0 = __builtin_convertvector(acc[ai][0][m][0], f32x4) * sg0 * a, g1 = __builtin_convertvector(acc[ai][0][m][1], f32x4) * sg1 * a;
                const f32x4 u0 = __builtin_convertvector(acc[ai][1][m][0], f32x4) * su0 * a, u1 = __builtin_convertvector(acc[ai][1][m][1], f32x4) * su1 * a;
                if constexpr (F8OUT) { unsigned char* rowp = (unsigned char*)O + (size_t)(row0 + ai * HALF + m * 16) * ldc + col0;
                    typedef unsigned u32x2 __attribute__((ext_vector_type(2))); u32x2 w;
                    w.x = pk4_fp8(silu_mul(g0[0], u0[0]), silu_mul(g0[1], u0[1]), silu_mul(g0[2], u0[2]), silu_mul(g0[3], u0[3]));
                    w.y = pk4_fp8(silu_mul(g1[0], u1[0]), silu_mul(g1[1], u1[1]), silu_mul(g1[2], u1[2]), silu_mul(g1[3], u1[3]));
                    *(u32x2*)rowp = w;
                } else { bf16_t* rowp = O + (size_t)(row0 + ai * HALF + m * 16) * ldc + col0;
                    u32x4 w; w.x = cvt_pk_bf16(silu_mul(g0[0], u0[0]), silu_mul(g0[1], u0[1])); w.y = cvt_pk_bf16(silu_mul(g0[2], u0[2]), silu_mul(g0[3], u0[3]));
                    w.z = cvt_pk_bf16(silu_mul(g1[0], u1[0]), silu_mul(g1[1], u1[1])); w.w = cvt_pk_bf16(silu_mul(g1[2], u1[2]), silu_mul(g1[3], u1[3]));
                    PG8_ST16(rowp, w); }
                asm volatile("" ::: "memory"); }
    }
};
struct EpiYMoE {
    static constexpr bool PERM = true, AFTER_DRAIN = false;
    bf16_t* O; bf16_t* Ypart; int ldc; const float* sb; int ksb;
    __device__ __forceinline__ void operator()(const f32x4 (&acc)[2][2][4][2], const Unit& u, int wr, int wc, int fr, int fq) const {
        const int col0 = u.cn * BM + wc * 32 + 8 * fq;
        bf16_t* base = u.split ? Ypart + ((size_t)(u.koff / ksb) * 2048 + (size_t)(u.po - 128) * BM) * ldc : O + (size_t)u.po * BM * ldc;
        const int row0 = wr * 64 + fr;
        const float* sbp = sb + (size_t)u.pn * BM + wc * 32 + 8 * fq;
        f32x4 s4[2][2];
#pragma unroll
        for (int bj = 0; bj < 2; ++bj) { s4[bj][0] = *(const f32x4*)(sbp + bj * HALF); s4[bj][1] = *(const f32x4*)(sbp + bj * HALF + 4); }
#pragma unroll
        for (int ai = 0; ai < 2; ++ai)
#pragma unroll
            for (int m = 0; m < 4; ++m) { bf16_t* rowp = base + (size_t)(row0 + ai * HALF + m * 16) * ldc + col0;
#pragma unroll
                for (int bj = 0; bj < 2; ++bj) { const f32x4 v0 = acc[ai][bj][m][0] * s4[bj][0], v1 = acc[ai][bj][m][1] * s4[bj][1];
                    u32x4 w; w.x = cvt_pk_bf16(v0[0], v0[1]); w.y = cvt_pk_bf16(v0[2], v0[3]); w.z = cvt_pk_bf16(v1[0], v1[1]); w.w = cvt_pk_bf16(v1[2], v1[3]);
                    PG8_ST16(rowp + bj * HALF, w); }
                asm volatile("" ::: "memory"); }
    }
};
template <bool BASE_F32> struct EpiResBf {
    static constexpr bool PERM = true, AFTER_DRAIN = false;
    const void* base; bf16_t* out; int ldc; const float* sb;
    __device__ __forceinline__ void operator()(const f32x4 (&acc)[2][2][4][2], const Unit& u, int wr, int wc, int fr, int fq) const {
        const int row0 = u.po * BM + wr * 64 + fr, col0 = u.cn * BM + wc * 32 + 8 * fq;
        f32x4 s[2][2];
#pragma unroll
        for (int bj = 0; bj < 2; ++bj) { s[bj][0] = (f32x4){1.f, 1.f, 1.f, 1.f}; s[bj][1] = s[bj][0]; if (sb) { s[bj][0] = *(const f32x4*)(sb + col0 + bj * HALF); s[bj][1] = *(const f32x4*)(sb + col0 + bj * HALF + 4); } }
        if constexpr (BASE_F32) {
#pragma unroll
            for (int ai = 0; ai < 2; ++ai) {
                f32x4 b[4][2][2];
#pragma unroll
                for (int m = 0; m < 4; ++m)
#pragma unroll
                    for (int bj = 0; bj < 2; ++bj) { const float* bp = (const float*)base + (size_t)(row0 + ai * HALF + m * 16) * ldc + col0 + bj * HALF; b[m][bj][0] = *(const f32x4*)bp; b[m][bj][1] = *(const f32x4*)(bp + 4); }
#pragma unroll
                for (int m = 0; m < 4; ++m) { const size_t off = (size_t)(row0 + ai * HALF + m * 16) * ldc + col0;
#pragma unroll
                    for (int bj = 0; bj < 2; ++bj) { const f32x4 v0 = b[m][bj][0] + acc[ai][bj][m][0] * s[bj][0], v1 = b[m][bj][1] + acc[ai][bj][m][1] * s[bj][1];
                        u32x4 w; w.x = cvt_pk_bf16(v0[0], v0[1]); w.y = cvt_pk_bf16(v0[2], v0[3]); w.z = cvt_pk_bf16(v1[0], v1[1]); w.w = cvt_pk_bf16(v1[2], v1[3]);
                        PG8_ST16(out + off + bj * HALF, w); } }
                asm volatile("" ::: "memory"); }
        } else {
            u32x4 b[2][4][2];
#pragma unroll
            for (int ai = 0; ai < 2; ++ai)
#pragma unroll
                for (int m = 0; m < 4; ++m)
#pragma unroll
                    for (int bj = 0; bj < 2; ++bj) b[ai][m][bj] = *(const u32x4*)((const bf16_t*)base + (size_t)(row0 + ai * HALF + m * 16) * ldc + col0 + bj * HALF);
#pragma unroll
            for (int ai = 0; ai < 2; ++ai)
#pragma unroll
                for (int m = 0; m < 4; ++m) { const size_t off = (size_t)(row0 + ai * HALF + m * 16) * ldc + col0;
#pragma unroll
                    for (int bj = 0; bj < 2; ++bj) { const u32x4 w0 = b[ai][m][bj];
                        const f32x4 b0 = (f32x4){__uint_as_float(w0.x << 16), __uint_as_float(w0.x & 0xffff0000u), __uint_as_float(w0.y << 16), __uint_as_float(w0.y & 0xffff0000u)};
                        const f32x4 b1 = (f32x4){__uint_as_float(w0.z << 16), __uint_as_float(w0.z & 0xffff0000u), __uint_as_float(w0.w << 16), __uint_as_float(w0.w & 0xffff0000u)};
                        const f32x4 v0 = b0 + acc[ai][bj][m][0] * s[bj][0], v1 = b1 + acc[ai][bj][m][1] * s[bj][1];
                        u32x4 w; w.x = cvt_pk_bf16(v0[0], v0[1]); w.y = cvt_pk_bf16(v0[2], v0[3]); w.z = cvt_pk_bf16(v1[0], v1[1]); w.w = cvt_pk_bf16(v1[2], v1[3]);
                        PG8_ST16(out + off + bj * HALF, w); }
                    asm volatile("" ::: "memory"); }
        }
    }
};
struct EpiResF32 {
    static constexpr bool PERM = false, AFTER_DRAIN = false;
    const float* base; float* out; int ldc; const float* sb;
    __device__ __forceinline__ void operator()(const f32x4 (&acc)[2][2][4][2], const Unit& u, int wr, int wc, int fr, int fq) const {
        const int row0 = u.po * BM + wr * 64 + fr, col0 = u.cn * BM + wc * 32 + 4 * fq;
#pragma unroll
        for (int ai = 0; ai < 2; ++ai)
#pragma unroll
            for (int m = 0; m < 4; ++m) { const size_t off = (size_t)(row0 + ai * HALF + m * 16) * ldc + col0;
#pragma unroll
                for (int bj = 0; bj < 2; ++bj)
#pragma unroll
                    for (int n = 0; n < 2; ++n) { const f32x4 bs = *(const f32x4*)(base + off + bj * HALF + n * 16);
                        const f32x4 s = sb ? *(const f32x4*)(sb + col0 + bj * HALF + n * 16) : (f32x4){1.f, 1.f, 1.f, 1.f};
                        PG8_ST16F(out + off + bj * HALF + n * 16, bs + acc[ai][bj][m][n] * s); }
                asm volatile("" ::: "memory"); }
    }
};
typedef int i32x4 __attribute__((ext_vector_type(4)));
template <bool I8> struct AccT { typedef f32x4 type; };
template <> struct AccT<true> { typedef i32x4 type; };
template <bool I8> __device__ __forceinline__ typename AccT<I8>::type mma16(const bf16x8 b, const bf16x8 a, const typename AccT<I8>::type c);
template <> __device__ __forceinline__ f32x4 mma16<false>(const bf16x8 b, const bf16x8 a, const f32x4 c) { return __builtin_amdgcn_mfma_f32_16x16x32_bf16(b, a, c, 0, 0, 0); }
template <> __device__ __forceinline__ i32x4 mma16<true>(const bf16x8 b, const bf16x8 a, const i32x4 c) { return __builtin_amdgcn_mfma_i32_16x16x64_i8(__builtin_bit_cast(i32x4, b), __builtin_bit_cast(i32x4, a), c, 0, 0, 0); }
typedef int i32x8 __attribute__((ext_vector_type(8)));
__device__ __forceinline__ void mma_f8(f32x4& c, const i32x8 b, const i32x8 a, const int one) {
    asm volatile("v_mfma_scale_f32_16x16x128_f8f6f4 %0, %1, %2, %0, %3, %3 op_sel_hi:[0,0,0]" : "+v"(c) : "v"(b), "v"(a), "v"(one));
}
template <class Epi, class Sched, bool ALIGN_EPI, bool I8 = false, bool F8 = false>
__device__ __forceinline__ void gemm_phase(PG8_LAS unsigned char* lds, const Gemm g, const Sched& S, const Epi& E) {
    int tid_ = threadIdx.x; asm volatile("" : "+v"(tid_));
    const int tid = tid_, wid = __builtin_amdgcn_readfirstlane(tid >> 6), lane = tid & 63, wr = wid >> 2, wc = wid & 3, fr = lane & 15, fq = lane >> 4;
    const int K = g.K, nt = K / BK;
    unsigned voffA[2], voffB[2];
#pragma unroll
    for (int i = 0; i < 2; ++i) { int R, C; stage_rc(tid * 16 + i * 8192, R, C); const int Rb = Epi::PERM ? ((R & ~31) + perm32(R & 31)) : R;
        voffA[i] = (unsigned)(R * K + C) * 2u; voffB[i] = (unsigned)(Rb * K + C) * 2u; }
    const size_t kstep = (size_t)(BK * 2);
    const size_t hstep = (size_t)HALF * K * 2;
    const size_t tstep = 2 * hstep;
    const unsigned ldsw = (unsigned)wid * 1024u;
    const int aoff = lds_byte(wr * 64 + fr, fq * 8), boff = lds_byte(wc * 32 + fr, fq * 8);
#define PG8_SA(b, h) (((b) * 2 + (h)) * HTB)
#define PG8_SB(b, h) ((4 + (b) * 2 + (h)) * HTB)
#define PG8_STAGE(bufoff, gbase, voff) do { _Pragma("unroll") for (int _i = 0; _i < 2; ++_i) \
        __builtin_amdgcn_global_load_lds((const unsigned*)((const char*)(gbase) + (voff)[_i]), (PG8_LAS unsigned*)(lds + (bufoff) + ldsw + _i * 8192), 16, 0, 0); } while (0)
#define PG8_LDA(dst, b, h) do { if constexpr (F8) { _Pragma("unroll") for (int m = 0; m < 4; ++m) { const i32x4 lo_ = *(const PG8_LAS i32x4*)(lds + PG8_SA(b, h) + aoff + m * 2048), hi_ = *(const PG8_LAS i32x4*)(lds + PG8_SA(b, h) + aoff + m * 2048 + 1024); dst##8[m] = __builtin_shufflevector(lo_, hi_, 0, 1, 2, 3, 4, 5, 6, 7); } } \
        else { _Pragma("unroll") for (int m = 0; m < 4; ++m) _Pragma("unroll") for (int k = 0; k < 2; ++k) dst[m][k] = *(const PG8_LAS bf16x8*)(lds + PG8_SA(b, h) + aoff + m * 2048 + k * 1024); } } while (0)
#define PG8_LDB(dst, b, h) do { if constexpr (F8) { _Pragma("unroll") for (int n = 0; n < 2; ++n) { const i32x4 lo_ = *(const PG8_LAS i32x4*)(lds + PG8_SB(b, h) + boff + n * 2048), hi_ = *(const PG8_LAS i32x4*)(lds + PG8_SB(b, h) + boff + n * 2048 + 1024); dst##8[n] = __builtin_shufflevector(lo_, hi_, 0, 1, 2, 3, 4, 5, 6, 7); } } \
        else { _Pragma("unroll") for (int n = 0; n < 2; ++n) _Pragma("unroll") for (int k = 0; k < 2; ++k) dst[n][k] = *(const PG8_LAS bf16x8*)(lds + PG8_SB(b, h) + boff + n * 2048 + k * 1024); } } while (0)
#define PG8_MMA(ai, bj, At, Bt) do { __builtin_amdgcn_s_setprio(1); \
        if constexpr (F8) { _Pragma("unroll") for (int m = 0; m < 4; ++m) _Pragma("unroll") for (int n = 0; n < 2; ++n) mma_f8(acc[ai][bj][m][n], Bt##8[n], At##8[m], f8one); } \
        else { _Pragma("unroll") for (int m = 0; m < 4; ++m) _Pragma("unroll") for (int n = 0; n < 2; ++n) _Pragma("unroll") for (int k = 0; k < 2; ++k) \
            acc[ai][bj][m][n] = mma16<I8>(Bt[n][k], At[m][k], acc[ai][bj][m][n]); } __builtin_amdgcn_s_setprio(0); } while (0)
#define PG8_WAIT_V(n) asm volatile("s_waitcnt vmcnt(" #n ")" ::: "memory")
#define PG8_WAIT_L(n) asm volatile("s_waitcnt lgkmcnt(" #n ")" ::: "memory")
#define PG8_BAR __builtin_amdgcn_s_barrier()
#define PG8_SCHED __builtin_amdgcn_sched_barrier(0)
    Unit cur, nxt; int ui = 0;
    if (!S.next(0, cur)) return;
    typedef typename AccT<I8>::type acc_t;
    acc_t acc[2][2][4][2];
#pragma unroll
    for (int a = 0; a < 2; ++a)
#pragma unroll
        for (int b = 0; b < 2; ++b)
#pragma unroll
            for (int m = 0; m < 4; ++m)
#pragma unroll
                for (int n = 0; n < 2; ++n) acc[a][b][m][n] = (acc_t){0, 0, 0, 0};
    bf16x8 At[4][2], B0[2][2], B1[2][2];
    int f8one = 0x7f7f7f7f; asm volatile("" : "+v"(f8one));
    i32x8 At8[4], B08[2], B18[2];
    const char* cA = (const char*)g.A + (size_t)cur.pm * tstep + cur.koff; const char* cB = (const char*)g.Bt + (size_t)cur.pn * tstep + cur.koff;
    PG8_STAGE(PG8_SB(0, 0), cB, voffB); PG8_STAGE(PG8_SB(0, 1), cB + hstep, voffB); PG8_STAGE(PG8_SA(0, 0), cA, voffA); PG8_STAGE(PG8_SA(0, 1), cA + hstep, voffA);
    if (wr == 1) PG8_BAR;
    PG8_WAIT_V(2); PG8_BAR;
    PG8_STAGE(PG8_SB(1, 0), cB + kstep, voffB); PG8_STAGE(PG8_SA(1, 0), cA + kstep, voffA); PG8_STAGE(PG8_SB(1, 1), cB + hstep + kstep, voffB);
    PG8_WAIT_V(6); PG8_BAR;
    for (;;) {
        const bool has_next = S.next(ui + 1, nxt);
        const char* nA = has_next ? (const char*)g.A + (size_t)nxt.pm * tstep + nxt.koff : cA; const char* nB = has_next ? (const char*)g.Bt + (size_t)nxt.pn * tstep + nxt.koff : cB;
        const int ntc = cur.kt ? cur.kt : nt;
        for (int t = 0; t < ntc; t += 2) {
            const bool last = (t == ntc - 2);
            const char* a1 = cA + (size_t)(t + 1) * kstep;
            const char* a2 = last ? nA : cA + (size_t)(t + 2) * kstep; const char* b2 = last ? nB : cB + (size_t)(t + 2) * kstep;
            const char* a3 = a2 + kstep; const char* b3 = b2 + kstep;
            PG8_LDB(B0, 0, 0); PG8_LDB(B1, 0, 1); PG8_SCHED; PG8_LDA(At, 0, 0); PG8_STAGE(PG8_SA(1, 1), a1 + hstep, voffA);
            PG8_WAIT_V(8); PG8_WAIT_L(0); PG8_BAR; PG8_MMA(0, 0, At, B0); PG8_MMA(0, 1, At, B1); PG8_BAR; PG8_SCHED;
            PG8_LDA(At, 0, 1); PG8_STAGE(PG8_SB(0, 0), b2, voffB); PG8_STAGE(PG8_SB(0, 1), b2 + hstep, voffB); PG8_STAGE(PG8_SA(0, 0), a2, voffA);
            PG8_WAIT_V(8); PG8_WAIT_L(0); PG8_BAR; PG8_MMA(1, 0, At, B0); PG8_MMA(1, 1, At, B1); PG8_BAR; PG8_SCHED;
            PG8_LDB(B0, 1, 0); PG8_LDB(B1, 1, 1); PG8_SCHED; PG8_LDA(At, 1, 0); PG8_STAGE(PG8_SA(0, 1), a2 + hstep, voffA);
            PG8_WAIT_V(8); PG8_WAIT_L(0); PG8_BAR; PG8_MMA(0, 0, At, B0); PG8_MMA(0, 1, At, B1); PG8_BAR; PG8_SCHED;
            PG8_LDA(At, 1, 1); PG8_STAGE(PG8_SB(1, 0), b3, voffB); PG8_STAGE(PG8_SB(1, 1), b3 + hstep, voffB); PG8_STAGE(PG8_SA(1, 0), a3, voffA);
            PG8_WAIT_V(8); PG8_WAIT_L(0); PG8_BAR; PG8_MMA(1, 0, At, B0); PG8_MMA(1, 1, At, B1); PG8_BAR; PG8_SCHED;
        }
        if constexpr (ALIGN_EPI) { if (wr == 0) PG8_BAR; }
        if constexpr (F8) asm volatile("s_nop 15\n\ts_nop 15" ::: "memory");
        if constexpr (!Epi::AFTER_DRAIN) E(acc, cur, wr, wc, fr, fq);
#if defined(DBL_PHASE) && DBL_PHASE == 30
        if constexpr (I8) { asm volatile("" ::: "memory"); E(acc, cur, wr, wc, fr, fq); }
#endif
        if (!has_next) break;
#pragma unroll
        for (int a = 0; a < 2; ++a)
#pragma unroll
            for (int b = 0; b < 2; ++b)
#pragma unroll
                for (int m = 0; m < 4; ++m)
#pragma unroll
                    for (int n = 0; n < 2; ++n) acc[a][b][m][n] = (acc_t){0, 0, 0, 0};
        cur = nxt; cA = nA; cB = nB; ++ui;
        if constexpr (ALIGN_EPI) { if (wr == 1) PG8_BAR; }
    }
    PG8_WAIT_V(0);
    if constexpr (!ALIGN_EPI) { if (wr == 0) PG8_BAR; }
    PG8_BAR;
    if constexpr (Epi::AFTER_DRAIN) E.fused(acc, cur, wr, wc, fr, fq, lds, wid, lane);
#undef PG8_SA
#undef PG8_SB
#undef PG8_STAGE
#undef PG8_LDA
#undef PG8_LDB
#undef PG8_MMA
#undef PG8_WAIT_V
#undef PG8_WAIT_L
#undef PG8_BAR
#undef PG8_SCHED
}
}
constexpr int NWAVES = 8;
constexpr int SEQ = 8192, M = 16384, D = 1024, NIN = 3080, NPROJ = 3072;
constexpr int FD = 2752, FDP = 2816, FE = 3584, NEXP = 8;
constexpr float EPS = 1e-6f, LOG2E = 1.4426950408889634f;
constexpr int PC_Q = 0, PC_K = 256, PC_V = 512, PC_Z = 768, PC_XBC = 1280, PC_RQ = 2048, PC_RK = 2304, PC_RV = 2560, PC_RG = 2816;
constexpr size_t MiB = 1u << 20;
constexpr size_t WS_CTL = 0, CTL_ZERO_BYTES = 1 * MiB;
constexpr size_t WS_WIN = 2 * MiB;
constexpr size_t WS_WOUT = 14 * MiB;
constexpr size_t WS_WGU = 18 * MiB;
constexpr size_t WS_WD = 29 * MiB;
constexpr size_t WS_EGU = 35 * MiB;
constexpr size_t WS_ED = 147 * MiB;
constexpr size_t WS_XN = 203 * MiB;
constexpr size_t WS_MIX = 235 * MiB;
constexpr size_t WS_BIG = 303 * MiB;
constexpr size_t WS_SMALL = 430 * MiB;
constexpr size_t WS_DT = WS_SMALL, WS_TI = WS_SMALL + 512 * 1024, WS_TG = WS_SMALL + 768 * 1024, WS_LIST = WS_SMALL + 1024 * 1024;
constexpr size_t WS_XCH = 434 * MiB;
constexpr size_t WS_END = 438 * MiB;
constexpr size_t WS_SST = 203 * MiB;
constexpr size_t WS_RST = 219 * MiB;
constexpr size_t WS_QR = 227 * MiB;
constexpr size_t WS_YD = 267 * MiB;
constexpr size_t WS_OI = 283 * MiB;
constexpr size_t WS_XC = 399 * MiB;
constexpr size_t WS_SBD = WS_SMALL + 2176 * 1024, WS_SBE = WS_SMALL + 2240 * 1024;
constexpr size_t WS_SBI = WS_SMALL + 2900 * 1024;
constexpr size_t WS_SBWD = WS_SMALL + 2930 * 1024, WS_SBED = WS_SMALL + 2940 * 1024;
constexpr size_t WS_XR = 91 * MiB;
constexpr size_t WS_XNS = WS_SMALL + 2560 * 1024, WS_XGS = WS_SMALL + 2688 * 1024;
constexpr size_t WS_XGS2 = 299 * MiB;
__host__ __device__ constexpr int xg_panel(int e) { return e < 6 ? (203 + 16 * e) * 4 : (2 + 16 * (e - 6)) * 4; }
constexpr size_t WS_XG8 = 269 * MiB;
constexpr size_t WS_DTOT = WS_SMALL + 1536 * 1024, WS_EOFF = WS_SMALL + 1600 * 1024;
constexpr int SLAB0_PANELS = 64, SLAB1_MAX = 72;
constexpr int CW_BAR = 4096;
constexpr int CW_SEAM = 16384, SEAM_BANK = 64 * 64;
constexpr int CW_SCAN = 20480;
constexpr int CW_CNT = 8192;
constexpr int RING_BYTES = 131072;
constexpr int LDSCTL_OFF = RING_BYTES, MISC_OFF = LDSCTL_OFF + 320;
constexpr int LDS_BYTES = 147456;
#define GAS __attribute__((address_space(1)))
#define LAS __attribute__((address_space(3)))
typedef unsigned short bf16;
typedef unsigned v4u __attribute__((ext_vector_type(4)));
typedef float f32x4 __attribute__((ext_vector_type(4)));
typedef short bf16x8 __attribute__((ext_vector_type(8)));
typedef GAS unsigned gu32;
typedef GAS unsigned long long gu64;
#define RLX_AGENT __ATOMIC_RELAXED, __HIP_MEMORY_SCOPE_AGENT
#define LDS_WAIT() asm volatile("s_waitcnt lgkmcnt(0)" ::: "memory")
#define VM_WAIT() asm volatile("s_waitcnt vmcnt(0)" ::: "memory")
__device__ __forceinline__ unsigned long long rt() { return __builtin_amdgcn_s_memrealtime(); }
__device__ __forceinline__ unsigned f2bf(float f) { unsigned u = __builtin_bit_cast(unsigned, f); return (u + 0x7fffu + ((u >> 16) & 1u)) >> 16; }
typedef float f32x2_t __attribute__((ext_vector_type(2))); typedef __bf16 bf16x2_t __attribute__((ext_vector_type(2)));
__device__ __forceinline__ unsigned pk2(float lo, float hi) { f32x2_t v = {lo, hi}; bf16x2_t b = __builtin_convertvector(v, bf16x2_t); return __builtin_bit_cast(unsigned, b); }

#define XB_TMO      128
#define XB_XCNT(j)  (256  + 64 * (j))
#define XB_XSUB(j)  (1280 + 64 * (j))
#define XB_XGEN(j)  (2304 + 64 * (j))
#define XB_TOP      3328
#define XB_TOPGEN   3392
#define XCD_BAR_WORDS 3456
#define XB_SPIN_CAP (1u << 18)

__device__ __forceinline__ unsigned xb_ld(unsigned* p)              { return __hip_atomic_load(p, __ATOMIC_RELAXED, __HIP_MEMORY_SCOPE_AGENT); }
__device__ __forceinline__ unsigned xb_add(unsigned* p, unsigned v) { return __hip_atomic_fetch_add(p, v, __ATOMIC_RELAXED, __HIP_MEMORY_SCOPE_AGENT); }
__device__ __forceinline__ unsigned xb_xcc_id() { return (unsigned)__builtin_amdgcn_s_getreg((3 << 11) | 20) & 0xFu; }
#define XB_SPIN(cond, bar) do { unsigned _sp = 0; while (cond) { __builtin_amdgcn_s_sleep(1); \
    if ((++_sp & 255u) == 0u) { if (xb_ld(&(bar)[XB_TMO])) break; if (_sp > XB_SPIN_CAP) { atomicAdd(&(bar)[XB_TMO], 1u); break; } } } } while (0)

struct XcdBarrier {
    unsigned* bar; unsigned x;
    volatile LAS unsigned* st;
};

__device__ __forceinline__ XcdBarrier xcd_barrier_post(unsigned* bar, volatile LAS unsigned* st) {
    XcdBarrier b; b.bar = bar; b.x = xb_xcc_id(); b.st = st;
    if (threadIdx.x == 0) (void)xb_add(&bar[XB_XCNT(b.x)], 1u);
    return b;
}
__device__ __forceinline__ void xcd_barrier_complete(unsigned* bar, unsigned x, unsigned& nloc, unsigned& nx) {
    const unsigned G = gridDim.x * gridDim.y * gridDim.z;
    unsigned sum, cnt, mine, sp = 0u;
    for (;;) {
        sum = 0u; cnt = 0u; mine = 0u;
#pragma unroll
        for (unsigned j = 0; j < 16; ++j) { const unsigned c = xb_ld(&bar[XB_XCNT(j)]); sum += c; cnt += (c > 0u) ? 1u : 0u; mine = (j == x) ? c : mine; }
        if (sum == G) break;
        __builtin_amdgcn_s_sleep(1);
        if ((++sp & 255u) == 0u) { if (xb_ld(&bar[XB_TMO])) break; if (sp > XB_SPIN_CAP) { atomicAdd(&bar[XB_TMO], 1u); break; } }
    }
    nloc = mine > 0u ? mine : 1u; nx = cnt > 0u ? cnt : 1u;
}

__device__ __forceinline__ void xcd_barrier(const XcdBarrier& b) {
    asm volatile("s_waitcnt vmcnt(0)" ::: "memory");
    __syncthreads();
    if (threadIdx.x == 0) {
        unsigned* bar = b.bar;
        __builtin_amdgcn_s_waitcnt(0);
        unsigned nloc = b.st[0], nx = b.st[1];
        if (nloc == 0u) { xcd_barrier_complete(bar, b.x, nloc, nx); b.st[0] = nloc; b.st[1] = nx; }
        const unsigned old = xb_add(&bar[XB_XSUB(b.x)], 1u);
        const unsigned gen = old / nloc;
        if (old + 1u == (gen + 1u) * nloc) {
            __builtin_amdgcn_fence(__ATOMIC_RELEASE, "agent");
            asm volatile("s_waitcnt vmcnt(0)" ::: "memory");
            const unsigned og = xb_add(&bar[XB_TOP], 1u);
            const unsigned tg = og / nx;
            if (og + 1u == (tg + 1u) * nx) xb_add(&bar[XB_TOPGEN], 1u);
            else XB_SPIN(xb_ld(&bar[XB_TOPGEN]) == tg, bar);
            __builtin_amdgcn_fence(__ATOMIC_ACQUIRE, "agent");
            xb_add(&bar[XB_XGEN(b.x)], 1u);
            asm volatile("s_waitcnt vmcnt(0)" ::: "memory");
        } else {
            XB_SPIN(xb_ld(&bar[XB_XGEN(b.x)]) == gen, bar);
            __builtin_amdgcn_fence(__ATOMIC_ACQUIRE, "agent");
            asm volatile("s_waitcnt vmcnt(0)" ::: "memory");
        }
    }
    __syncthreads();
}

struct Args { const float* in[26]; float* out; unsigned char* ws; };
struct Frame {
    LAS unsigned char* lds;
    volatile LAS unsigned* MISC;
    LAS int* META;
    gu32* ctl;
    unsigned char* ws; float* out;
    int tid, lane, wave, G, bx;
};
__device__ __forceinline__ Frame refresh(const Frame& f) { Frame r = f; int t = threadIdx.x; asm volatile("" : "+v"(t)); r.tid = t; r.lane = t & 63; r.wave = __builtin_amdgcn_readfirstlane(t >> 6); return r; }
__device__ __forceinline__ float bf2f(unsigned short u) { return __uint_as_float((unsigned)u << 16); }
__device__ __forceinline__ float bflo(unsigned w) { return __uint_as_float(w << 16); }
__device__ __forceinline__ float bfhi(unsigned w) { return __uint_as_float(w & 0xffff0000u); }
__device__ __forceinline__ float wave_sum(float v) {
#pragma unroll
    for (int o = 1; o < 64; o <<= 1) v += __shfl_xor(v, o);
    return v;
}
__device__ __forceinline__ float silu_f(float v) { return v * __builtin_amdgcn_rcpf(1.0f + __builtin_amdgcn_exp2f(-LOG2E * v)); }

__device__ __forceinline__ void tr_item(const float* W, int ldw, int k0, int nsrc0, bool valid, bf16* WT, int ldk, int drow0, float scale, LAS float* scr, int lane) {
    (void)scr;
    const int c4 = lane & 7, r8 = lane >> 3;
    f32x4 v[8];
    if (valid) { const float* wp = W + (size_t)(k0 + 8 * r8) * ldw + nsrc0 + 4 * c4;
#pragma unroll
        for (int i = 0; i < 8; ++i) v[i] = *(const f32x4*)(wp + (size_t)i * ldw) * scale;
    } else {
#pragma unroll
        for (int i = 0; i < 8; ++i) v[i] = (f32x4){0.f, 0.f, 0.f, 0.f};
    }
#pragma unroll
    for (int j = 0; j < 4; ++j) { v4u o; o.x = pk2(v[0][j], v[1][j]); o.y = pk2(v[2][j], v[3][j]); o.z = pk2(v[4][j], v[5][j]); o.w = pk2(v[6][j], v[7][j]);
        *(GAS v4u*)(WT + (size_t)(drow0 + 4 * c4 + j) * ldk + k0 + 8 * r8) = o; }
}
__device__ __forceinline__ void q_item(const float* W, int ldw, int nsrc0, bool valid, signed char* WT8, int drow0, float* sb, float post, LAS unsigned char* lds, int wave, int lane) {
    LAS float* cm = (LAS float*)lds;
    const int c4 = lane & 7, rs = lane >> 3;
    f32x4 v[16]; f32x4 mx = (f32x4){0.f, 0.f, 0.f, 0.f};
    if (valid) { const float* wp = W + (size_t)(wave * 128 + 16 * rs) * ldw + nsrc0 + 4 * c4;
#pragma unroll
        for (int i = 0; i < 16; ++i) v[i] = *(const f32x4*)(wp + (size_t)i * ldw);
#pragma unroll
        for (int i = 0; i < 16; ++i) { mx.x = fmaxf(mx.x, fabsf(v[i].x)); mx.y = fmaxf(mx.y, fabsf(v[i].y)); mx.z = fmaxf(mx.z, fabsf(v[i].z)); mx.w = fmaxf(mx.w, fabsf(v[i].w)); }
    } else {
#pragma unroll
        for (int i = 0; i < 16; ++i) v[i] = (f32x4){0.f, 0.f, 0.f, 0.f};
    }
#pragma unroll
    for (int o = 8; o < 64; o <<= 1) { mx.x = fmaxf(mx.x, __shfl_xor(mx.x, o)); mx.y = fmaxf(mx.y, __shfl_xor(mx.y, o)); mx.z = fmaxf(mx.z, __shfl_xor(mx.z, o)); mx.w = fmaxf(mx.w, __shfl_xor(mx.w, o)); }
    __syncthreads();
    if (rs == 0) *(LAS f32x4*)(cm + wave * 32 + 4 * c4) = mx;
    __syncthreads();
    f32x4 bm = *(const LAS f32x4*)(cm + 4 * c4);
#pragma unroll
    for (int w = 1; w < 8; ++w) { const f32x4 t = *(const LAS f32x4*)(cm + w * 32 + 4 * c4); bm.x = fmaxf(bm.x, t.x); bm.y = fmaxf(bm.y, t.y); bm.z = fmaxf(bm.z, t.z); bm.w = fmaxf(bm.w, t.w); }
    f32x4 sc; sc.x = bm.x > 0.f ? 127.0f / bm.x : 0.f; sc.y = bm.y > 0.f ? 127.0f / bm.y : 0.f; sc.z = bm.z > 0.f ? 127.0f / bm.z : 0.f; sc.w = bm.w > 0.f ? 127.0f / bm.w : 0.f;
#pragma unroll
    for (int j = 0; j < 4; ++j) { v4u o;
#pragma unroll
        for (int g = 0; g < 4; ++g) { const int q0 = (int)rintf(v[4 * g][j] * sc[j]), q1 = (int)rintf(v[4 * g + 1][j] * sc[j]), q2 = (int)rintf(v[4 * g + 2][j] * sc[j]), q3 = (int)rintf(v[4 * g + 3][j] * sc[j]);
            o[g] = (unsigned)(q0 & 255) | ((unsigned)(q1 & 255) << 8) | ((unsigned)(q2 & 255) << 16) | ((unsigned)(q3 & 255) << 24); }
        *(GAS v4u*)(WT8 + (size_t)(drow0 + 4 * c4 + j) * 1024 + wave * 128 + 16 * rs) = o; }
    if (wave == 0 && rs == 0) *(f32x4*)(sb + drow0 + 4 * c4) = bm * ((1.0f / 127.0f) * post);
}
__device__ __forceinline__ void f8_item(const float* W, int Kvalid, int Kdst, int nsrc0, unsigned char* WT8, int drow0, float* sb, LAS unsigned char* lds, int wave, int lane) {
    LAS float* cm = (LAS float*)lds;
    const int c4 = lane & 7, rs = lane >> 3, slot = wave * 8 + rs;
    const float* wp = W + nsrc0 + 4 * c4;
    f32x4 mx = (f32x4){0.f, 0.f, 0.f, 0.f};
#pragma unroll 16
    for (int k = slot; k < Kvalid; k += 64) { const f32x4 v = *(const f32x4*)(wp + (size_t)k * 1024); mx.x = fmaxf(mx.x, fabsf(v.x)); mx.y = fmaxf(mx.y, fabsf(v.y)); mx.z = fmaxf(mx.z, fabsf(v.z)); mx.w = fmaxf(mx.w, fabsf(v.w)); }
#pragma unroll
    for (int o = 8; o < 64; o <<= 1) { mx.x = fmaxf(mx.x, __shfl_xor(mx.x, o)); mx.y = fmaxf(mx.y, __shfl_xor(mx.y, o)); mx.z = fmaxf(mx.z, __shfl_xor(mx.z, o)); mx.w = fmaxf(mx.w, __shfl_xor(mx.w, o)); }
    __syncthreads();
    if (rs == 0) *(LAS f32x4*)(cm + wave * 32 + 4 * c4) = mx;
    __syncthreads();
    f32x4 bm = *(const LAS f32x4*)(cm + 4 * c4);
#pragma unroll
    for (int w = 1; w < 8; ++w) { const f32x4 t = *(const LAS f32x4*)(cm + w * 32 + 4 * c4); bm.x = fmaxf(bm.x, t.x); bm.y = fmaxf(bm.y, t.y); bm.z = fmaxf(bm.z, t.z); bm.w = fmaxf(bm.w, t.w); }
    f32x4 sc; sc.x = bm.x > 0.f ? 384.0f / bm.x : 0.f; sc.y = bm.y > 0.f ? 384.0f / bm.y : 0.f; sc.z = bm.z > 0.f ? 384.0f / bm.z : 0.f; sc.w = bm.w > 0.f ? 384.0f / bm.w : 0.f;
    for (int q = slot; q * 16 < Kdst; q += 64) {
        f32x4 v[16];
#pragma unroll
        for (int i = 0; i < 16; ++i) { const int k = q * 16 + i; v[i] = k < Kvalid ? *(const f32x4*)(wp + (size_t)k * 1024) : (f32x4){0.f, 0.f, 0.f, 0.f}; }
#pragma unroll
        for (int j = 0; j < 4; ++j) { v4u o;
#pragma unroll
            for (int g = 0; g < 4; ++g) o[g] = pg8::pk4_fp8(v[4 * g][j] * sc[j], v[4 * g + 1][j] * sc[j], v[4 * g + 2][j] * sc[j], v[4 * g + 3][j] * sc[j]);
            *(GAS v4u*)(WT8 + (size_t)(drow0 + 4 * c4 + j) * Kdst + q * 16) = o; }
    }
    if (wave == 0 && rs == 0) *(f32x4*)(sb + drow0 + 4 * c4) = bm * (1.0f / 384.0f);
}
constexpr float C2Q = 0.17677669529663687f * LOG2E;
__device__ __forceinline__ void p0_weights(Frame& F_, const Args& A) {
    Frame F = refresh(F_);
    for (int it0 = F.bx; it0 < 192 + 176 + 32; it0 += F.G) { int it = it0;
        if (it >= 192 + 176) { const int nb = it - 368; f8_item(A.in[21], FD, FDP, nb * 32, (unsigned char*)(F.ws + WS_WD), nb * 32, (float*)(F.ws + WS_SBWD), (LAS unsigned char*)F.lds, F.wave, F.lane); continue; }
        if (it < 192) { const int l = it / 96, nb = it - l * 96; const float post = nb < 8 ? C2Q : ((nb >= 72 && nb < 80) ? 0.125f : 1.0f);
            q_item(A.in[1] + (size_t)l * D * NIN, NIN, nb < 64 ? nb * 32 : nb * 32 + 8, true, (signed char*)(F.ws + WS_WIN) + (size_t)l * NPROJ * D, nb * 32, (float*)(F.ws + WS_SBI) + l * NPROJ, post, (LAS unsigned char*)F.lds, F.wave, F.lane); continue; }
        it -= 192;
        { const int nb = it, t = nb >> 3, sub = nb & 7, fcol = t * 128 + (sub & 3) * 32;
            q_item(sub < 4 ? A.in[19] : A.in[20], FD, fcol, fcol < FD, (signed char*)(F.ws + WS_WGU), nb * 32, (float*)(F.ws + WS_SBD), 1.0f, (LAS unsigned char*)F.lds, F.wave, F.lane); }
    }
    __syncthreads();
    LAS float* scr = (LAS float*)(F.lds + F.wave * 16384);
    const int gw = F.bx * NWAVES + F.wave, NGW = F.G * NWAVES;
    constexpr int I_OUT = 32 * 16;
    for (int it = gw; it < 2 * I_OUT; it += NGW) { const int l = it / I_OUT, r = it - l * I_OUT, kb = r / 32, nb = r % 32;
        tr_item(A.in[2] + (size_t)l * D * D, D, kb * 64, nb * 32, true, ((bf16*)(F.ws + WS_WOUT)) + (size_t)l * D * D, D, nb * 32, 1.0f, scr, F.lane); }
}
__device__ __forceinline__ void expert_weights(Frame& F_, const Args& A) {
    Frame F = refresh(F_);
    for (int r = F.bx; r < NEXP * 224; r += F.G) { const int e = r / 224, nb = r - e * 224, t = nb >> 3, sub = nb & 7, fcol = t * 128 + (sub & 3) * 32;
        q_item((sub < 4 ? A.in[23] : A.in[24]) + (size_t)e * D * FE, FE, fcol, true, (signed char*)(F.ws + WS_EGU) + (size_t)e * 2 * FE * D, nb * 32, (float*)(F.ws + WS_SBE) + e * 2 * FE, 1.0f, (LAS unsigned char*)F.lds, F.wave, F.lane); }
    for (int r = F.bx; r < NEXP * 32; r += F.G) { const int e = r >> 5, nb = r & 31;
        f8_item(A.in[25] + (size_t)e * FE * D, FE, FE, nb * 32, (unsigned char*)(F.ws + WS_ED) + (size_t)e * D * FE, nb * 32, (float*)(F.ws + WS_SBED) + e * D, (LAS unsigned char*)F.lds, F.wave, F.lane); }
    __syncthreads();
}

struct W16 { float v[16]; };
__device__ __forceinline__ W16 norm_wload(const float* wx, int ldw) { W16 w; const int tid = threadIdx.x;
#pragma unroll
    for (int i = 0; i < 16; ++i) { const int idx = tid + 512 * i, k = idx >> 3, j = idx & 7; w.v[i] = wx[(size_t)k * ldw + j]; }
    return w; }
template <int MODE, bool OUT8 = false, bool SRC16 = false, bool PRE = false>
__device__ __forceinline__ void norm_phase(Frame& F_, const float* src, const float* gain, const float* wx, int ldw, const W16 wpre = W16{}) {
    Frame F = refresh(F_);
    LAS float* Wl = (LAS float*)F.lds;
    if (MODE != 0) {
        if constexpr (PRE) {
#pragma unroll
            for (int i = 0; i < 16; ++i) { const int idx = F.tid + 512 * i, k = idx >> 3, j = idx & 7; Wl[j * D + k] = wpre.v[i]; }
        } else { for (int idx = F.tid; idx < 8 * D; idx += NWAVES * 64) { const int k = idx >> 3, j = idx & 7; Wl[j * D + k] = wx[(size_t)k * ldw + j]; } }
        __syncthreads();
    }
    const int hl = F.lane & 31, hw = F.lane >> 5, gw = F.bx * NWAVES + F.wave, NGW = F.G * NWAVES;
    f32x4 g8[4][2];
#pragma unroll
    for (int j = 0; j < 4; ++j) { g8[j][0] = *(const f32x4*)(gain + 8 * (hl + 32 * j)); g8[j][1] = *(const f32x4*)(gain + 8 * (hl + 32 * j) + 4); }
#define NP_HSUM(x) do { _Pragma("unroll") for (int o_ = 1; o_ < 32; o_ <<= 1) x += __shfl_xor(x, o_); } while (0)
    for (int m = 2 * gw + hw; m < M; m += 2 * NGW) {
        f32x4 v[4][2]; float s = 0.f; uint2 q8[4]; float qsc = 0.f; (void)q8; (void)qsc;
        if constexpr (SRC16) { const v4u* xr = (const v4u*)((const bf16*)src + (size_t)m * D) + hl;
#pragma unroll
            for (int j = 0; j < 4; ++j) { const v4u w = xr[32 * j]; v[j][0] = (f32x4){bflo(w.x), bfhi(w.x), bflo(w.y), bfhi(w.y)}; v[j][1] = (f32x4){bflo(w.z), bfhi(w.z), bflo(w.w), bfhi(w.w)}; }
        } else { const f32x4* xr = (const f32x4*)(src + (size_t)m * D) + 2 * hl;
#pragma unroll
            for (int j = 0; j < 4; ++j) { v[j][0] = xr[64 * j]; v[j][1] = xr[64 * j + 1]; } }
#pragma unroll
        for (int j = 0; j < 4; ++j)
#pragma unroll
            for (int t = 0; t < 2; ++t) s += (v[j][t].x * v[j][t].x + v[j][t].y * v[j][t].y) + (v[j][t].z * v[j][t].z + v[j][t].w * v[j][t].w);
        NP_HSUM(s);
        const float rstd = __builtin_amdgcn_rsqf(s * (1.f / D) + EPS);
        float amax = 0.f;
#pragma unroll
        for (int j = 0; j < 4; ++j)
#pragma unroll
            for (int t = 0; t < 2; ++t) { v[j][t] = v[j][t] * rstd * g8[j][t]; amax = fmaxf(amax, fmaxf(fmaxf(fabsf(v[j][t].x), fabsf(v[j][t].y)), fmaxf(fabsf(v[j][t].z), fabsf(v[j][t].w)))); }
        if (!OUT8) {
            v4u* o16 = (v4u*)(((bf16*)(F.ws + WS_XN)) + (size_t)m * D) + hl;
#pragma unroll
            for (int j = 0; j < 4; ++j) { v4u o; o.x = pk2(v[j][0].x, v[j][0].y); o.y = pk2(v[j][0].z, v[j][0].w); o.z = pk2(v[j][1].x, v[j][1].y); o.w = pk2(v[j][1].z, v[j][1].w); o16[32 * j] = o; }
        } else {
#pragma unroll
            for (int o = 1; o < 32; o <<= 1) amax = fmaxf(amax, __shfl_xor(amax, o));
            const float qs = amax > 0.f ? 127.0f / amax : 0.f;
            uint2* o8 = (uint2*)(F.ws + WS_XN + (size_t)m * D) + hl;
            (void)o8;
#pragma unroll
            for (int j = 0; j < 4; ++j) { uint2 o;
                { const int q0 = (int)rintf(v[j][0].x * qs), q1 = (int)rintf(v[j][0].y * qs), q2 = (int)rintf(v[j][0].z * qs), q3 = (int)rintf(v[j][0].w * qs); o.x = (unsigned)(q0 & 255) | ((unsigned)(q1 & 255) << 8) | ((unsigned)(q2 & 255) << 16) | ((unsigned)(q3 & 255) << 24); }
                { const int q0 = (int)rintf(v[j][1].x * qs), q1 = (int)rintf(v[j][1].y * qs), q2 = (int)rintf(v[j][1].z * qs), q3 = (int)rintf(v[j][1].w * qs); o.y = (unsigned)(q0 & 255) | ((unsigned)(q1 & 255) << 8) | ((unsigned)(q2 & 255) << 16) | ((unsigned)(q3 & 255) << 24); }
                if constexpr (MODE == 2) q8[j] = o; else o8[32 * j] = o; }
            if constexpr (MODE == 2) qsc = amax * (1.0f / 127.0f); else if (hl == 0) ((float*)(F.ws + WS_XNS))[m] = amax * (1.0f / 127.0f);
        }
        if (MODE != 0) {
            float ex[8];
#pragma unroll
            for (int e = 0; e < 8; ++e) { float a = 0.f;
#pragma unroll
                for (int j = 0; j < 4; ++j) { const f32x4 w0 = *(const LAS f32x4*)(Wl + e * D + 8 * (hl + 32 * j)), w1 = *(const LAS f32x4*)(Wl + e * D + 8 * (hl + 32 * j) + 4);
                    a += (v[j][0].x * w0.x + v[j][0].y * w0.y) + (v[j][0].z * w0.z + v[j][0].w * w0.w) + (v[j][1].x * w1.x + v[j][1].y * w1.y) + (v[j][1].z * w1.z + v[j][1].w * w1.w); }
                NP_HSUM(a); ex[e] = a; asm volatile("" ::: "memory"); }
            if (MODE == 1) {
                float val = ex[0];
#pragma unroll
                for (int e = 1; e < 8; ++e) val = (hl == e) ? ex[e] : val;
                if (hl < 8) ((float*)(F.ws + WS_DT))[(size_t)m * 8 + hl] = val;
            } else {
                int e0 = 0; float v0 = ex[0];
#pragma unroll
                for (int e = 1; e < 8; ++e) if (ex[e] > v0) { v0 = ex[e]; e0 = e; }
                int e1 = -1; float v1 = -3.0e38f;
#pragma unroll
                for (int e = 0; e < 8; ++e) if (e != e0 && ex[e] > v1) { v1 = ex[e]; e1 = e; }
                int pos0 = 0, pos1 = 0;
                if (hl == 0) {
                    const float g0 = 1.0f / (1.0f + __expf(v1 - v0)), g1 = 1.0f - g0;
                    pos0 = (int)atomicAdd((unsigned*)(F.ctl + CW_CNT + 64 * e0), 1u); pos1 = (int)atomicAdd((unsigned*)(F.ctl + CW_CNT + 64 * e1), 1u);
                    ((int*)(F.ws + WS_TI))[m * 4 + 0] = e0 | (e1 << 8); ((int*)(F.ws + WS_TI))[m * 4 + 1] = pos0; ((int*)(F.ws + WS_TI))[m * 4 + 2] = pos1; ((int*)(F.ws + WS_TI))[m * 4 + 3] = 0;
                    ((float*)(F.ws + WS_TG))[m * 2 + 0] = g0; ((float*)(F.ws + WS_TG))[m * 2 + 1] = g1;
                }
                pos0 = __shfl(pos0, hw * 32); pos1 = __shfl(pos1, hw * 32);
                { const int pa = xg_panel(e0), pb = xg_panel(e1);
                  uint2* d0 = (uint2*)(F.ws + (size_t)pa * 262144 + (size_t)pos0 * 1024) + hl; uint2* d1 = (uint2*)(F.ws + (size_t)pb * 262144 + (size_t)pos1 * 1024) + hl;
#pragma unroll
                  for (int j = 0; j < 4; ++j) { d0[32 * j] = q8[j]; d1[32 * j] = q8[j]; }
                  if (hl == 0) { ((float*)(F.ws + WS_XGS2))[pa * 256 + pos0] = qsc; ((float*)(F.ws + WS_XGS2))[pb * 256 + pos1] = qsc; } }
            }
        }
    }
#undef NP_HSUM
    if (MODE != 0) __syncthreads();
}
__device__ __forceinline__ void combine_phase(Frame& F_, const Args& A) {
    Frame F = refresh(F_);
    const int hl = F.lane & 31, hw = F.lane >> 5, gw = F.bx * NWAVES + F.wave, NGW = F.G * NWAVES;
    f32x4 g8[4][2];
#pragma unroll
    for (int j = 0; j < 4; ++j) { g8[j][0] = *(const f32x4*)(A.in[5] + 8 * (hl + 32 * j)); g8[j][1] = *(const f32x4*)(A.in[5] + 8 * (hl + 32 * j) + 4); }
    for (int m = 2 * gw + hw; m < M; m += 2 * NGW) {
        const int ti = ((int*)(F.ws + WS_TI))[m * 4], e0 = ti & 255, e1 = ti >> 8;
        const size_t r0 = (size_t)F.META[8 + e0] * 256 + ((int*)(F.ws + WS_TI))[m * 4 + 1], r1 = (size_t)F.META[8 + e1] * 256 + ((int*)(F.ws + WS_TI))[m * 4 + 2];
        const float g0 = ((float*)(F.ws + WS_TG))[m * 2], g1 = ((float*)(F.ws + WS_TG))[m * 2 + 1];
        const v4u* xb = (const v4u*)((const bf16*)(F.ws + WS_XR) + (size_t)m * D) + hl;
        const v4u* y0 = (const v4u*)(((const bf16*)(F.ws + WS_MIX)) + r0 * D) + hl; const v4u* y1 = (const v4u*)(((const bf16*)(F.ws + WS_MIX)) + r1 * D) + hl;
        const v4u* z0 = (const v4u*)(((const bf16*)(F.ws + WS_XN)) + (r0 >= 32768 ? r0 - 32768 : 0) * D) + hl; const v4u* z1 = (const v4u*)(((const bf16*)(F.ws + WS_XN)) + (r1 >= 32768 ? r1 - 32768 : 0) * D) + hl;
        f32x4 v[4][2]; float s = 0.f;
#define CB_LO(w_) ((f32x4){bflo((w_).x), bfhi((w_).x), bflo((w_).y), bfhi((w_).y)})
#define CB_HI(w_) ((f32x4){bflo((w_).z), bfhi((w_).z), bflo((w_).w), bfhi((w_).w)})
#pragma unroll
        for (int j = 0; j < 4; ++j) { f32x4 ya0, ya1, yb0, yb1;
            if (r0 >= 32768) { ya0 = (f32x4){0.f, 0.f, 0.f, 0.f}; ya1 = ya0;
#pragma unroll
                for (int ks = 0; ks < 7; ++ks) { const v4u a = z0[(size_t)ks * 2048 * 128 + 32 * j]; ya0 += CB_LO(a); ya1 += CB_HI(a); } }
            else { const v4u a = y0[32 * j]; ya0 = CB_LO(a); ya1 = CB_HI(a); }
            if (r1 >= 32768) { yb0 = (f32x4){0.f, 0.f, 0.f, 0.f}; yb1 = yb0;
#pragma unroll
                for (int ks = 0; ks < 7; ++ks) { const v4u b = z1[(size_t)ks * 2048 * 128 + 32 * j]; yb0 += CB_LO(b); yb1 += CB_HI(b); } }
            else { const v4u b = y1[32 * j]; yb0 = CB_LO(b); yb1 = CB_HI(b); }
            const v4u xw = xb[32 * j];
            v[j][0] = CB_LO(xw) + ya0 * g0 + yb0 * g1; v[j][1] = CB_HI(xw) + ya1 * g0 + yb1 * g1;
            s += (v[j][0].x * v[j][0].x + v[j][0].y * v[j][0].y) + (v[j][0].z * v[j][0].z + v[j][0].w * v[j][0].w) + (v[j][1].x * v[j][1].x + v[j][1].y * v[j][1].y) + (v[j][1].z * v[j][1].z + v[j][1].w * v[j][1].w); }
#undef CB_LO
#undef CB_HI
#pragma unroll
        for (int o = 1; o < 32; o <<= 1) s += __shfl_xor(s, o);
        const float rstd = __builtin_amdgcn_rsqf(s * (1.f / D) + EPS);
        f32x4* xr = (f32x4*)(F.out + (size_t)m * D) + 2 * hl;
#pragma unroll
        for (int j = 0; j < 4; ++j) { xr[64 * j] = v[j][0] * rstd * g8[j][0]; xr[64 * j + 1] = v[j][1] * rstd * g8[j][1]; }
    }
}
__device__ __forceinline__ int t5_bucket(int rel) {
    const int n = rel < 0 ? -rel : rel;
    int b = n < 8 ? n : n < 12 ? 8 : n < 16 ? 9 : n < 23 ? 10 : n < 32 ? 11 : n < 46 ? 12 : n < 64 ? 13 : n < 91 ? 14 : 15;
    return rel > 0 ? b + 16 : b;
}
__device__ __forceinline__ void unpack8(const v4u w, float* f) { f[0] = bflo(w.x); f[1] = bfhi(w.x); f[2] = bflo(w.y); f[3] = bfhi(w.y); f[4] = bflo(w.z); f[5] = bfhi(w.z); f[6] = bflo(w.w); f[7] = bfhi(w.w); }

namespace pg8 {
template <int MODE> struct EpiResNorm {
    static constexpr bool PERM = false, AFTER_DRAIN = true;
    const float* base; float* out; const float* gain; const float* wx; int ldw;
    unsigned char* ws; unsigned* cnt;
    __device__ __forceinline__ void fused(f32x4 (&acc)[2][2][4][2], const Unit& u, int wr, int wc, int fr, int fq, PG8_LAS unsigned char* lds, int wid, int lane) const {
        PG8_LAS float* Wt = (PG8_LAS float*)lds;
        PG8_LAS float* P = (PG8_LAS float*)(lds + 8192);
        PG8_LAS float* S = (PG8_LAS float*)(lds + 8192 + 49152);
        PG8_LAS unsigned* flag = (PG8_LAS unsigned*)(lds + 8192 + 49152 + 1024);
        const int tid = wid * 64 + lane, ldc = 1024;
        if (MODE != 0) { for (int idx = tid; idx < 2048; idx += 512) { const int e = idx >> 8, c = idx & 255; Wt[idx] = wx[(size_t)(u.cn * BM + c) * ldw + e]; } }
        const int col0 = u.cn * BM + wc * 32 + 4 * fq;
        f32x4 g4[2][2];
#pragma unroll
        for (int bj = 0; bj < 2; ++bj)
#pragma unroll
            for (int n = 0; n < 2; ++n) g4[bj][n] = *(const f32x4*)(gain + col0 + bj * HALF + n * 16);
        asm volatile("s_waitcnt lgkmcnt(0)" ::: "memory"); __builtin_amdgcn_s_barrier(); asm volatile("" ::: "memory");
#pragma unroll
        for (int ai = 0; ai < 2; ++ai)
#pragma unroll
            for (int m = 0; m < 4; ++m) { const int r = ai * HALF + wr * 64 + m * 16 + fr; const size_t off = (size_t)(u.po * BM + r) * ldc + col0;
                float st[10];
#pragma unroll
                for (int k = 0; k < 10; ++k) st[k] = 0.f;
#pragma unroll
                for (int bj = 0; bj < 2; ++bj)
#pragma unroll
                    for (int n = 0; n < 2; ++n) { const f32x4 bs = *(const f32x4*)(base + off + bj * HALF + n * 16); const f32x4 x1 = bs + acc[ai][bj][m][n]; acc[ai][bj][m][n] = x1;
                        *(f32x4*)(out + off + bj * HALF + n * 16) = x1;
                        const f32x4 xg = x1 * g4[bj][n];
                        st[0] += (x1.x * x1.x + x1.y * x1.y) + (x1.z * x1.z + x1.w * x1.w);
                        st[1] = fmaxf(st[1], fmaxf(fmaxf(fabsf(xg.x), fabsf(xg.y)), fmaxf(fabsf(xg.z), fabsf(xg.w))));
                        if (MODE != 0) { const int cl = bj * HALF + wc * 32 + n * 16 + 4 * fq;
#pragma unroll
                            for (int e = 0; e < 8; ++e) { const f32x4 w = *(const PG8_LAS f32x4*)(Wt + e * 256 + cl); st[2 + e] += (xg.x * w.x + xg.y * w.y) + (xg.z * w.z + xg.w * w.w); if (e & 1) asm volatile("" ::: "memory"); } } }
                st[0] += __shfl_xor(st[0], 16); st[0] += __shfl_xor(st[0], 32); st[1] = fmaxf(st[1], __shfl_xor(st[1], 16)); st[1] = fmaxf(st[1], __shfl_xor(st[1], 32));
                if (MODE != 0) {
#pragma unroll
                    for (int e = 0; e < 8; ++e) { st[2 + e] += __shfl_xor(st[2 + e], 16); st[2 + e] += __shfl_xor(st[2 + e], 32); } }
                if (fq == 0) { PG8_LAS float* p = P + (r * 4 + wc) * 12;
                    p[0] = st[0]; p[1] = st[1];
                    if (MODE != 0) {
#pragma unroll
                        for (int e = 0; e < 8; ++e) p[2 + e] = st[2 + e]; } }
                asm volatile("" ::: "memory"); }
        asm volatile("s_waitcnt lgkmcnt(0)" ::: "memory"); __builtin_amdgcn_s_barrier(); asm volatile("" ::: "memory");
        const int row = wid * 32 + (lane & 31);
        unsigned long long* slot = (unsigned long long*)((float*)(ws + WS_XCH) + ((size_t)(u.po * BM + row) * 4 + u.cn) * 12);
        if (lane < 32) { float t[10];
#pragma unroll
            for (int k = 0; k < 10; ++k) { const float a = P[(row * 4 + 0) * 12 + k], b = P[(row * 4 + 1) * 12 + k], c = P[(row * 4 + 2) * 12 + k], d = P[(row * 4 + 3) * 12 + k];
                t[k] = (k == 1) ? fmaxf(fmaxf(a, b), fmaxf(c, d)) : (a + b) + (c + d); }
#pragma unroll
            for (int k = 0; k < 5; ++k) __hip_atomic_store(slot + k, ((unsigned long long)__float_as_uint(t[2 * k + 1]) << 32) | __float_as_uint(t[2 * k]), __ATOMIC_RELAXED, __HIP_MEMORY_SCOPE_AGENT); }
        asm volatile("s_waitcnt vmcnt(0)" ::: "memory");
        if (lane == 0) __hip_atomic_fetch_add(cnt + 64 * u.po, 1u, __ATOMIC_RELAXED, __HIP_MEMORY_SCOPE_AGENT);
        if (wid == 0) {
            const unsigned long long t0 = __builtin_amdgcn_s_memrealtime();
            for (;;) {
                if ((unsigned)__builtin_amdgcn_readfirstlane(__hip_atomic_load(cnt + 64 * u.po, __ATOMIC_RELAXED, __HIP_MEMORY_SCOPE_AGENT)) >= 32u) break;
                if (__builtin_amdgcn_s_memrealtime() - t0 > 2000000ull) break;
                __builtin_amdgcn_s_sleep(2);
            }
            __builtin_amdgcn_fence(__ATOMIC_ACQUIRE, "agent");
            if (lane == 0) flag[0] = 1u;
        }
        asm volatile("s_waitcnt vmcnt(0) lgkmcnt(0)" ::: "memory"); __builtin_amdgcn_s_barrier(); asm volatile("" ::: "memory");
        if (lane < 32) { const unsigned long long* sl = (const unsigned long long*)((const float*)(ws + WS_XCH) + (size_t)(u.po * BM + row) * 4 * 12);
            float t[10];
#pragma unroll
            for (int k = 0; k < 10; ++k) t[k] = 0.f;
#pragma unroll
            for (int tl = 0; tl < 4; ++tl)
#pragma unroll
                for (int k = 0; k < 5; ++k) { const unsigned long long w = __hip_atomic_load(sl + tl * 6 + k, __ATOMIC_RELAXED, __HIP_MEMORY_SCOPE_AGENT);
                    const float lo = __uint_as_float((unsigned)w), hi = __uint_as_float((unsigned)(w >> 32));
                    if (k == 0) { t[0] += lo; t[1] = fmaxf(t[1], hi); } else { t[2 * k] += lo; t[2 * k + 1] += hi; } }
            const float rstd = __builtin_amdgcn_rsqf(t[0] * (1.f / 1024.f) + 1e-6f), arow = t[1] * rstd;
            S[row] = arow > 0.f ? rstd * (127.0f / arow) : 0.f;
            if (u.cn == 0) { const size_t grow = (size_t)u.po * BM + row;
                ((float*)(ws + WS_XNS))[grow] = arow * (1.0f / 127.0f);
                if (MODE == 1) { *(f32x4*)((float*)(ws + WS_DT) + grow * 8) = (f32x4){t[2] * rstd, t[3] * rstd, t[4] * rstd, t[5] * rstd}; *(f32x4*)((float*)(ws + WS_DT) + grow * 8 + 4) = (f32x4){t[6] * rstd, t[7] * rstd, t[8] * rstd, t[9] * rstd}; }
                if (MODE == 2) { float ex[8];
#pragma unroll
                    for (int e = 0; e < 8; ++e) ex[e] = t[2 + e] * rstd;
                    int e0 = 0; float v0 = ex[0];
#pragma unroll
                    for (int e = 1; e < 8; ++e) if (ex[e] > v0) { v0 = ex[e]; e0 = e; }
                    int e1 = -1; float v1 = -3.0e38f;
#pragma unroll
                    for (int e = 0; e < 8; ++e) if (e != e0 && ex[e] > v1) { v1 = ex[e]; e1 = e; }
                    const float g0 = 1.0f / (1.0f + __expf(v1 - v0)), g1 = 1.0f - g0; const int mtok = (int)grow;
                    unsigned* ctl = (unsigned*)(ws + WS_CTL);
                    const int pos0 = (int)atomicAdd(ctl + CW_CNT + 64 * e0, 1u), pos1 = (int)atomicAdd(ctl + CW_CNT + 64 * e1, 1u);
                    int* LIST = (int*)(ws + WS_LIST); int* TI = (int*)(ws + WS_TI); float* TG = (float*)(ws + WS_TG);
                    LIST[e0 * 16384 + pos0] = mtok; LIST[e1 * 16384 + pos1] = mtok;
                    TI[mtok * 4 + 0] = e0 | (e1 << 8); TI[mtok * 4 + 1] = pos0; TI[mtok * 4 + 2] = pos1; TI[mtok * 4 + 3] = 0;
                    TG[mtok * 2 + 0] = g0; TG[mtok * 2 + 1] = g1; } } }
        asm volatile("s_waitcnt lgkmcnt(0)" ::: "memory"); __builtin_amdgcn_s_barrier(); asm volatile("" ::: "memory");
        unsigned char* XN8 = ws + WS_XN;
#pragma unroll
        for (int ai = 0; ai < 2; ++ai)
#pragma unroll
            for (int m = 0; m < 4; ++m) { const int r = ai * HALF + wr * 64 + m * 16 + fr; const float s = S[r]; unsigned char* rowp = XN8 + (size_t)(u.po * BM + r) * 1024 + col0;
#pragma unroll
                for (int bj = 0; bj < 2; ++bj)
#pragma unroll
                    for (int n = 0; n < 2; ++n) { const f32x4 q = acc[ai][bj][m][n] * g4[bj][n] * s;
                        const int q0 = (int)rintf(q.x), q1 = (int)rintf(q.y), q2 = (int)rintf(q.z), q3 = (int)rintf(q.w);
                        *(unsigned*)(rowp + bj * HALF + n * 16) = (unsigned)(q0 & 255) | ((unsigned)(q1 & 255) << 8) | ((unsigned)(q2 & 255) << 16) | ((unsigned)(q3 & 255) << 24); } }
    }
};
}
namespace att {
typedef short v4i16_t __attribute__((ext_vector_type(4)));
typedef short s16x4 __attribute__((ext_vector_type(4)));
typedef float f32x16 __attribute__((ext_vector_type(16)));
constexpr int NSLOT = 3, SLOTB = 8192;
constexpr int LDS_K = 0, LDS_V = NSLOT * SLOTB, LDS_BT = 2 * NSLOT * SLOTB, LDS_WS = LDS_BT + 2048, LDS_OST = LDS_WS + 2048, OST_W = 32 * 68, LDS_END = LDS_OST + 8 * OST_W * 4;
static_assert(LDS_END <= RING_BYTES, "attention LDS map");
constexpr float THR = 8.0f;
__device__ __forceinline__ s16x4 vtr(const LAS char* p) { return __builtin_bit_cast(s16x4, __builtin_amdgcn_ds_read_tr16_b64_v4i16((LAS v4i16_t*)p)); }
__device__ __forceinline__ int crow(int r, int hi) { return (r & 3) + 8 * (r >> 2) + 4 * hi; }
__device__ __forceinline__ float xhalf_max(float v) { auto rr = __builtin_amdgcn_permlane32_swap(__float_as_uint(v), __float_as_uint(v), false, false); return fmaxf(__uint_as_float(rr[0]), __uint_as_float(rr[1])); }
__device__ __forceinline__ float xhalf_sum(float v) { auto rr = __builtin_amdgcn_permlane32_swap(__float_as_uint(v), __float_as_uint(v), false, false); return __uint_as_float(rr[0]) + __uint_as_float(rr[1]); }
#define ATT_WAIT_BAR(N) asm volatile("s_waitcnt vmcnt(" #N ") lgkmcnt(0)\n\ts_barrier" ::: "memory")

__device__ __forceinline__ void attn_unit(Frame& F_, const Args& A, int l, int b, int h, int qb, float lam, float oscale) {
    Frame F = refresh(F_);
    const int tid = F.tid, lane = tid & 63, wid = F.wave, r32 = lane & 31, hi = lane >> 5, t = wid >> 2, wq = wid & 3;
    const int Q0 = qb * 128, row0 = Q0 + 32 * wq, NT = 2 * qb + 2, cq = 2 * qb + (wq >> 1);
    const bf16* PROJ = (const bf16*)(F.ws + WS_BIG); const size_t rb = (size_t)b * SEQ;
    LAS char* L = (LAS char*)F.lds;
    LAS float* Bt = (LAS float*)(L + LDS_BT); LAS float* wsf = (LAS float*)(L + LDS_WS) + wid * 64; LAS float* stg = (LAS float*)(L + LDS_OST) + wid * OST_W;
    ATT_WAIT_BAR(0);
    const float cb = A.in[6][15 * 4 + h] * LOG2E;
    if (tid < 320) Bt[tid] = A.in[6][t5_bucket(tid - 255) * 4 + h] * LOG2E - cb;
    bf16x8 qr[2];
#pragma unroll
    for (int s = 0; s < 2; ++s) qr[s] = *(const bf16x8*)(PROJ + (rb + row0 + r32) * NPROJ + PC_Q + h * 64 + t * 32 + s * 16 + hi * 8);
    const int krow = wid * 8 + (lane >> 3);
    const bf16* ksrc = PROJ + (rb + krow) * NPROJ + PC_K + h * 64 + (((lane & 7) ^ (krow & 7)) * 8);
    const bf16* vsrc = PROJ + (rb + 16 * (wid & 3) + (lane >> 2)) * NPROJ + PC_V + h * 64 + (wid >> 2) * 32 + (lane & 3) * 8;
#define ATT_DMA(tile, sl) do { \
        __builtin_amdgcn_global_load_lds((const unsigned*)(ksrc + (size_t)(tile) * 64 * NPROJ), (LAS unsigned*)(L + LDS_K + (sl) * SLOTB + wid * 1024), 16, 0, 0); \
        __builtin_amdgcn_global_load_lds((const unsigned*)(vsrc + (size_t)(tile) * 64 * NPROJ), (LAS unsigned*)(L + LDS_V + (sl) * SLOTB + wid * 1024), 16, 0, 0); } while (0)
    ATT_DMA(0, 0); ATT_DMA(1, 1);
    f32x16 o0, o1, zero16;
#pragma unroll
    for (int r = 0; r < 16; ++r) { o0[r] = 0.f; o1[r] = 0.f; zero16[r] = 0.f; }
    float lsum = 0.f;
    const int kf0 = r32 * 128 + (((t * 4 + hi) ^ (r32 & 7)) * 16), kf1 = r32 * 128 + (((t * 4 + 2 + hi) ^ (r32 & 7)) * 16);
    const int vfo = ((lane >> 4) & 1) * 32 + (lane & 3) * 8 + (4 * hi + ((lane & 15) >> 2)) * 64;
    int slot = 0;
    for (int tile = 0; tile < NT; ++tile) {
        if (tile + 1 < NT) ATT_WAIT_BAR(2); else ATT_WAIT_BAR(0);
        if (tile + 2 < NT) { const int s2 = slot >= 1 ? slot - 1 : 2; ATT_DMA(tile + 2, s2); }
        if (tile <= cq) {
            const LAS char* Ks = L + LDS_K + slot * SLOTB; const LAS char* Vs = L + LDS_V + slot * SLOTB + vfo;
            f32x16 p0, p1;
            { const bf16x8 k00 = *(const LAS bf16x8*)(Ks + kf0), k01 = *(const LAS bf16x8*)(Ks + kf1), k10 = *(const LAS bf16x8*)(Ks + 4096 + kf0), k11 = *(const LAS bf16x8*)(Ks + 4096 + kf1);
              p0 = __builtin_amdgcn_mfma_f32_32x32x16_bf16(k00, qr[0], zero16, 0, 0, 0); p0 = __builtin_amdgcn_mfma_f32_32x32x16_bf16(k01, qr[1], p0, 0, 0, 0);
              p1 = __builtin_amdgcn_mfma_f32_32x32x16_bf16(k10, qr[0], zero16, 0, 0, 0); p1 = __builtin_amdgcn_mfma_f32_32x32x16_bf16(k11, qr[1], p1, 0, 0, 0); }
            const int K0 = tile * 64;
            if (K0 > row0 - 154) {
                const LAS float* bp = Bt + (K0 - row0 + 255 + 4 * hi - r32);
#pragma unroll
                for (int r = 0; r < 16; ++r) { p0[r] += bp[(r & 3) + 8 * (r >> 2)]; p1[r] += bp[32 + (r & 3) + 8 * (r >> 2)]; }
            }
            float sacc = 0.f;
#pragma unroll
            for (int r = 0; r < 16; ++r) { p0[r] = __builtin_amdgcn_exp2f(p0[r]); p1[r] = __builtin_amdgcn_exp2f(p1[r]); sacc += p0[r] + p1[r]; }
            lsum += sacc;
            bf16x8 pa[4];
            { v4u w;
              w.x = pk2(p0[0], p0[1]); w.y = pk2(p0[2], p0[3]); w.z = pk2(p0[4], p0[5]); w.w = pk2(p0[6], p0[7]); pa[0] = __builtin_bit_cast(bf16x8, w);
              w.x = pk2(p0[8], p0[9]); w.y = pk2(p0[10], p0[11]); w.z = pk2(p0[12], p0[13]); w.w = pk2(p0[14], p0[15]); pa[1] = __builtin_bit_cast(bf16x8, w);
              w.x = pk2(p1[0], p1[1]); w.y = pk2(p1[2], p1[3]); w.z = pk2(p1[4], p1[5]); w.w = pk2(p1[6], p1[7]); pa[2] = __builtin_bit_cast(bf16x8, w);
              w.x = pk2(p1[8], p1[9]); w.y = pk2(p1[10], p1[11]); w.z = pk2(p1[12], p1[13]); w.w = pk2(p1[14], p1[15]); pa[3] = __builtin_bit_cast(bf16x8, w); }
#pragma unroll
            for (int k = 0; k < 4; ++k) {
                const s16x4 a0 = vtr(Vs + k * 1024), a1 = vtr(Vs + k * 1024 + 512), c0 = vtr(Vs + 4096 + k * 1024), c1 = vtr(Vs + 4096 + k * 1024 + 512);
                const bf16x8 v0 = (bf16x8){a0[0], a0[1], a0[2], a0[3], a1[0], a1[1], a1[2], a1[3]}, v1 = (bf16x8){c0[0], c0[1], c0[2], c0[3], c1[0], c1[1], c1[2], c1[3]};
                o0 = __builtin_amdgcn_mfma_f32_32x32x16_bf16(pa[k], v0, o0, 0, 0, 0);
                o1 = __builtin_amdgcn_mfma_f32_32x32x16_bf16(pa[k], v1, o1, 0, 0, 0);
            }
        }
        slot = slot == 2 ? 0 : slot + 1;
    }
    lsum = xhalf_sum(lsum);
    if (hi == 0) wsf[32 + r32] = lsum;
    asm volatile("s_waitcnt lgkmcnt(0)" ::: "memory");
#pragma unroll
    for (int r = 0; r < 16; ++r) { const int q = crow(r, hi); const float rl = __builtin_amdgcn_rcpf(wsf[32 + q]); stg[q * 68 + r32] = o0[r] * rl; stg[q * 68 + 32 + r32] = o1[r] * rl; }
    ATT_WAIT_BAR(0);
    if (t == 0) {
        const LAS float* s1 = stg + 4 * OST_W; const float* gn = A.in[11] + l * 64; bf16* MIXp = (bf16*)(F.ws + WS_MIX);
#pragma unroll
        for (int i = 0; i < 4; ++i) { const int row = i * 8 + (lane >> 3), ch = lane & 7;
            const f32x4 a0 = *(const LAS f32x4*)(stg + row * 68 + ch * 8), a1 = *(const LAS f32x4*)(stg + row * 68 + ch * 8 + 4), b0 = *(const LAS f32x4*)(s1 + row * 68 + ch * 8), b1 = *(const LAS f32x4*)(s1 + row * 68 + ch * 8 + 4);
            const f32x4 x0 = a0 - b0 * lam, x1 = a1 - b1 * lam;
            float ss = (x0.x * x0.x + x0.y * x0.y) + (x0.z * x0.z + x0.w * x0.w) + (x1.x * x1.x + x1.y * x1.y) + (x1.z * x1.z + x1.w * x1.w);
            ss += __shfl_xor(ss, 1); ss += __shfl_xor(ss, 2); ss += __shfl_xor(ss, 4);
            const float rstd = __builtin_amdgcn_rsqf(ss * (1.f / 64.f) + EPS) * oscale;
            const f32x4 g0 = *(const f32x4*)(gn + ch * 8), g1 = *(const f32x4*)(gn + ch * 8 + 4);
            v4u w; w.x = pk2(x0.x * rstd * g0.x, x0.y * rstd * g0.y); w.y = pk2(x0.z * rstd * g0.z, x0.w * rstd * g0.w); w.z = pk2(x1.x * rstd * g1.x, x1.y * rstd * g1.y); w.w = pk2(x1.z * rstd * g1.z, x1.w * rstd * g1.w);
            *(v4u*)(MIXp + (rb + row0 + row) * D + h * 64 + ch * 8) = w; }
    }
#undef ATT_DMA
}
}
namespace ssd {
typedef unsigned u32x2 __attribute__((ext_vector_type(2)));
using att::f32x16; using att::s16x4; using att::vtr; using att::crow;
constexpr int XS = 0, BK = 32768, CK = 40960, BW = 49152, HB = 81920, SM = 114688, CW = 122880;
constexpr int SM_VL = 0, SM_US = 256, SM_EO = 512, SM_WS = 768, SM_DT = 1024, SM_DK = 1028, SM_AK = 1032, SM_DB = 1036, SM_GN = 1040;
#define SSD_BAR() asm volatile("s_waitcnt lgkmcnt(0)\n\ts_barrier" ::: "memory")
__device__ __forceinline__ bf16x8 trfrag(const LAS char* p) { const s16x4 a = vtr(p), b = vtr(p + 512); return (bf16x8){a[0], a[1], a[2], a[3], b[0], b[1], b[2], b[3]}; }
__device__ __forceinline__ bf16x8 packfrag(const f32x16& x, int s) { v4u w; w.x = pk2(x[8 * s], x[8 * s + 1]); w.y = pk2(x[8 * s + 2], x[8 * s + 3]); w.z = pk2(x[8 * s + 4], x[8 * s + 5]); w.w = pk2(x[8 * s + 6], x[8 * s + 7]); return __builtin_bit_cast(bf16x8, w); }
#define SSD_LO(q_) ((f32x4){bflo((q_).x), bfhi((q_).x), bflo((q_).y), bfhi((q_).y)})
#define SSD_HI(q_) ((f32x4){bflo((q_).z), bfhi((q_).z), bflo((q_).w), bfhi((q_).w)})

__device__ __forceinline__ void ssd_m1_unit(Frame& F_, const Args& A, int l, int b, int c, int g) {
    Frame F = refresh(F_);
    const int tid = F.tid, lane = tid & 63, wid = F.wave, r32 = lane & 31, hi = lane >> 5, hh = wid >> 1, lh = wid & 1;
    LAS char* L = (LAS char*)F.lds; LAS float* sm = (LAS float*)(L + SM); LAS float* cwl = (LAS float*)(L + CW);
    const bf16* PROJ = (const bf16*)(F.ws + WS_BIG); const float* DTg = (const float*)(F.ws + WS_DT);
    bf16* XC = (bf16*)(F.ws + WS_XC); bf16* YD = (bf16*)(F.ws + WS_YD); bf16* SST = (bf16*)(F.ws + WS_SST);
    const size_t rowb = (size_t)b * SEQ + (size_t)c * 64;
    const int tg = tid / 48, cc = tid - tg * 48;
    const int gcol = PC_XBC + (cc < 32 ? g * 256 + cc * 8 : cc < 40 ? 512 + g * 64 + (cc - 32) * 8 : 640 + g * 64 + (cc - 40) * 8);
    v4u raw[11];
#pragma unroll
    for (int i = 0; i < 11; ++i) { const int trow = c * 64 + 8 * tg - 3 + i; raw[i] = (tid < 384 && trow >= 0) ? *(const v4u*)(PROJ + ((size_t)b * SEQ + trow) * NPROJ + gcol) : (v4u){0u, 0u, 0u, 0u}; }
    f32x4 d4 = (f32x4){0.f, 0.f, 0.f, 0.f};
    if (wid == 7) d4 = *(const f32x4*)(DTg + (rowb + lane) * 8 + g * 4);
    SSD_BAR();
    for (int i = tid; i < 5 * 384; i += 512) { const int w = i / 384, li = i - w * 384; const int ch = li < 256 ? g * 256 + li : li < 320 ? 512 + g * 64 + (li - 256) : 640 + g * 64 + (li - 320);
        cwl[i] = w < 4 ? A.in[12][(size_t)l * 4 * 768 + w * 768 + ch] : A.in[13][l * 768 + ch]; }
    if (tid < 4) { sm[SM_AK + tid] = -__expf(A.in[15][l * 8 + g * 4 + tid]); sm[SM_DB + tid] = A.in[14][l * 8 + g * 4 + tid]; }
    SSD_BAR();
    if (tid < 384) {
        const int dsto = cc < 32 ? XS + (cc >> 3) * 8192 + ((cc & 7) >> 2) * 4096 + ((cc & 3) * 8) * 2 : cc < 40 ? BK + (cc - 32) * 1024 : CK + (cc - 40) * 1024;
        const int dstr = cc < 32 ? 64 : 16;
        const int xcol = cc < 32 ? g * 256 + cc * 8 : 512 + g * 64 + (cc - 40) * 8;
        const f32x4 w0a = *(const LAS f32x4*)(cwl + cc * 8), w0b = *(const LAS f32x4*)(cwl + cc * 8 + 4), w1a = *(const LAS f32x4*)(cwl + 384 + cc * 8), w1b = *(const LAS f32x4*)(cwl + 384 + cc * 8 + 4);
        const f32x4 w2a = *(const LAS f32x4*)(cwl + 768 + cc * 8), w2b = *(const LAS f32x4*)(cwl + 768 + cc * 8 + 4), w3a = *(const LAS f32x4*)(cwl + 1152 + cc * 8), w3b = *(const LAS f32x4*)(cwl + 1152 + cc * 8 + 4);
        const f32x4 cba = *(const LAS f32x4*)(cwl + 1536 + cc * 8), cbb = *(const LAS f32x4*)(cwl + 1536 + cc * 8 + 4);
#pragma unroll
        for (int j = 0; j < 8; ++j) {
            const f32x4 va = cba + SSD_LO(raw[j]) * w0a + SSD_LO(raw[j + 1]) * w1a + SSD_LO(raw[j + 2]) * w2a + SSD_LO(raw[j + 3]) * w3a;
            const f32x4 vb = cbb + SSD_HI(raw[j]) * w0b + SSD_HI(raw[j + 1]) * w1b + SSD_HI(raw[j + 2]) * w2b + SSD_HI(raw[j + 3]) * w3b;
            v4u o; o.x = pk2(silu_f(va.x), silu_f(va.y)); o.y = pk2(silu_f(va.z), silu_f(va.w)); o.z = pk2(silu_f(vb.x), silu_f(vb.y)); o.w = pk2(silu_f(vb.z), silu_f(vb.w));
            *(LAS v4u*)(L + dsto + (8 * tg + j) * dstr) = o;
            if (cc < 32 || cc >= 40) *(v4u*)(XC + (rowb + 8 * tg + j) * 640 + xcol) = o;
        }
    } else if (wid == 7) {
        float dtr[4] = {d4.x, d4.y, d4.z, d4.w}; float tot[4];
#pragma unroll
        for (int k = 0; k < 4; ++k) { const float Ak = sm[SM_AK + k], dbk = sm[SM_DB + k];
            const float xr = dtr[k] + dbk; const float dt = xr > 20.f ? xr : log1pf(__expf(xr));
            float acs = Ak * dt;
#pragma unroll
            for (int o = 1; o < 64; o <<= 1) { const float u = __shfl_up(acs, o); if (lane >= o) acs += u; }
            tot[k] = __shfl(acs, 63);
            sm[SM_VL + k * 64 + lane] = acs * LOG2E; sm[SM_US + k * 64 + lane] = acs * LOG2E - __log2f(dt);
            sm[SM_WS + k * 64 + lane] = __expf(tot[k] - acs) * dt; dtr[k] = __expf(acs); }
        *(f32x4*)((float*)(F.ws + WS_EOFF) + (rowb + lane) * 8 + g * 4) = (f32x4){dtr[0], dtr[1], dtr[2], dtr[3]};
        if (lane == 0) *(f32x4*)((float*)(F.ws + WS_DTOT) + ((size_t)(b * 128 + c)) * 8 + g * 4) = (f32x4){__expf(tot[0]), __expf(tot[1]), __expf(tot[2]), __expf(tot[3])};
    }
    SSD_BAR();
    { const int s = tid >> 3, nc = tid & 7; const v4u b8 = *(const LAS v4u*)(L + BK + nc * 1024 + s * 16);
      const f32x4 ba = SSD_LO(b8), bb = SSD_HI(b8);
#pragma unroll
      for (int k = 0; k < 4; ++k) { const float w = sm[SM_WS + k * 64 + s]; v4u o; o.x = pk2(ba.x * w, ba.y * w); o.y = pk2(ba.z * w, ba.w * w); o.z = pk2(bb.x * w, bb.y * w); o.w = pk2(bb.z * w, bb.w * w);
          *(LAS v4u*)(L + BW + k * 8192 + (nc >> 2) * 4096 + s * 64 + (nc & 3) * 16) = o; } }
    SSD_BAR();
    const int kfo = hi * 1024 + r32 * 16;
    const int vfo = ((lane >> 4) & 1) * 32 + (lane & 3) * 8 + (4 * hi + ((lane & 15) >> 2)) * 64;
    f32x16 y0, y1, h0, h1;
#pragma unroll
    for (int r = 0; r < 16; ++r) { y0[r] = 0.f; y1[r] = 0.f; h0[r] = 0.f; h1[r] = 0.f; }
    {
        bf16x8 cf[4];
#pragma unroll
        for (int ks = 0; ks < 4; ++ks) cf[ks] = *(const LAS bf16x8*)(L + CK + kfo + ks * 2048 + lh * 512);
        const float vl = sm[SM_VL + hh * 64 + 32 * lh + r32];
#pragma unroll
        for (int sb = 0; sb < 2; ++sb) {
            if (sb <= lh) {
                f32x16 T;
#pragma unroll
                for (int r = 0; r < 16; ++r) T[r] = 0.f;
#pragma unroll
                for (int ks = 0; ks < 4; ++ks) { const bf16x8 bfr = *(const LAS bf16x8*)(L + BK + kfo + ks * 2048 + sb * 512); T = __builtin_amdgcn_mfma_f32_32x32x16_bf16(bfr, cf[ks], T, 0, 0, 0); }
#pragma unroll
                for (int r = 0; r < 16; ++r) { const float us = sm[SM_US + hh * 64 + 32 * sb + crow(r, hi)]; float w = T[r] * __builtin_amdgcn_exp2f(vl - us);
                    if (sb == lh && crow(r, hi) > r32) w = 0.f; T[r] = w; }
                const bf16x8 pa0 = packfrag(T, 0), pa1 = packfrag(T, 1);
                const LAS char* xb = L + XS + hh * 8192 + vfo + sb * 2048;
                const bf16x8 x00 = trfrag(xb), x01 = trfrag(xb + 4096), x10 = trfrag(xb + 1024), x11 = trfrag(xb + 4096 + 1024);
                y0 = __builtin_amdgcn_mfma_f32_32x32x16_bf16(pa0, x00, y0, 0, 0, 0); y1 = __builtin_amdgcn_mfma_f32_32x32x16_bf16(pa0, x01, y1, 0, 0, 0);
                y0 = __builtin_amdgcn_mfma_f32_32x32x16_bf16(pa1, x10, y0, 0, 0, 0); y1 = __builtin_amdgcn_mfma_f32_32x32x16_bf16(pa1, x11, y1, 0, 0, 0);
            }
        }
#pragma unroll
        for (int ks = 0; ks < 4; ++ks) { const bf16x8 xa = trfrag(L + XS + hh * 8192 + lh * 4096 + vfo + ks * 1024), b0 = trfrag(L + BW + hh * 8192 + vfo + ks * 1024), b1 = trfrag(L + BW + hh * 8192 + 4096 + vfo + ks * 1024);
            h0 = __builtin_amdgcn_mfma_f32_32x32x16_bf16(xa, b0, h0, 0, 0, 0); h1 = __builtin_amdgcn_mfma_f32_32x32x16_bf16(xa, b1, h1, 0, 0, 0); }
    }
    { bf16* img = SST + ((size_t)((b * 128 + c) * 8 + g * 4 + hh)) * 4096;
#pragma unroll
      for (int r = 0; r < 16; ++r) { const int p = 32 * lh + crow(r, hi);
          img[(r32 >> 3) * 512 + p * 8 + (r32 & 7)] = (bf16)f2bf(h0[r]); img[(4 + (r32 >> 3)) * 512 + p * 8 + (r32 & 7)] = (bf16)f2bf(h1[r]); } }
    SSD_BAR();
#pragma unroll
    for (int r = 0; r < 16; ++r) { const int lrow = 32 * lh + crow(r, hi);
        *(LAS unsigned short*)(L + BW + (lrow * 256 + hh * 64 + r32) * 2) = (unsigned short)f2bf(y0[r]);
        *(LAS unsigned short*)(L + BW + (lrow * 256 + hh * 64 + 32 + r32) * 2) = (unsigned short)f2bf(y1[r]); }
    SSD_BAR();
#pragma unroll
    for (int k = 0; k < 4; ++k) { const int tk = wid * 8 + 2 * k + (lane >> 5), chn = (lane & 31) * 8;
        *(v4u*)(YD + (rowb + tk) * 512 + g * 256 + chn) = *(const LAS v4u*)(L + BW + (tk * 256 + chn) * 2); }
}

__device__ __forceinline__ void ssd_m3_unit(Frame& F_, const Args& A, int l, int b, int c, int g) {
    Frame F = refresh(F_);
    const int tid = F.tid, lane = tid & 63, wid = F.wave, r32 = lane & 31, hi = lane >> 5, hh = wid >> 1, lh = wid & 1;
    LAS char* L = (LAS char*)F.lds; LAS float* sm = (LAS float*)(L + SM);
    const bf16* PROJ = (const bf16*)(F.ws + WS_BIG); const bf16* XC = (const bf16*)(F.ws + WS_XC); const bf16* YD = (const bf16*)(F.ws + WS_YD); const bf16* SST = (const bf16*)(F.ws + WS_SST);
    bf16* MIXp = (bf16*)(F.ws + WS_MIX);
    const size_t rowb = (size_t)b * SEQ + (size_t)c * 64;
    const v4u c8 = *(const v4u*)(XC + (rowb + (tid >> 3)) * 640 + 512 + g * 64 + (tid & 7) * 8);
    v4u hp[4];
    { const v4u* src = (const v4u*)(SST + ((size_t)((b * 128 + c) * 8 + g * 4)) * 4096);
#pragma unroll
      for (int i = 0; i < 4; ++i) hp[i] = src[tid + 512 * i]; }
    float eo = 0.f; if (tid < 256) eo = ((const float*)(F.ws + WS_EOFF))[(rowb + (tid & 63)) * 8 + g * 4 + (tid >> 6)];
    SSD_BAR();
    *(LAS v4u*)(L + CK + (tid & 7) * 1024 + (tid >> 3) * 16) = c8;
#pragma unroll
    for (int i = 0; i < 4; ++i) *(LAS v4u*)(L + HB + (tid + 512 * i) * 16) = hp[i];
    if (tid < 256) { sm[SM_EO + tid] = eo; sm[SM_GN + tid] = A.in[17][l * 512 + g * 256 + tid]; }
    if (tid < 4) sm[SM_DK + tid] = A.in[16][l * 8 + g * 4 + tid];
    SSD_BAR();
    const int kfo = hi * 1024 + r32 * 16;
    f32x16 y0, y1;
#pragma unroll
    for (int r = 0; r < 16; ++r) { y0[r] = 0.f; y1[r] = 0.f; }
#pragma unroll
    for (int ks = 0; ks < 4; ++ks) { const bf16x8 cf = *(const LAS bf16x8*)(L + CK + kfo + ks * 2048 + lh * 512);
        const bf16x8 h0 = *(const LAS bf16x8*)(L + HB + hh * 8192 + kfo + ks * 2048), h1 = *(const LAS bf16x8*)(L + HB + hh * 8192 + kfo + ks * 2048 + 512);
        y0 = __builtin_amdgcn_mfma_f32_32x32x16_bf16(cf, h0, y0, 0, 0, 0); y1 = __builtin_amdgcn_mfma_f32_32x32x16_bf16(cf, h1, y1, 0, 0, 0); }
#pragma unroll
    for (int r = 0; r < 16; ++r) { const int lrow = 32 * lh + crow(r, hi); const float e = sm[SM_EO + hh * 64 + lrow];
        *(LAS unsigned short*)(L + BW + (lrow * 256 + hh * 64 + r32) * 2) = (unsigned short)f2bf(y0[r] * e);
        *(LAS unsigned short*)(L + BW + (lrow * 256 + hh * 64 + 32 + r32) * 2) = (unsigned short)f2bf(y1[r] * e); }
    SSD_BAR();
    const float Dk = sm[SM_DK + (lane >> 4)]; const f32x4 gn4 = *(const LAS f32x4*)(sm + SM_GN + 4 * lane);
    u32x2 zr[8], xr[8], yr[8];
#pragma unroll
    for (int k = 0; k < 8; ++k) { const size_t row = rowb + wid * 8 + k; zr[k] = *(const u32x2*)(PROJ + row * NPROJ + PC_Z + g * 256 + 4 * lane); xr[k] = *(const u32x2*)(XC + row * 640 + g * 256 + 4 * lane); yr[k] = *(const u32x2*)(YD + row * 512 + g * 256 + 4 * lane); }
#pragma unroll
    for (int k = 0; k < 8; ++k) { const int tk = wid * 8 + k;
        const u32x2 yo = *(const LAS u32x2*)(L + BW + (tk * 256 + 4 * lane) * 2);
        f32x4 v; v.x = (bflo(yo.x) + bflo(yr[k].x) + Dk * bflo(xr[k].x)) * silu_f(bflo(zr[k].x)); v.y = (bfhi(yo.x) + bfhi(yr[k].x) + Dk * bfhi(xr[k].x)) * silu_f(bfhi(zr[k].x));
        v.z = (bflo(yo.y) + bflo(yr[k].y) + Dk * bflo(xr[k].y)) * silu_f(bflo(zr[k].y)); v.w = (bfhi(yo.y) + bfhi(yr[k].y) + Dk * bfhi(xr[k].y)) * silu_f(bfhi(zr[k].y));
        const float rstd = __builtin_amdgcn_rsqf(wave_sum((v.x * v.x + v.y * v.y) + (v.z * v.z + v.w * v.w)) * (1.f / 256.f) + EPS);
        u32x2 o; o.x = pk2(v.x * rstd * gn4.x, v.y * rstd * gn4.y); o.y = pk2(v.z * rstd * gn4.z, v.w * rstd * gn4.w);
        *(u32x2*)(MIXp + (rowb + tk) * D + 256 + g * 256 + 4 * lane) = o; }
}

__device__ __forceinline__ void scan_unit(Frame& F_, int kind, int u) {
    Frame F = refresh(F_);
    const int e = u * 1024 + F.tid * 2, nh = kind == 0 ? 8 : 4;
    const int idx = e & 4095, head = (e >> 12) & (nh - 1), b = e >> (kind == 0 ? 15 : 14);
    unsigned* base = (unsigned*)((bf16*)(F.ws + (kind == 0 ? WS_SST : WS_RST)) + ((size_t)(b * 128) * nh + head) * 4096 + idx);
    const size_t cstride = (size_t)nh * 4096 / 2;
    const float* dtot = (const float*)(F.ws + WS_DTOT) + (size_t)(b * 128) * 8 + head;
    const float gdec = exp2f(64.f * log2f(1.0f - exp2f(-5.0f - (float)head)));
    float h0 = 0.f, h1 = 0.f;
    for (int c0 = 0; c0 < 128; c0 += 16) {
        unsigned v[16]; float d[16];
#pragma unroll
        for (int i = 0; i < 16; ++i) { v[i] = base[(size_t)(c0 + i) * cstride]; d[i] = kind == 0 ? dtot[(size_t)(c0 + i) * 8] : gdec; }
#pragma unroll
        for (int i = 0; i < 16; ++i) { base[(size_t)(c0 + i) * cstride] = pk2(h0, h1); h0 = d[i] * h0 + bflo(v[i]); h1 = d[i] * h1 + bfhi(v[i]); }
    }
}
#undef SSD_LO
#undef SSD_HI
}
namespace ret {
using att::f32x16; using att::crow; using ssd::trfrag; using ssd::packfrag; using ssd::u32x2;
constexpr int QK = 0, KK = 8192, KW = 16384, VV = 24576, SB = 32768, OS = 40960, TB = 58368;
#define RET_BAR() asm volatile("s_waitcnt lgkmcnt(0)\n\ts_barrier" ::: "memory")
__device__ __forceinline__ f32x4 lo4(const v4u q_) { return (f32x4){bflo(q_.x), bfhi(q_.x), bflo(q_.y), bfhi(q_.y)}; }
__device__ __forceinline__ f32x4 hi4(const v4u q_) { return (f32x4){bflo(q_.z), bfhi(q_.z), bflo(q_.w), bfhi(q_.w)}; }
__device__ __forceinline__ v4u pack8(const f32x4 a, const f32x4 b) { v4u o; o.x = pk2(a.x, a.y); o.y = pk2(a.z, a.w); o.z = pk2(b.x, b.y); o.w = pk2(b.z, b.w); return o; }

__device__ __forceinline__ void ret_m1_unit(Frame& F_, const Args& A, int l, int b, int c, int h) {
    Frame F = refresh(F_);
    const int tid = F.tid, lane = tid & 63, wid = F.wave, r32 = lane & 31, hi = lane >> 5;
    LAS char* L = (LAS char*)F.lds; LAS float* tb = (LAS float*)(L + TB); LAS float* os = (LAS float*)(L + OS);
    const bf16* PROJ = (const bf16*)(F.ws + WS_BIG);
    const float gam = 1.0f - exp2f(-5.0f - (float)h), lg2 = log2f(gam);
    const int tok = tid >> 3, seg = tid & 7;
    const size_t rowb = (size_t)b * SEQ + (size_t)c * 64;
    v4u ld[4];
    { const bf16* rp = PROJ + (rowb + tok) * NPROJ;
      if (seg < 4) { ld[0] = *(const v4u*)(rp + PC_RQ + h * 64 + seg * 8); ld[1] = *(const v4u*)(rp + PC_RQ + h * 64 + 32 + seg * 8); ld[2] = *(const v4u*)(rp + PC_RK + h * 64 + seg * 8); ld[3] = *(const v4u*)(rp + PC_RK + h * 64 + 32 + seg * 8); }
      else { ld[0] = *(const v4u*)(rp + PC_RV + h * 64 + (seg - 4) * 16); ld[1] = *(const v4u*)(rp + PC_RV + h * 64 + (seg - 4) * 16 + 8); ld[2] = ld[0]; ld[3] = ld[0]; } }
    RET_BAR();
    if (tid < 128) tb[tid] = exp2f(lg2 * (float)(tid < 63 ? 63 - tid : tid - 63));
    if (seg < 4) {
        const f32x4 qla = lo4(ld[0]), qlb = hi4(ld[0]), qha = lo4(ld[1]), qhb = hi4(ld[1]), kla = lo4(ld[2]), klb = hi4(ld[2]), kha = lo4(ld[3]), khb = hi4(ld[3]);
        float ql[8] = {qla.x, qla.y, qla.z, qla.w, qlb.x, qlb.y, qlb.z, qlb.w}, qh[8] = {qha.x, qha.y, qha.z, qha.w, qhb.x, qhb.y, qhb.z, qhb.w};
        float kl[8] = {kla.x, kla.y, kla.z, kla.w, klb.x, klb.y, klb.z, klb.w}, kh[8] = {kha.x, kha.y, kha.z, kha.w, khb.x, khb.y, khb.z, khb.w};
        float q1[8], q2[8], k1[8], k2[8];
        const float pos = (float)(c * 64 + tok);
#pragma unroll
        for (int i = 0; i < 8; ++i) { const int fi = seg * 8 + i; const float invf = exp2f(-(float)fi * (13.287712379549449f / 32.0f)); const float ang = pos * invf;
            double rev = (double)ang * 0.15915494309189535; rev -= __builtin_rint(rev); const float fr = (float)rev;
            const float sn = __builtin_amdgcn_sinf(fr), cs = __builtin_amdgcn_cosf(fr);
            q1[i] = ql[i] * cs - qh[i] * sn; q2[i] = ql[i] * sn + qh[i] * cs; k1[i] = kl[i] * cs - kh[i] * sn; k2[i] = kl[i] * sn + kh[i] * cs; }
        const float kd = exp2f(lg2 * (float)(63 - tok));
        const v4u qa = pack8((f32x4){q1[0], q1[1], q1[2], q1[3]}, (f32x4){q1[4], q1[5], q1[6], q1[7]}), qb = pack8((f32x4){q2[0], q2[1], q2[2], q2[3]}, (f32x4){q2[4], q2[5], q2[6], q2[7]});
        *(LAS v4u*)(L + QK + seg * 1024 + tok * 16) = qa; *(LAS v4u*)(L + QK + (seg + 4) * 1024 + tok * 16) = qb;
        { char* qimg = (char*)(F.ws + WS_QR) + ((size_t)((b * 128 + c) * 4 + h)) * 8192; *(v4u*)(qimg + seg * 1024 + tok * 16) = qa; *(v4u*)(qimg + (seg + 4) * 1024 + tok * 16) = qb; }
        *(LAS v4u*)(L + KK + seg * 1024 + tok * 16) = pack8((f32x4){k1[0], k1[1], k1[2], k1[3]}, (f32x4){k1[4], k1[5], k1[6], k1[7]});
        *(LAS v4u*)(L + KK + (seg + 4) * 1024 + tok * 16) = pack8((f32x4){k2[0], k2[1], k2[2], k2[3]}, (f32x4){k2[4], k2[5], k2[6], k2[7]});
        *(LAS v4u*)(L + KW + tok * 64 + seg * 16) = pack8((f32x4){k1[0], k1[1], k1[2], k1[3]} * kd, (f32x4){k1[4], k1[5], k1[6], k1[7]} * kd);
        *(LAS v4u*)(L + KW + 4096 + tok * 64 + seg * 16) = pack8((f32x4){k2[0], k2[1], k2[2], k2[3]} * kd, (f32x4){k2[4], k2[5], k2[6], k2[7]} * kd);
    } else {
        const int s4 = seg - 4;
        *(LAS v4u*)(L + VV + (s4 >> 1) * 4096 + tok * 64 + (s4 & 1) * 32) = ld[0];
        *(LAS v4u*)(L + VV + (s4 >> 1) * 4096 + tok * 64 + (s4 & 1) * 32 + 16) = ld[1];
    }
    RET_BAR();
    const int kfo = hi * 1024 + r32 * 16;
    const int vfo = ((lane >> 4) & 1) * 32 + (lane & 3) * 8 + (4 * hi + ((lane & 15) >> 2)) * 64;
    const int lb = wid & 1, eb = (wid >> 1) & 1;
    if (wid < 4) {
        bf16x8 qf[4];
#pragma unroll
        for (int ks = 0; ks < 4; ++ks) qf[ks] = *(const LAS bf16x8*)(L + QK + kfo + ks * 2048 + lb * 512);
        f32x16 o;
#pragma unroll
        for (int r = 0; r < 16; ++r) o[r] = 0.f;
        const LAS float* rt = tb + (63 + 4 * hi - 32 * lb - r32);
#pragma unroll
        for (int sb = 0; sb < 2; ++sb) {
            f32x16 T;
#pragma unroll
            for (int r = 0; r < 16; ++r) T[r] = 0.f;
#pragma unroll
            for (int ks = 0; ks < 4; ++ks) { const bf16x8 kf = *(const LAS bf16x8*)(L + KK + kfo + ks * 2048 + sb * 512); T = __builtin_amdgcn_mfma_f32_32x32x16_bf16(kf, qf[ks], T, 0, 0, 0); }
#pragma unroll
            for (int r = 0; r < 16; ++r) T[r] *= rt[32 * sb + (r & 3) + 8 * (r >> 2)];
            const bf16x8 pa0 = packfrag(T, 0), pa1 = packfrag(T, 1);
            const LAS char* vb = L + VV + eb * 4096 + vfo + sb * 2048;
            const bf16x8 v0 = trfrag(vb), v1 = trfrag(vb + 1024);
            o = __builtin_amdgcn_mfma_f32_32x32x16_bf16(pa0, v0, o, 0, 0, 0); o = __builtin_amdgcn_mfma_f32_32x32x16_bf16(pa1, v1, o, 0, 0, 0);
        }
#pragma unroll
        for (int r = 0; r < 16; ++r) os[(32 * lb + crow(r, hi)) * 68 + 32 * eb + r32] = o[r];
    } else {
        f32x16 S;
#pragma unroll
        for (int r = 0; r < 16; ++r) S[r] = 0.f;
#pragma unroll
        for (int ks = 0; ks < 4; ++ks) { const bf16x8 ka = trfrag(L + KW + lb * 4096 + vfo + ks * 1024), vbf = trfrag(L + VV + eb * 4096 + vfo + ks * 1024);
            S = __builtin_amdgcn_mfma_f32_32x32x16_bf16(ka, vbf, S, 0, 0, 0); }
        char* simg = (char*)(F.ws + WS_RST) + ((size_t)((b * 128 + c) * 4 + h)) * 8192;
#pragma unroll
        for (int gq = 0; gq < 4; ++gq) { u32x2 w; w.x = pk2(S[4 * gq], S[4 * gq + 1]); w.y = pk2(S[4 * gq + 2], S[4 * gq + 3]);
            *(u32x2*)(simg + (4 * lb + gq) * 1024 + (32 * eb + r32) * 16 + hi * 8) = w; }
    }
    RET_BAR();
    { const int row = wid * 8 + (lane >> 3), ch = lane & 7;
      const f32x4 a0 = *(const LAS f32x4*)(os + row * 68 + ch * 8), a1 = *(const LAS f32x4*)(os + row * 68 + ch * 8 + 4);
      *(v4u*)((bf16*)(F.ws + WS_OI) + (rowb + row) * 256 + h * 64 + ch * 8) = pack8(a0, a1); }
}

__device__ __forceinline__ void ret_m3_unit(Frame& F_, const Args& A, int l, int b, int c, int h) {
    Frame F = refresh(F_);
    const int tid = F.tid, lane = tid & 63, wid = F.wave, r32 = lane & 31, hi = lane >> 5;
    LAS char* L = (LAS char*)F.lds; LAS float* os = (LAS float*)(L + OS);
    const bf16* PROJ = (const bf16*)(F.ws + WS_BIG); bf16* MIXp = (bf16*)(F.ws + WS_MIX);
    const float lg2 = log2f(1.0f - exp2f(-5.0f - (float)h));
    const size_t rowb = (size_t)b * SEQ + (size_t)c * 64;
    const size_t ioff = ((size_t)((b * 128 + c) * 4 + h)) * 8192;
    const v4u q16 = *(const v4u*)((const char*)(F.ws + WS_QR) + ioff + tid * 16);
#if defined(RTEST) && RTEST == 3
    v4u s16; { const unsigned long long* sp = (const unsigned long long*)((const char*)(F.ws + WS_RST) + ioff + tid * 16);
        const unsigned long long a = __hip_atomic_load(sp, __ATOMIC_RELAXED, __HIP_MEMORY_SCOPE_AGENT), b2 = __hip_atomic_load(sp + 1, __ATOMIC_RELAXED, __HIP_MEMORY_SCOPE_AGENT);
        s16.x = (unsigned)a; s16.y = (unsigned)(a >> 32); s16.z = (unsigned)b2; s16.w = (unsigned)(b2 >> 32); }
#else
    const v4u s16 = *(const v4u*)((const char*)(F.ws + WS_RST) + ioff + tid * 16);
#endif
    const size_t erow = rowb + wid * 8 + (lane >> 3); const int ch = lane & 7;
    const v4u gt = *(const v4u*)(PROJ + erow * NPROJ + PC_RG + h * 64 + ch * 8);
    const v4u oi = *(const v4u*)((const bf16*)(F.ws + WS_OI) + erow * 256 + h * 64 + ch * 8);
    RET_BAR();
#if defined(RTEST) && RTEST == 5
    { v4u qq; qq.x = 0x3f803f80u; qq.y = 0x3f803f80u; qq.z = 0x3f803f80u; qq.w = 0x3f803f80u; (void)q16; *(LAS v4u*)(L + QK + tid * 16) = qq; *(LAS v4u*)(L + SB + tid * 16) = s16; }
#elif defined(RTEST) && RTEST == 6
    { v4u qq; qq.x = 0x3f803f80u; qq.y = 0x3f803f80u; qq.z = 0x3f803f80u; qq.w = 0x3f803f80u; (void)s16; *(LAS v4u*)(L + QK + tid * 16) = q16; *(LAS v4u*)(L + SB + tid * 16) = qq; }
#else
    *(LAS v4u*)(L + QK + tid * 16) = q16; *(LAS v4u*)(L + SB + tid * 16) = s16;
#endif
    RET_BAR();
    if (wid < 4) {
        const int kfo = hi * 1024 + r32 * 16, lb = wid & 1, eb = wid >> 1;
        f32x16 o;
#pragma unroll
        for (int r = 0; r < 16; ++r) o[r] = 0.f;
#pragma unroll
        for (int ks = 0; ks < 4; ++ks) { const bf16x8 qf = *(const LAS bf16x8*)(L + QK + kfo + ks * 2048 + lb * 512), sf = *(const LAS bf16x8*)(L + SB + kfo + ks * 2048 + eb * 512);
            o = __builtin_amdgcn_mfma_f32_32x32x16_bf16(qf, sf, o, 0, 0, 0); }
#pragma unroll
        for (int r = 0; r < 16; ++r) { const int lrow = 32 * lb + crow(r, hi); os[lrow * 68 + 32 * eb + r32] = o[r] * exp2f(lg2 * (float)(lrow + 1)); }
    }
    RET_BAR();
    { const int row = wid * 8 + (lane >> 3);
      f32x4 a0 = *(const LAS f32x4*)(os + row * 68 + ch * 8), a1 = *(const LAS f32x4*)(os + row * 68 + ch * 8 + 4);
#if defined(RTEST) && RTEST == 1
      a0 = lo4(oi); a1 = hi4(oi);
#elif defined(RTEST) && RTEST == 2
      (void)oi;
#else
      a0 += lo4(oi); a1 += hi4(oi);
#endif
      float ss = (a0.x * a0.x + a0.y * a0.y) + (a0.z * a0.z + a0.w * a0.w) + (a1.x * a1.x + a1.y * a1.y) + (a1.z * a1.z + a1.w * a1.w);
      ss += __shfl_xor(ss, 1); ss += __shfl_xor(ss, 2); ss += __shfl_xor(ss, 4);
      const float rstd = __builtin_amdgcn_rsqf(ss * (1.f / 64.f) + EPS);
      const f32x4 g0 = *(const f32x4*)(A.in[18] + l * 64 + ch * 8), g1 = *(const f32x4*)(A.in[18] + l * 64 + ch * 8 + 4);
      const f32x4 z0 = lo4(gt), z1 = hi4(gt);
      v4u w; w.x = pk2(silu_f(z0.x) * a0.x * rstd * g0.x, silu_f(z0.y) * a0.y * rstd * g0.y); w.y = pk2(silu_f(z0.z) * a0.z * rstd * g0.z, silu_f(z0.w) * a0.w * rstd * g0.w);
      w.z = pk2(silu_f(z1.x) * a1.x * rstd * g1.x, silu_f(z1.y) * a1.y * rstd * g1.y); w.w = pk2(silu_f(z1.z) * a1.z * rstd * g1.z, silu_f(z1.w) * a1.w * rstd * g1.w);
      *(v4u*)(MIXp + erow * D + 768 + h * 64 + ch * 8) = w; }
}
}
namespace ssds {
using ssd::u32x2;
using att::f32x16; using att::s16x4; using att::vtr; using att::crow;
constexpr int XS = 0, BK = 32768, CK = 40960, BW = 49152, HB = 81920, SM = 114688, CW = 122880;
constexpr int SM_VL = 0, SM_US = 256, SM_EO = 512, SM_WS = 768, SM_DT = 1024, SM_DK = 1028, SM_AK = 1032, SM_DB = 1036, SM_GN = 1040;
#undef SSD_BAR
#define SSD_BAR() asm volatile("s_waitcnt lgkmcnt(0)\n\ts_barrier" ::: "memory")
using ssd::trfrag;
using ssd::packfrag;

__device__ __forceinline__ void ssd_unit(Frame& F_, const Args& A, int l, int b, int g) {
    Frame F = refresh(F_);
    const int tid = F.tid, lane = tid & 63, wid = F.wave, r32 = lane & 31, hi = lane >> 5, hh = wid >> 1, lh = wid & 1;
    LAS char* L = (LAS char*)F.lds; LAS float* sm = (LAS float*)(L + SM); LAS float* cwl = (LAS float*)(L + CW);
    const bf16* PROJ = (const bf16*)(F.ws + WS_BIG); const float* DTg = (const float*)(F.ws + WS_DT); bf16* MIXp = (bf16*)(F.ws + WS_MIX);
    SSD_BAR();
    for (int i = tid; i < 5 * 384; i += 512) { const int w = i / 384, li = i - w * 384; const int ch = li < 256 ? g * 256 + li : li < 320 ? 512 + g * 64 + (li - 256) : 640 + g * 64 + (li - 320);
        cwl[i] = w < 4 ? A.in[12][(size_t)l * 4 * 768 + w * 768 + ch] : A.in[13][l * 768 + ch]; }
    for (int i = tid; i < 32768 / 16; i += 512) *(LAS v4u*)(L + HB + i * 16) = (v4u){0u, 0u, 0u, 0u};
    if (tid < 256) sm[SM_GN + tid] = A.in[17][l * 512 + g * 256 + tid];
    if (tid < 4) { sm[SM_DK + tid] = A.in[16][l * 8 + g * 4 + tid]; sm[SM_AK + tid] = -__expf(A.in[15][l * 8 + g * 4 + tid]); sm[SM_DB + tid] = A.in[14][l * 8 + g * 4 + tid]; }
    const int tg = tid / 48, cc = tid - tg * 48;
    const int gcol = PC_XBC + (cc < 32 ? g * 256 + cc * 8 : cc < 40 ? 512 + g * 64 + (cc - 32) * 8 : 640 + g * 64 + (cc - 40) * 8);
    const int dsto = cc < 32 ? XS + (cc >> 3) * 8192 + ((cc & 7) >> 2) * 4096 + ((cc & 3) * 8) * 2 : cc < 40 ? BK + (cc - 32) * 1024 : CK + (cc - 40) * 1024;
    const int dstr = cc < 32 ? 64 : 16;
    const size_t rb = (size_t)b * SEQ;
    v4u raw[11];
#define SSD_LOADRAW(c) do { _Pragma("unroll") for (int i = 0; i < 11; ++i) { const int trow = (c) * 64 + 8 * tg - 3 + i; \
        raw[i] = (tid < 384 && trow >= 0) ? *(const v4u*)(PROJ + (rb + trow) * NPROJ + gcol) : (v4u){0u, 0u, 0u, 0u}; } } while (0)
    SSD_LOADRAW(0);
    float dtr[4]; u32x2 zr[8];
#define SSD_LOADDT(c) do { if (wid == 7) { const f32x4 d4 = *(const f32x4*)(DTg + (rb + (c) * 64 + lane) * 8 + g * 4); dtr[0] = d4.x; dtr[1] = d4.y; dtr[2] = d4.z; dtr[3] = d4.w; } } while (0)
#define SSD_LOADZ(c) do { _Pragma("unroll") for (int k = 0; k < 8; ++k) zr[k] = *(const u32x2*)(PROJ + (rb + (c) * 64 + wid * 8 + k) * NPROJ + PC_Z + g * 256 + 4 * lane); } while (0)
    SSD_LOADDT(0);
    f32x16 hacc0, hacc1;
#pragma unroll
    for (int r = 0; r < 16; ++r) { hacc0[r] = 0.f; hacc1[r] = 0.f; }
    const int kfo0 = hi * 1024 + r32 * 16;
    const int vfo0 = ((lane >> 4) & 1) * 32 + (lane & 3) * 8 + (4 * hi + ((lane & 15) >> 2)) * 64;
    SSD_BAR();
    for (int c = 0; c < SEQ / 64; ++c) {
        const size_t rowb = rb + (size_t)c * 64;
        int kfo = kfo0, vfo = vfo0; asm volatile("" : "+v"(kfo), "+v"(vfo));
        if (tid < 384) {
            f32x4 w0a = *(const LAS f32x4*)(cwl + cc * 8), w0b = *(const LAS f32x4*)(cwl + cc * 8 + 4), w1a = *(const LAS f32x4*)(cwl + 384 + cc * 8), w1b = *(const LAS f32x4*)(cwl + 384 + cc * 8 + 4);
            f32x4 w2a = *(const LAS f32x4*)(cwl + 768 + cc * 8), w2b = *(const LAS f32x4*)(cwl + 768 + cc * 8 + 4), w3a = *(const LAS f32x4*)(cwl + 1152 + cc * 8), w3b = *(const LAS f32x4*)(cwl + 1152 + cc * 8 + 4);
            const f32x4 cba = *(const LAS f32x4*)(cwl + 1536 + cc * 8), cbb = *(const LAS f32x4*)(cwl + 1536 + cc * 8 + 4);
#define SSD_LO(q_) ((f32x4){bflo((q_).x), bfhi((q_).x), bflo((q_).y), bfhi((q_).y)})
#define SSD_HI(q_) ((f32x4){bflo((q_).z), bfhi((q_).z), bflo((q_).w), bfhi((q_).w)})
#pragma unroll
            for (int j = 0; j < 8; ++j) {
                f32x4 va = cba + SSD_LO(raw[j]) * w0a + SSD_LO(raw[j + 1]) * w1a + SSD_LO(raw[j + 2]) * w2a + SSD_LO(raw[j + 3]) * w3a;
                f32x4 vb = cbb + SSD_HI(raw[j]) * w0b + SSD_HI(raw[j + 1]) * w1b + SSD_HI(raw[j + 2]) * w2b + SSD_HI(raw[j + 3]) * w3b;
                v4u o; o.x = pk2(silu_f(va.x), silu_f(va.y)); o.y = pk2(silu_f(va.z), silu_f(va.w)); o.z = pk2(silu_f(vb.x), silu_f(vb.y)); o.w = pk2(silu_f(vb.z), silu_f(vb.w));
                *(LAS v4u*)(L + dsto + (8 * tg + j) * dstr) = o;
            }
        } else if (wid == 7) {
            float tot[4];
#pragma unroll
            for (int k = 0; k < 4; ++k) { const float Ak = sm[SM_AK + k], dbk = sm[SM_DB + k];
                const float xr = dtr[k] + dbk; const float dt = xr > 20.f ? xr : log1pf(__expf(xr));
                float acs = Ak * dt;
#pragma unroll
                for (int o = 1; o < 64; o <<= 1) { const float u = __shfl_up(acs, o); if (lane >= o) acs += u; }
                tot[k] = __shfl(acs, 63);
                sm[SM_VL + k * 64 + lane] = acs * LOG2E; sm[SM_US + k * 64 + lane] = acs * LOG2E - __log2f(dt);
                sm[SM_EO + k * 64 + lane] = __expf(acs); sm[SM_WS + k * 64 + lane] = __expf(tot[k] - acs) * dt; }
            if (lane == 0) { sm[SM_DT + 0] = __expf(tot[0]); sm[SM_DT + 1] = __expf(tot[1]); sm[SM_DT + 2] = __expf(tot[2]); sm[SM_DT + 3] = __expf(tot[3]); }
        }
        if (c + 1 < SEQ / 64) { SSD_LOADRAW(c + 1); SSD_LOADDT(c + 1); }
        SSD_BAR();
        { const int s = tid >> 3, nc = tid & 7; const v4u b8 = *(const LAS v4u*)(L + BK + nc * 1024 + s * 16);
          const f32x4 ba = SSD_LO(b8), bb = SSD_HI(b8);
#pragma unroll
          for (int k = 0; k < 4; ++k) { const float w = sm[SM_WS + k * 64 + s]; v4u o; o.x = pk2(ba.x * w, ba.y * w); o.y = pk2(ba.z * w, ba.w * w); o.z = pk2(bb.x * w, bb.y * w); o.w = pk2(bb.z * w, bb.w * w);
              *(LAS v4u*)(L + BW + k * 8192 + (nc >> 2) * 4096 + s * 64 + (nc & 3) * 16) = o; } }
        SSD_BAR();
        SSD_LOADZ(c);
        f32x16 y0, y1;
        {
            bf16x8 cf[4];
#pragma unroll
            for (int ks = 0; ks < 4; ++ks) cf[ks] = *(const LAS bf16x8*)(L + CK + kfo + ks * 2048 + lh * 512);
#pragma unroll
            for (int r = 0; r < 16; ++r) { y0[r] = 0.f; y1[r] = 0.f; }
#pragma unroll
            for (int ks = 0; ks < 4; ++ks) { const bf16x8 h0 = *(const LAS bf16x8*)(L + HB + hh * 8192 + kfo + ks * 2048), h1 = *(const LAS bf16x8*)(L + HB + hh * 8192 + kfo + ks * 2048 + 512);
                y0 = __builtin_amdgcn_mfma_f32_32x32x16_bf16(cf[ks], h0, y0, 0, 0, 0); y1 = __builtin_amdgcn_mfma_f32_32x32x16_bf16(cf[ks], h1, y1, 0, 0, 0); }
#pragma unroll
            for (int r = 0; r < 16; ++r) { const float e = sm[SM_EO + hh * 64 + 32 * lh + crow(r, hi)]; y0[r] *= e; y1[r] *= e; }
            const float vl = sm[SM_VL + hh * 64 + 32 * lh + r32];
#pragma unroll
            for (int sb = 0; sb < 2; ++sb) {
                if (sb <= lh) {
                    f32x16 T;
#pragma unroll
                    for (int r = 0; r < 16; ++r) T[r] = 0.f;
#pragma unroll
                    for (int ks = 0; ks < 4; ++ks) { const bf16x8 bfr = *(const LAS bf16x8*)(L + BK + kfo + ks * 2048 + sb * 512); T = __builtin_amdgcn_mfma_f32_32x32x16_bf16(bfr, cf[ks], T, 0, 0, 0); }
#pragma unroll
                    for (int r = 0; r < 16; ++r) { const float us = sm[SM_US + hh * 64 + 32 * sb + crow(r, hi)]; float w = T[r] * __builtin_amdgcn_exp2f(vl - us);
                        if (sb == lh && crow(r, hi) > r32) w = 0.f; T[r] = w; }
                    const bf16x8 pa0 = packfrag(T, 0), pa1 = packfrag(T, 1);
                    const LAS char* xb = L + XS + hh * 8192 + vfo + sb * 2048;
                    const bf16x8 x00 = trfrag(xb), x01 = trfrag(xb + 4096), x10 = trfrag(xb + 1024), x11 = trfrag(xb + 4096 + 1024);
                    y0 = __builtin_amdgcn_mfma_f32_32x32x16_bf16(pa0, x00, y0, 0, 0, 0); y1 = __builtin_amdgcn_mfma_f32_32x32x16_bf16(pa0, x01, y1, 0, 0, 0);
                    y0 = __builtin_amdgcn_mfma_f32_32x32x16_bf16(pa1, x10, y0, 0, 0, 0); y1 = __builtin_amdgcn_mfma_f32_32x32x16_bf16(pa1, x11, y1, 0, 0, 0);
                }
            }
            const float dtot = sm[SM_DT + hh];
#pragma unroll
            for (int r = 0; r < 16; ++r) { hacc0[r] *= dtot; hacc1[r] *= dtot; }
#pragma unroll
            for (int ks = 0; ks < 4; ++ks) { const bf16x8 xa = trfrag(L + XS + hh * 8192 + lh * 4096 + vfo + ks * 1024), b0 = trfrag(L + BW + hh * 8192 + vfo + ks * 1024), b1 = trfrag(L + BW + hh * 8192 + 4096 + vfo + ks * 1024);
                hacc0 = __builtin_amdgcn_mfma_f32_32x32x16_bf16(xa, b0, hacc0, 0, 0, 0); hacc1 = __builtin_amdgcn_mfma_f32_32x32x16_bf16(xa, b1, hacc1, 0, 0, 0); }
        }
        SSD_BAR();
#pragma unroll
        for (int r = 0; r < 16; ++r) { const int p = 32 * lh + crow(r, hi);
            *(LAS unsigned short*)(L + HB + hh * 8192 + (r32 >> 3) * 1024 + p * 16 + (r32 & 7) * 2) = (unsigned short)f2bf(hacc0[r]);
            *(LAS unsigned short*)(L + HB + hh * 8192 + (4 + (r32 >> 3)) * 1024 + p * 16 + (r32 & 7) * 2) = (unsigned short)f2bf(hacc1[r]);
            const int lrow = 32 * lh + crow(r, hi);
            *(LAS unsigned short*)(L + BW + (lrow * 256 + hh * 64 + r32) * 2) = (unsigned short)f2bf(y0[r]);
            *(LAS unsigned short*)(L + BW + (lrow * 256 + hh * 64 + 32 + r32) * 2) = (unsigned short)f2bf(y1[r]); }
        SSD_BAR();
        const float Dk = sm[SM_DK + (lane >> 4)]; const f32x4 gn4 = *(const LAS f32x4*)(sm + SM_GN + 4 * lane);
#pragma unroll
        for (int k = 0; k < 8; ++k) { const int tk = wid * 8 + k; const int hd = lane >> 4, p = (4 * lane) & 63;
            const u32x2 yv = *(const LAS u32x2*)(L + BW + (tk * 256 + 4 * lane) * 2), xv = *(const LAS u32x2*)(L + XS + hd * 8192 + (p >> 5) * 4096 + tk * 64 + (p & 31) * 2);
            f32x4 v; v.x = (bflo(yv.x) + Dk * bflo(xv.x)) * silu_f(bflo(zr[k].x)); v.y = (bfhi(yv.x) + Dk * bfhi(xv.x)) * silu_f(bfhi(zr[k].x));
            v.z = (bflo(yv.y) + Dk * bflo(xv.y)) * silu_f(bflo(zr[k].y)); v.w = (bfhi(yv.y) + Dk * bfhi(xv.y)) * silu_f(bfhi(zr[k].y));
            const float rstd = __builtin_amdgcn_rsqf(wave_sum((v.x * v.x + v.y * v.y) + (v.z * v.z + v.w * v.w)) * (1.f / 256.f) + EPS);
            u32x2 o; o.x = pk2(v.x * rstd * gn4.x, v.y * rstd * gn4.y); o.y = pk2(v.z * rstd * gn4.z, v.w * rstd * gn4.w);
            *(u32x2*)(MIXp + (rowb + tk) * D + 256 + g * 256 + 4 * lane) = o; }
        SSD_BAR();
    }
#undef SSD_LOADRAW
#undef SSD_LOADDT
#undef SSD_LOADZ
#undef SSD_LO
#undef SSD_HI
}
}
namespace rets {
using att::f32x16; using att::crow; using ssd::trfrag; using ssd::packfrag; using ssd::u32x2;
constexpr int QK = 0, KK = 8192, KW = 16384, VV = 24576, SB = 32768, OS = 40960, TB = 58368;
#undef RET_BAR
#define RET_BAR() asm volatile("s_waitcnt lgkmcnt(0)\n\ts_barrier" ::: "memory")
__device__ __forceinline__ f32x4 lo4(const v4u q_) { return (f32x4){bflo(q_.x), bfhi(q_.x), bflo(q_.y), bfhi(q_.y)}; }
__device__ __forceinline__ f32x4 hi4(const v4u q_) { return (f32x4){bflo(q_.z), bfhi(q_.z), bflo(q_.w), bfhi(q_.w)}; }
__device__ __forceinline__ v4u pack8(const f32x4 a, const f32x4 b) { v4u o; o.x = pk2(a.x, a.y); o.y = pk2(a.z, a.w); o.z = pk2(b.x, b.y); o.w = pk2(b.z, b.w); return o; }

__device__ __forceinline__ void ret_unit(Frame& F_, const Args& A, int l, int b, int h) {
    Frame F = refresh(F_);
    const int tid = F.tid, lane = tid & 63, wid = F.wave, r32 = lane & 31, hi = lane >> 5;
    LAS char* L = (LAS char*)F.lds; LAS float* tb = (LAS float*)(L + TB); LAS float* os = (LAS float*)(L + OS);
    const bf16* PROJ = (const bf16*)(F.ws + WS_BIG); bf16* MIXp = (bf16*)(F.ws + WS_MIX);
    const float gam = 1.0f - exp2f(-5.0f - (float)h), lg2 = log2f(gam), g64 = exp2f(lg2 * 64.f);
    RET_BAR();
    if (tid < 128) tb[tid] = exp2f(lg2 * (float)(tid < 63 ? 63 - tid : tid - 63));
    else if (tid < 192) tb[tid] = exp2f(lg2 * (float)(tid - 128 + 1));
    else if (tid < 256) tb[tid] = exp2f(lg2 * (float)(63 - (tid - 192)));
    for (int i = tid; i < 8192 / 16; i += 512) *(LAS v4u*)(L + SB + i * 16) = (v4u){0u, 0u, 0u, 0u};
    const int tok = tid >> 3, seg = tid & 7;
    const size_t rb = (size_t)b * SEQ;
    v4u ld[4];
#define RET_LOAD(c) do { const bf16* rp = PROJ + (rb + (c) * 64 + tok) * NPROJ; \
        if (seg < 4) { ld[0] = *(const v4u*)(rp + PC_RQ + h * 64 + seg * 8); ld[1] = *(const v4u*)(rp + PC_RQ + h * 64 + 32 + seg * 8); ld[2] = *(const v4u*)(rp + PC_RK + h * 64 + seg * 8); ld[3] = *(const v4u*)(rp + PC_RK + h * 64 + 32 + seg * 8); } \
        else { ld[0] = *(const v4u*)(rp + PC_RV + h * 64 + (seg - 4) * 16); ld[1] = *(const v4u*)(rp + PC_RV + h * 64 + (seg - 4) * 16 + 8); } } while (0)
    RET_LOAD(0);
    f32x16 Sacc;
#pragma unroll
    for (int r = 0; r < 16; ++r) Sacc[r] = 0.f;
    const int kfo0 = hi * 1024 + r32 * 16;
    const int vfo0 = ((lane >> 4) & 1) * 32 + (lane & 3) * 8 + (4 * hi + ((lane & 15) >> 2)) * 64;
    const int lb = wid & 1, eb = (wid >> 1) & 1;
    RET_BAR();
    for (int c = 0; c < SEQ / 64; ++c) {
        int kfo = kfo0, vfo = vfo0; asm volatile("" : "+v"(kfo), "+v"(vfo));
        if (seg < 4) {
            const f32x4 qla = lo4(ld[0]), qlb = hi4(ld[0]), qha = lo4(ld[1]), qhb = hi4(ld[1]), kla = lo4(ld[2]), klb = hi4(ld[2]), kha = lo4(ld[3]), khb = hi4(ld[3]);
            float ql[8] = {qla.x, qla.y, qla.z, qla.w, qlb.x, qlb.y, qlb.z, qlb.w}, qh[8] = {qha.x, qha.y, qha.z, qha.w, qhb.x, qhb.y, qhb.z, qhb.w};
            float kl[8] = {kla.x, kla.y, kla.z, kla.w, klb.x, klb.y, klb.z, klb.w}, kh[8] = {kha.x, kha.y, kha.z, kha.w, khb.x, khb.y, khb.z, khb.w};
            float q1[8], q2[8], k1[8], k2[8];
            const float pos = (float)(c * 64 + tok);
#pragma unroll
            for (int i = 0; i < 8; ++i) { const int fi = seg * 8 + i; const float invf = exp2f(-(float)fi * (13.287712379549449f / 32.0f)); const float ang = pos * invf;
                double rev = (double)ang * 0.15915494309189535; rev -= __builtin_rint(rev); const float fr = (float)rev;
                const float sn = __builtin_amdgcn_sinf(fr), cs = __builtin_amdgcn_cosf(fr);
                q1[i] = ql[i] * cs - qh[i] * sn; q2[i] = ql[i] * sn + qh[i] * cs; k1[i] = kl[i] * cs - kh[i] * sn; k2[i] = kl[i] * sn + kh[i] * cs; }
            const float kd = tb[192 + tok];
            *(LAS v4u*)(L + QK + seg * 1024 + tok * 16) = pack8((f32x4){q1[0], q1[1], q1[2], q1[3]}, (f32x4){q1[4], q1[5], q1[6], q1[7]});
            *(LAS v4u*)(L + QK + (seg + 4) * 1024 + tok * 16) = pack8((f32x4){q2[0], q2[1], q2[2], q2[3]}, (f32x4){q2[4], q2[5], q2[6], q2[7]});
            *(LAS v4u*)(L + KK + seg * 1024 + tok * 16) = pack8((f32x4){k1[0], k1[1], k1[2], k1[3]}, (f32x4){k1[4], k1[5], k1[6], k1[7]});
            *(LAS v4u*)(L + KK + (seg + 4) * 1024 + tok * 16) = pack8((f32x4){k2[0], k2[1], k2[2], k2[3]}, (f32x4){k2[4], k2[5], k2[6], k2[7]});
            *(LAS v4u*)(L + KW + tok * 64 + seg * 16) = pack8((f32x4){k1[0], k1[1], k1[2], k1[3]} * kd, (f32x4){k1[4], k1[5], k1[6], k1[7]} * kd);
            *(LAS v4u*)(L + KW + 4096 + tok * 64 + seg * 16) = pack8((f32x4){k2[0], k2[1], k2[2], k2[3]} * kd, (f32x4){k2[4], k2[5], k2[6], k2[7]} * kd);
        } else {
            const int s4 = seg - 4;
            *(LAS v4u*)(L + VV + (s4 >> 1) * 4096 + tok * 64 + (s4 & 1) * 32) = ld[0];
            *(LAS v4u*)(L + VV + (s4 >> 1) * 4096 + tok * 64 + (s4 & 1) * 32 + 16) = ld[1];
        }
        if (c + 1 < SEQ / 64) RET_LOAD(c + 1);
        const size_t erow = rb + (size_t)c * 64 + wid * 8 + (lane >> 3);
        const v4u gt = *(const v4u*)(PROJ + erow * NPROJ + PC_RG + h * 64 + (lane & 7) * 8);
        RET_BAR();
        f32x16 o;
        if (wid < 4) {
            bf16x8 qf[4];
#pragma unroll
            for (int ks = 0; ks < 4; ++ks) qf[ks] = *(const LAS bf16x8*)(L + QK + kfo + ks * 2048 + lb * 512);
#pragma unroll
            for (int r = 0; r < 16; ++r) o[r] = 0.f;
#pragma unroll
            for (int ks = 0; ks < 4; ++ks) { const bf16x8 sf = *(const LAS bf16x8*)(L + SB + kfo + ks * 2048 + eb * 512); o = __builtin_amdgcn_mfma_f32_32x32x16_bf16(qf[ks], sf, o, 0, 0, 0); }
#pragma unroll
            for (int r = 0; r < 16; ++r) o[r] *= tb[128 + 32 * lb + crow(r, hi)];
            const LAS float* rt = tb + (63 + 4 * hi - 32 * lb - r32);
#pragma unroll
            for (int sb = 0; sb < 2; ++sb) {
                f32x16 T;
#pragma unroll
                for (int r = 0; r < 16; ++r) T[r] = 0.f;
#pragma unroll
                for (int ks = 0; ks < 4; ++ks) { const bf16x8 kf = *(const LAS bf16x8*)(L + KK + kfo + ks * 2048 + sb * 512); T = __builtin_amdgcn_mfma_f32_32x32x16_bf16(kf, qf[ks], T, 0, 0, 0); }
#pragma unroll
                for (int r = 0; r < 16; ++r) T[r] *= rt[32 * sb + (r & 3) + 8 * (r >> 2)];
                const bf16x8 pa0 = packfrag(T, 0), pa1 = packfrag(T, 1);
                const LAS char* vb = L + VV + eb * 4096 + vfo + sb * 2048;
                const bf16x8 v0 = trfrag(vb), v1 = trfrag(vb + 1024);
                o = __builtin_amdgcn_mfma_f32_32x32x16_bf16(pa0, v0, o, 0, 0, 0); o = __builtin_amdgcn_mfma_f32_32x32x16_bf16(pa1, v1, o, 0, 0, 0);
            }
        } else {
#pragma unroll
            for (int r = 0; r < 16; ++r) Sacc[r] *= g64;
#pragma unroll
            for (int ks = 0; ks < 4; ++ks) { const bf16x8 ka = trfrag(L + KW + lb * 4096 + vfo + ks * 1024), vbf = trfrag(L + VV + eb * 4096 + vfo + ks * 1024);
                Sacc = __builtin_amdgcn_mfma_f32_32x32x16_bf16(ka, vbf, Sacc, 0, 0, 0); }
        }
        RET_BAR();
        if (wid < 4) {
#pragma unroll
            for (int r = 0; r < 16; ++r) os[(32 * lb + crow(r, hi)) * 68 + 32 * eb + r32] = o[r];
        } else {
#pragma unroll
            for (int gq = 0; gq < 4; ++gq) { u32x2 w; w.x = pk2(Sacc[4 * gq], Sacc[4 * gq + 1]); w.y = pk2(Sacc[4 * gq + 2], Sacc[4 * gq + 3]);
                *(LAS u32x2*)(L + SB + (4 * lb + gq) * 1024 + (32 * eb + r32) * 16 + hi * 8) = w; }
        }
        RET_BAR();
        { const int row = wid * 8 + (lane >> 3), ch = lane & 7;
          const f32x4 a0 = *(const LAS f32x4*)(os + row * 68 + ch * 8), a1 = *(const LAS f32x4*)(os + row * 68 + ch * 8 + 4);
          float ss = (a0.x * a0.x + a0.y * a0.y) + (a0.z * a0.z + a0.w * a0.w) + (a1.x * a1.x + a1.y * a1.y) + (a1.z * a1.z + a1.w * a1.w);
          ss += __shfl_xor(ss, 1); ss += __shfl_xor(ss, 2); ss += __shfl_xor(ss, 4);
          const float rstd = __builtin_amdgcn_rsqf(ss * (1.f / 64.f) + EPS);
          const f32x4 g0 = *(const f32x4*)(A.in[18] + l * 64 + ch * 8), g1 = *(const f32x4*)(A.in[18] + l * 64 + ch * 8 + 4);
          const f32x4 z0 = lo4(gt), z1 = hi4(gt);
          v4u w; w.x = pk2(silu_f(z0.x) * a0.x * rstd * g0.x, silu_f(z0.y) * a0.y * rstd * g0.y); w.y = pk2(silu_f(z0.z) * a0.z * rstd * g0.z, silu_f(z0.w) * a0.w * rstd * g0.w);
          w.z = pk2(silu_f(z1.x) * a1.x * rstd * g1.x, silu_f(z1.y) * a1.y * rstd * g1.y); w.w = pk2(silu_f(z1.z) * a1.z * rstd * g1.z, silu_f(z1.w) * a1.w * rstd * g1.w);
          *(v4u*)(MIXp + erow * D + 768 + h * 64 + ch * 8) = w; }
    }
    RET_BAR();
#undef RET_LOAD
}
}
__device__ __forceinline__ void attn_naive_unit(Frame& F_, const Args& A, int l, int b, int h, int qb, float lam, float lam_init) {
    Frame F = refresh(F_);
    LAS float* Ks = (LAS float*)F.lds;
    LAS float* Vs = Ks + 4096;
    LAS float* Bt = Vs + 4096;
    LAS float* Ob = (LAS float*)(F.lds + 36864);
    const int tid = F.tid, t = tid >> 8, r = tid & 255;
    const int Q0 = qb * 256, row = Q0 + r; const size_t grow = (size_t)b * SEQ + row;
    const bf16* PROJ = (const bf16*)(F.ws + WS_BIG);
    __syncthreads();
    if (tid < 192) Bt[tid] = A.in[6][t5_bucket(tid - 128) * 4 + h] * LOG2E;
    f32x4 q4[8];
    { const v4u* qp = (const v4u*)(PROJ + grow * NPROJ + PC_Q + h * 64 + t * 32);
#pragma unroll
      for (int i = 0; i < 4; ++i) { const v4u w = qp[i]; q4[2 * i] = (f32x4){bflo(w.x), bfhi(w.x), bflo(w.y), bfhi(w.y)}; q4[2 * i + 1] = (f32x4){bflo(w.z), bfhi(w.z), bflo(w.w), bfhi(w.w)}; } }
    f32x4 O4[16];
#pragma unroll
    for (int e = 0; e < 16; ++e) O4[e] = (f32x4){0.f, 0.f, 0.f, 0.f};
    float mrun = -1.0e30f, lsum = 0.f;
    const int cq = row >> 6, nck = (Q0 >> 6) + 4;
    for (int ck = 0; ck < nck; ++ck) {
        __syncthreads();
        { const int key = tid >> 3, seg = tid & 7; const bf16* kp = PROJ + ((size_t)b * SEQ + ck * 64 + key) * NPROJ + PC_K + h * 64 + seg * 8;
          const v4u kw = *(const v4u*)kp, vw = *(const v4u*)(kp + 256);
          LAS f32x4* kd = (LAS f32x4*)(Ks + (seg >> 2) * 2048 + key * 32 + (seg & 3) * 8); LAS f32x4* vd = (LAS f32x4*)(Vs + key * 64 + seg * 8);
          kd[0] = (f32x4){bflo(kw.x), bfhi(kw.x), bflo(kw.y), bfhi(kw.y)}; kd[1] = (f32x4){bflo(kw.z), bfhi(kw.z), bflo(kw.w), bfhi(kw.w)};
          vd[0] = (f32x4){bflo(vw.x), bfhi(vw.x), bflo(vw.y), bfhi(vw.y)}; vd[1] = (f32x4){bflo(vw.z), bfhi(vw.z), bflo(vw.w), bfhi(vw.w)}; }
        __syncthreads();
        if (ck <= cq) {
            const int kbase = ck * 64 - row;
#pragma unroll 1
            for (int j = 0; j < 64; ++j) {
                const LAS f32x4* kr = (const LAS f32x4*)(Ks + t * 2048 + j * 32);
                f32x4 a4 = q4[0] * kr[0];
#pragma unroll
                for (int d = 1; d < 8; ++d) a4 += q4[d] * kr[d];
                int rel = kbase + j; rel = rel < -128 ? -128 : rel;
                const float sj = (a4.x + a4.y) + (a4.z + a4.w) + Bt[rel + 128];
                if (sj > mrun) { const float sc = __builtin_amdgcn_exp2f(mrun - sj); lsum *= sc;
#pragma unroll
                    for (int e = 0; e < 16; ++e) O4[e] *= sc;
                    mrun = sj; }
                const float p = __builtin_amdgcn_exp2f(sj - mrun); lsum += p;
                const LAS f32x4* vr = (const LAS f32x4*)(Vs + j * 64);
#pragma unroll
                for (int e = 0; e < 16; ++e) O4[e] += vr[e] * p;
            }
        }
    }
    __syncthreads();
    const float inv = 1.0f / lsum;
    if (t == 1) {
#pragma unroll
        for (int e = 0; e < 16; ++e) *(LAS f32x4*)(Ob + r * 68 + 4 * e) = O4[e] * inv; }
    __syncthreads();
    if (t == 0) { f32x4 ss4 = (f32x4){0.f, 0.f, 0.f, 0.f};
#pragma unroll
        for (int e = 0; e < 16; ++e) { const f32x4 o = O4[e] * inv - *(const LAS f32x4*)(Ob + r * 68 + 4 * e) * lam; O4[e] = o; ss4 += o * o; }
        const float rstd = __builtin_amdgcn_rsqf(((ss4.x + ss4.y) + (ss4.z + ss4.w)) * (1.f / 64.f) + EPS) * (1.0f - lam_init);
        const f32x4* gn = (const f32x4*)(A.in[11] + l * 64); v4u* op = (v4u*)((bf16*)(F.ws + WS_MIX) + grow * D + h * 64);
#pragma unroll
        for (int e = 0; e < 16; e += 2) { const f32x4 o0 = O4[e] * gn[e] * rstd, o1 = O4[e + 1] * gn[e + 1] * rstd;
            v4u w; w.x = pk2(o0.x, o0.y); w.y = pk2(o0.z, o0.w); w.z = pk2(o1.x, o1.y); w.w = pk2(o1.z, o1.w); op[e >> 1] = w; } }
    __syncthreads();
}

__device__ __forceinline__ void ssd_naive_unit(Frame& F_, const Args& A, int l, int b, int g) {
    Frame F = refresh(F_);
    LAS float* xs = (LAS float*)F.lds;
    LAS float* Bs = xs + 64 * 256;
    LAS float* Cs = Bs + 4096;
    LAS float* dts = Cs + 4096;
    LAS float* dAs = dts + 256;
    const int tid = F.tid, hh = tid >> 7, p = (tid & 127) >> 1, nh = tid & 1, head = g * 4 + hh;
    const float Dk = A.in[16][l * 8 + head];
    float hst[32];
#pragma unroll
    for (int i = 0; i < 32; ++i) hst[i] = 0.f;
    int ch = 0; float w0 = 0.f, w1 = 0.f, w2 = 0.f, w3 = 0.f, cb = 0.f, r0 = 0.f, r1 = 0.f, r2 = 0.f;
    if (tid < 384) { ch = tid < 256 ? g * 256 + tid : tid < 320 ? 512 + g * 64 + (tid - 256) : 640 + g * 64 + (tid - 320);
        const float* cw = A.in[12] + (size_t)l * 4 * 768; w0 = cw[ch]; w1 = cw[768 + ch]; w2 = cw[2 * 768 + ch]; w3 = cw[3 * 768 + ch]; cb = A.in[13][l * 768 + ch]; }
    for (int c = 0; c < SEQ / 64; ++c) {
        __syncthreads();
        const size_t rowb = (size_t)b * SEQ + c * 64;
        if (tid < 384) { const bf16* src = ((bf16*)(F.ws + WS_BIG)) + rowb * NPROJ + PC_XBC + ch; LAS float* dst = tid < 256 ? xs + tid : tid < 320 ? Bs + (tid - 256) : Cs + (tid - 320); const int dstr = tid < 256 ? 256 : 64;
            _Pragma("unroll 16") for (int tt = 0; tt < 64; ++tt) { const float r3 = bf2f(src[(size_t)tt * NPROJ]); const float v = cb + r0 * w0 + r1 * w1 + r2 * w2 + r3 * w3; dst[tt * dstr] = silu_f(v); r0 = r1; r1 = r2; r2 = r3; } }
        else if (tid < 384 + 64) { const int tt = tid - 384;
#pragma unroll
            for (int k = 0; k < 4; ++k) { const int hd = g * 4 + k; const float xr = ((float*)(F.ws + WS_DT))[(rowb + tt) * 8 + hd] + A.in[14][l * 8 + hd]; const float dt = xr > 20.f ? xr : log1pf(__expf(xr));
                dts[tt * 4 + k] = dt; dAs[tt * 4 + k] = __expf(-__expf(A.in[15][l * 8 + hd]) * dt); } }
        __syncthreads();
        for (int tt = 0; tt < 64; ++tt) {
            const float x = xs[tt * 256 + hh * 64 + p], dt = dts[tt * 4 + hh], dA = dAs[tt * 4 + hh], cx = dt * x;
            const LAS float* Br = Bs + tt * 64 + nh * 32; const LAS float* Cr = Cs + tt * 64 + nh * 32; float a = 0.f;
#pragma unroll
            for (int i = 0; i < 32; i += 4) { const f32x4 bb = *(const LAS f32x4*)(Br + i), cc = *(const LAS f32x4*)(Cr + i);
                hst[i] = hst[i] * dA + cx * bb.x; hst[i + 1] = hst[i + 1] * dA + cx * bb.y; hst[i + 2] = hst[i + 2] * dA + cx * bb.z; hst[i + 3] = hst[i + 3] * dA + cx * bb.w;
                a += (hst[i] * cc.x + hst[i + 1] * cc.y) + (hst[i + 2] * cc.z + hst[i + 3] * cc.w); }
            a += __shfl_xor(a, 1);
            if (nh == 0) xs[tt * 256 + hh * 64 + p] = a + Dk * x;
        }
        __syncthreads();
        for (int k = 0; k < 8; ++k) { const int tt = F.wave * 8 + k; const size_t row = rowb + tt;
            const f32x4 y = *(const LAS f32x4*)(xs + tt * 256 + 4 * F.lane); const uint2 zz = *(const uint2*)(((bf16*)(F.ws + WS_BIG)) + row * NPROJ + PC_Z + g * 256 + 4 * F.lane);
            f32x4 v; v.x = y.x * silu_f(bflo(zz.x)); v.y = y.y * silu_f(bfhi(zz.x)); v.z = y.z * silu_f(bflo(zz.y)); v.w = y.w * silu_f(bfhi(zz.y));
            const float rstd = __builtin_amdgcn_rsqf(wave_sum((v.x * v.x + v.y * v.y) + (v.z * v.z + v.w * v.w)) * (1.f / 256.f) + EPS);
            const f32x4 gn = *(const f32x4*)(A.in[17] + l * 512 + g * 256 + 4 * F.lane);
            uint2 o; o.x = pk2(v.x * rstd * gn.x, v.y * rstd * gn.y); o.y = pk2(v.z * rstd * gn.z, v.w * rstd * gn.w);
            *(uint2*)(((bf16*)(F.ws + WS_MIX)) + row * D + 256 + g * 256 + 4 * F.lane) = o; }
    }
    __syncthreads();
}

__device__ __forceinline__ void ret_naive_unit(Frame& F_, const Args& A, int l, int b, int h) {
    Frame F = refresh(F_);
    constexpr int ST = 68;
    LAS float* qs = (LAS float*)F.lds; LAS float* ks = qs + 64 * ST; LAS float* vs = ks + 64 * ST; LAS float* sc = vs + 64 * ST; LAS float* Ss = sc + 64 * ST; LAS float* os = Ss + 64 * ST;
    const int tid = F.tid, ra = tid >> 3, eg = tid & 7;
    const float gam = 1.0f - exp2f(-5.0f - (float)h), lg2 = log2f(gam), g64 = exp2f(lg2 * 64.f);
    float Sreg[8];
#pragma unroll
    for (int i = 0; i < 8; ++i) Sreg[i] = 0.f;
    __syncthreads();
#pragma unroll
    for (int i = 0; i < 8; ++i) Ss[ra * ST + eg * 8 + i] = 0.f;
    for (int c = 0; c < SEQ / 64; ++c) {
        __syncthreads();
        const size_t rowb = (size_t)b * SEQ + c * 64;
        { const int tok = ra, seg = eg; const bf16* rp = ((bf16*)(F.ws + WS_BIG)) + (rowb + tok) * NPROJ;
          if (seg < 4) { float ql[8], qh[8], kl[8], kh[8];
              unpack8(*(const v4u*)(rp + PC_RQ + h * 64 + seg * 8), ql); unpack8(*(const v4u*)(rp + PC_RQ + h * 64 + 32 + seg * 8), qh);
              unpack8(*(const v4u*)(rp + PC_RK + h * 64 + seg * 8), kl); unpack8(*(const v4u*)(rp + PC_RK + h * 64 + 32 + seg * 8), kh);
              const float pos = (float)(c * 64 + tok);
#pragma unroll
              for (int i = 0; i < 8; ++i) { const int fi = seg * 8 + i; const float invf = exp2f(-(float)fi * (13.287712379549449f / 32.0f)); const float ang = pos * invf;
                  double rev = (double)ang * 0.15915494309189535; rev -= __builtin_rint(rev); const float fr = (float)rev;
                  const float sn = __builtin_amdgcn_sinf(fr), cs = __builtin_amdgcn_cosf(fr);
                  qs[tok * ST + fi] = ql[i] * cs - qh[i] * sn; qs[tok * ST + fi + 32] = ql[i] * sn + qh[i] * cs;
                  ks[tok * ST + fi] = kl[i] * cs - kh[i] * sn; ks[tok * ST + fi + 32] = kl[i] * sn + kh[i] * cs; } }
          else { float va[8], vb[8]; const int c0 = (seg - 4) * 16; unpack8(*(const v4u*)(rp + PC_RV + h * 64 + c0), va); unpack8(*(const v4u*)(rp + PC_RV + h * 64 + c0 + 8), vb);
#pragma unroll
              for (int i = 0; i < 8; ++i) { vs[tok * ST + c0 + i] = va[i]; vs[tok * ST + c0 + 8 + i] = vb[i]; } } }
        __syncthreads();
        { float a[8];
#pragma unroll
          for (int jj = 0; jj < 8; ++jj) a[jj] = 0.f;
          for (int d = 0; d < 64; d += 4) { const f32x4 qq = *(const LAS f32x4*)(qs + ra * ST + d);
#pragma unroll
              for (int jj = 0; jj < 8; ++jj) { const f32x4 kk = *(const LAS f32x4*)(ks + (jj * 8 + eg) * ST + d); a[jj] += (qq.x * kk.x + qq.y * kk.y) + (qq.z * kk.z + qq.w * kk.w); } }
#pragma unroll
          for (int jj = 0; jj < 8; ++jj) { const int s = jj * 8 + eg; const int dd = ra > s ? ra - s : s - ra; sc[ra * ST + s] = a[jj] * exp2f(lg2 * (float)dd); } }
        __syncthreads();
        { float a[8];
#pragma unroll
          for (int i = 0; i < 8; ++i) a[i] = 0.f;
          for (int s = 0; s < 64; ++s) { const float w = sc[ra * ST + s]; const f32x4 v0 = *(const LAS f32x4*)(vs + s * ST + eg * 8), v1 = *(const LAS f32x4*)(vs + s * ST + eg * 8 + 4);
              a[0] += w * v0.x; a[1] += w * v0.y; a[2] += w * v0.z; a[3] += w * v0.w; a[4] += w * v1.x; a[5] += w * v1.y; a[6] += w * v1.z; a[7] += w * v1.w; }
          const float qd = exp2f(lg2 * (float)(ra + 1));
          for (int d = 0; d < 64; ++d) { const float w = qs[ra * ST + d] * qd; const f32x4 v0 = *(const LAS f32x4*)(Ss + d * ST + eg * 8), v1 = *(const LAS f32x4*)(Ss + d * ST + eg * 8 + 4);
              a[0] += w * v0.x; a[1] += w * v0.y; a[2] += w * v0.z; a[3] += w * v0.w; a[4] += w * v1.x; a[5] += w * v1.y; a[6] += w * v1.z; a[7] += w * v1.w; }
#pragma unroll
          for (int i = 0; i < 8; ++i) os[ra * ST + eg * 8 + i] = a[i]; }
        __syncthreads();
        { float a[8];
#pragma unroll
          for (int i = 0; i < 8; ++i) a[i] = 0.f;
          for (int s = 0; s < 64; ++s) { const float w = ks[s * ST + ra] * exp2f(lg2 * (float)(63 - s)); const f32x4 v0 = *(const LAS f32x4*)(vs + s * ST + eg * 8), v1 = *(const LAS f32x4*)(vs + s * ST + eg * 8 + 4);
              a[0] += w * v0.x; a[1] += w * v0.y; a[2] += w * v0.z; a[3] += w * v0.w; a[4] += w * v1.x; a[5] += w * v1.y; a[6] += w * v1.z; a[7] += w * v1.w; }
#pragma unroll
          for (int i = 0; i < 8; ++i) { Sreg[i] = Sreg[i] * g64 + a[i]; Ss[ra * ST + eg * 8 + i] = Sreg[i]; } }
        for (int k = 0; k < 8; ++k) { const int tok = F.wave * 8 + k; const size_t row = rowb + tok;
            const float v = os[tok * ST + F.lane]; const float rstd = __builtin_amdgcn_rsqf(wave_sum(v * v) * (1.f / 64.f) + EPS);
            const float gt = bf2f(((bf16*)(F.ws + WS_BIG))[row * NPROJ + PC_RG + h * 64 + F.lane]);
            ((bf16*)(F.ws + WS_MIX))[row * D + 768 + h * 64 + F.lane] = (bf16)f2bf(silu_f(gt) * v * rstd * A.in[18][l * 64 + F.lane]); }
    }
    __syncthreads();
}
__device__ __forceinline__ void mixer_2a(Frame& F, const Args& A, int l) {
    for (int u = F.bx; u < 1536; u += F.G) {
#if !defined(BISECT) || BISECT != 2
        if (u < 512) ssd::ssd_m1_unit(F, A, l, u >> 8, (u >> 1) & 127, u & 1);
#else
        if (u < 512) {}
#endif
#if !defined(BISECT) || BISECT != 1
        else { const int v = u - 512; ret::ret_m1_unit(F, A, l, v >> 9, (v >> 2) & 127, v & 3); }
#endif
    }
}
__device__ __forceinline__ void mixer_2b(Frame& F_, const Args& A, int l) {
    Frame F = refresh(F_);
    const float lam_init = 0.8f - 0.6f * __expf(-0.3f * (float)l);
    float d1 = 0.f, d2 = 0.f;
    for (int i = 0; i < 32; ++i) { d1 += A.in[7][l * 32 + i] * A.in[8][l * 32 + i]; d2 += A.in[9][l * 32 + i] * A.in[10][l * 32 + i]; }
    const float lam = __expf(d1) - __expf(d2) + lam_init;
    if (F.bx < 64) ssd::scan_unit(F, 0, F.bx); else if (F.bx < 96) ssd::scan_unit(F, 1, F.bx - 64);
    if (F.bx < 96) {
        asm volatile("s_waitcnt vmcnt(0)" ::: "memory");
        __syncthreads();
        if (F.tid == 0) { __builtin_amdgcn_fence(__ATOMIC_RELEASE, "agent"); asm volatile("s_waitcnt vmcnt(0)" ::: "memory");
            (void)__hip_atomic_fetch_add((unsigned*)(F.ctl + CW_SCAN + 64 * l), 1u, __ATOMIC_RELAXED, __HIP_MEMORY_SCOPE_AGENT); }
    }
    const int na = F.G, j = F.bx;
    const int wpos = (F.bx >> 3) % 3;
    for (int rnd = 0; rnd < 3 || rnd * na < 512; ++rnd) {
#ifndef EXPERTS_IN_P0
        if (l == 0 && rnd == wpos) expert_weights(F, A);
#endif
        const int i = (rnd & 1) ? (rnd + 1) * na - 1 - j : rnd * na + j;
        if (i < 512) { const int qb = 63 - (i >> 3), bh = i & 7; att::attn_unit(F, A, l, bh >> 2, bh & 3, qb, lam, 1.0f - lam_init);
#if defined(DBL_PHASE) && DBL_PHASE == 23
            att::attn_unit(F, A, l, bh >> 2, bh & 3, qb, lam, 1.0f - lam_init);
#endif
        }
    }
}
__device__ __forceinline__ void mixer_2bc_seam(Frame& F, int l) {
    asm volatile("s_waitcnt vmcnt(0)" ::: "memory");
    __syncthreads();
    if (F.tid == 0) {
        unsigned* fl = (unsigned*)(F.ctl + CW_SCAN + 64 * l); unsigned sp = 0;
        while (__hip_atomic_load(fl, __ATOMIC_RELAXED, __HIP_MEMORY_SCOPE_AGENT) < 96u) { __builtin_amdgcn_s_sleep(1); if (++sp > (1u << 20)) break; }
        __builtin_amdgcn_fence(__ATOMIC_ACQUIRE, "agent");
        asm volatile("s_waitcnt vmcnt(0)" ::: "memory");
    }
    __syncthreads();
}
__device__ __forceinline__ void mixer_2c(Frame& F, const Args& A, int l) {
    for (int u = F.bx; u < 1536; u += F.G) {
#if !defined(BISECT) || BISECT != 2
        if (u < 512) ssd::ssd_m3_unit(F, A, l, u >> 8, (u >> 1) & 127, u & 1);
#else
        if (u < 512) {}
#endif
#if !defined(BISECT) || BISECT != 1
        else { const int v = u - 512; ret::ret_m3_unit(F, A, l, v >> 9, (v >> 2) & 127, v & 3); }
#endif
    }
}
__device__ __forceinline__ void gather_phase(Frame& F_) {
    Frame F = refresh(F_);
    const int gw = F.bx * NWAVES + F.wave, NGW = F.G * NWAVES, nrows = F.META[16] * 256;
    const v4u* XN8 = (const v4u*)(F.ws + WS_XN); v4u* XG8 = (v4u*)(F.ws + WS_XG8); const int* LIST = (const int*)(F.ws + WS_LIST);
    const float* XNS = (const float*)(F.ws + WS_XNS); float* XGS = (float*)(F.ws + WS_XGS);
    for (int row0 = gw; row0 < nrows; row0 += 4 * NGW) {
        int tok[4]; bool ok[4];
#pragma unroll
        for (int i = 0; i < 4; ++i) { const int row = row0 + i * NGW; ok[i] = false; tok[i] = 0;
            if (row < nrows) { const int p = row >> 8, r = row & 255; int e = 0;
#pragma unroll
                for (int k = 1; k < 8; ++k) e += (p >= F.META[8 + k]) ? 1 : 0;
                const int pos = (p - F.META[8 + e]) * 256 + r;
                if (pos < F.META[e]) { ok[i] = true; tok[i] = LIST[e * 16384 + pos]; } } }
        v4u a[4]; float s[4];
#pragma unroll
        for (int i = 0; i < 4; ++i) { a[i] = (v4u){0u, 0u, 0u, 0u}; s[i] = 0.f; if (ok[i]) { a[i] = XN8[(size_t)tok[i] * 64 + F.lane]; s[i] = XNS[tok[i]]; } }
#pragma unroll
        for (int i = 0; i < 4; ++i) { const int row = row0 + i * NGW; if (row < nrows) { XG8[(size_t)row * 64 + F.lane] = a[i]; if (F.lane == 0) XGS[row] = s[i]; } }
    }
}
__device__ __forceinline__ void zero_yacc(Frame& F_) {
    Frame F = refresh(F_);
    v4u* za = (v4u*)(F.ws + WS_XN);
    for (size_t i = (size_t)F.bx * 512 + F.tid; i < (size_t)8 * 256 * 1024 / 4; i += (size_t)F.G * 512) za[i] = (v4u){0u, 0u, 0u, 0u};
}
#if defined(DBL_PHASE) && DBL_PHASE == 40
#define GRID_BAR() do { xcd_barrier(bar); xcd_barrier(bar); } while (0)
#else
#define GRID_BAR() xcd_barrier(bar)
#endif
#ifndef DBL_PHASE
#define DBL_PHASE -1
#endif
#ifdef PROBE_A
#define STAMP(i) do { if (F.bx == 0 && threadIdx.x == 0) ((LAS unsigned long long*)(F.lds + LDSCTL_OFF + 2048))[i] = __builtin_amdgcn_s_memrealtime(); } while (0)
#else
#define STAMP(i) do { } while (0)
#endif
#define WSB(off) ((bf16*)(F.ws + (off)))
template <int l>
__device__ __forceinline__ void layer_body(Frame& F, const Args& args, const XcdBarrier& bar) {

        { pg8::Gemm g{WSB(WS_XN), (const bf16*)((const signed char*)(F.ws + WS_WIN) + (size_t)l * NPROJ * D), D / 2}; pg8::StaticOrder S; S.init(M, NPROJ, F.G, F.bx);
          pg8::EpiBf16S E{WSB(WS_BIG), NPROJ, (const float*)(F.ws + WS_XNS), (const float*)(F.ws + WS_SBI) + l * NPROJ};
          pg8::gemm_phase<pg8::EpiBf16S, pg8::StaticOrder, true, true>(F.lds, g, S, E); }
#if DBL_PHASE == 1
        { pg8::Gemm g{WSB(WS_XN), (const bf16*)((const signed char*)(F.ws + WS_WIN) + (size_t)l * NPROJ * D), D / 2}; pg8::StaticOrder S; S.init(M, NPROJ, F.G, F.bx);
          pg8::EpiBf16S E{WSB(WS_BIG), NPROJ, (const float*)(F.ws + WS_XNS), (const float*)(F.ws + WS_SBI) + l * NPROJ};
          pg8::gemm_phase<pg8::EpiBf16S, pg8::StaticOrder, true, true>(F.lds, g, S, E); }
#endif
        GRID_BAR(); STAMP(1 + 1 + (l == 0 ? 0 : 7));
        mixer_2a(F, args, l);
#if DBL_PHASE == 20
        mixer_2a(F, args, l);
#endif
        GRID_BAR();
        mixer_2b(F, args, l);
#if DBL_PHASE == 21
        mixer_2b(F, args, l);
#endif
        mixer_2bc_seam(F, l);
        mixer_2c(F, args, l);
#if DBL_PHASE == 22
        mixer_2c(F, args, l);
#endif
        GRID_BAR(); STAMP(1 + 2 + (l == 0 ? 0 : 7));
        { pg8::Gemm g{WSB(WS_MIX), WSB(WS_WOUT) + (size_t)l * D * D, D}; pg8::StaticOrder S; S.init(M, D, F.G, F.bx);
          if constexpr (l == 0) { pg8::EpiResBf<true> E{args.in[0], WSB(WS_XR), D, nullptr}; pg8::gemm_phase<pg8::EpiResBf<true>, pg8::StaticOrder, false>(F.lds, g, S, E); }
          else { pg8::EpiResBf<false> E{WSB(WS_XR), WSB(WS_XR), D, nullptr}; pg8::gemm_phase<pg8::EpiResBf<false>, pg8::StaticOrder, false>(F.lds, g, S, E); } }
#if DBL_PHASE == 41
        if constexpr (l == 0) { pg8::Gemm g{WSB(WS_MIX), WSB(WS_WOUT), D}; pg8::StaticOrder S; S.init(M, D, F.G, F.bx);
          pg8::EpiResBf<true> E{args.in[0], WSB(WS_XR), D, nullptr}; pg8::gemm_phase<pg8::EpiResBf<true>, pg8::StaticOrder, false>(F.lds, g, S, E); }
#endif
        W16 wrt{}; if constexpr (l == 1) wrt = norm_wload(args.in[22], 8);
        GRID_BAR(); STAMP(1 + 3 + (l == 0 ? 0 : 7));
        if constexpr (l == 0) {
            norm_phase<0, true, true>(F, (const float*)(F.ws + WS_XR), args.in[4], nullptr, 0);
            GRID_BAR(); STAMP(5);
            { pg8::Gemm g{WSB(WS_XN), WSB(WS_WGU), D / 2}; pg8::StaticOrder S; S.init(M, 2 * FDP, F.G, F.bx);
              pg8::EpiSwiGLU8<true> E{WSB(WS_BIG), FDP, (const float*)(F.ws + WS_XNS), (const float*)(F.ws + WS_SBD)};
              pg8::gemm_phase<pg8::EpiSwiGLU8<true>, pg8::StaticOrder, true, true>(F.lds, g, S, E); }
#if DBL_PHASE == 4
        { pg8::Gemm g{WSB(WS_XN), WSB(WS_WGU), D / 2}; pg8::StaticOrder S; S.init(M, 2 * FDP, F.G, F.bx);
              pg8::EpiSwiGLU8<true> E{WSB(WS_BIG), FDP, (const float*)(F.ws + WS_XNS), (const float*)(F.ws + WS_SBD)};
              pg8::gemm_phase<pg8::EpiSwiGLU8<true>, pg8::StaticOrder, true, true>(F.lds, g, S, E); }
#endif
            GRID_BAR(); STAMP(6);
            { pg8::Gemm g{WSB(WS_BIG), WSB(WS_WD), FDP / 2}; pg8::StaticOrder S; S.init(M, D, F.G, F.bx);
              pg8::EpiResBf<false> E{WSB(WS_XR), WSB(WS_XR), D, (const float*)(F.ws + WS_SBWD)};
              pg8::gemm_phase<pg8::EpiResBf<false>, pg8::StaticOrder, false, false, true>(F.lds, g, S, E); }
            const W16 wp7 = norm_wload(args.in[1] + (size_t)D * NIN + 2048, NIN);
            GRID_BAR(); STAMP(7);
            norm_phase<1, true, true, true>(F, (const float*)(F.ws + WS_XR), args.in[3] + D, args.in[1] + (size_t)D * NIN + 2048, NIN, wp7);
            GRID_BAR(); STAMP(8);
        } else {
            norm_phase<2, true, true, true>(F, (const float*)(F.ws + WS_XR), args.in[4] + D, args.in[22], 8, wrt);
            GRID_BAR(); STAMP(12);
            if (F.tid == 0) { int acc = 0;
                for (int e = 0; e < 8; ++e) { const int c = (int)__hip_atomic_load(F.ctl + CW_CNT + 64 * e, RLX_AGENT); F.META[e] = c; F.META[8 + e] = acc; acc += (c + 255) >> 8; }
                F.META[16] = acc; }
            __syncthreads();
            const int ptot = F.META[16];
            {
                const int p0 = 0; int np = ptot; if (np > 136) np = 136; const int slab = 0; (void)slab;
                { pg8::Gemm g{WSB(0), WSB(WS_EGU), D / 2}; pg8::GroupedOrder S{2 * FE / 256, p0, np, F.G, F.bx, 0, F.META, 0, 0, 1};
                  pg8::EpiSwiGLU8<true> E{WSB(WS_BIG), FE, (const float*)(F.ws + WS_XGS2), (const float*)(F.ws + WS_SBE)};
                  pg8::gemm_phase<pg8::EpiSwiGLU8<true>, pg8::GroupedOrder, true, true>(F.lds, g, S, E); }
#if DBL_PHASE == 5
        { pg8::Gemm g{WSB(0), WSB(WS_EGU), D / 2}; pg8::GroupedOrder S{2 * FE / 256, p0, np, F.G, F.bx, 0, F.META, 0, 0, 1};
                  pg8::EpiSwiGLU8<true> E{WSB(WS_BIG), FE, (const float*)(F.ws + WS_XGS2), (const float*)(F.ws + WS_SBE)};
                  pg8::gemm_phase<pg8::EpiSwiGLU8<true>, pg8::GroupedOrder, true, true>(F.lds, g, S, E); }
#endif
                GRID_BAR(); STAMP(14 + 2 * slab);
                { pg8::Gemm g{WSB(WS_BIG), WSB(WS_ED), FE / 2}; pg8::GroupedOrder S{D / 256, p0, np, F.G, F.bx, 1, F.META, 512, 4};
                  pg8::EpiYMoE E{WSB(WS_MIX), WSB(WS_XN), D, (const float*)(F.ws + WS_SBED), 512};
                  pg8::gemm_phase<pg8::EpiYMoE, pg8::GroupedOrder, true, false, true>(F.lds, g, S, E); }
#if DBL_PHASE == 6
        { pg8::Gemm g{WSB(WS_BIG), WSB(WS_ED), FE / 2}; pg8::GroupedOrder S{D / 256, p0, np, F.G, F.bx, 1, F.META, 512, 4};
                  pg8::EpiYMoE E{WSB(WS_MIX), WSB(WS_XN), D, (const float*)(F.ws + WS_SBED), 512};
                  pg8::gemm_phase<pg8::EpiYMoE, pg8::GroupedOrder, true, false, true>(F.lds, g, S, E); }
#endif
                GRID_BAR(); STAMP(15 + 2 * slab);
            }
#ifdef PROBE_A
            if (F.bx == 0 && threadIdx.x == 0) { const LAS unsigned long long* ts = (const LAS unsigned long long*)(F.lds + LDSCTL_OFF + 2048);
                float ta = 0.f, tbv = 0.f;
                for (int i = 1; i <= 17; ++i) { const float d = (float)(ts[i] - ts[i - 1]) * 0.01f;
                    if ((PROBE_A >> i) & 1) ta += d; if ((PROBE_B >> i) & 1) tbv += d; }
                ((float*)(F.ws + WS_CTL))[100] = ta / PROBE_SA; ((float*)(F.ws + WS_CTL))[101] = tbv / PROBE_SB * 100.0f; }
            GRID_BAR();
#endif
            combine_phase(F, args);
#ifdef PROBE_A
            GRID_BAR();
            { const float eps = ((const float*)(F.ws + WS_CTL))[100], vv = ((const float*)(F.ws + WS_CTL))[101];
              for (size_t i = (size_t)F.bx * 512 + threadIdx.x; i < (size_t)M * D; i += (size_t)F.G * 512) F.out[i] = (i == 0) ? vv : F.out[i] * (1.0f + eps); }
#endif
        }
}
__global__ void __launch_bounds__(NWAVES * 64, 2) mk_fwd(Args args) {
    extern __shared__ __attribute__((aligned(16))) unsigned char lds[];
    Frame F;
    F.lds = (LAS unsigned char*)lds;
    F.MISC = (volatile LAS unsigned*)(F.lds + MISC_OFF);
    F.META = (LAS int*)(F.lds + MISC_OFF + 64);
    F.tid = threadIdx.x; F.lane = F.tid & 63; F.wave = __builtin_amdgcn_readfirstlane(F.tid >> 6);
    F.G = gridDim.x; F.bx = blockIdx.x;
    F.ws = args.ws; F.out = args.out;
    F.ctl = (gu32*)(F.ws + WS_CTL);
    for (int u = F.tid; u < (LDS_BYTES - LDSCTL_OFF) / 4; u += NWAVES * 64) ((LAS unsigned*)(F.lds + LDSCTL_OFF))[u] = 0u;
    __syncthreads();
    XcdBarrier bar = xcd_barrier_post((unsigned*)(F.ctl + CW_BAR), F.MISC + 8);
    STAMP(0);
    p0_weights(F, args);
    __syncthreads();
#ifdef EXPERTS_IN_P0
    expert_weights(F, args);
#endif
#if DBL_PHASE == 0
    p0_weights(F, args);
    __syncthreads();
#endif
    __syncthreads();
    norm_phase<1, true>(F, args.in[0], args.in[3], args.in[1] + 2048, NIN);
    GRID_BAR(); STAMP(1);
    layer_body<0>(F, args, bar);
    layer_body<1>(F, args, bar);
}

extern "C" void kernel_launch(void* const* d_in, const int* in_sizes, int n_in, void* d_out, int out_size, void* d_ws, size_t ws_size, hipStream_t stream) {
    static int grid = 0;
    if (grid == 0) {
        if (n_in != 26 || in_sizes[0] != M * D || out_size != M * D || ws_size < WS_END) { fprintf(stderr, "kernel_launch: unexpected shapes (n_in %d, in0 %d, out %d, ws %zu); nothing launched\n", n_in, n_in > 0 ? in_sizes[0] : -1, out_size, ws_size); grid = -1; return; }
        int dev = 0, cus = 0, per_cu = 0;
        if (hipGetDevice(&dev) != hipSuccess || hipDeviceGetAttribute(&cus, hipDeviceAttributeMultiprocessorCount, dev) != hipSuccess) { grid = -1; return; }
        if (hipFuncSetAttribute((const void*)mk_fwd, hipFuncAttributeMaxDynamicSharedMemorySize, LDS_BYTES) != hipSuccess) { fprintf(stderr, "kernel_launch: hipFuncSetAttribute failed\n"); grid = -1; return; }
        if (hipOccupancyMaxActiveBlocksPerMultiprocessor(&per_cu, (const void*)mk_fwd, NWAVES * 64, LDS_BYTES) != hipSuccess || per_cu < 1) fprintf(stderr, "kernel_launch: occupancy query reports %d blocks per CU\n", per_cu);
        (void)hipGetLastError();
        grid = cus;
    }
    if (grid < 0) return;
    if (hipMemsetAsync((char*)d_ws + WS_CTL, 0, CTL_ZERO_BYTES, stream) != hipSuccess) return;
    Args a{};
    for (int i = 0; i < 26; ++i) a.in[i] = (const float*)d_in[i];
    a.out = (float*)d_out; a.ws = (unsigned char*)d_ws;
    hipLaunchKernelGGL(mk_fwd, dim3(grid), dim3(NWAVES * 64), LDS_BYTES, stream, a);
}
```

```cpp
#include <hip/hip_runtime.h>
#include <cstdio>
#include <cstdint>
namespace pg8 {
#define PG8_LAS __attribute__((address_space(3)))
typedef unsigned short bf16_t;
typedef short bf16x8 __attribute__((ext_vector_type(8)));
typedef float f32x4 __attribute__((ext_vector_type(4)));
typedef unsigned u32x4 __attribute__((ext_vector_type(4)));
constexpr int BM = 256, BK = 64, HALF = 128, HTB = HALF * BK * 2  , STAGE_BYTES = 8 * HTB, NXCD = 8, WGM = 8;

__host__ __device__ __forceinline__ int lds_byte(int r, int c) { const int st = (r >> 4) * 2 + (c >> 5), rr = r & 15, cc = c & 31, ob = rr * 64 + cc * 2; return st * 1024 + (ob ^ (((ob >> 9) & 1) << 5)); }
__host__ __device__ __forceinline__ void stage_rc(int b, int& R, int& C) { const int st = b / 1024, sb = b % 1024, swz = sb ^ (((sb >> 9) & 1) << 5); R = (st >> 1) * 16 + swz / 64; C = (st & 1) * 32 + (swz % 64) / 2; }
__host__ __device__ __forceinline__ int perm32(int rho) { const int n = rho >> 4, i = rho & 15; return 8 * (i >> 2) + 4 * n + (i & 3); }

struct Unit { int pm, pn, cn, po, e, j, koff, kt, split; };
struct Gemm { const bf16_t* A; const bf16_t* Bt; int K; };

struct StaticOrder {
    int nM, nN, nwg, G, c;
    __host__ __device__ void init(int M, int N, int G_, int c_) { nM = M / BM; nN = N / BM; nwg = nM * nN; G = G_; c = c_; }
    __host__ __device__ bool next(int i, Unit& u) const {
        const long L = (long)i * G + c; if (L >= nwg) return false;
        int wgid = (int)L; { const int q = nwg / NXCD, r = nwg % NXCD, xcd = wgid % NXCD, off = wgid / NXCD; wgid = (xcd < r ? xcd * (q + 1) : r * (q + 1) + (xcd - r) * q) + off; }
        const int nig = WGM * nN, gid = wgid / nig, fm = gid * WGM, gsz = (nM - fm) < WGM ? (nM - fm) : WGM;
        u.pm = fm + ((wgid % nig) % gsz); u.pn = (wgid % nig) / gsz; u.cn = u.pn; u.po = u.pm; u.e = 0; u.j = 0; u.koff = 0; u.kt = 0; u.split = 0; return true;
    }
};
struct GroupedOrder {
    int nN, p0, np, G, c, a_local;
    const PG8_LAS int* meta;
    int ksb, kst;
    int aregion;
    __device__ __forceinline__ bool next(int i, Unit& u) const {
        int pl, n, koff = 0, kt = 0, split = 0;
        if (a_local && nN == 4 && G == 256) {
            {
            const int nfull = np < 128 ? np : 128, pl0 = ((c >> 3) >> 2) * 8 + (c & 7);
            const int nmine = (pl0 < nfull ? 1 : 0) + (64 + pl0 < nfull ? 1 : 0);
            if (i < nmine) { pl = i * 64 + pl0; n = (c >> 3) & 3; }
            else if (i == nmine) { if (c >= (np - nfull) * 28) return false; pl = nfull + c / 28; const int rem = c - (c / 28) * 28; n = rem / 7; koff = (rem - n * 7) * ksb; kt = kst; split = 1; }
            else return false;
            }
        } else { const int L = i * G + c; if (L >= np * nN) return false; pl = L / nN; n = L - pl * nN; }
        const int p = p0 + pl;
        int e = 0;
#pragma unroll
        for (int k = 1; k < 8; ++k) e += (p >= meta[8 + k]) ? 1 : 0;
        e = __builtin_amdgcn_readfirstlane(e);
        u.e = e; u.j = 0; u.pm = a_local ? pl : p; u.po = a_local ? p : pl;
        if (aregion) u.pm = (e < 6 ? (203 + 16 * e) * 4 : (2 + 16 * (e - 6)) * 4) + (p - meta[8 + e]); u.pn = e * nN + n; u.cn = n; u.koff = koff; u.kt = kt; u.split = split; return true;
    }
};

__device__ __forceinline__ unsigned cvt_pk_bf16(float lo, float hi) { unsigned r; asm volatile("v_cvt_pk_bf16_f32 %0, %1, %2" : "=v"(r) : "v"(lo), "v"(hi)); return r; }

#ifdef EPI_NT
#define PG8_ST16(p, v) __builtin_nontemporal_store((v), (u32x4*)(p))
#define PG8_ST16F(p, v) __builtin_nontemporal_store((v), (f32x4*)(p))
#else
#define PG8_ST16(p, v) (*(u32x4*)(p) = (v))
#define PG8_ST16F(p, v) (*(f32x4*)(p) = (v))
#endif
struct EpiBf16 {
    static constexpr bool PERM = true, AFTER_DRAIN = false;
    bf16_t* O; int ldc;
    __device__ __forceinline__ void operator()(const f32x4 (&acc)[2][2][4][2], const Unit& u, int wr, int wc, int fr, int fq) const {
        const int row0 = u.po * BM + wr * 64 + fr, col0 = u.cn * BM + wc * 32 + 8 * fq;
#pragma unroll
        for (int ai = 0; ai < 2; ++ai)
#pragma unroll
            for (int m = 0; m < 4; ++m) { bf16_t* rowp = O + (size_t)(row0 + ai * HALF + m * 16) * ldc + col0;
#pragma unroll
                for (int bj = 0; bj < 2; ++bj) { const f32x4 v0 = acc[ai][bj][m][0], v1 = acc[ai][bj][m][1];
                    u32x4 w; w.x = cvt_pk_bf16(v0[0], v0[1]); w.y = cvt_pk_bf16(v0[2], v0[3]); w.z = cvt_pk_bf16(v1[0], v1[1]); w.w = cvt_pk_bf16(v1[2], v1[3]);
                    PG8_ST16(rowp + bj * HALF, w); } }
    }
};
__device__ __forceinline__ float silu_mul(float g, float u) { return g * u * __builtin_amdgcn_rcpf(1.0f + __builtin_amdgcn_exp2f(-1.4426950408889634f * g)); }
struct EpiSwiGLU {
    static constexpr bool PERM = true, AFTER_DRAIN = false;
    bf16_t* O; int ldc;
    __device__ __forceinline__ void operator()(const f32x4 (&acc)[2][2][4][2], const Unit& u, int wr, int wc, int fr, int fq) const {
        const int row0 = u.po * BM + wr * 64 + fr, col0 = u.cn * HALF + wc * 32 + 8 * fq;
#pragma unroll
        for (int ai = 0; ai < 2; ++ai)
#pragma unroll
            for (int m = 0; m < 4; ++m) { bf16_t* rowp = O + (size_t)(row0 + ai * HALF + m * 16) * ldc + col0;
                const f32x4 g0 = acc[ai][0][m][0], g1 = acc[ai][0][m][1], u0 = acc[ai][1][m][0], u1 = acc[ai][1][m][1];
                u32x4 w; w.x = cvt_pk_bf16(silu_mul(g0[0], u0[0]), silu_mul(g0[1], u0[1])); w.y = cvt_pk_bf16(silu_mul(g0[2], u0[2]), silu_mul(g0[3], u0[3]));
                w.z = cvt_pk_bf16(silu_mul(g1[0], u1[0]), silu_mul(g1[1], u1[1])); w.w = cvt_pk_bf16(silu_mul(g1[2], u1[2]), silu_mul(g1[3], u1[3]));
                PG8_ST16(rowp, w); asm volatile("" ::: "memory"); }
    }
};
struct EpiBf16S {
    static constexpr bool PERM = true, AFTER_DRAIN = false;
    bf16_t* O; int ldc; const float* sa; const float* sb;
    __device__ __forceinline__ void operator()(const int __attribute__((ext_vector_type(4))) (&acc)[2][2][4][2], const Unit& u, int wr, int wc, int fr, int fq) const {
        const int row0 = u.po * BM + wr * 64 + fr, col0 = u.cn * BM + wc * 32 + 8 * fq;
        const float* sbp = sb + (size_t)u.pn * BM + wc * 32 + 8 * fq;
        f32x4 s4[2][2];
#pragma unroll
        for (int bj = 0; bj < 2; ++bj) { s4[bj][0] = *(const f32x4*)(sbp + bj * HALF); s4[bj][1] = *(const f32x4*)(sbp + bj * HALF + 4); }
        float av[2][4];
#pragma unroll
        for (int ai = 0; ai < 2; ++ai)
#pragma unroll
            for (int m = 0; m < 4; ++m) av[ai][m] = sa[(size_t)u.pm * BM + wr * 64 + fr + ai * HALF + m * 16];
#pragma unroll
        for (int ai = 0; ai < 2; ++ai)
#pragma unroll
            for (int m = 0; m < 4; ++m) { bf16_t* rowp = O + (size_t)(row0 + ai * HALF + m * 16) * ldc + col0;
                const float a = av[ai][m];
#pragma unroll
                for (int bj = 0; bj < 2; ++bj) { const f32x4 v0 = __builtin_convertvector(acc[ai][bj][m][0], f32x4) * s4[bj][0] * a, v1 = __builtin_convertvector(acc[ai][bj][m][1], f32x4) * s4[bj][1] * a;
                    u32x4 w; w.x = cvt_pk_bf16(v0[0], v0[1]); w.y = cvt_pk_bf16(v0[2], v0[3]); w.z = cvt_pk_bf16(v1[0], v1[1]); w.w = cvt_pk_bf16(v1[2], v1[3]);
                    PG8_ST16(rowp + bj * HALF, w); }
                asm volatile("" ::: "memory"); }
    }
};
__device__ __forceinline__ unsigned pk4_fp8(float a, float b, float c, float d) {
    a = __builtin_amdgcn_fmed3f(a, -448.f, 448.f); b = __builtin_amdgcn_fmed3f(b, -448.f, 448.f); c = __builtin_amdgcn_fmed3f(c, -448.f, 448.f); d = __builtin_amdgcn_fmed3f(d, -448.f, 448.f);
    int w = __builtin_amdgcn_cvt_pk_fp8_f32(a, b, 0, false); w = __builtin_amdgcn_cvt_pk_fp8_f32(c, d, w, true); return (unsigned)w; }
template <bool F8OUT> struct EpiSwiGLU8 {
    static constexpr bool PERM = true, AFTER_DRAIN = false;
    bf16_t* O; int ldc; const float* sa; const float* sb;
    __device__ __forceinline__ void operator()(const int __attribute__((ext_vector_type(4))) (&acc)[2][2][4][2], const Unit& u, int wr, int wc, int fr, int fq) const {
        const int row0 = u.po * BM + wr * 64 + fr, col0 = u.cn * HALF + wc * 32 + 8 * fq;
        const float* sbp = sb + (size_t)u.pn * BM + wc * 32 + 8 * fq;
        const f32x4 sg0 = *(const f32x4*)(sbp), sg1 = *(const f32x4*)(sbp + 4), su0 = *(const f32x4*)(sbp + HALF), su1 = *(const f32x4*)(sbp + HALF + 4);
        float av[2][4];
#pragma unroll
        for (int ai = 0; ai < 2; ++ai)
#pragma unroll
            for (int m = 0; m < 4; ++m) av[ai][m] = sa[(size_t)u.pm * BM + wr * 64 + fr + ai * HALF + m * 16];
#pragma unroll
        for (int ai = 0; ai < 2; ++ai)
#pragma unroll
            for (int m = 0; m < 4; ++m) {
                const float a = av[ai][m];
                const f32x4 g0 = __builtin_convertvector(acc[ai][0][m][0], f32x4) * sg0 * a, g1 = __builtin_convertvector(acc[ai][0][m][1], f32x4) * sg1 * a;
                const f32x4 u0 = __builtin_convertvector(acc[ai][1][m][0], f32x4) * su0 * a, u1 = __builtin_convertvector(acc[ai][1][m][1], f32x4) * su1 * a;
                if constexpr (F8OUT) { unsigned char* rowp = (unsigned char*)O + (size_t)(row0 + ai * HALF + m * 16) * ldc + col0;
                    typedef unsigned u32x2 __attribute__((ext_vector_type(2))); u32x2 w;
                    w.x = pk4_fp8(silu_mul(g0[0], u0[0]), silu_mul(g0[1], u0[1]), silu_mul(g0[2], u0[2]), silu_mul(g0[3], u0[3]));
                    w.y = pk4_fp8(silu_mul(g1[0], u1[0]), silu_mul(g1[1], u1[1]), silu_mul(g1[2], u1[2]), silu_mul(g1[3], u1[3]));
                    *(u32x2*)rowp = w;
                } else { bf16_t* rowp = O + (size_t)(row0 + ai * HALF + m * 16) * ldc + col0;
                    u32x4 w; w.x = cvt_pk_bf16(silu_mul(g0[0], u0[0]), silu_mul(g0[1], u0[1])); w.y = cvt_pk_bf16(silu_mul(g0[2], u0[2]), silu_mul(g0[3], u0[3]));
                    w.z = cvt_pk_bf16(silu_mul(g1[0], u1[0]), silu_mul(g1[1], u1[1])); w.w = cvt_pk_bf16(silu_mul(g1[2], u1[2]), silu_mul(g1[3], u1[3]));
                    PG8_ST16(rowp, w); }
                asm volatile("" ::: "memory"); }
    }
};
struct EpiYMoE {
    static constexpr bool PERM = true, AFTER_DRAIN = false;
    bf16_t* O; bf16_t* Ypart; int ldc; const float* sb; int ksb;
    __device__ __forceinline__ void operator()(const f32x4 (&acc)[2][2][4][2], const Unit& u, int wr, int wc, int fr, int fq) const {
        const int col0 = u.cn * BM + wc * 32 + 8 * fq;
        bf16_t* base = u.split ? Ypart + ((size_t)(u.koff / ksb) * 2048 + (size_t)(u.po - 128) * BM) * ldc : O + (size_t)u.po * BM * ldc;
        const int row0 = wr * 64 + fr;
        const float* sbp = sb + (size_t)u.pn * BM + wc * 32 + 8 * fq;
        f32x4 s4[2][2];
#pragma unroll
        for (int bj = 0; bj < 2; ++bj) { s4[bj][0] = *(const f32x4*)(sbp + bj * HALF); s4[bj][1] = *(const f32x4*)(sbp + bj * HALF + 4); }
#pragma unroll
        for (int ai = 0; ai < 2; ++ai)
#pragma unroll
            for (int m = 0; m < 4; ++m) { bf16_t* rowp = base + (size_t)(row0 + ai * HALF + m * 16) * ldc + col0;
#pragma unroll
                for (int bj = 0; bj < 2; ++bj) { const f32x4 v0 = acc[ai][bj][m][0] * s4[bj][0], v1 = acc[ai][bj][m][1] * s4[bj][1];
                    u32x4 w; w.x = cvt_pk_bf16(v0[0], v0[1]); w.y = cvt_pk_bf16(v0[2], v0[3]); w.z = cvt_pk_bf16(v1[0], v1[1]); w.w = cvt_pk_bf16(v1[2], v1[3]);
                    PG8_ST16(rowp + bj * HALF, w); }
                asm volatile("" ::: "memory"); }
    }
};
template <bool BASE_F32> struct EpiResBf {
    static constexpr bool PERM = true, AFTER_DRAIN = false;
    const void* base; bf16_t* out; int ldc; const float* sb;
    __device__ __forceinline__ void operator()(const f32x4 (&acc)[2][2][4][2], const Unit& u, int wr, int wc, int fr, int fq) const {
        const int row0 = u.po * BM + wr * 64 + fr, col0 = u.cn * BM + wc * 32 + 8 * fq;
        f32x4 s[2][2];
#pragma unroll
        for (int bj = 0; bj < 2; ++bj) { s[bj][0] = (f32x4){1.f, 1.f, 1.f, 1.f}; s[bj][1] = s[bj][0]; if (sb) { s[bj][0] = *(const f32x4*)(sb + col0 + bj * HALF); s[bj][1] = *(const f32x4*)(sb + col0 + bj * HALF + 4); } }
        if constexpr (BASE_F32) {
#pragma unroll
            for (int ai = 0; ai < 2; ++ai) {
                f32x4 b[4][2][2];
#pragma unroll
                for (int m = 0; m < 4; ++m)
#pragma unroll
                    for (int bj = 0; bj < 2; ++bj) { const float* bp = (const float*)base + (size_t)(row0 + ai * HALF + m * 16) * ldc + col0 + bj * HALF; b[m][bj][0] = *(const f32x4*)bp; b[m][bj][1] = *(const f32x4*)(bp + 4); }
#pragma unroll
                for (int m = 0; m < 4; ++m) { const size_t off = (size_t)(row0 + ai * HALF + m * 16) * ldc + col0;
#pragma unroll
                    for (int bj = 0; bj < 2; ++bj) { const f32x4 v0 = b[m][bj][0] + acc[ai][bj][m][0] * s[bj][0], v1 = b[m][bj][1] + acc[ai][bj][m][1] * s[bj][1];
                        u32x4 w; w.x = cvt_pk_bf16(v0[0], v0[1]); w.y = cvt_pk_bf16(v0[2], v0[3]); w.z = cvt_pk_bf16(v1[0], v1[1]); w.w = cvt_pk_bf16(v1[2], v1[3]);
                        PG8_ST16(out + off + bj * HALF, w); } }
                asm volatile("" ::: "memory"); }
        } else {
            u32x4 b[2][4][2];
#pragma unroll
            for (int ai = 0; ai < 2; ++ai)
#pragma unroll
                for (int m = 0; m < 4; ++m)
#pragma unroll
                    for (int bj = 0; bj < 2; ++bj) b[ai][m][bj] = *(const u32x4*)((const bf16_t*)base + (size_t)(row0 + ai * HALF + m * 16) * ldc + col0 + bj * HALF);
#pragma unroll
            for (int ai = 0; ai < 2; ++ai)
#pragma unroll
                for (int m = 0; m < 4; ++m) { const size_t off = (size_t)(row0 + ai * HALF + m * 16) * ldc + col0;
#pragma unroll
                    for (int bj = 0; bj < 2; ++bj) { const u32x4 w0 = b[ai][m][bj];
                        const f32x4 b0 = (f32x4){__uint_as_float(w0.x << 16), __uint_as_float(w0.x & 0xffff0000u), __uint_as_float(w0.y << 16), __uint_as_float(w0.y & 0xffff0000u)};
                        const f32x4 b1 = (f32x4){__uint_as_float(w0.z << 16), __uint_as_float(w0.z & 0xffff0000u), __uint_as_float(w0.w << 16), __uint_as_float(w0.w & 0xffff0000u)};
                        const f32x4 v0 = b0 + acc[ai][bj][m][0] * s[bj][0], v1 = b1 + acc[ai][bj][m][1] * s[bj][1];
                        u32x4 w; w.x = cvt_pk_bf16(v0[0], v0[1]); w.y = cvt_pk_bf16(v0[2], v0[3]); w.z = cvt_pk_bf16(v1[0], v1[1]); w.w = cvt_pk_bf16(v1[2], v1[3]);
                        PG8_ST16(out + off + bj * HALF, w); }
                    asm volatile("" ::: "memory"); }
        }
    }
};
struct EpiResF32 {
    static constexpr bool PERM = false, AFTER_DRAIN = false;
    const float* base; float* out; int ldc; const float* sb;
    __device__ __forceinline__ void operator()(const f32x4 (&acc)[2][2][4][2], const Unit& u, int wr, int wc, int fr, int fq) const {
        const int row0 = u.po * BM + wr * 64 + fr, col0 = u.cn * BM + wc * 32 + 4 * fq;
#pragma unroll
        for (int ai = 0; ai < 2; ++ai)
#pragma unroll
            for (int m = 0; m < 4; ++m) { const size_t off = (size_t)(row0 + ai * HALF + m * 16) * ldc + col0;
#pragma unroll
                for (int bj = 0; bj < 2; ++bj)
#pragma unroll
                    for (int n = 0; n < 2; ++n) { const f32x4 bs = *(const f32x4*)(base + off + bj * HALF + n * 16);
                        const f32x4 s = sb ? *(const f32x4*)(sb + col0 + bj * HALF + n * 16) : (f32x4){1.f, 1.f, 1.f, 1.f};
                        PG8_ST16F(out + off + bj * HALF + n * 16, bs + acc[ai][bj][m][n] * s); }
                asm volatile("" ::: "memory"); }
    }
};
typedef int i32x4 __attribute__((ext_vector_type(4)));
template <bool I8> struct AccT { typedef f32x4 type; };
template <> struct AccT<true> { typedef i32x4 type; };
template <bool I8> __device__ __forceinline__ typename AccT<I8>::type mma16(const bf16x8 b, const bf16x8 a, const typename AccT<I8>::type c);
template <> __device__ __forceinline__ f32x4 mma16<false>(const bf16x8 b, const bf16x8 a, const f32x4 c) { return __builtin_amdgcn_mfma_f32_16x16x32_bf16(b, a, c, 0, 0, 0); }
template <> __device__ __forceinline__ i32x4 mma16<true>(const bf16x8 b, const bf16x8 a, const i32x4 c) { return __builtin_amdgcn_mfma_i32_16x16x64_i8(__builtin_bit_cast(i32x4, b), __builtin_bit_cast(i32x4, a), c, 0, 0, 0); }
typedef int i32x8 __attribute__((ext_vector_type(8)));
__device__ __forceinline__ void mma_f8(f32x4& c, const i32x8 b, const i32x8 a, const int one) {
    asm volatile("v_mfma_scale_f32_16x16x128_f8f6f4 %0, %1, %2, %0, %3, %3 op_sel_hi:[0,0,0]" : "+v"(c) : "v"(b), "v"(a), "v"(one));
}
template <class Epi, class Sched, bool ALIGN_EPI, bool I8 = false, bool F8 = false>
__device__ __forceinline__ void gemm_phase(PG8_LAS unsigned char* lds, const Gemm g, const Sched& S, const Epi& E) {
    int tid_ = threadIdx.x; asm volatile("" : "+v"(tid_));
    const int tid = tid_, wid = __builtin_amdgcn_readfirstlane(tid >> 6), lane = tid & 63, wr = wid >> 2, wc = wid & 3, fr = lane & 15, fq = lane >> 4;
    const int K = g.K, nt = K / BK;
    unsigned voffA[2], voffB[2];
#pragma unroll
    for (int i = 0; i < 2; ++i) { int R, C; stage_rc(tid * 16 + i * 8192, R, C); const int Rb = Epi::PERM ? ((R & ~31) + perm32(R & 31)) : R;
        voffA[i] = (unsigned)(R * K + C) * 2u; voffB[i] = (unsigned)(Rb * K + C) * 2u; }
    const size_t kstep = (size_t)(BK * 2);
    const size_t hstep = (size_t)HALF * K * 2;
    const size_t tstep = 2 * hstep;
    const unsigned ldsw = (unsigned)wid * 1024u;
    const int aoff = lds_byte(wr * 64 + fr, fq * 8), boff = lds_byte(wc * 32 + fr, fq * 8);
#define PG8_SA(b, h) (((b) * 2 + (h)) * HTB)
#define PG8_SB(b, h) ((4 + (b) * 2 + (h)) * HTB)
#define PG8_STAGE(bufoff, gbase, voff) do { _Pragma("unroll") for (int _i = 0; _i < 2; ++_i) \
        __builtin_amdgcn_global_load_lds((const unsigned*)((const char*)(gbase) + (voff)[_i]), (PG8_LAS unsigned*)(lds + (bufoff) + ldsw + _i * 8192), 16, 0, 0); } while (0)
#define PG8_LDA(dst, b, h) do { if constexpr (F8) { _Pragma("unroll") for (int m = 0; m < 4; ++m) { const i32x4 lo_ = *(const PG8_LAS i32x4*)(lds + PG8_SA(b, h) + aoff + m * 2048), hi_ = *(const PG8_LAS i32x4*)(lds + PG8_SA(b, h) + aoff + m * 2048 + 1024); dst##8[m] = __builtin_shufflevector(lo_, hi_, 0, 1, 2, 3, 4, 5, 6, 7); } } \
        else { _Pragma("unroll") for (int m = 0; m < 4; ++m) _Pragma("unroll") for (int k = 0; k < 2; ++k) dst[m][k] = *(const PG8_LAS bf16x8*)(lds + PG8_SA(b, h) + aoff + m * 2048 + k * 1024); } } while (0)
#define PG8_LDB(dst, b, h) do { if constexpr (F8) { _Pragma("unroll") for (int n = 0; n < 2; ++n) { const i32x4 lo_ = *(const PG8_LAS i32x4*)(lds + PG8_SB(b, h) + boff + n * 2048), hi_ = *(const PG8_LAS i32x4*)(lds + PG8_SB(b, h) + boff + n * 2048 + 1024); dst##8[n] = __builtin_shufflevector(lo_, hi_, 0, 1, 2, 3, 4, 5, 6, 7); } } \
        else { _Pragma("unroll") for (int n = 0; n < 2; ++n) _Pragma("unroll") for (int k = 0; k < 2; ++k) dst[n][k] = *(const PG8_LAS bf16x8*)(lds + PG8_SB(b, h) + boff + n * 2048 + k * 1024); } } while (0)
#define PG8_MMA(ai, bj, At, Bt) do { __builtin_amdgcn_s_setprio(1); \
        if constexpr (F8) { _Pragma("unroll") for (int m = 0; m < 4; ++m) _Pragma("unroll") for (int n = 0; n < 2; ++n) mma_f8(acc[ai][bj][m][n], Bt##8[n], At##8[m], f8one); } \
        else { _Pragma("unroll") for (int m = 0; m < 4; ++m) _Pragma("unroll") for (int n = 0; n < 2; ++n) _Pragma("unroll") for (int k = 0; k < 2; ++k) \
            acc[ai][bj][m][n] = mma16<I8>(Bt[n][k], At[m][k], acc[ai][bj][m][n]); } __builtin_amdgcn_s_setprio(0); } while (0)
#define PG8_WAIT_V(n) asm volatile("s_waitcnt vmcnt(" #n ")" ::: "memory")
#define PG8_WAIT_L(n) asm volatile("s_waitcnt lgkmcnt(" #n ")" ::: "memory")
#define PG8_BAR __builtin_amdgcn_s_barrier()
#define PG8_SCHED __builtin_amdgcn_sched_barrier(0)
    Unit cur, nxt; int ui = 0;
    if (!S.next(0, cur)) return;
    typedef typename AccT<I8>::type acc_t;
    acc_t acc[2][2][4][2];
#pragma unroll
    for (int a = 0; a < 2; ++a)
#pragma unroll
        for (int b = 0; b < 2; ++b)
#pragma unroll
            for (int m = 0; m < 4; ++m)
#pragma unroll
                for (int n = 0; n < 2; ++n) acc[a][b][m][n] = (acc_t){0, 0, 0, 0};
    bf16x8 At[4][2], B0[2][2], B1[2][2];
    int f8one = 0x7f7f7f7f; asm volatile("" : "+v"(f8one));
    i32x8 At8[4], B08[2], B18[2];
    const char* cA = (const char*)g.A + (size_t)cur.pm * tstep + cur.koff; const char* cB = (const char*)g.Bt + (size_t)cur.pn * tstep + cur.koff;
    PG8_STAGE(PG8_SB(0, 0), cB, voffB); PG8_STAGE(PG8_SB(0, 1), cB + hstep, voffB); PG8_STAGE(PG8_SA(0, 0), cA, voffA); PG8_STAGE(PG8_SA(0, 1), cA + hstep, voffA);
    if (wr == 1) PG8_BAR;
    PG8_WAIT_V(2); PG8_BAR;
    PG8_STAGE(PG8_SB(1, 0), cB + kstep, voffB); PG8_STAGE(PG8_SA(1, 0), cA + kstep, voffA); PG8_STAGE(PG8_SB(1, 1), cB + hstep + kstep, voffB);
    PG8_WAIT_V(6); PG8_BAR;
    for (;;) {
        const bool has_next = S.next(ui + 1, nxt);
        const char* nA = has_next ? (const char*)g.A + (size_t)nxt.pm * tstep + nxt.koff : cA; const char* nB = has_next ? (const char*)g.Bt + (size_t)nxt.pn * tstep + nxt.koff : cB;
        const int ntc = cur.kt ? cur.kt : nt;
        for (int t = 0; t < ntc; t += 2) {
            const bool last = (t == ntc - 2);
            const char* a1 = cA + (size_t)(t + 1) * kstep;
            const char* a2 = last ? nA : cA + (size_t)(t + 2) * kstep; const char* b2 = last ? nB : cB + (size_t)(t + 2) * kstep;
            const char* a3 = a2 + kstep; const char* b3 = b2 + kstep;
            PG8_LDB(B0, 0, 0); PG8_LDB(B1, 0, 1); PG8_SCHED; PG8_LDA(At, 0, 0); PG8_STAGE(PG8_SA(1, 1), a1 + hstep, voffA);
            PG8_WAIT_V(8); PG8_WAIT_L(0); PG8_BAR; PG8_MMA(0, 0, At, B0); PG8_MMA(0, 1, At, B1); PG8_BAR; PG8_SCHED;
            PG8_LDA(At, 0, 1); PG8_STAGE(PG8_SB(0, 0), b2, voffB); PG8_STAGE(PG8_SB(0, 1), b2 + hstep, voffB); PG8_STAGE(PG8_SA(0, 0), a2, voffA);
            PG8_WAIT_V(8); PG8_WAIT_L(0); PG8_BAR; PG8_MMA(1, 0, At, B0); PG8_MMA(1, 1, At, B1); PG8_BAR; PG8_SCHED;
            PG8_LDB(B0, 1, 0); PG8_LDB(B1, 1, 1); PG8_SCHED; PG8_LDA(At, 1, 0); PG8_STAGE(PG8_SA(0, 1), a2 + hstep, voffA);
            PG8_WAIT_V(8); PG8_WAIT_L(0); PG8_BAR; PG8_MMA(0, 0, At, B0); PG8_MMA(0, 1, At, B1); PG8_BAR; PG8_SCHED;
            PG8_LDA(At, 1, 1); PG8_STAGE(PG8_SB(1, 0), b3, voffB); PG8_STAGE(PG8_SB(1, 1), b3 + hstep, voffB); PG8_STAGE(PG8_SA(1, 0), a3, voffA);
            PG8_WAIT_V(8); PG8_WAIT_L(0); PG8_BAR; PG8_MMA(1, 0, At, B0); PG8_MMA(1, 1, At, B1); PG8_BAR; PG8_SCHED;
        }
        if constexpr (ALIGN_EPI) { if (wr == 0) PG8_BAR; }
        if constexpr (F8) asm volatile("s_nop 15\n\ts_nop 15" ::: "memory");
        if constexpr (!Epi::AFTER_DRAIN) E(acc, cur, wr, wc, fr, fq);
#if defined(DBL_PHASE) && DBL_PHASE == 30
        if constexpr (I8) { asm volatile("" ::: "memory"); E(acc, cur, wr, wc, fr, fq); }
#endif
        if (!has_next) break;
#pragma unroll
        for (int a = 0; a < 2; ++a)
#pragma unroll
            for (int b = 0; b < 2; ++b)
#pragma unroll
                for (int m = 0; m < 4; ++m)
#pragma unroll
                    for (int n = 0; n < 2; ++n) acc[a][b][m][n] = (acc_t){0, 0, 0, 0};
        cur = nxt; cA = nA; cB = nB; ++ui;
        if constexpr (ALIGN_EPI) { if (wr == 1) PG8_BAR; }
    }
    PG8_WAIT_V(0);
    if constexpr (!ALIGN_EPI) { if (wr == 0) PG8_BAR; }
    PG8_BAR;
    if constexpr (Epi::AFTER_DRAIN) E.fused(acc, cur, wr, wc, fr, fq, lds, wid, lane);
#undef PG8_SA
#undef PG8_SB
#undef PG8_STAGE
#undef PG8_LDA
#undef PG8_LDB
#undef PG8_MMA
#undef PG8_WAIT_V
#undef PG8_WAIT_L
#undef PG8_BAR
#undef PG8_SCHED
}
}
constexpr int NWAVES = 8;
constexpr int SEQ = 8192, M = 16384, D = 1024, NIN = 3080, NPROJ = 3072;
constexpr int FD = 2752, FDP = 2816, FE = 3584, NEXP = 8;
constexpr float EPS = 1e-6f, LOG2E = 1.4426950408889634f;
constexpr int PC_Q = 0, PC_K = 256, PC_V = 512, PC_Z = 768, PC_XBC = 1280, PC_RQ = 2048, PC_RK = 2304, PC_RV = 2560, PC_RG = 2816;
constexpr size_t MiB = 1u << 20;
constexpr size_t WS_CTL = 0, CTL_ZERO_BYTES = 1 * MiB;
constexpr size_t WS_WIN = 2 * MiB;
constexpr size_t WS_WOUT = 14 * MiB;
constexpr size_t WS_WGU = 18 * MiB;
constexpr size_t WS_WD = 29 * MiB;
constexpr size_t WS_EGU = 35 * MiB;
constexpr size_t WS_ED = 147 * MiB;
constexpr size_t WS_XN = 203 * MiB;
constexpr size_t WS_MIX = 235 * MiB;
constexpr size_t WS_BIG = 303 * MiB;
constexpr size_t WS_SMALL = 430 * MiB;
constexpr size_t WS_DT = WS_SMALL, WS_TI = WS_SMALL + 512 * 1024, WS_TG = WS_SMALL + 768 * 1024, WS_LIST = WS_SMALL + 1024 * 1024;
constexpr size_t WS_XCH = 434 * MiB;
constexpr size_t WS_END = 438 * MiB;
constexpr size_t WS_SST = 203 * MiB;
constexpr size_t WS_RST = 219 * MiB;
constexpr size_t WS_QR = 227 * MiB;
constexpr size_t WS_YD = 267 * MiB;
constexpr size_t WS_OI = 283 * MiB;
constexpr size_t WS_XC = 399 * MiB;
constexpr size_t WS_SBD = WS_SMALL + 2176 * 1024, WS_SBE = WS_SMALL + 2240 * 1024;
constexpr size_t WS_SBI = WS_SMALL + 2900 * 1024;
constexpr size_t WS_SBWD = WS_SMALL + 2930 * 1024, WS_SBED = WS_SMALL + 2940 * 1024;
constexpr size_t WS_XR = 91 * MiB;
constexpr size_t WS_XNS = WS_SMALL + 2560 * 1024, WS_XGS = WS_SMALL + 2688 * 1024;
constexpr size_t WS_XGS2 = 299 * MiB;
__host__ __device__ constexpr int xg_panel(int e) { return e < 6 ? (203 + 16 * e) * 4 : (2 + 16 * (e - 6)) * 4; }
constexpr size_t WS_XG8 = 269 * MiB;
constexpr size_t WS_DTOT = WS_SMALL + 1536 * 1024, WS_EOFF = WS_SMALL + 1600 * 1024;
constexpr int SLAB0_PANELS = 64, SLAB1_MAX = 72;
constexpr int CW_BAR = 4096;
constexpr int CW_SEAM = 16384, SEAM_BANK = 64 * 64;
constexpr int CW_SCAN = 20480;
constexpr int CW_CNT = 8192;
constexpr int RING_BYTES = 131072;
constexpr int LDSCTL_OFF = RING_BYTES, MISC_OFF = LDSCTL_OFF + 320;
constexpr int LDS_BYTES = 147456;
#define GAS __attribute__((address_space(1)))
#define LAS __attribute__((address_space(3)))
typedef unsigned short bf16;
typedef unsigned v4u __attribute__((ext_vector_type(4)));
typedef float f32x4 __attribute__((ext_vector_type(4)));
typedef short bf16x8 __attribute__((ext_vector_type(8)));
typedef GAS unsigned gu32;
typedef GAS unsigned long long gu64;
#define RLX_AGENT __ATOMIC_RELAXED, __HIP_MEMORY_SCOPE_AGENT
#define LDS_WAIT() asm volatile("s_waitcnt lgkmcnt(0)" ::: "memory")
#define VM_WAIT() asm volatile("s_waitcnt vmcnt(0)" ::: "memory")
__device__ __forceinline__ unsigned long long rt() { return __builtin_amdgcn_s_memrealtime(); }
__device__ __forceinline__ unsigned f2bf(float f) { unsigned u = __builtin_bit_cast(unsigned, f); return (u + 0x7fffu + ((u >> 16) & 1u)) >> 16; }
typedef float f32x2_t __attribute__((ext_vector_type(2))); typedef __bf16 bf16x2_t __attribute__((ext_vector_type(2)));
__device__ __forceinline__ unsigned pk2(float lo, float hi) { f32x2_t v = {lo, hi}; bf16x2_t b = __builtin_convertvector(v, bf16x2_t); return __builtin_bit_cast(unsigned, b); }

#define XB_TMO      128
#define XB_XCNT(j)  (256  + 64 * (j))
#define XB_XSUB(j)  (1280 + 64 * (j))
#define XB_XGEN(j)  (2304 + 64 * (j))
#define XB_TOP      3328
#define XB_TOPGEN   3392
#define XCD_BAR_WORDS 3456
#define XB_SPIN_CAP (1u << 18)

__device__ __forceinline__ unsigned xb_ld(unsigned* p)              { return __hip_atomic_load(p, __ATOMIC_RELAXED, __HIP_MEMORY_SCOPE_AGENT); }
__device__ __forceinline__ unsigned xb_add(unsigned* p, unsigned v) { return __hip_atomic_fetch_add(p, v, __ATOMIC_RELAXED, __HIP_MEMORY_SCOPE_AGENT); }
__device__ __forceinline__ unsigned xb_xcc_id() { return (unsigned)__builtin_amdgcn_s_getreg((3 << 11) | 20) & 0xFu; }
#define XB_SPIN(cond, bar) do { unsigned _sp = 0; while (cond) { __builtin_amdgcn_s_sleep(1); \
    if ((++_sp & 255u) == 0u) { if (xb_ld(&(bar)[XB_TMO])) break; if (_sp > XB_SPIN_CAP) { atomicAdd(&(bar)[XB_TMO], 1u); break; } } } } while (0)

struct XcdBarrier {
    unsigned* bar; unsigned x;
    volatile LAS unsigned* st;
};

__device__ __forceinline__ XcdBarrier xcd_barrier_post(unsigned* bar, volatile LAS unsigned* st) {
    XcdBarrier b; b.bar = bar; b.x = xb_xcc_id(); b.st = st;
    if (threadIdx.x == 0) (void)xb_add(&bar[XB_XCNT(b.x)], 1u);
    return b;
}
__device__ __forceinline__ void xcd_barrier_complete(unsigned* bar, unsigned x, unsigned& nloc, unsigned& nx) {
    const unsigned G = gridDim.x * gridDim.y * gridDim.z;
    unsigned sum, cnt, mine, sp = 0u;
    for (;;) {
        sum = 0u; cnt = 0u; mine = 0u;
#pragma unroll
        for (unsigned j = 0; j < 16; ++j) { const unsigned c = xb_ld(&bar[XB_XCNT(j)]); sum += c; cnt += (c > 0u) ? 1u : 0u; mine = (j == x) ? c : mine; }
        if (sum == G) break;
        __builtin_amdgcn_s_sleep(1);
        if ((++sp & 255u) == 0u) { if (xb_ld(&bar[XB_TMO])) break; if (sp > XB_SPIN_CAP) { atomicAdd(&bar[XB_TMO], 1u); break; } }
    }
    nloc = mine > 0u ? mine : 1u; nx = cnt > 0u ? cnt : 1u;
}

__device__ __forceinline__ void xcd_barrier(const XcdBarrier& b) {
    asm volatile("s_waitcnt vmcnt(0)" ::: "memory");
    __syncthreads();
    if (threadIdx.x == 0) {
        unsigned* bar = b.bar;
        __builtin_amdgcn_s_waitcnt(0);
        unsigned nloc = b.st[0], nx = b.st[1];
        if (nloc == 0u) { xcd_barrier_complete(bar, b.x, nloc, nx); b.st[0] = nloc; b.st[1] = nx; }
        const unsigned old = xb_add(&bar[XB_XSUB(b.x)], 1u);
        const unsigned gen = old / nloc;
        if (old + 1u == (gen + 1u) * nloc) {
            __builtin_amdgcn_fence(__ATOMIC_RELEASE, "agent");
            asm volatile("s_waitcnt vmcnt(0)" ::: "memory");
            const unsigned og = xb_add(&bar[XB_TOP], 1u);
            const unsigned tg = og / nx;
            if (og + 1u == (tg + 1u) * nx) xb_add(&bar[XB_TOPGEN], 1u);
            else XB_SPIN(xb_ld(&bar[XB_TOPGEN]) == tg, bar);
            __builtin_amdgcn_fence(__ATOMIC_ACQUIRE, "agent");
            xb_add(&bar[XB_XGEN(b.x)], 1u);
            asm volatile("s_waitcnt vmcnt(0)" ::: "memory");
        } else {
            XB_SPIN(xb_ld(&bar[XB_XGEN(b.x)]) == gen, bar);
            __builtin_amdgcn_fence(__ATOMIC_ACQUIRE, "agent");
            asm volatile("s_waitcnt vmcnt(0)" ::: "memory");
        }
    }
    __syncthreads();
}

struct Args { const float* in[26]; float* out; unsigned char* ws; };
struct Frame {
    LAS unsigned char* lds;
    volatile LAS unsigned* MISC;
    LAS int* META;
    gu32* ctl;
    unsigned char* ws; float* out;
    int tid, lane, wave, G, bx;
};
__device__ __forceinline__ Frame refresh(const Frame& f) { Frame r = f; int t = threadIdx.x; asm volatile("" : "+v"(t)); r.tid = t; r.lane = t & 63; r.wave = __builtin_amdgcn_readfirstlane(t >> 6); return r; }
__device__ __forceinline__ float bf2f(unsigned short u) { return __uint_as_float((unsigned)u << 16); }
__device__ __forceinline__ float bflo(unsigned w) { return __uint_as_float(w << 16); }
__device__ __forceinline__ float bfhi(unsigned w) { return __uint_as_float(w & 0xffff0000u); }
__device__ __forceinline__ float wave_sum(float v) {
#pragma unroll
    for (int o = 1; o < 64; o <<= 1) v += __shfl_xor(v, o);
    return v;
}
__device__ __forceinline__ float silu_f(float v) { return v * __builtin_amdgcn_rcpf(1.0f + __builtin_amdgcn_exp2f(-LOG2E * v)); }

__device__ __forceinline__ void tr_item(const float* W, int ldw, int k0, int nsrc0, bool valid, bf16* WT, int ldk, int drow0, float scale, LAS float* scr, int lane) {
    (void)scr;
    const int c4 = lane & 7, r8 = lane >> 3;
    f32x4 v[8];
    if (valid) { const float* wp = W + (size_t)(k0 + 8 * r8) * ldw + nsrc0 + 4 * c4;
#pragma unroll
        for (int i = 0; i < 8; ++i) v[i] = *(const f32x4*)(wp + (size_t)i * ldw) * scale;
    } else {
#pragma unroll
        for (int i = 0; i < 8; ++i) v[i] = (f32x4){0.f, 0.f, 0.f, 0.f};
    }
#pragma unroll
    for (int j = 0; j < 4; ++j) { v4u o; o.x = pk2(v[0][j], v[1][j]); o.y = pk2(v[2][j], v[3][j]); o.z = pk2(v[4][j], v[5][j]); o.w = pk2(v[6][j], v[7][j]);
        *(GAS v4u*)(WT + (size_t)(drow0 + 4 * c4 + j) * ldk + k0 + 8 * r8) = o; }
}
__device__ __forceinline__ void q_item(const float* W, int ldw, int nsrc0, bool valid, signed char* WT8, int drow0, float* sb, float post, LAS unsigned char* lds, int wave, int lane) {
    LAS float* cm = (LAS float*)lds;
    const int c4 = lane & 7, rs = lane >> 3;
    f32x4 v[16]; f32x4 mx = (f32x4){0.f, 0.f, 0.f, 0.f};
    if (valid) { const float* wp = W + (size_t)(wave * 128 + 16 * rs) * ldw + nsrc0 + 4 * c4;
#pragma unroll
        for (int i = 0; i < 16; ++i) v[i] = *(const f32x4*)(wp + (size_t)i * ldw);
#pragma unroll
        for (int i = 0; i < 16; ++i) { mx.x = fmaxf(mx.x, fabsf(v[i].x)); mx.y = fmaxf(mx.y, fabsf(v[i].y)); mx.z = fmaxf(mx.z, fabsf(v[i].z)); mx.w = fmaxf(mx.w, fabsf(v[i].w)); }
    } else {
#pragma unroll
        for (int i = 0; i < 16; ++i) v[i] = (f32x4){0.f, 0.f, 0.f, 0.f};
    }
#pragma unroll
    for (int o = 8; o < 64; o <<= 1) { mx.x = fmaxf(mx.x, __shfl_xor(mx.x, o)); mx.y = fmaxf(mx.y, __shfl_xor(mx.y, o)); mx.z = fmaxf(mx.z, __shfl_xor(mx.z, o)); mx.w = fmaxf(mx.w, __shfl_xor(mx.w, o)); }
    __syncthreads();
    if (rs == 0) *(LAS f32x4*)(cm + wave * 32 + 4 * c4) = mx;
    __syncthreads();
    f32x4 bm = *(const LAS f32x4*)(cm + 4 * c4);
#pragma unroll
    for (int w = 1; w < 8; ++w) { const f32x4 t = *(const LAS f32x4*)(cm + w * 32 + 4 * c4); bm.x = fmaxf(bm.x, t.x); bm.y = fmaxf(bm.y, t.y); bm.z = fmaxf(bm.z, t.z); bm.w = fmaxf(bm.w, t.w); }
    f32x4 sc; sc.x = bm.x > 0.f ? 127.0f / bm.x : 0.f; sc.y = bm.y > 0.f ? 127.0f / bm.y : 0.f; sc.z = bm.z > 0.f ? 127.0f / bm.z : 0.f; sc.w = bm.w > 0.f ? 127.0f / bm.w : 0.f;
#pragma unroll
    for (int j = 0; j < 4; ++j) { v4u o;
#pragma unroll
        for (int g = 0; g < 4; ++g) { const int q0 = (int)rintf(v[4 * g][j] * sc[j]), q1 = (int)rintf(v[4 * g + 1][j] * sc[j]), q2 = (int)rintf(v[4 * g + 2][j] * sc[j]), q3 = (int)rintf(v[4 * g + 3][j] * sc[j]);
            o[g] = (unsigned)(q0 & 255) | ((unsigned)(q1 & 255) << 8) | ((unsigned)(q2 & 255) << 16) | ((unsigned)(q3 & 255) << 24); }
        *(GAS v4u*)(WT8 + (size_t)(drow0 + 4 * c4 + j) * 1024 + wave * 128 + 16 * rs) = o; }
    if (wave == 0 && rs == 0) *(f32x4*)(sb + drow0 + 4 * c4) = bm * ((1.0f / 127.0f) * post);
}
__device__ __forceinline__ void f8_item(const float* W, int Kvalid, int Kdst, int nsrc0, unsigned char* WT8, int drow0, float* sb, LAS unsigned char* lds, int wave, int lane) {
    LAS float* cm = (LAS float*)lds;
    const int c4 = lane & 7, rs = lane >> 3, slot = wave * 8 + rs;
    const float* wp = W + nsrc0 + 4 * c4;
    f32x4 mx = (f32x4){0.f, 0.f, 0.f, 0.f};
#pragma unroll 16
    for (int k = slot; k < Kvalid; k += 64) { const f32x4 v = *(const f32x4*)(wp + (size_t)k * 1024); mx.x = fmaxf(mx.x, fabsf(v.x)); mx.y = fmaxf(mx.y, fabsf(v.y)); mx.z = fmaxf(mx.z, fabsf(v.z)); mx.w = fmaxf(mx.w, fabsf(v.w)); }
#pragma unroll
    for (int o = 8; o < 64; o <<= 1) { mx.x = fmaxf(mx.x, __shfl_xor(mx.x, o)); mx.y = fmaxf(mx.y, __shfl_xor(mx.y, o)); mx.z = fmaxf(mx.z, __shfl_xor(mx.z, o)); mx.w = fmaxf(mx.w, __shfl_xor(mx.w, o)); }
    __syncthreads();
    if (rs == 0) *(LAS f32x4*)(cm + wave * 32 + 4 * c4) = mx;
    __syncthreads();
    f32x4 bm = *(const LAS f32x4*)(cm + 4 * c4);
#pragma unroll
    for (int w = 1; w < 8; ++w) { const f32x4 t = *(const LAS f32x4*)(cm + w * 32 + 4 * c4); bm.x = fmaxf(bm.x, t.x); bm.y = fmaxf(bm.y, t.y); bm.z = fmaxf(bm.z, t.z); bm.w = fmaxf(bm.w, t.w); }
    f32x4 sc; sc.x = bm.x > 0.f ? 384.0f / bm.x : 0.f; sc.y = bm.y > 0.f ? 384.0f / bm.y : 0.f; sc.z = bm.z > 0.f ? 384.0f / bm.z : 0.f; sc.w = bm.w > 0.f ? 384.0f / bm.w : 0.f;
    for (int q = slot; q * 16 < Kdst; q += 64) {
        f32x4 v[16];
#pragma unroll
        for (int i = 0; i < 16; ++i) { const int k = q * 16 + i; v[i] = k < Kvalid ? *(const f32x4*)(wp + (size_t)k * 1024) : (f32x4){0.f, 0.f, 0.f, 0.f}; }
#pragma unroll
        for (int j = 0; j < 4; ++j) { v4u o;
#pragma unroll
            for (int g = 0; g < 4; ++g) o[g] = pg8::pk4_fp8(v[4 * g][j] * sc[j], v[4 * g + 1][j] * sc[j], v[4 * g + 2][j] * sc[j], v[4 * g + 3][j] * sc[j]);
            *(GAS v4u*)(WT8 + (size_t)(drow0 + 4 * c4 + j) * Kdst + q * 16) = o; }
    }
    if (wave == 0 && rs == 0) *(f32x4*)(sb + drow0 + 4 * c4) = bm * (1.0f / 384.0f);
}
constexpr float C2Q = 0.17677669529663687f * LOG2E;
__device__ __forceinline__ void p0_weights(Frame& F_, const Args& A) {
    Frame F = refresh(F_);
    for (int it0 = F.bx; it0 < 192 + 176 + 32; it0 += F.G) { int it = it0;
        if (it >= 192 + 176) { const int nb = it - 368; f8_item(A.in[21], FD, FDP, nb * 32, (unsigned char*)(F.ws + WS_WD), nb * 32, (float*)(F.ws + WS_SBWD), (LAS unsigned char*)F.lds, F.wave, F.lane); continue; }
        if (it < 192) { const int l = it / 96, nb = it - l * 96; const float post = nb < 8 ? C2Q : ((nb >= 72 && nb < 80) ? 0.125f : 1.0f);
            q_item(A.in[1] + (size_t)l * D * NIN, NIN, nb < 64 ? nb * 32 : nb * 32 + 8, true, (signed char*)(F.ws + WS_WIN) + (size_t)l * NPROJ * D, nb * 32, (float*)(F.ws + WS_SBI) + l * NPROJ, post, (LAS unsigned char*)F.lds, F.wave, F.lane); continue; }
        it -= 192;
        { const int nb = it, t = nb >> 3, sub = nb & 7, fcol = t * 128 + (sub & 3) * 32;
            q_item(sub < 4 ? A.in[19] : A.in[20], FD, fcol, fcol < FD, (signed char*)(F.ws + WS_WGU), nb * 32, (float*)(F.ws + WS_SBD), 1.0f, (LAS unsigned char*)F.lds, F.wave, F.lane); }
    }
    __syncthreads();
    LAS float* scr = (LAS float*)(F.lds + F.wave * 16384);
    const int gw = F.bx * NWAVES + F.wave, NGW = F.G * NWAVES;
    constexpr int I_OUT = 32 * 16;
    for (int it = gw; it < 2 * I_OUT; it += NGW) { const int l = it / I_OUT, r = it - l * I_OUT, kb = r / 32, nb = r % 32;
        tr_item(A.in[2] + (size_t)l * D * D, D, kb * 64, nb * 32, true, ((bf16*)(F.ws + WS_WOUT)) + (size_t)l * D * D, D, nb * 32, 1.0f, scr, F.lane); }
}
__device__ __forceinline__ void expert_weights(Frame& F_, const Args& A) {
    Frame F = refresh(F_);
    for (int r = F.bx; r < NEXP * 224; r += F.G) { const int e = r / 224, nb = r - e * 224, t = nb >> 3, sub = nb & 7, fcol = t * 128 + (sub & 3) * 32;
        q_item((sub < 4 ? A.in[23] : A.in[24]) + (size_t)e * D * FE, FE, fcol, true, (signed char*)(F.ws + WS_EGU) + (size_t)e * 2 * FE * D, nb * 32, (float*)(F.ws + WS_SBE) + e * 2 * FE, 1.0f, (LAS unsigned char*)F.lds, F.wave, F.lane); }
    for (int r = F.bx; r < NEXP * 32; r += F.G) { const int e = r >> 5, nb = r & 31;
        f8_item(A.in[25] + (size_t)e * FE * D, FE, FE, nb * 32, (unsigned char*)(F.ws + WS_ED) + (size_t)e * D * FE, nb * 32, (float*)(F.ws + WS_SBED) + e * D, (LAS unsigned char*)F.lds, F.wave, F.lane); }
    __syncthreads();
}

struct W16 { float v[16]; };
__device__ __forceinline__ W16 norm_wload(const float* wx, int ldw) { W16 w; const int tid = threadIdx.x;
#pragma unroll
    for (int i = 0; i < 16; ++i) { const int idx = tid + 512 * i, k = idx >> 3, j = idx & 7; w.v[i] = wx[(size_t)k * ldw + j]; }
    return w; }
template <int N> struct IntC { static constexpr int v = N; };
template <int MODE, bool OUT8 = false, bool SRC16 = false, bool PRE = false>
__device__ __forceinline__ void norm_phase(Frame& F_, const float* src, const float* gain, const float* wx, int ldw, const W16 wpre = W16{}) {
    Frame F = refresh(F_);
    LAS float* Wl = (LAS float*)F.lds;
    if (MODE != 0) {
        if constexpr (PRE) {
#pragma unroll
            for (int i = 0; i < 16; ++i) { const int idx = F.tid + 512 * i, k = idx >> 3, j = idx & 7; Wl[j * D + k] = wpre.v[i]; }
        } else { for (int idx = F.tid; idx < 8 * D; idx += NWAVES * 64) { const int k = idx >> 3, j = idx & 7; Wl[j * D + k] = wx[(size_t)k * ldw + j]; } }
        __syncthreads();
    }
    const int hl = F.lane & 31, hw = F.lane >> 5, gw = F.bx * NWAVES + F.wave, NGW = F.G * NWAVES;
    f32x4 g8[4][2];
#pragma unroll
    for (int j = 0; j < 4; ++j) { g8[j][0] = *(const f32x4*)(gain + 8 * (hl + 32 * j)); g8[j][1] = *(const f32x4*)(gain + 8 * (hl + 32 * j) + 4); }
#define NP_HSUM(x) do { _Pragma("unroll") for (int o_ = 1; o_ < 32; o_ <<= 1) x += __shfl_xor(x, o_); } while (0)
    constexpr int NIT = 4;
    const int step = 2 * NGW;
    const bool agg = (MODE == 2) && (M == NIT * step);
    LAS unsigned* lcnt = (LAS unsigned*)(F.lds + 8 * D * 4);
    if (MODE == 2) { if (F.tid < 16) lcnt[F.tid] = 0u; __syncthreads(); }
    uint2 rq[NIT][4]; float rsc[NIT], rg0[NIT]; int re[NIT], rl0[NIT], rl1[NIT];
    (void)rq; (void)rsc; (void)rg0; (void)re; (void)rl0; (void)rl1;
    auto body = [&](const int m, auto itc) __attribute__((always_inline)) {
        constexpr int IT = decltype(itc)::v;
        f32x4 v[4][2]; float s = 0.f; uint2 q8[4]; float qsc = 0.f; (void)q8; (void)qsc;
        if constexpr (SRC16) { const v4u* xr = (const v4u*)((const bf16*)src + (size_t)m * D) + hl;
#pragma unroll
            for (int j = 0; j < 4; ++j) { const v4u w = xr[32 * j]; v[j][0] = (f32x4){bflo(w.x), bfhi(w.x), bflo(w.y), bfhi(w.y)}; v[j][1] = (f32x4){bflo(w.z), bfhi(w.z), bflo(w.w), bfhi(w.w)}; }
        } else { const f32x4* xr = (const f32x4*)(src + (size_t)m * D) + 2 * hl;
#pragma unroll
            for (int j = 0; j < 4; ++j) { v[j][0] = xr[64 * j]; v[j][1] = xr[64 * j + 1]; } }
#pragma unroll
        for (int j = 0; j < 4; ++j)
#pragma unroll
            for (int t = 0; t < 2; ++t) s += (v[j][t].x * v[j][t].x + v[j][t].y * v[j][t].y) + (v[j][t].z * v[j][t].z + v[j][t].w * v[j][t].w);
        NP_HSUM(s);
        const float rstd = __builtin_amdgcn_rsqf(s * (1.f / D) + EPS);
        float amax = 0.f;
#pragma unroll
        for (int j = 0; j < 4; ++j)
#pragma unroll
            for (int t = 0; t < 2; ++t) { v[j][t] = v[j][t] * rstd * g8[j][t]; amax = fmaxf(amax, fmaxf(fmaxf(fabsf(v[j][t].x), fabsf(v[j][t].y)), fmaxf(fabsf(v[j][t].z), fabsf(v[j][t].w)))); }
        if (!OUT8) {
            v4u* o16 = (v4u*)(((bf16*)(F.ws + WS_XN)) + (size_t)m * D) + hl;
#pragma unroll
            for (int j = 0; j < 4; ++j) { v4u o; o.x = pk2(v[j][0].x, v[j][0].y); o.y = pk2(v[j][0].z, v[j][0].w); o.z = pk2(v[j][1].x, v[j][1].y); o.w = pk2(v[j][1].z, v[j][1].w); o16[32 * j] = o; }
        } else {
#pragma unroll
            for (int o = 1; o < 32; o <<= 1) amax = fmaxf(amax, __shfl_xor(amax, o));
            const float qs = amax > 0.f ? 127.0f / amax : 0.f;
            uint2* o8 = (uint2*)(F.ws + WS_XN + (size_t)m * D) + hl;
            (void)o8;
#pragma unroll
            for (int j = 0; j < 4; ++j) { uint2 o;
                { const int q0 = (int)rintf(v[j][0].x * qs), q1 = (int)rintf(v[j][0].y * qs), q2 = (int)rintf(v[j][0].z * qs), q3 = (int)rintf(v[j][0].w * qs); o.x = (unsigned)(q0 & 255) | ((unsigned)(q1 & 255) << 8) | ((unsigned)(q2 & 255) << 16) | ((unsigned)(q3 & 255) << 24); }
                { const int q0 = (int)rintf(v[j][1].x * qs), q1 = (int)rintf(v[j][1].y * qs), q2 = (int)rintf(v[j][1].z * qs), q3 = (int)rintf(v[j][1].w * qs); o.y = (unsigned)(q0 & 255) | ((unsigned)(q1 & 255) << 8) | ((unsigned)(q2 & 255) << 16) | ((unsigned)(q3 & 255) << 24); }
                if constexpr (MODE == 2) q8[j] = o; else o8[32 * j] = o; }
            if constexpr (MODE == 2) qsc = amax * (1.0f / 127.0f); else if (hl == 0) ((float*)(F.ws + WS_XNS))[m] = amax * (1.0f / 127.0f);
        }
        if (MODE != 0) {
            float ex[8];
#pragma unroll
            for (int e = 0; e < 8; ++e) { float a = 0.f;
#pragma unroll
                for (int j = 0; j < 4; ++j) { const f32x4 w0 = *(const LAS f32x4*)(Wl + e * D + 8 * (hl + 32 * j)), w1 = *(const LAS f32x4*)(Wl + e * D + 8 * (hl + 32 * j) + 4);
                    a += (v[j][0].x * w0.x + v[j][0].y * w0.y) + (v[j][0].z * w0.z + v[j][0].w * w0.w) + (v[j][1].x * w1.x + v[j][1].y * w1.y) + (v[j][1].z * w1.z + v[j][1].w * w1.w); }
                NP_HSUM(a); ex[e] = a; asm volatile("" ::: "memory"); }
            if (MODE == 1) {
                float val = ex[0];
#pragma unroll
                for (int e = 1; e < 8; ++e) val = (hl == e) ? ex[e] : val;
                if (hl < 8) ((float*)(F.ws + WS_DT))[(size_t)m * 8 + hl] = val;
            } else {
                int e0 = 0; float v0 = ex[0];
#pragma unroll
                for (int e = 1; e < 8; ++e) if (ex[e] > v0) { v0 = ex[e]; e0 = e; }
                int e1 = -1; float v1 = -3.0e38f;
#pragma unroll
                for (int e = 0; e < 8; ++e) if (e != e0 && ex[e] > v1) { v1 = ex[e]; e1 = e; }
                if (agg) {
                    int lp0 = 0, lp1 = 0;
                    if (hl == 0) { lp0 = (int)__hip_atomic_fetch_add(lcnt + e0, 1u, __ATOMIC_RELAXED, __HIP_MEMORY_SCOPE_WORKGROUP); lp1 = (int)__hip_atomic_fetch_add(lcnt + e1, 1u, __ATOMIC_RELAXED, __HIP_MEMORY_SCOPE_WORKGROUP); }
                    rl0[IT] = __shfl(lp0, hw * 32); rl1[IT] = __shfl(lp1, hw * 32); re[IT] = e0 | (e1 << 8); rg0[IT] = 1.0f / (1.0f + __expf(v1 - v0)); rsc[IT] = qsc;
#pragma unroll
                    for (int j = 0; j < 4; ++j) rq[IT][j] = q8[j];
                    return;
                }
                int pos0 = 0, pos1 = 0;
                if (hl == 0) {
                    const float g0 = 1.0f / (1.0f + __expf(v1 - v0)), g1 = 1.0f - g0;
                    pos0 = (int)atomicAdd((unsigned*)(F.ctl + CW_CNT + 64 * e0), 1u); pos1 = (int)atomicAdd((unsigned*)(F.ctl + CW_CNT + 64 * e1), 1u);
                    ((int*)(F.ws + WS_TI))[m * 4 + 0] = e0 | (e1 << 8); ((int*)(F.ws + WS_TI))[m * 4 + 1] = pos0; ((int*)(F.ws + WS_TI))[m * 4 + 2] = pos1; ((int*)(F.ws + WS_TI))[m * 4 + 3] = 0;
                    ((float*)(F.ws + WS_TG))[m * 2 + 0] = g0; ((float*)(F.ws + WS_TG))[m * 2 + 1] = g1;
                }
                pos0 = __shfl(pos0, hw * 32); pos1 = __shfl(pos1, hw * 32);
                { const int pa = xg_panel(e0), pb = xg_panel(e1);
                  uint2* d0 = (uint2*)(F.ws + (size_t)pa * 262144 + (size_t)pos0 * 1024) + hl; uint2* d1 = (uint2*)(F.ws + (size_t)pb * 262144 + (size_t)pos1 * 1024) + hl;
#pragma unroll
                  for (int j = 0; j < 4; ++j) { d0[32 * j] = q8[j]; d1[32 * j] = q8[j]; }
                  if (hl == 0) { ((float*)(F.ws + WS_XGS2))[pa * 256 + pos0] = qsc; ((float*)(F.ws + WS_XGS2))[pb * 256 + pos1] = qsc; } }
            }
        }
    };
    if (agg) {
        const int m0 = 2 * gw + hw;
        body(m0, IntC<0>{}); body(m0 + step, IntC<1>{}); body(m0 + 2 * step, IntC<2>{}); body(m0 + 3 * step, IntC<3>{});
        __syncthreads();
        if (F.tid < 8) lcnt[8 + F.tid] = atomicAdd((unsigned*)(F.ctl + CW_CNT + 64 * F.tid), lcnt[F.tid]);
        __syncthreads();
#pragma unroll
        for (int it = 0; it < NIT; ++it) { const int m = m0 + it * step, e0 = re[it] & 255, e1 = re[it] >> 8;
            const int pos0 = (int)lcnt[8 + e0] + rl0[it], pos1 = (int)lcnt[8 + e1] + rl1[it];
            if (hl == 0) { ((int*)(F.ws + WS_TI))[m * 4 + 0] = re[it]; ((int*)(F.ws + WS_TI))[m * 4 + 1] = pos0; ((int*)(F.ws + WS_TI))[m * 4 + 2] = pos1; ((int*)(F.ws + WS_TI))[m * 4 + 3] = 0;
                ((float*)(F.ws + WS_TG))[m * 2 + 0] = rg0[it]; ((float*)(F.ws + WS_TG))[m * 2 + 1] = 1.0f - rg0[it]; }
            const int pa = xg_panel(e0), pb = xg_panel(e1);
            uint2* d0 = (uint2*)(F.ws + (size_t)pa * 262144 + (size_t)pos0 * 1024) + hl; uint2* d1 = (uint2*)(F.ws + (size_t)pb * 262144 + (size_t)pos1 * 1024) + hl;
#pragma unroll
            for (int j = 0; j < 4; ++j) { d0[32 * j] = rq[it][j]; d1[32 * j] = rq[it][j]; }
            if (hl == 0) { ((float*)(F.ws + WS_XGS2))[pa * 256 + pos0] = rsc[it]; ((float*)(F.ws + WS_XGS2))[pb * 256 + pos1] = rsc[it]; } }
    } else {
        for (int m = 2 * gw + hw; m < M; m += step) body(m, IntC<0>{});
    }
#undef NP_HSUM
    if (MODE != 0) __syncthreads();
}
__device__ __forceinline__ void combine_phase(Frame& F_, const Args& A) {
    Frame F = refresh(F_);
    const int hl = F.lane & 31, hw = F.lane >> 5, gw = F.bx * NWAVES + F.wave, NGW = F.G * NWAVES;
    f32x4 g8[4][2];
#pragma unroll
    for (int j = 0; j < 4; ++j) { g8[j][0] = *(const f32x4*)(A.in[5] + 8 * (hl + 32 * j)); g8[j][1] = *(const f32x4*)(A.in[5] + 8 * (hl + 32 * j) + 4); }
    for (int m = 2 * gw + hw; m < M; m += 2 * NGW) {
        const int ti = ((int*)(F.ws + WS_TI))[m * 4], e0 = ti & 255, e1 = ti >> 8;
        const size_t r0 = (size_t)F.META[8 + e0] * 256 + ((int*)(F.ws + WS_TI))[m * 4 + 1], r1 = (size_t)F.META[8 + e1] * 256 + ((int*)(F.ws + WS_TI))[m * 4 + 2];
        const float g0 = ((float*)(F.ws + WS_TG))[m * 2], g1 = ((float*)(F.ws + WS_TG))[m * 2 + 1];
        const v4u* xb = (const v4u*)((const bf16*)(F.ws + WS_XR) + (size_t)m * D) + hl;
        const v4u* y0 = (const v4u*)(((const bf16*)(F.ws + WS_MIX)) + r0 * D) + hl; const v4u* y1 = (const v4u*)(((const bf16*)(F.ws + WS_MIX)) + r1 * D) + hl;
        const v4u* z0 = (const v4u*)(((const bf16*)(F.ws + WS_XN)) + (r0 >= 32768 ? r0 - 32768 : 0) * D) + hl; const v4u* z1 = (const v4u*)(((const bf16*)(F.ws + WS_XN)) + (r1 >= 32768 ? r1 - 32768 : 0) * D) + hl;
        f32x4 v[4][2]; float s = 0.f;
#define CB_LO(w_) ((f32x4){bflo((w_).x), bfhi((w_).x), bflo((w_).y), bfhi((w_).y)})
#define CB_HI(w_) ((f32x4){bflo((w_).z), bfhi((w_).z), bflo((w_).w), bfhi((w_).w)})
#pragma unroll
        for (int j = 0; j < 4; ++j) { f32x4 ya0, ya1, yb0, yb1;
            if (r0 >= 32768) { ya0 = (f32x4){0.f, 0.f, 0.f, 0.f}; ya1 = ya0;
#pragma unroll
                for (int ks = 0; ks < 7; ++ks) { const v4u a = z0[(size_t)ks * 2048 * 128 + 32 * j]; ya0 += CB_LO(a); ya1 += CB_HI(a); } }
            else { const v4u a = y0[32 * j]; ya0 = CB_LO(a); ya1 = CB_HI(a); }
            if (r1 >= 32768) { yb0 = (f32x4){0.f, 0.f, 0.f, 0.f}; yb1 = yb0;
#pragma unroll
                for (int ks = 0; ks < 7; ++ks) { const v4u b = z1[(size_t)ks * 2048 * 128 + 32 * j]; yb0 += CB_LO(b); yb1 += CB_HI(b); } }
            else { const v4u b = y1[32 * j]; yb0 = CB_LO(b); yb1 = CB_HI(b); }
            const v4u xw = xb[32 * j];
            v[j][0] = CB_LO(xw) + ya0 * g0 + yb0 * g1; v[j][1] = CB_HI(xw) + ya1 * g0 + yb1 * g1;
            s += (v[j][0].x * v[j][0].x + v[j][0].y * v[j][0].y) + (v[j][0].z * v[j][0].z + v[j][0].w * v[j][0].w) + (v[j][1].x * v[j][1].x + v[j][1].y * v[j][1].y) + (v[j][1].z * v[j][1].z + v[j][1].w * v[j][1].w); }
#undef CB_LO
#undef CB_HI
#pragma unroll
        for (int o = 1; o < 32; o <<= 1) s += __shfl_xor(s, o);
        const float rstd = __builtin_amdgcn_rsqf(s * (1.f / D) + EPS);
        f32x4* xr = (f32x4*)(F.out + (size_t)m * D) + 2 * hl;
#pragma unroll
        for (int j = 0; j < 4; ++j) { xr[64 * j] = v[j][0] * rstd * g8[j][0]; xr[64 * j + 1] = v[j][1] * rstd * g8[j][1]; }
    }
}
__device__ __forceinline__ int t5_bucket(int rel) {
    const int n = rel < 0 ? -rel : rel;
    int b = n < 8 ? n : n < 12 ? 8 : n < 16 ? 9 : n < 23 ? 10 : n < 32 ? 11 : n < 46 ? 12 : n < 64 ? 13 : n < 91 ? 14 : 15;
    return rel > 0 ? b + 16 : b;
}
__device__ __forceinline__ void unpack8(const v4u w, float* f) { f[0] = bflo(w.x); f[1] = bfhi(w.x); f[2] = bflo(w.y); f[3] = bfhi(w.y); f[4] = bflo(w.z); f[5] = bfhi(w.z); f[6] = bflo(w.w); f[7] = bfhi(w.w); }

namespace pg8 {
template <int MODE> struct EpiResNorm {
    static constexpr bool PERM = false, AFTER_DRAIN = true;
    const float* base; float* out; const float* gain; const float* wx; int ldw;
    unsigned char* ws; unsigned* cnt;
    __device__ __forceinline__ void fused(f32x4 (&acc)[2][2][4][2], const Unit& u, int wr, int wc, int fr, int fq, PG8_LAS unsigned char* lds, int wid, int lane) const {
        PG8_LAS float* Wt = (PG8_LAS float*)lds;
        PG8_LAS float* P = (PG8_LAS float*)(lds + 8192);
        PG8_LAS float* S = (PG8_LAS float*)(lds + 8192 + 49152);
        PG8_LAS unsigned* flag = (PG8_LAS unsigned*)(lds + 8192 + 49152 + 1024);
        const int tid = wid * 64 + lane, ldc = 1024;
        if (MODE != 0) { for (int idx = tid; idx < 2048; idx += 512) { const int e = idx >> 8, c = idx & 255; Wt[idx] = wx[(size_t)(u.cn * BM + c) * ldw + e]; } }
        const int col0 = u.cn * BM + wc * 32 + 4 * fq;
        f32x4 g4[2][2];
#pragma unroll
        for (int bj = 0; bj < 2; ++bj)
#pragma unroll
            for (int n = 0; n < 2; ++n) g4[bj][n] = *(const f32x4*)(gain + col0 + bj * HALF + n * 16);
        asm volatile("s_waitcnt lgkmcnt(0)" ::: "memory"); __builtin_amdgcn_s_barrier(); asm volatile("" ::: "memory");
#pragma unroll
        for (int ai = 0; ai < 2; ++ai)
#pragma unroll
            for (int m = 0; m < 4; ++m) { const int r = ai * HALF + wr * 64 + m * 16 + fr; const size_t off = (size_t)(u.po * BM + r) * ldc + col0;
                float st[10];
#pragma unroll
                for (int k = 0; k < 10; ++k) st[k] = 0.f;
#pragma unroll
                for (int bj = 0; bj < 2; ++bj)
#pragma unroll
                    for (int n = 0; n < 2; ++n) { const f32x4 bs = *(const f32x4*)(base + off + bj * HALF + n * 16); const f32x4 x1 = bs + acc[ai][bj][m][n]; acc[ai][bj][m][n] = x1;
                        *(f32x4*)(out + off + bj * HALF + n * 16) = x1;
                        const f32x4 xg = x1 * g4[bj][n];
                        st[0] += (x1.x * x1.x + x1.y * x1.y) + (x1.z * x1.z + x1.w * x1.w);
                        st[1] = fmaxf(st[1], fmaxf(fmaxf(fabsf(xg.x), fabsf(xg.y)), fmaxf(fabsf(xg.z), fabsf(xg.w))));
                        if (MODE != 0) { const int cl = bj * HALF + wc * 32 + n * 16 + 4 * fq;
#pragma unroll
                            for (int e = 0; e < 8; ++e) { const f32x4 w = *(const PG8_LAS f32x4*)(Wt + e * 256 + cl); st[2 + e] += (xg.x * w.x + xg.y * w.y) + (xg.z * w.z + xg.w * w.w); if (e & 1) asm volatile("" ::: "memory"); } } }
                st[0] += __shfl_xor(st[0], 16); st[0] += __shfl_xor(st[0], 32); st[1] = fmaxf(st[1], __shfl_xor(st[1], 16)); st[1] = fmaxf(st[1], __shfl_xor(st[1], 32));
                if (MODE != 0) {
#pragma unroll
                    for (int e = 0; e < 8; ++e) { st[2 + e] += __shfl_xor(st[2 + e], 16); st[2 + e] += __shfl_xor(st[2 + e], 32); } }
                if (fq == 0) { PG8_LAS float* p = P + (r * 4 + wc) * 12;
                    p[0] = st[0]; p[1] = st[1];
                    if (MODE != 0) {
#pragma unroll
                        for (int e = 0; e < 8; ++e) p[2 + e] = st[2 + e]; } }
                asm volatile("" ::: "memory"); }
        asm volatile("s_waitcnt lgkmcnt(0)" ::: "memory"); __builtin_amdgcn_s_barrier(); asm volatile("" ::: "memory");
        const int row = wid * 32 + (lane & 31);
        unsigned long long* slot = (unsigned long long*)((float*)(ws + WS_XCH) + ((size_t)(u.po * BM + row) * 4 + u.cn) * 12);
        if (lane < 32) { float t[10];
#pragma unroll
            for (int k = 0; k < 10; ++k) { const float a = P[(row * 4 + 0) * 12 + k], b = P[(row * 4 + 1) * 12 + k], c = P[(row * 4 + 2) * 12 + k], d = P[(row * 4 + 3) * 12 + k];
                t[k] = (k == 1) ? fmaxf(fmaxf(a, b), fmaxf(c, d)) : (a + b) + (c + d); }
#pragma unroll
            for (int k = 0; k < 5; ++k) __hip_atomic_store(slot + k, ((unsigned long long)__float_as_uint(t[2 * k + 1]) << 32) | __float_as_uint(t[2 * k]), __ATOMIC_RELAXED, __HIP_MEMORY_SCOPE_AGENT); }
        asm volatile("s_waitcnt vmcnt(0)" ::: "memory");
        if (lane == 0) __hip_atomic_fetch_add(cnt + 64 * u.po, 1u, __ATOMIC_RELAXED, __HIP_MEMORY_SCOPE_AGENT);
        if (wid == 0) {
            const unsigned long long t0 = __builtin_amdgcn_s_memrealtime();
            for (;;) {
                if ((unsigned)__builtin_amdgcn_readfirstlane(__hip_atomic_load(cnt + 64 * u.po, __ATOMIC_RELAXED, __HIP_MEMORY_SCOPE_AGENT)) >= 32u) break;
                if (__builtin_amdgcn_s_memrealtime() - t0 > 2000000ull) break;
                __builtin_amdgcn_s_sleep(2);
            }
            __builtin_amdgcn_fence(__ATOMIC_ACQUIRE, "agent");
            if (lane == 0) flag[0] = 1u;
        }
        asm volatile("s_waitcnt vmcnt(0) lgkmcnt(0)" ::: "memory"); __builtin_amdgcn_s_barrier(); asm volatile("" ::: "memory");
        if (lane < 32) { const unsigned long long* sl = (const unsigned long long*)((const float*)(ws + WS_XCH) + (size_t)(u.po * BM + row) * 4 * 12);
            float t[10];
#pragma unroll
            for (int k = 0; k < 10; ++k) t[k] = 0.f;
#pragma unroll
            for (int tl = 0; tl < 4; ++tl)
#pragma unroll
                for (int k = 0; k < 5; ++k) { const unsigned long long w = __hip_atomic_load(sl + tl * 6 + k, __ATOMIC_RELAXED, __HIP_MEMORY_SCOPE_AGENT);
                    const float lo = __uint_as_float((unsigned)w), hi = __uint_as_float((unsigned)(w >> 32));
                    if (k == 0) { t[0] += lo; t[1] = fmaxf(t[1], hi); } else { t[2 * k] += lo; t[2 * k + 1] += hi; } }
            const float rstd = __builtin_amdgcn_rsqf(t[0] * (1.f / 1024.f) + 1e-6f), arow = t[1] * rstd;
            S[row] = arow > 0.f ? rstd * (127.0f / arow) : 0.f;
            if (u.cn == 0) { const size_t grow = (size_t)u.po * BM + row;
                ((float*)(ws + WS_XNS))[grow] = arow * (1.0f / 127.0f);
                if (MODE == 1) { *(f32x4*)((float*)(ws + WS_DT) + grow * 8) = (f32x4){t[2] * rstd, t[3] * rstd, t[4] * rstd, t[5] * rstd}; *(f32x4*)((float*)(ws + WS_DT) + grow * 8 + 4) = (f32x4){t[6] * rstd, t[7] * rstd, t[8] * rstd, t[9] * rstd}; }
                if (MODE == 2) { float ex[8];
#pragma unroll
                    for (int e = 0; e < 8; ++e) ex[e] = t[2 + e] * rstd;
                    int e0 = 0; float v0 = ex[0];
#pragma unroll
                    for (int e = 1; e < 8; ++e) if (ex[e] > v0) { v0 = ex[e]; e0 = e; }
                    int e1 = -1; float v1 = -3.0e38f;
#pragma unroll
                    for (int e = 0; e < 8; ++e) if (e != e0 && ex[e] > v1) { v1 = ex[e]; e1 = e; }
                    const float g0 = 1.0f / (1.0f + __expf(v1 - v0)), g1 = 1.0f - g0; const int mtok = (int)grow;
                    unsigned* ctl = (unsigned*)(ws + WS_CTL);
                    const int pos0 = (int)atomicAdd(ctl + CW_CNT + 64 * e0, 1u), pos1 = (int)atomicAdd(ctl + CW_CNT + 64 * e1, 1u);
                    int* LIST = (int*)(ws + WS_LIST); int* TI = (int*)(ws + WS_TI); float* TG = (float*)(ws + WS_TG);
                    LIST[e0 * 16384 + pos0] = mtok; LIST[e1 * 16384 + pos1] = mtok;
                    TI[mtok * 4 + 0] = e0 | (e1 << 8); TI[mtok * 4 + 1] = pos0; TI[mtok * 4 + 2] = pos1; TI[mtok * 4 + 3] = 0;
                    TG[mtok * 2 + 0] = g0; TG[mtok * 2 + 1] = g1; } } }
        asm volatile("s_waitcnt lgkmcnt(0)" ::: "memory"); __builtin_amdgcn_s_barrier(); asm volatile("" ::: "memory");
        unsigned char* XN8 = ws + WS_XN;
#pragma unroll
        for (int ai = 0; ai < 2; ++ai)
#pragma unroll
            for (int m = 0; m < 4; ++m) { const int r = ai * HALF + wr * 64 + m * 16 + fr; const float s = S[r]; unsigned char* rowp = XN8 + (size_t)(u.po * BM + r) * 1024 + col0;
#pragma unroll
                for (int bj = 0; bj < 2; ++bj)
#pragma unroll
                    for (int n = 0; n < 2; ++n) { const f32x4 q = acc[ai][bj][m][n] * g4[bj][n] * s;
                        const int q0 = (int)rintf(q.x), q1 = (int)rintf(q.y), q2 = (int)rintf(q.z), q3 = (int)rintf(q.w);
                        *(unsigned*)(rowp + bj * HALF + n * 16) = (unsigned)(q0 & 255) | ((unsigned)(q1 & 255) << 8) | ((unsigned)(q2 & 255) << 16) | ((unsigned)(q3 & 255) << 24); } }
    }
};
}
namespace att {
typedef short v4i16_t __attribute__((ext_vector_type(4)));
typedef short s16x4 __attribute__((ext_vector_type(4)));
typedef float f32x16 __attribute__((ext_vector_type(16)));
constexpr int NSLOT = 3, SLOTB = 8192;
constexpr int LDS_K = 0, LDS_V = NSLOT * SLOTB, LDS_BT = 2 * NSLOT * SLOTB, LDS_WS = LDS_BT + 2048, LDS_OST = LDS_WS + 2048, OST_W = 32 * 68, LDS_END = LDS_OST + 8 * OST_W * 4;
static_assert(LDS_END <= RING_BYTES, "attention LDS map");
constexpr float THR = 8.0f;
__device__ __forceinline__ s16x4 vtr(const LAS char* p) { return __builtin_bit_cast(s16x4, __builtin_amdgcn_ds_read_tr16_b64_v4i16((LAS v4i16_t*)p)); }
__device__ __forceinline__ int crow(int r, int hi) { return (r & 3) + 8 * (r >> 2) + 4 * hi; }
__device__ __forceinline__ float xhalf_max(float v) { auto rr = __builtin_amdgcn_permlane32_swap(__float_as_uint(v), __float_as_uint(v), false, false); return fmaxf(__uint_as_float(rr[0]), __uint_as_float(rr[1])); }
__device__ __forceinline__ float xhalf_sum(float v) { auto rr = __builtin_amdgcn_permlane32_swap(__float_as_uint(v), __float_as_uint(v), false, false); return __uint_as_float(rr[0]) + __uint_as_float(rr[1]); }
#define ATT_WAIT_BAR(N) asm volatile("s_waitcnt vmcnt(" #N ") lgkmcnt(0)\n\ts_barrier" ::: "memory")

__device__ __forceinline__ void attn_unit(Frame& F_, const Args& A, int l, int b, int h, int qb, float lam, float oscale) {
    Frame F = refresh(F_);
    const int tid = F.tid, lane = tid & 63, wid = F.wave, r32 = lane & 31, hi = lane >> 5, t = wid >> 2, wq = wid & 3;
    const int Q0 = qb * 128, row0 = Q0 + 32 * wq, NT = 2 * qb + 2, cq = 2 * qb + (wq >> 1);
    const bf16* PROJ = (const bf16*)(F.ws + WS_BIG); const size_t rb = (size_t)b * SEQ;
    LAS char* L = (LAS char*)F.lds;
    LAS float* Bt = (LAS float*)(L + LDS_BT); LAS float* wsf = (LAS float*)(L + LDS_WS) + wid * 64; LAS float* stg = (LAS float*)(L + LDS_OST) + wid * OST_W;
    ATT_WAIT_BAR(0);
    const float cb = A.in[6][15 * 4 + h] * LOG2E;
    if (tid < 320) Bt[tid] = A.in[6][t5_bucket(tid - 255) * 4 + h] * LOG2E - cb;
    bf16x8 qr[2];
#pragma unroll
    for (int s = 0; s < 2; ++s) qr[s] = *(const bf16x8*)(PROJ + (rb + row0 + r32) * NPROJ + PC_Q + h * 64 + t * 32 + s * 16 + hi * 8);
    const int krow = wid * 8 + (lane >> 3);
    const bf16* ksrc = PROJ + (rb + krow) * NPROJ + PC_K + h * 64 + (((lane & 7) ^ (krow & 7)) * 8);
    const bf16* vsrc = PROJ + (rb + 16 * (wid & 3) + (lane >> 2)) * NPROJ + PC_V + h * 64 + (wid >> 2) * 32 + (lane & 3) * 8;
#define ATT_DMA(tile, sl) do { \
        __builtin_amdgcn_global_load_lds((const unsigned*)(ksrc + (size_t)(tile) * 64 * NPROJ), (LAS unsigned*)(L + LDS_K + (sl) * SLOTB + wid * 1024), 16, 0, 0); \
        __builtin_amdgcn_global_load_lds((const unsigned*)(vsrc + (size_t)(tile) * 64 * NPROJ), (LAS unsigned*)(L + LDS_V + (sl) * SLOTB + wid * 1024), 16, 0, 0); } while (0)
    ATT_DMA(0, 0); ATT_DMA(1, 1);
    f32x16 o0, o1, zero16;
#pragma unroll
    for (int r = 0; r < 16; ++r) { o0[r] = 0.f; o1[r] = 0.f; zero16[r] = 0.f; }
    float lsum = 0.f;
    const int kf0 = r32 * 128 + (((t * 4 + hi) ^ (r32 & 7)) * 16), kf1 = r32 * 128 + (((t * 4 + 2 + hi) ^ (r32 & 7)) * 16);
    const int vfo = ((lane >> 4) & 1) * 32 + (lane & 3) * 8 + (4 * hi + ((lane & 15) >> 2)) * 64;
    int slot = 0;
    for (int tile = 0; tile < NT; ++tile) {
        if (tile + 1 < NT) ATT_WAIT_BAR(2); else ATT_WAIT_BAR(0);
        if (tile + 2 < NT) { const int s2 = slot >= 1 ? slot - 1 : 2; ATT_DMA(tile + 2, s2); }
        if (tile <= cq) {
            const LAS char* Ks = L + LDS_K + slot * SLOTB; const LAS char* Vs = L + LDS_V + slot * SLOTB + vfo;
            f32x16 p0, p1;
            { const bf16x8 k00 = *(const LAS bf16x8*)(Ks + kf0), k01 = *(const LAS bf16x8*)(Ks + kf1), k10 = *(const LAS bf16x8*)(Ks + 4096 + kf0), k11 = *(const LAS bf16x8*)(Ks + 4096 + kf1);
              p0 = __builtin_amdgcn_mfma_f32_32x32x16_bf16(k00, qr[0], zero16, 0, 0, 0); p0 = __builtin_amdgcn_mfma_f32_32x32x16_bf16(k01, qr[1], p0, 0, 0, 0);
              p1 = __builtin_amdgcn_mfma_f32_32x32x16_bf16(k10, qr[0], zero16, 0, 0, 0); p1 = __builtin_amdgcn_mfma_f32_32x32x16_bf16(k11, qr[1], p1, 0, 0, 0); }
            const int K0 = tile * 64;
            if (K0 > row0 - 154) {
                const LAS float* bp = Bt + (K0 - row0 + 255 + 4 * hi - r32);
#pragma unroll
                for (int r = 0; r < 16; ++r) { p0[r] += bp[(r & 3) + 8 * (r >> 2)]; p1[r] += bp[32 + (r & 3) + 8 * (r >> 2)]; }
            }
            float sacc = 0.f;
#pragma unroll
            for (int r = 0; r < 16; ++r) { p0[r] = __builtin_amdgcn_exp2f(p0[r]); p1[r] = __builtin_amdgcn_exp2f(p1[r]); sacc += p0[r] + p1[r]; }
            lsum += sacc;
            bf16x8 pa[4];
            { v4u w;
              w.x = pk2(p0[0], p0[1]); w.y = pk2(p0[2], p0[3]); w.z = pk2(p0[4], p0[5]); w.w = pk2(p0[6], p0[7]); pa[0] = __builtin_bit_cast(bf16x8, w);
              w.x = pk2(p0[8], p0[9]); w.y = pk2(p0[10], p0[11]); w.z = pk2(p0[12], p0[13]); w.w = pk2(p0[14], p0[15]); pa[1] = __builtin_bit_cast(bf16x8, w);
              w.x = pk2(p1[0], p1[1]); w.y = pk2(p1[2], p1[3]); w.z = pk2(p1[4], p1[5]); w.w = pk2(p1[6], p1[7]); pa[2] = __builtin_bit_cast(bf16x8, w);
              w.x = pk2(p1[8], p1[9]); w.y = pk2(p1[10], p1[11]); w.z = pk2(p1[12], p1[13]); w.w = pk2(p1[14], p1[15]); pa[3] = __builtin_bit_cast(bf16x8, w); }
#pragma unroll
            for (int k = 0; k < 4; ++k) {
                const s16x4 a0 = vtr(Vs + k * 1024), a1 = vtr(Vs + k * 1024 + 512), c0 = vtr(Vs + 4096 + k * 1024), c1 = vtr(Vs + 4096 + k * 1024 + 512);
                const bf16x8 v0 = (bf16x8){a0[0], a0[1], a0[2], a0[3], a1[0], a1[1], a1[2], a1[3]}, v1 = (bf16x8){c0[0], c0[1], c0[2], c0[3], c1[0], c1[1], c1[2], c1[3]};
                o0 = __builtin_amdgcn_mfma_f32_32x32x16_bf16(pa[k], v0, o0, 0, 0, 0);
                o1 = __builtin_amdgcn_mfma_f32_32x32x16_bf16(pa[k], v1, o1, 0, 0, 0);
            }
        }
        slot = slot == 2 ? 0 : slot + 1;
    }
    lsum = xhalf_sum(lsum);
    if (hi == 0) wsf[32 + r32] = lsum;
    asm volatile("s_waitcnt lgkmcnt(0)" ::: "memory");
#pragma unroll
    for (int r = 0; r < 16; ++r) { const int q = crow(r, hi); const float rl = __builtin_amdgcn_rcpf(wsf[32 + q]); stg[q * 68 + r32] = o0[r] * rl; stg[q * 68 + 32 + r32] = o1[r] * rl; }
    ATT_WAIT_BAR(0);
    if (t == 0) {
        const LAS float* s1 = stg + 4 * OST_W; const float* gn = A.in[11] + l * 64; bf16* MIXp = (bf16*)(F.ws + WS_MIX);
#pragma unroll
        for (int i = 0; i < 4; ++i) { const int row = i * 8 + (lane >> 3), ch = lane & 7;
            const f32x4 a0 = *(const LAS f32x4*)(stg + row * 68 + ch * 8), a1 = *(const LAS f32x4*)(stg + row * 68 + ch * 8 + 4), b0 = *(const LAS f32x4*)(s1 + row * 68 + ch * 8), b1 = *(const LAS f32x4*)(s1 + row * 68 + ch * 8 + 4);
            const f32x4 x0 = a0 - b0 * lam, x1 = a1 - b1 * lam;
            float ss = (x0.x * x0.x + x0.y * x0.y) + (x0.z * x0.z + x0.w * x0.w) + (x1.x * x1.x + x1.y * x1.y) + (x1.z * x1.z + x1.w * x1.w);
            ss += __shfl_xor(ss, 1); ss += __shfl_xor(ss, 2); ss += __shfl_xor(ss, 4);
            const float rstd = __builtin_amdgcn_rsqf(ss * (1.f / 64.f) + EPS) * oscale;
            const f32x4 g0 = *(const f32x4*)(gn + ch * 8), g1 = *(const f32x4*)(gn + ch * 8 + 4);
            v4u w; w.x = pk2(x0.x * rstd * g0.x, x0.y * rstd * g0.y); w.y = pk2(x0.z * rstd * g0.z, x0.w * rstd * g0.w); w.z = pk2(x1.x * rstd * g1.x, x1.y * rstd * g1.y); w.w = pk2(x1.z * rstd * g1.z, x1.w * rstd * g1.w);
            *(v4u*)(MIXp + (rb + row0 + row) * D + h * 64 + ch * 8) = w; }
    }
#undef ATT_DMA
}
}
namespace ssd {
typedef unsigned u32x2 __attribute__((ext_vector_type(2)));
using att::f32x16; using att::s16x4; using att::vtr; using att::crow;
constexpr int XS = 0, BK = 32768, CK = 40960, BW = 49152, HB = 81920, SM = 114688, CW = 122880;
constexpr int SM_VL = 0, SM_US = 256, SM_EO = 512, SM_WS = 768, SM_DT = 1024, SM_DK = 1028, SM_AK = 1032, SM_DB = 1036, SM_GN = 1040;
#define SSD_BAR() asm volatile("s_waitcnt lgkmcnt(0)\n\ts_barrier" ::: "memory")
__device__ __forceinline__ bf16x8 trfrag(const LAS char* p) { const s16x4 a = vtr(p), b = vtr(p + 512); return (bf16x8){a[0], a[1], a[2], a[3], b[0], b[1], b[2], b[3]}; }
__device__ __forceinline__ bf16x8 packfrag(const f32x16& x, int s) { v4u w; w.x = pk2(x[8 * s], x[8 * s + 1]); w.y = pk2(x[8 * s + 2], x[8 * s + 3]); w.z = pk2(x[8 * s + 4], x[8 * s + 5]); w.w = pk2(x[8 * s + 6], x[8 * s + 7]); return __builtin_bit_cast(bf16x8, w); }
#define SSD_LO(q_) ((f32x4){bflo((q_).x), bfhi((q_).x), bflo((q_).y), bfhi((q_).y)})
#define SSD_HI(q_) ((f32x4){bflo((q_).z), bfhi((q_).z), bflo((q_).w), bfhi((q_).w)})

__device__ __forceinline__ void ssd_m1_unit(Frame& F_, const Args& A, int l, int b, int c, int g) {
    Frame F = refresh(F_);
    const int tid = F.tid, lane = tid & 63, wid = F.wave, r32 = lane & 31, hi = lane >> 5, hh = wid >> 1, lh = wid & 1;
    LAS char* L = (LAS char*)F.lds; LAS float* sm = (LAS float*)(L + SM); LAS float* cwl = (LAS float*)(L + CW);
    const bf16* PROJ = (const bf16*)(F.ws + WS_BIG); const float* DTg = (const float*)(F.ws + WS_DT);
    bf16* XC = (bf16*)(F.ws + WS_XC); bf16* YD = (bf16*)(F.ws + WS_YD); bf16* SST = (bf16*)(F.ws + WS_SST);
    const size_t rowb = (size_t)b * SEQ + (size_t)c * 64;
    const int tg = tid / 48, cc = tid - tg * 48;
    const int gcol = PC_XBC + (cc < 32 ? g * 256 + cc * 8 : cc < 40 ? 512 + g * 64 + (cc - 32) * 8 : 640 + g * 64 + (cc - 40) * 8);
    v4u raw[11];
#pragma unroll
    for (int i = 0; i < 11; ++i) { const int trow = c * 64 + 8 * tg - 3 + i; raw[i] = (tid < 384 && trow >= 0) ? *(const v4u*)(PROJ + ((size_t)b * SEQ + trow) * NPROJ + gcol) : (v4u){0u, 0u, 0u, 0u}; }
    f32x4 d4 = (f32x4){0.f, 0.f, 0.f, 0.f};
    if (wid == 7) d4 = *(const f32x4*)(DTg + (rowb + lane) * 8 + g * 4);
    SSD_BAR();
    for (int i = tid; i < 5 * 384; i += 512) { const int w = i / 384, li = i - w * 384; const int ch = li < 256 ? g * 256 + li : li < 320 ? 512 + g * 64 + (li - 256) : 640 + g * 64 + (li - 320);
        cwl[i] = w < 4 ? A.in[12][(size_t)l * 4 * 768 + w * 768 + ch] : A.in[13][l * 768 + ch]; }
    if (tid < 4) { sm[SM_AK + tid] = -__expf(A.in[15][l * 8 + g * 4 + tid]); sm[SM_DB + tid] = A.in[14][l * 8 + g * 4 + tid]; }
    SSD_BAR();
    if (tid < 384) {
        const int dsto = cc < 32 ? XS + (cc >> 3) * 8192 + ((cc & 7) >> 2) * 4096 + ((cc & 3) * 8) * 2 : cc < 40 ? BK + (cc - 32) * 1024 : CK + (cc - 40) * 1024;
        const int dstr = cc < 32 ? 64 : 16;
        const int xcol = cc < 32 ? g * 256 + cc * 8 : 512 + g * 64 + (cc - 40) * 8;
        const f32x4 w0a = *(const LAS f32x4*)(cwl + cc * 8), w0b = *(const LAS f32x4*)(cwl + cc * 8 + 4), w1a = *(const LAS f32x4*)(cwl + 384 + cc * 8), w1b = *(const LAS f32x4*)(cwl + 384 + cc * 8 + 4);
        const f32x4 w2a = *(const LAS f32x4*)(cwl + 768 + cc * 8), w2b = *(const LAS f32x4*)(cwl + 768 + cc * 8 + 4), w3a = *(const LAS f32x4*)(cwl + 1152 + cc * 8), w3b = *(const LAS f32x4*)(cwl + 1152 + cc * 8 + 4);
        const f32x4 cba = *(const LAS f32x4*)(cwl + 1536 + cc * 8), cbb = *(const LAS f32x4*)(cwl + 1536 + cc * 8 + 4);
#pragma unroll
        for (int j = 0; j < 8; ++j) {
            const f32x4 va = cba + SSD_LO(raw[j]) * w0a + SSD_LO(raw[j + 1]) * w1a + SSD_LO(raw[j + 2]) * w2a + SSD_LO(raw[j + 3]) * w3a;
            const f32x4 vb = cbb + SSD_HI(raw[j]) * w0b + SSD_HI(raw[j + 1]) * w1b + SSD_HI(raw[j + 2]) * w2b + SSD_HI(raw[j + 3]) * w3b;
            v4u o; o.x = pk2(silu_f(va.x), silu_f(va.y)); o.y = pk2(silu_f(va.z), silu_f(va.w)); o.z = pk2(silu_f(vb.x), silu_f(vb.y)); o.w = pk2(silu_f(vb.z), silu_f(vb.w));
            *(LAS v4u*)(L + dsto + (8 * tg + j) * dstr) = o;
            if (cc < 32 || cc >= 40) *(v4u*)(XC + (rowb + 8 * tg + j) * 640 + xcol) = o;
        }
    } else if (wid == 7) {
        float dtr[4] = {d4.x, d4.y, d4.z, d4.w}; float tot[4];
#pragma unroll
        for (int k = 0; k < 4; ++k) { const float Ak = sm[SM_AK + k], dbk = sm[SM_DB + k];
            const float xr = dtr[k] + dbk; const float dt = xr > 20.f ? xr : log1pf(__expf(xr));
            float acs = Ak * dt;
#pragma unroll
            for (int o = 1; o < 64; o <<= 1) { const float u = __shfl_up(acs, o); if (lane >= o) acs += u; }
            tot[k] = __shfl(acs, 63);
            sm[SM_VL + k * 64 + lane] = acs * LOG2E; sm[SM_US + k * 64 + lane] = acs * LOG2E - __log2f(dt);
            sm[SM_WS + k * 64 + lane] = __expf(tot[k] - acs) * dt; dtr[k] = __expf(acs); }
        *(f32x4*)((float*)(F.ws + WS_EOFF) + (rowb + lane) * 8 + g * 4) = (f32x4){dtr[0], dtr[1], dtr[2], dtr[3]};
        if (lane == 0) *(f32x4*)((float*)(F.ws + WS_DTOT) + ((size_t)(b * 128 + c)) * 8 + g * 4) = (f32x4){__expf(tot[0]), __expf(tot[1]), __expf(tot[2]), __expf(tot[3])};
    }
    SSD_BAR();
    { const int s = tid >> 3, nc = tid & 7; const v4u b8 = *(const LAS v4u*)(L + BK + nc * 1024 + s * 16);
      const f32x4 ba = SSD_LO(b8), bb = SSD_HI(b8);
#pragma unroll
      for (int k = 0; k < 4; ++k) { const float w = sm[SM_WS + k * 64 + s]; v4u o; o.x = pk2(ba.x * w, ba.y * w); o.y = pk2(ba.z * w, ba.w * w); o.z = pk2(bb.x * w, bb.y * w); o.w = pk2(bb.z * w, bb.w * w);
          *(LAS v4u*)(L + BW + k * 8192 + (nc >> 2) * 4096 + s * 64 + (nc & 3) * 16) = o; } }
    SSD_BAR();
    const int kfo = hi * 1024 + r32 * 16;
    const int vfo = ((lane >> 4) & 1) * 32 + (lane & 3) * 8 + (4 * hi + ((lane & 15) >> 2)) * 64;
    f32x16 y0, y1, h0, h1;
#pragma unroll
    for (int r = 0; r < 16; ++r) { y0[r] = 0.f; y1[r] = 0.f; h0[r] = 0.f; h1[r] = 0.f; }
    {
        bf16x8 cf[4];
#pragma unroll
        for (int ks = 0; ks < 4; ++ks) cf[ks] = *(const LAS bf16x8*)(L + CK + kfo + ks * 2048 + lh * 512);
        const float vl = sm[SM_VL + hh * 64 + 32 * lh + r32];
#pragma unroll
        for (int sb = 0; sb < 2; ++sb) {
            if (sb <= lh) {
                f32x16 T;
#pragma unroll
                for (int r = 0; r < 16; ++r) T[r] = 0.f;
#pragma unroll
                for (int ks = 0; ks < 4; ++ks) { const bf16x8 bfr = *(const LAS bf16x8*)(L + BK + kfo + ks * 2048 + sb * 512); T = __builtin_amdgcn_mfma_f32_32x32x16_bf16(bfr, cf[ks], T, 0, 0, 0); }
#pragma unroll
                for (int r = 0; r < 16; ++r) { const float us = sm[SM_US + hh * 64 + 32 * sb + crow(r, hi)]; float w = T[r] * __builtin_amdgcn_exp2f(vl - us);
                    if (sb == lh && crow(r, hi) > r32) w = 0.f; T[r] = w; }
                const bf16x8 pa0 = packfrag(T, 0), pa1 = packfrag(T, 1);
                const LAS char* xb = L + XS + hh * 8192 + vfo + sb * 2048;
                const bf16x8 x00 = trfrag(xb), x01 = trfrag(xb + 4096), x10 = trfrag(xb + 1024), x11 = trfrag(xb + 4096 + 1024);
                y0 = __builtin_amdgcn_mfma_f32_32x32x16_bf16(pa0, x00, y0, 0, 0, 0); y1 = __builtin_amdgcn_mfma_f32_32x32x16_bf16(pa0, x01, y1, 0, 0, 0);
                y0 = __builtin_amdgcn_mfma_f32_32x32x16_bf16(pa1, x10, y0, 0, 0, 0); y1 = __builtin_amdgcn_mfma_f32_32x32x16_bf16(pa1, x11, y1, 0, 0, 0);
            }
        }
#pragma unroll
        for (int ks = 0; ks < 4; ++ks) { const bf16x8 xa = trfrag(L + XS + hh * 8192 + lh * 4096 + vfo + ks * 1024), b0 = trfrag(L + BW + hh * 8192 + vfo + ks * 1024), b1 = trfrag(L + BW + hh * 8192 + 4096 + vfo + ks * 1024);
            h0 = __builtin_amdgcn_mfma_f32_32x32x16_bf16(xa, b0, h0, 0, 0, 0); h1 = __builtin_amdgcn_mfma_f32_32x32x16_bf16(xa, b1, h1, 0, 0, 0); }
    }
    { bf16* img = SST + ((size_t)((b * 128 + c) * 8 + g * 4 + hh)) * 4096;
#pragma unroll
      for (int r = 0; r < 16; ++r) { const int p = 32 * lh + crow(r, hi);
          img[(r32 >> 3) * 512 + p * 8 + (r32 & 7)] = (bf16)f2bf(h0[r]); img[(4 + (r32 >> 3)) * 512 + p * 8 + (r32 & 7)] = (bf16)f2bf(h1[r]); } }
    SSD_BAR();
#pragma unroll
    for (int r = 0; r < 16; ++r) { const int lrow = 32 * lh + crow(r, hi);
        *(LAS unsigned short*)(L + BW + (lrow * 256 + hh * 64 + r32) * 2) = (unsigned short)f2bf(y0[r]);
        *(LAS unsigned short*)(L + BW + (lrow * 256 + hh * 64 + 32 + r32) * 2) = (unsigned short)f2bf(y1[r]); }
    SSD_BAR();
#pragma unroll
    for (int k = 0; k < 4; ++k) { const int tk = wid * 8 + 2 * k + (lane >> 5), chn = (lane & 31) * 8;
        *(v4u*)(YD + (rowb + tk) * 512 + g * 256 + chn) = *(const LAS v4u*)(L + BW + (tk * 256 + chn) * 2); }
}

__device__ __forceinline__ void ssd_m3_unit(Frame& F_, const Args& A, int l, int b, int c, int g) {
    Frame F = refresh(F_);
    const int tid = F.tid, lane = tid & 63, wid = F.wave, r32 = lane & 31, hi = lane >> 5, hh = wid >> 1, lh = wid & 1;
    LAS char* L = (LAS char*)F.lds; LAS float* sm = (LAS float*)(L + SM);
    const bf16* PROJ = (const bf16*)(F.ws + WS_BIG); const bf16* XC = (const bf16*)(F.ws + WS_XC); const bf16* YD = (const bf16*)(F.ws + WS_YD); const bf16* SST = (const bf16*)(F.ws + WS_SST);
    bf16* MIXp = (bf16*)(F.ws + WS_MIX);
    const size_t rowb = (size_t)b * SEQ + (size_t)c * 64;
    const v4u c8 = *(const v4u*)(XC + (rowb + (tid >> 3)) * 640 + 512 + g * 64 + (tid & 7) * 8);
    v4u hp[4];
    { const v4u* src = (const v4u*)(SST + ((size_t)((b * 128 + c) * 8 + g * 4)) * 4096);
#pragma unroll
      for (int i = 0; i < 4; ++i) hp[i] = src[tid + 512 * i]; }
    float eo = 0.f; if (tid < 256) eo = ((const float*)(F.ws + WS_EOFF))[(rowb + (tid & 63)) * 8 + g * 4 + (tid >> 6)];
    SSD_BAR();
    *(LAS v4u*)(L + CK + (tid & 7) * 1024 + (tid >> 3) * 16) = c8;
#pragma unroll
    for (int i = 0; i < 4; ++i) *(LAS v4u*)(L + HB + (tid + 512 * i) * 16) = hp[i];
    if (tid < 256) { sm[SM_EO + tid] = eo; sm[SM_GN + tid] = A.in[17][l * 512 + g * 256 + tid]; }
    if (tid < 4) sm[SM_DK + tid] = A.in[16][l * 8 + g * 4 + tid];
    SSD_BAR();
    const int kfo = hi * 1024 + r32 * 16;
    f32x16 y0, y1;
#pragma unroll
    for (int r = 0; r < 16; ++r) { y0[r] = 0.f; y1[r] = 0.f; }
#pragma unroll
    for (int ks = 0; ks < 4; ++ks) { const bf16x8 cf = *(const LAS bf16x8*)(L + CK + kfo + ks * 2048 + lh * 512);
        const bf16x8 h0 = *(const LAS bf16x8*)(L + HB + hh * 8192 + kfo + ks * 2048), h1 = *(const LAS bf16x8*)(L + HB + hh * 8192 + kfo + ks * 2048 + 512);
        y0 = __builtin_amdgcn_mfma_f32_32x32x16_bf16(cf, h0, y0, 0, 0, 0); y1 = __builtin_amdgcn_mfma_f32_32x32x16_bf16(cf, h1, y1, 0, 0, 0); }
#pragma unroll
    for (int r = 0; r < 16; ++r) { const int lrow = 32 * lh + crow(r, hi); const float e = sm[SM_EO + hh * 64 + lrow];
        *(LAS unsigned short*)(L + BW + (lrow * 256 + hh * 64 + r32) * 2) = (unsigned short)f2bf(y0[r] * e);
        *(LAS unsigned short*)(L + BW + (lrow * 256 + hh * 64 + 32 + r32) * 2) = (unsigned short)f2bf(y1[r] * e); }
    SSD_BAR();
    const float Dk = sm[SM_DK + (lane >> 4)]; const f32x4 gn4 = *(const LAS f32x4*)(sm + SM_GN + 4 * lane);
    u32x2 zr[8], xr[8], yr[8];
#pragma unroll
    for (int k = 0; k < 8; ++k) { const size_t row = rowb + wid * 8 + k; zr[k] = *(const u32x2*)(PROJ + row * NPROJ + PC_Z + g * 256 + 4 * lane); xr[k] = *(const u32x2*)(XC + row * 640 + g * 256 + 4 * lane); yr[k] = *(const u32x2*)(YD + row * 512 + g * 256 + 4 * lane); }
#pragma unroll
    for (int k = 0; k < 8; ++k) { const int tk = wid * 8 + k;
        const u32x2 yo = *(const LAS u32x2*)(L + BW + (tk * 256 + 4 * lane) * 2);
        f32x4 v; v.x = (bflo(yo.x) + bflo(yr[k].x) + Dk * bflo(xr[k].x)) * silu_f(bflo(zr[k].x)); v.y = (bfhi(yo.x) + bfhi(yr[k].x) + Dk * bfhi(xr[k].x)) * silu_f(bfhi(zr[k].x));
        v.z = (bflo(yo.y) + bflo(yr[k].y) + Dk * bflo(xr[k].y)) * silu_f(bflo(zr[k].y)); v.w = (bfhi(yo.y) + bfhi(yr[k].y) + Dk * bfhi(xr[k].y)) * silu_f(bfhi(zr[k].y));
        const float rstd = __builtin_amdgcn_rsqf(wave_sum((v.x * v.x + v.y * v.y) + (v.z * v.z + v.w * v.w)) * (1.f / 256.f) + EPS);
        u32x2 o; o.x = pk2(v.x * rstd * gn4.x, v.y * rstd * gn4.y); o.y = pk2(v.z * rstd * gn4.z, v.w * rstd * gn4.w);
        *(u32x2*)(MIXp + (rowb + tk) * D + 256 + g * 256 + 4 * lane) = o; }
}

__device__ __forceinline__ void scan_unit(Frame& F_, int kind, int u) {
    Frame F = refresh(F_);
    const int e = u * 1024 + F.tid * 2, nh = kind == 0 ? 8 : 4;
    const int idx = e & 4095, head = (e >> 12) & (nh - 1), b = e >> (kind == 0 ? 15 : 14);
    unsigned* base = (unsigned*)((bf16*)(F.ws + (kind == 0 ? WS_SST : WS_RST)) + ((size_t)(b * 128) * nh + head) * 4096 + idx);
    const size_t cstride = (size_t)nh * 4096 / 2;
    const float* dtot = (const float*)(F.ws + WS_DTOT) + (size_t)(b * 128) * 8 + head;
    const float gdec = exp2f(64.f * log2f(1.0f - exp2f(-5.0f - (float)head)));
    float h0 = 0.f, h1 = 0.f;
    for (int c0 = 0; c0 < 128; c0 += 16) {
        unsigned v[16]; float d[16];
#pragma unroll
        for (int i = 0; i < 16; ++i) { v[i] = base[(size_t)(c0 + i) * cstride]; d[i] = kind == 0 ? dtot[(size_t)(c0 + i) * 8] : gdec; }
#pragma unroll
        for (int i = 0; i < 16; ++i) { base[(size_t)(c0 + i) * cstride] = pk2(h0, h1); h0 = d[i] * h0 + bflo(v[i]); h1 = d[i] * h1 + bfhi(v[i]); }
    }
}
#undef SSD_LO
#undef SSD_HI
}
namespace ret {
using att::f32x16; using att::crow; using ssd::trfrag; using ssd::packfrag; using ssd::u32x2;
constexpr int QK = 0, KK = 8192, KW = 16384, VV = 24576, SB = 32768, OS = 40960, TB = 58368;
#define RET_BAR() asm volatile("s_waitcnt lgkmcnt(0)\n\ts_barrier" ::: "memory")
__device__ __forceinline__ f32x4 lo4(const v4u q_) { return (f32x4){bflo(q_.x), bfhi(q_.x), bflo(q_.y), bfhi(q_.y)}; }
__device__ __forceinline__ f32x4 hi4(const v4u q_) { return (f32x4){bflo(q_.z), bfhi(q_.z), bflo(q_.w), bfhi(q_.w)}; }
__device__ __forceinline__ v4u pack8(const f32x4 a, const f32x4 b) { v4u o; o.x = pk2(a.x, a.y); o.y = pk2(a.z, a.w); o.z = pk2(b.x, b.y); o.w = pk2(b.z, b.w); return o; }

__device__ __forceinline__ void ret_m1_unit(Frame& F_, const Args& A, int l, int b, int c, int h) {
    Frame F = refresh(F_);
    const int tid = F.tid, lane = tid & 63, wid = F.wave, r32 = lane & 31, hi = lane >> 5;
    LAS char* L = (LAS char*)F.lds; LAS float* tb = (LAS float*)(L + TB); LAS float* os = (LAS float*)(L + OS);
    const bf16* PROJ = (const bf16*)(F.ws + WS_BIG);
    const float gam = 1.0f - exp2f(-5.0f - (float)h), lg2 = log2f(gam);
    const int tok = tid >> 3, seg = tid & 7;
    const size_t rowb = (size_t)b * SEQ + (size_t)c * 64;
    v4u ld[4];
    { const bf16* rp = PROJ + (rowb + tok) * NPROJ;
      if (seg < 4) { ld[0] = *(const v4u*)(rp + PC_RQ + h * 64 + seg * 8); ld[1] = *(const v4u*)(rp + PC_RQ + h * 64 + 32 + seg * 8); ld[2] = *(const v4u*)(rp + PC_RK + h * 64 + seg * 8); ld[3] = *(const v4u*)(rp + PC_RK + h * 64 + 32 + seg * 8); }
      else { ld[0] = *(const v4u*)(rp + PC_RV + h * 64 + (seg - 4) * 16); ld[1] = *(const v4u*)(rp + PC_RV + h * 64 + (seg - 4) * 16 + 8); ld[2] = ld[0]; ld[3] = ld[0]; } }
    RET_BAR();
    if (tid < 128) tb[tid] = exp2f(lg2 * (float)(tid < 63 ? 63 - tid : tid - 63));
    if (seg < 4) {
        const f32x4 qla = lo4(ld[0]), qlb = hi4(ld[0]), qha = lo4(ld[1]), qhb = hi4(ld[1]), kla = lo4(ld[2]), klb = hi4(ld[2]), kha = lo4(ld[3]), khb = hi4(ld[3]);
        float ql[8] = {qla.x, qla.y, qla.z, qla.w, qlb.x, qlb.y, qlb.z, qlb.w}, qh[8] = {qha.x, qha.y, qha.z, qha.w, qhb.x, qhb.y, qhb.z, qhb.w};
        float kl[8] = {kla.x, kla.y, kla.z, kla.w, klb.x, klb.y, klb.z, klb.w}, kh[8] = {kha.x, kha.y, kha.z, kha.w, khb.x, khb.y, khb.z, khb.w};
        float q1[8], q2[8], k1[8], k2[8];
        const float pos = (float)(c * 64 + tok);
#pragma unroll
        for (int i = 0; i < 8; ++i) { const int fi = seg * 8 + i; const float invf = exp2f(-(float)fi * (13.287712379549449f / 32.0f)); const float ang = pos * invf;
            double rev = (double)ang * 0.15915494309189535; rev -= __builtin_rint(rev); const float fr = (float)rev;
            const float sn = __builtin_amdgcn_sinf(fr), cs = __builtin_amdgcn_cosf(fr);
            q1[i] = ql[i] * cs - qh[i] * sn; q2[i] = ql[i] * sn + qh[i] * cs; k1[i] = kl[i] * cs - kh[i] * sn; k2[i] = kl[i] * sn + kh[i] * cs; }
        const float kd = exp2f(lg2 * (float)(63 - tok));
        const v4u qa = pack8((f32x4){q1[0], q1[1], q1[2], q1[3]}, (f32x4){q1[4], q1[5], q1[6], q1[7]}), qb = pack8((f32x4){q2[0], q2[1], q2[2], q2[3]}, (f32x4){q2[4], q2[5], q2[6], q2[7]});
        *(LAS v4u*)(L + QK + seg * 1024 + tok * 16) = qa; *(LAS v4u*)(L + QK + (seg + 4) * 1024 + tok * 16) = qb;
        { char* qimg = (char*)(F.ws + WS_QR) + ((size_t)((b * 128 + c) * 4 + h)) * 8192; *(v4u*)(qimg + seg * 1024 + tok * 16) = qa; *(v4u*)(qimg + (seg + 4) * 1024 + tok * 16) = qb; }
        *(LAS v4u*)(L + KK + seg * 1024 + tok * 16) = pack8((f32x4){k1[0], k1[1], k1[2], k1[3]}, (f32x4){k1[4], k1[5], k1[6], k1[7]});
        *(LAS v4u*)(L + KK + (seg + 4) * 1024 + tok * 16) = pack8((f32x4){k2[0], k2[1], k2[2], k2[3]}, (f32x4){k2[4], k2[5], k2[6], k2[7]});
        *(LAS v4u*)(L + KW + tok * 64 + seg * 16) = pack8((f32x4){k1[0], k1[1], k1[2], k1[3]} * kd, (f32x4){k1[4], k1[5], k1[6], k1[7]} * kd);
        *(LAS v4u*)(L + KW + 4096 + tok * 64 + seg * 16) = pack8((f32x4){k2[0], k2[1], k2[2], k2[3]} * kd, (f32x4){k2[4], k2[5], k2[6], k2[7]} * kd);
    } else {
        const int s4 = seg - 4;
        *(LAS v4u*)(L + VV + (s4 >> 1) * 4096 + tok * 64 + (s4 & 1) * 32) = ld[0];
        *(LAS v4u*)(L + VV + (s4 >> 1) * 4096 + tok * 64 + (s4 & 1) * 32 + 16) = ld[1];
    }
    RET_BAR();
    const int kfo = hi * 1024 + r32 * 16;
    const int vfo = ((lane >> 4) & 1) * 32 + (lane & 3) * 8 + (4 * hi + ((lane & 15) >> 2)) * 64;
    const int lb = wid & 1, eb = (wid >> 1) & 1;
    if (wid < 4) {
        bf16x8 qf[4];
#pragma unroll
        for (int ks = 0; ks < 4; ++ks) qf[ks] = *(const LAS bf16x8*)(L + QK + kfo + ks * 2048 + lb * 512);
        f32x16 o;
#pragma unroll
        for (int r = 0; r < 16; ++r) o[r] = 0.f;
        const LAS float* rt = tb + (63 + 4 * hi - 32 * lb - r32);
#pragma unroll
        for (int sb = 0; sb < 2; ++sb) {
            f32x16 T;
#pragma unroll
            for (int r = 0; r < 16; ++r) T[r] = 0.f;
#pragma unroll
            for (int ks = 0; ks < 4; ++ks) { const bf16x8 kf = *(const LAS bf16x8*)(L + KK + kfo + ks * 2048 + sb * 512); T = __builtin_amdgcn_mfma_f32_32x32x16_bf16(kf, qf[ks], T, 0, 0, 0); }
#pragma unroll
            for (int r = 0; r < 16; ++r) T[r] *= rt[32 * sb + (r & 3) + 8 * (r >> 2)];
            const bf16x8 pa0 = packfrag(T, 0), pa1 = packfrag(T, 1);
            const LAS char* vb = L + VV + eb * 4096 + vfo + sb * 2048;
            const bf16x8 v0 = trfrag(vb), v1 = trfrag(vb + 1024);
            o = __builtin_amdgcn_mfma_f32_32x32x16_bf16(pa0, v0, o, 0, 0, 0); o = __builtin_amdgcn_mfma_f32_32x32x16_bf16(pa1, v1, o, 0, 0, 0);
        }
#pragma unroll
        for (int r = 0; r < 16; ++r) os[(32 * lb + crow(r, hi)) * 68 + 32 * eb + r32] = o[r];
    } else {
        f32x16 S;
#pragma unroll
        for (int r = 0; r < 16; ++r) S[r] = 0.f;
#pragma unroll
        for (int ks = 0; ks < 4; ++ks) { const bf16x8 ka = trfrag(L + KW + lb * 4096 + vfo + ks * 1024), vbf = trfrag(L + VV + eb * 4096 + vfo + ks * 1024);
            S = __builtin_amdgcn_mfma_f32_32x32x16_bf16(ka, vbf, S, 0, 0, 0); }
        char* simg = (char*)(F.ws + WS_RST) + ((size_t)((b * 128 + c) * 4 + h)) * 8192;
#pragma unroll
        for (int gq = 0; gq < 4; ++gq) { u32x2 w; w.x = pk2(S[4 * gq], S[4 * gq + 1]); w.y = pk2(S[4 * gq + 2], S[4 * gq + 3]);
            *(u32x2*)(simg + (4 * lb + gq) * 1024 + (32 * eb + r32) * 16 + hi * 8) = w; }
    }
    RET_BAR();
    { const int row = wid * 8 + (lane >> 3), ch = lane & 7;
      const f32x4 a0 = *(const LAS f32x4*)(os + row * 68 + ch * 8), a1 = *(const LAS f32x4*)(os + row * 68 + ch * 8 + 4);
      *(v4u*)((bf16*)(F.ws + WS_OI) + (rowb + row) * 256 + h * 64 + ch * 8) = pack8(a0, a1); }
}

__device__ __forceinline__ void ret_m3_unit(Frame& F_, const Args& A, int l, int b, int c, int h) {
    Frame F = refresh(F_);
    const int tid = F.tid, lane = tid & 63, wid = F.wave, r32 = lane & 31, hi = lane >> 5;
    LAS char* L = (LAS char*)F.lds; LAS float* os = (LAS float*)(L + OS);
    const bf16* PROJ = (const bf16*)(F.ws + WS_BIG); bf16* MIXp = (bf16*)(F.ws + WS_MIX);
    const float lg2 = log2f(1.0f - exp2f(-5.0f - (float)h));
    const size_t rowb = (size_t)b * SEQ + (size_t)c * 64;
    const size_t ioff = ((size_t)((b * 128 + c) * 4 + h)) * 8192;
    const v4u q16 = *(const v4u*)((const char*)(F.ws + WS_QR) + ioff + tid * 16);
#if defined(RTEST) && RTEST == 3
    v4u s16; { const unsigned long long* sp = (const unsigned long long*)((const char*)(F.ws + WS_RST) + ioff + tid * 16);
        const unsigned long long a = __hip_atomic_load(sp, __ATOMIC_RELAXED, __HIP_MEMORY_SCOPE_AGENT), b2 = __hip_atomic_load(sp + 1, __ATOMIC_RELAXED, __HIP_MEMORY_SCOPE_AGENT);
        s16.x = (unsigned)a; s16.y = (unsigned)(a >> 32); s16.z = (unsigned)b2; s16.w = (unsigned)(b2 >> 32); }
#else
    const v4u s16 = *(const v4u*)((const char*)(F.ws + WS_RST) + ioff + tid * 16);
#endif
    const size_t erow = rowb + wid * 8 + (lane >> 3); const int ch = lane & 7;
    const v4u gt = *(const v4u*)(PROJ + erow * NPROJ + PC_RG + h * 64 + ch * 8);
    const v4u oi = *(const v4u*)((const bf16*)(F.ws + WS_OI) + erow * 256 + h * 64 + ch * 8);
    RET_BAR();
#if defined(RTEST) && RTEST == 5
    { v4u qq; qq.x = 0x3f803f80u; qq.y = 0x3f803f80u; qq.z = 0x3f803f80u; qq.w = 0x3f803f80u; (void)q16; *(LAS v4u*)(L + QK + tid * 16) = qq; *(LAS v4u*)(L + SB + tid * 16) = s16; }
#elif defined(RTEST) && RTEST == 6
    { v4u qq; qq.x = 0x3f803f80u; qq.y = 0x3f803f80u; qq.z = 0x3f803f80u; qq.w = 0x3f803f80u; (void)s16; *(LAS v4u*)(L + QK + tid * 16) = q16; *(LAS v4u*)(L + SB + tid * 16) = qq; }
#else
    *(LAS v4u*)(L + QK + tid * 16) = q16; *(LAS v4u*)(L + SB + tid * 16) = s16;
#endif
    RET_BAR();
    if (wid < 4) {
        const int kfo = hi * 1024 + r32 * 16, lb = wid & 1, eb = wid >> 1;
        f32x16 o;
#pragma unroll
        for (int r = 0; r < 16; ++r) o[r] = 0.f;
#pragma unroll
        for (int ks = 0; ks < 4; ++ks) { const bf16x8 qf = *(const LAS bf16x8*)(L + QK + kfo + ks * 2048 + lb * 512), sf = *(const LAS bf16x8*)(L + SB + kfo + ks * 2048 + eb * 512);
            o = __builtin_amdgcn_mfma_f32_32x32x16_bf16(qf, sf, o, 0, 0, 0); }
#pragma unroll
        for (int r = 0; r < 16; ++r) { const int lrow = 32 * lb + crow(r, hi); os[lrow * 68 + 32 * eb + r32] = o[r] * exp2f(lg2 * (float)(lrow + 1)); }
    }
    RET_BAR();
    { const int row = wid * 8 + (lane >> 3);
      f32x4 a0 = *(const LAS f32x4*)(os + row * 68 + ch * 8), a1 = *(const LAS f32x4*)(os + row * 68 + ch * 8 + 4);
#if defined(RTEST) && RTEST == 1
      a0 = lo4(oi); a1 = hi4(oi);
#elif defined(RTEST) && RTEST == 2
      (void)oi;
#else
      a0 += lo4(oi); a1 += hi4(oi);
#endif
      float ss = (a0.x * a0.x + a0.y * a0.y) + (a0.z * a0.z + a0.w * a0.w) + (a1.x * a1.x + a1.y * a1.y) + (a1.z * a1.z + a1.w * a1.w);
      ss += __shfl_xor(ss, 1); ss += __shfl_xor(ss, 2); ss += __shfl_xor(ss, 4);
      const float rstd = __builtin_amdgcn_rsqf(ss * (1.f / 64.f) + EPS);
      const f32x4 g0 = *(const f32x4*)(A.in[18] + l * 64 + ch * 8), g1 = *(const f32x4*)(A.in[18] + l * 64 + ch * 8 + 4);
      const f32x4 z0 = lo4(gt), z1 = hi4(gt);
      v4u w; w.x = pk2(silu_f(z0.x) * a0.x * rstd * g0.x, silu_f(z0.y) * a0.y * rstd * g0.y); w.y = pk2(silu_f(z0.z) * a0.z * rstd * g0.z, silu_f(z0.w) * a0.w * rstd * g0.w);
      w.z = pk2(silu_f(z1.x) * a1.x * rstd * g1.x, silu_f(z1.y) * a1.y * rstd * g1.y); w.w = pk2(silu_f(z1.z) * a1.z * rstd * g1.z, silu_f(z1.w) * a1.w * rstd * g1.w);
      *(v4u*)(MIXp + erow * D + 768 + h * 64 + ch * 8) = w; }
}
}
namespace ssds {
using ssd::u32x2;
using att::f32x16; using att::s16x4; using att::vtr; using att::crow;
constexpr int XS = 0, BK = 32768, CK = 40960, BW = 49152, HB = 81920, SM = 114688, CW = 122880;
constexpr int SM_VL = 0, SM_US = 256, SM_EO = 512, SM_WS = 768, SM_DT = 1024, SM_DK = 1028, SM_AK = 1032, SM_DB = 1036, SM_GN = 1040;
#undef SSD_BAR
#define SSD_BAR() asm volatile("s_waitcnt lgkmcnt(0)\n\ts_barrier" ::: "memory")
using ssd::trfrag;
using ssd::packfrag;

__device__ __forceinline__ void ssd_unit(Frame& F_, const Args& A, int l, int b, int g) {
    Frame F = refresh(F_);
    const int tid = F.tid, lane = tid & 63, wid = F.wave, r32 = lane & 31, hi = lane >> 5, hh = wid >> 1, lh = wid & 1;
    LAS char* L = (LAS char*)F.lds; LAS float* sm = (LAS float*)(L + SM); LAS float* cwl = (LAS float*)(L + CW);
    const bf16* PROJ = (const bf16*)(F.ws + WS_BIG); const float* DTg = (const float*)(F.ws + WS_DT); bf16* MIXp = (bf16*)(F.ws + WS_MIX);
    SSD_BAR();
    for (int i = tid; i < 5 * 384; i += 512) { const int w = i / 384, li = i - w * 384; const int ch = li < 256 ? g * 256 + li : li < 320 ? 512 + g * 64 + (li - 256) : 640 + g * 64 + (li - 320);
        cwl[i] = w < 4 ? A.in[12][(size_t)l * 4 * 768 + w * 768 + ch] : A.in[13][l * 768 + ch]; }
    for (int i = tid; i < 32768 / 16; i += 512) *(LAS v4u*)(L + HB + i * 16) = (v4u){0u, 0u, 0u, 0u};
    if (tid < 256) sm[SM_GN + tid] = A.in[17][l * 512 + g * 256 + tid];
    if (tid < 4) { sm[SM_DK + tid] = A.in[16][l * 8 + g * 4 + tid]; sm[SM_AK + tid] = -__expf(A.in[15][l * 8 + g * 4 + tid]); sm[SM_DB + tid] = A.in[14][l * 8 + g * 4 + tid]; }
    const int tg = tid / 48, cc = tid - tg * 48;
    const int gcol = PC_XBC + (cc < 32 ? g * 256 + cc * 8 : cc < 40 ? 512 + g * 64 + (cc - 32) * 8 : 640 + g * 64 + (cc - 40) * 8);
    const int dsto = cc < 32 ? XS + (cc >> 3) * 8192 + ((cc & 7) >> 2) * 4096 + ((cc & 3) * 8) * 2 : cc < 40 ? BK + (cc - 32) * 1024 : CK + (cc - 40) * 1024;
    const int dstr = cc < 32 ? 64 : 16;
    const size_t rb = (size_t)b * SEQ;
    v4u raw[11];
#define SSD_LOADRAW(c) do { _Pragma("unroll") for (int i = 0; i < 11; ++i) { const int trow = (c) * 64 + 8 * tg - 3 + i; \
        raw[i] = (tid < 384 && trow >= 0) ? *(const v4u*)(PROJ + (rb + trow) * NPROJ + gcol) : (v4u){0u, 0u, 0u, 0u}; } } while (0)
    SSD_LOADRAW(0);
    float dtr[4]; u32x2 zr[8];
#define SSD_LOADDT(c) do { if (wid == 7) { const f32x4 d4 = *(const f32x4*)(DTg + (rb + (c) * 64 + lane) * 8 + g * 4); dtr[0] = d4.x; dtr[1] = d4.y; dtr[2] = d4.z; dtr[3] = d4.w; } } while (0)
#define SSD_LOADZ(c) do { _Pragma("unroll") for (int k = 0; k < 8; ++k) zr[k] = *(const u32x2*)(PROJ + (rb + (c) * 64 + wid * 8 + k) * NPROJ + PC_Z + g * 256 + 4 * lane); } while (0)
    SSD_LOADDT(0);
    f32x16 hacc0, hacc1;
#pragma unroll
    for (int r = 0; r < 16; ++r) { hacc0[r] = 0.f; hacc1[r] = 0.f; }
    const int kfo0 = hi * 1024 + r32 * 16;
    const int vfo0 = ((lane >> 4) & 1) * 32 + (lane & 3) * 8 + (4 * hi + ((lane & 15) >> 2)) * 64;
    SSD_BAR();
    for (int c = 0; c < SEQ / 64; ++c) {
        const size_t rowb = rb + (size_t)c * 64;
        int kfo = kfo0, vfo = vfo0; asm volatile("" : "+v"(kfo), "+v"(vfo));
        if (tid < 384) {
            f32x4 w0a = *(const LAS f32x4*)(cwl + cc * 8), w0b = *(const LAS f32x4*)(cwl + cc * 8 + 4), w1a = *(const LAS f32x4*)(cwl + 384 + cc * 8), w1b = *(const LAS f32x4*)(cwl + 384 + cc * 8 + 4);
            f32x4 w2a = *(const LAS f32x4*)(cwl + 768 + cc * 8), w2b = *(const LAS f32x4*)(cwl + 768 + cc * 8 + 4), w3a = *(const LAS f32x4*)(cwl + 1152 + cc * 8), w3b = *(const LAS f32x4*)(cwl + 1152 + cc * 8 + 4);
            const f32x4 cba = *(const LAS f32x4*)(cwl + 1536 + cc * 8), cbb = *(const LAS f32x4*)(cwl + 1536 + cc * 8 + 4);
#define SSD_LO(q_) ((f32x4){bflo((q_).x), bfhi((q_).x), bflo((q_).y), bfhi((q_).y)})
#define SSD_HI(q_) ((f32x4){bflo((q_).z), bfhi((q_).z), bflo((q_).w), bfhi((q_).w)})
#pragma unroll
            for (int j = 0; j < 8; ++j) {
                f32x4 va = cba + SSD_LO(raw[j]) * w0a + SSD_LO(raw[j + 1]) * w1a + SSD_LO(raw[j + 2]) * w2a + SSD_LO(raw[j + 3]) * w3a;
                f32x4 vb = cbb + SSD_HI(raw[j]) * w0b + SSD_HI(raw[j + 1]) * w1b + SSD_HI(raw[j + 2]) * w2b + SSD_HI(raw[j + 3]) * w3b;
                v4u o; o.x = pk2(silu_f(va.x), silu_f(va.y)); o.y = pk2(silu_f(va.z), silu_f(va.w)); o.z = pk2(silu_f(vb.x), silu_f(vb.y)); o.w = pk2(silu_f(vb.z), silu_f(vb.w));
                *(LAS v4u*)(L + dsto + (8 * tg + j) * dstr) = o;
            }
        } else if (wid == 7) {
            float tot[4];
#pragma unroll
            for (int k = 0; k < 4; ++k) { const float Ak = sm[SM_AK + k], dbk = sm[SM_DB + k];
                const float xr = dtr[k] + dbk; const float dt = xr > 20.f ? xr : log1pf(__expf(xr));
                float acs = Ak * dt;
#pragma unroll
                for (int o = 1; o < 64; o <<= 1) { const float u = __shfl_up(acs, o); if (lane >= o) acs += u; }
                tot[k] = __shfl(acs, 63);
                sm[SM_VL + k * 64 + lane] = acs * LOG2E; sm[SM_US + k * 64 + lane] = acs * LOG2E - __log2f(dt);
                sm[SM_EO + k * 64 + lane] = __expf(acs); sm[SM_WS + k * 64 + lane] = __expf(tot[k] - acs) * dt; }
            if (lane == 0) { sm[SM_DT + 0] = __expf(tot[0]); sm[SM_DT + 1] = __expf(tot[1]); sm[SM_DT + 2] = __expf(tot[2]); sm[SM_DT + 3] = __expf(tot[3]); }
        }
        if (c + 1 < SEQ / 64) { SSD_LOADRAW(c + 1); SSD_LOADDT(c + 1); }
        SSD_BAR();
        { const int s = tid >> 3, nc = tid & 7; const v4u b8 = *(const LAS v4u*)(L + BK + nc * 1024 + s * 16);
          const f32x4 ba = SSD_LO(b8), bb = SSD_HI(b8);
#pragma unroll
          for (int k = 0; k < 4; ++k) { const float w = sm[SM_WS + k * 64 + s]; v4u o; o.x = pk2(ba.x * w, ba.y * w); o.y = pk2(ba.z * w, ba.w * w); o.z = pk2(bb.x * w, bb.y * w); o.w = pk2(bb.z * w, bb.w * w);
              *(LAS v4u*)(L + BW + k * 8192 + (nc >> 2) * 4096 + s * 64 + (nc & 3) * 16) = o; } }
        SSD_BAR();
        SSD_LOADZ(c);
        f32x16 y0, y1;
        {
            bf16x8 cf[4];
#pragma unroll
            for (int ks = 0; ks < 4; ++ks) cf[ks] = *(const LAS bf16x8*)(L + CK + kfo + ks * 2048 + lh * 512);
#pragma unroll
            for (int r = 0; r < 16; ++r) { y0[r] = 0.f; y1[r] = 0.f; }
#pragma unroll
            for (int ks = 0; ks < 4; ++ks) { const bf16x8 h0 = *(const LAS bf16x8*)(L + HB + hh * 8192 + kfo + ks * 2048), h1 = *(const LAS bf16x8*)(L + HB + hh * 8192 + kfo + ks * 2048 + 512);
                y0 = __builtin_amdgcn_mfma_f32_32x32x16_bf16(cf[ks], h0, y0, 0, 0, 0); y1 = __builtin_amdgcn_mfma_f32_32x32x16_bf16(cf[ks], h1, y1, 0, 0, 0); }
#pragma unroll
            for (int r = 0; r < 16; ++r) { const float e = sm[SM_EO + hh * 64 + 32 * lh + crow(r, hi)]; y0[r] *= e; y1[r] *= e; }
            const float vl = sm[SM_VL + hh * 64 + 32 * lh + r32];
#pragma unroll
            for (int sb = 0; sb < 2; ++sb) {
                if (sb <= lh) {
                    f32x16 T;
#pragma unroll
                    for (int r = 0; r < 16; ++r) T[r] = 0.f;
#pragma unroll
                    for (int ks = 0; ks < 4; ++ks) { const bf16x8 bfr = *(const LAS bf16x8*)(L + BK + kfo + ks * 2048 + sb * 512); T = __builtin_amdgcn_mfma_f32_32x32x16_bf16(bfr, cf[ks], T, 0, 0, 0); }
#pragma unroll
                    for (int r = 0; r < 16; ++r) { const float us = sm[SM_US + hh * 64 + 32 * sb + crow(r, hi)]; float w = T[r] * __builtin_amdgcn_exp2f(vl - us);
                        if (sb == lh && crow(r, hi) > r32) w = 0.f; T[r] = w; }
                    const bf16x8 pa0 = packfrag(T, 0), pa1 = packfrag(T, 1);
                    const LAS char* xb = L + XS + hh * 8192 + vfo + sb * 2048;
                    const bf16x8 x00 = trfrag(xb), x01 = trfrag(xb + 4096), x10 = trfrag(xb + 1024), x11 = trfrag(xb + 4096 + 1024);
                    y0 = __builtin_amdgcn_mfma_f32_32x32x16_bf16(pa0, x00, y0, 0, 0, 0); y1 = __builtin_amdgcn_mfma_f32_32x32x16_bf16(pa0, x01, y1, 0, 0, 0);
                    y0 = __builtin_amdgcn_mfma_f32_32x32x16_bf16(pa1, x10, y0, 0, 0, 0); y1 = __builtin_amdgcn_mfma_f32_32x32x16_bf16(pa1, x11, y1, 0, 0, 0);
                }
            }
            const float dtot = sm[SM_DT + hh];
#pragma unroll
            for (int r = 0; r < 16; ++r) { hacc0[r] *= dtot; hacc1[r] *= dtot; }
#pragma unroll
            for (int ks = 0; ks < 4; ++ks) { const bf16x8 xa = trfrag(L + XS + hh * 8192 + lh * 4096 + vfo + ks * 1024), b0 = trfrag(L + BW + hh * 8192 + vfo + ks * 1024), b1 = trfrag(L + BW + hh * 8192 + 4096 + vfo + ks * 1024);
                hacc0 = __builtin_amdgcn_mfma_f32_32x32x16_bf16(xa, b0, hacc0, 0, 0, 0); hacc1 = __builtin_amdgcn_mfma_f32_32x32x16_bf16(xa, b1, hacc1, 0, 0, 0); }
        }
        SSD_BAR();
#pragma unroll
        for (int r = 0; r < 16; ++r) { const int p = 32 * lh + crow(r, hi);
            *(LAS unsigned short*)(L + HB + hh * 8192 + (r32 >> 3) * 1024 + p * 16 + (r32 & 7) * 2) = (unsigned short)f2bf(hacc0[r]);
            *(LAS unsigned short*)(L + HB + hh * 8192 + (4 + (r32 >> 3)) * 1024 + p * 16 + (r32 & 7) * 2) = (unsigned short)f2bf(hacc1[r]);
            const int lrow = 32 * lh + crow(r, hi);
            *(LAS unsigned short*)(L + BW + (lrow * 256 + hh * 64 + r32) * 2) = (unsigned short)f2bf(y0[r]);
            *(LAS unsigned short*)(L + BW + (lrow * 256 + hh * 64 + 32 + r32) * 2) = (unsigned short)f2bf(y1[r]); }
        SSD_BAR();
        const float Dk = sm[SM_DK + (lane >> 4)]; const f32x4 gn4 = *(const LAS f32x4*)(sm + SM_GN + 4 * lane);
#pragma unroll
        for (int k = 0; k < 8; ++k) { const int tk = wid * 8 + k; const int hd = lane >> 4, p = (4 * lane) & 63;
            const u32x2 yv = *(const LAS u32x2*)(L + BW + (tk * 256 + 4 * lane) * 2), xv = *(const LAS u32x2*)(L + XS + hd * 8192 + (p >> 5) * 4096 + tk * 64 + (p & 31) * 2);
            f32x4 v; v.x = (bflo(yv.x) + Dk * bflo(xv.x)) * silu_f(bflo(zr[k].x)); v.y = (bfhi(yv.x) + Dk * bfhi(xv.x)) * silu_f(bfhi(zr[k].x));
            v.z = (bflo(yv.y) + Dk * bflo(xv.y)) * silu_f(bflo(zr[k].y)); v.w = (bfhi(yv.y) + Dk * bfhi(xv.y)) * silu_f(bfhi(zr[k].y));
            const float rstd = __builtin_amdgcn_rsqf(wave_sum((v.x * v.x + v.y * v.y) + (v.z * v.z + v.w * v.w)) * (1.f / 256.f) + EPS);
            u32x2 o; o.x = pk2(v.x * rstd * gn4.x, v.y * rstd * gn4.y); o.y = pk2(v.z * rstd * gn4.z, v.w * rstd * gn4.w);
            *(u32x2*)(MIXp + (rowb + tk) * D + 256 + g * 256 + 4 * lane) = o; }
        SSD_BAR();
    }
#undef SSD_LOADRAW
#undef SSD_LOADDT
#undef SSD_LOADZ
#undef SSD_LO
#undef SSD_HI
}
}
namespace rets {
using att::f32x16; using att::crow; using ssd::trfrag; using ssd::packfrag; using ssd::u32x2;
constexpr int QK = 0, KK = 8192, KW = 16384, VV = 24576, SB = 32768, OS = 40960, TB = 58368;
#undef RET_BAR
#define RET_BAR() asm volatile("s_waitcnt lgkmcnt(0)\n\ts_barrier" ::: "memory")
__device__ __forceinline__ f32x4 lo4(const v4u q_) { return (f32x4){bflo(q_.x), bfhi(q_.x), bflo(q_.y), bfhi(q_.y)}; }
__device__ __forceinline__ f32x4 hi4(const v4u q_) { return (f32x4){bflo(q_.z), bfhi(q_.z), bflo(q_.w), bfhi(q_.w)}; }
__device__ __forceinline__ v4u pack8(const f32x4 a, const f32x4 b) { v4u o; o.x = pk2(a.x, a.y); o.y = pk2(a.z, a.w); o.z = pk2(b.x, b.y); o.w = pk2(b.z, b.w); return o; }

__device__ __forceinline__ void ret_unit(Frame& F_, const Args& A, int l, int b, int h) {
    Frame F = refresh(F_);
    const int tid = F.tid, lane = tid & 63, wid = F.wave, r32 = lane & 31, hi = lane >> 5;
    LAS char* L = (LAS char*)F.lds; LAS float* tb = (LAS float*)(L + TB); LAS float* os = (LAS float*)(L + OS);
    const bf16* PROJ = (const bf16*)(F.ws + WS_BIG); bf16* MIXp = (bf16*)(F.ws + WS_MIX);
    const float gam = 1.0f - exp2f(-5.0f - (float)h), lg2 = log2f(gam), g64 = exp2f(lg2 * 64.f);
    RET_BAR();
    if (tid < 128) tb[tid] = exp2f(lg2 * (float)(tid < 63 ? 63 - tid : tid - 63));
    else if (tid < 192) tb[tid] = exp2f(lg2 * (float)(tid - 128 + 1));
    else if (tid < 256) tb[tid] = exp2f(lg2 * (float)(63 - (tid - 192)));
    for (int i = tid; i < 8192 / 16; i += 512) *(LAS v4u*)(L + SB + i * 16) = (v4u){0u, 0u, 0u, 0u};
    const int tok = tid >> 3, seg = tid & 7;
    const size_t rb = (size_t)b * SEQ;
    v4u ld[4];
#define RET_LOAD(c) do { const bf16* rp = PROJ + (rb + (c) * 64 + tok) * NPROJ; \
        if (seg < 4) { ld[0] = *(const v4u*)(rp + PC_RQ + h * 64 + seg * 8); ld[1] = *(const v4u*)(rp + PC_RQ + h * 64 + 32 + seg * 8); ld[2] = *(const v4u*)(rp + PC_RK + h * 64 + seg * 8); ld[3] = *(const v4u*)(rp + PC_RK + h * 64 + 32 + seg * 8); } \
        else { ld[0] = *(const v4u*)(rp + PC_RV + h * 64 + (seg - 4) * 16); ld[1] = *(const v4u*)(rp + PC_RV + h * 64 + (seg - 4) * 16 + 8); } } while (0)
    RET_LOAD(0);
    f32x16 Sacc;
#pragma unroll
    for (int r = 0; r < 16; ++r) Sacc[r] = 0.f;
    const int kfo0 = hi * 1024 + r32 * 16;
    const int vfo0 = ((lane >> 4) & 1) * 32 + (lane & 3) * 8 + (4 * hi + ((lane & 15) >> 2)) * 64;
    const int lb = wid & 1, eb = (wid >> 1) & 1;
    RET_BAR();
    for (int c = 0; c < SEQ / 64; ++c) {
        int kfo = kfo0, vfo = vfo0; asm volatile("" : "+v"(kfo), "+v"(vfo));
        if (seg < 4) {
            const f32x4 qla = lo4(ld[0]), qlb = hi4(ld[0]), qha = lo4(ld[1]), qhb = hi4(ld[1]), kla = lo4(ld[2]), klb = hi4(ld[2]), kha = lo4(ld[3]), khb = hi4(ld[3]);
            float ql[8] = {qla.x, qla.y, qla.z, qla.w, qlb.x, qlb.y, qlb.z, qlb.w}, qh[8] = {qha.x, qha.y, qha.z, qha.w, qhb.x, qhb.y, qhb.z, qhb.w};
            float kl[8] = {kla.x, kla.y, kla.z, kla.w, klb.x, klb.y, klb.z, klb.w}, kh[8] = {kha.x, kha.y, kha.z, kha.w, khb.x, khb.y, khb.z, khb.w};
            float q1[8], q2[8], k1[8], k2[8];
            const float pos = (float)(c * 64 + tok);
#pragma unroll
            for (int i = 0; i < 8; ++i) { const int fi = seg * 8 + i; const float invf = exp2f(-(float)fi * (13.287712379549449f / 32.0f)); const float ang = pos * invf;
                double rev = (double)ang * 0.15915494309189535; rev -= __builtin_rint(rev); const float fr = (float)rev;
                const float sn = __builtin_amdgcn_sinf(fr), cs = __builtin_amdgcn_cosf(fr);
                q1[i] = ql[i] * cs - qh[i] * sn; q2[i] = ql[i] * sn + qh[i] * cs; k1[i] = kl[i] * cs - kh[i] * sn; k2[i] = kl[i] * sn + kh[i] * cs; }
            const float kd = tb[192 + tok];
            *(LAS v4u*)(L + QK + seg * 1024 + tok * 16) = pack8((f32x4){q1[0], q1[1], q1[2], q1[3]}, (f32x4){q1[4], q1[5], q1[6], q1[7]});
            *(LAS v4u*)(L + QK + (seg + 4) * 1024 + tok * 16) = pack8((f32x4){q2[0], q2[1], q2[2], q2[3]}, (f32x4){q2[4], q2[5], q2[6], q2[7]});
            *(LAS v4u*)(L + KK + seg * 1024 + tok * 16) = pack8((f32x4){k1[0], k1[1], k1[2], k1[3]}, (f32x4){k1[4], k1[5], k1[6], k1[7]});
            *(LAS v4u*)(L + KK + (seg + 4) * 1024 + tok * 16) = pack8((f32x4){k2[0], k2[1], k2[2], k2[3]}, (f32x4){k2[4], k2[5], k2[6], k2[7]});
            *(LAS v4u*)(L + KW + tok * 64 + seg * 16) = pack8((f32x4){k1[0], k1[1], k1[2], k1[3]} * kd, (f32x4){k1[4], k1[5], k1[6], k1[7]} * kd);
            *(LAS v4u*)(L + KW + 4096 + tok * 64 + seg * 16) = pack8((f32x4){k2[0], k2[1], k2[2], k2[3]} * kd, (f32x4){k2[4], k2[5], k2[6], k2[7]} * kd);
        } else {
            const int s4 = seg - 4;
            *(LAS v4u*)(L + VV + (s4 >> 1) * 4096 + tok * 64 + (s4 & 1) * 32) = ld[0];
            *(LAS v4u*)(L + VV + (s4 >> 1) * 4096 + tok * 64 + (s4 & 1) * 32 + 16) = ld[1];
        }
        if (c + 1 < SEQ / 64) RET_LOAD(c + 1);
        const size_t erow = rb + (size_t)c * 64 + wid * 8 + (lane >> 3);
        const v4u gt = *(const v4u*)(PROJ + erow * NPROJ + PC_RG + h * 64 + (lane & 7) * 8);
        RET_BAR();
        f32x16 o;
        if (wid < 4) {
            bf16x8 qf[4];
#pragma unroll
            for (int ks = 0; ks < 4; ++ks) qf[ks] = *(const LAS bf16x8*)(L + QK + kfo + ks * 2048 + lb * 512);
#pragma unroll
            for (int r = 0; r < 16; ++r) o[r] = 0.f;
#pragma unroll
            for (int ks = 0; ks < 4; ++ks) { const bf16x8 sf = *(const LAS bf16x8*)(L + SB + kfo + ks * 2048 + eb * 512); o = __builtin_amdgcn_mfma_f32_32x32x16_bf16(qf[ks], sf, o, 0, 0, 0); }
#pragma unroll
            for (int r = 0; r < 16; ++r) o[r] *= tb[128 + 32 * lb + crow(r, hi)];
            const LAS float* rt = tb + (63 + 4 * hi - 32 * lb - r32);
#pragma unroll
            for (int sb = 0; sb < 2; ++sb) {
                f32x16 T;
#pragma unroll
                for (int r = 0; r < 16; ++r) T[r] = 0.f;
#pragma unroll
                for (int ks = 0; ks < 4; ++ks) { const bf16x8 kf = *(const LAS bf16x8*)(L + KK + kfo + ks * 2048 + sb * 512); T = __builtin_amdgcn_mfma_f32_32x32x16_bf16(kf, qf[ks], T, 0, 0, 0); }
#pragma unroll
                for (int r = 0; r < 16; ++r) T[r] *= rt[32 * sb + (r & 3) + 8 * (r >> 2)];
                const bf16x8 pa0 = packfrag(T, 0), pa1 = packfrag(T, 1);
                const LAS char* vb = L + VV + eb * 4096 + vfo + sb * 2048;
                const bf16x8 v0 = trfrag(vb), v1 = trfrag(vb + 1024);
                o = __builtin_amdgcn_mfma_f32_32x32x16_bf16(pa0, v0, o, 0, 0, 0); o = __builtin_amdgcn_mfma_f32_32x32x16_bf16(pa1, v1, o, 0, 0, 0);
            }
        } else {
#pragma unroll
            for (int r = 0; r < 16; ++r) Sacc[r] *= g64;
#pragma unroll
            for (int ks = 0; ks < 4; ++ks) { const bf16x8 ka = trfrag(L + KW + lb * 4096 + vfo + ks * 1024), vbf = trfrag(L + VV + eb * 4096 + vfo + ks * 1024);
                Sacc = __builtin_amdgcn_mfma_f32_32x32x16_bf16(ka, vbf, Sacc, 0, 0, 0); }
        }
        RET_BAR();
        if (wid < 4) {
#pragma unroll
            for (int r = 0; r < 16; ++r) os[(32 * lb + crow(r, hi)) * 68 + 32 * eb + r32] = o[r];
        } else {
#pragma unroll
            for (int gq = 0; gq < 4; ++gq) { u32x2 w; w.x = pk2(Sacc[4 * gq], Sacc[4 * gq + 1]); w.y = pk2(Sacc[4 * gq + 2], Sacc[4 * gq + 3]);
                *(LAS u32x2*)(L + SB + (4 * lb + gq) * 1024 + (32 * eb + r32) * 16 + hi * 8) = w; }
        }
        RET_BAR();
        { const int row = wid * 8 + (lane >> 3), ch = lane & 7;
          const f32x4 a0 = *(const LAS f32x4*)(os + row * 68 + ch * 8), a1 = *(const LAS f32x4*)(os + row * 68 + ch * 8 + 4);
          float ss = (a0.x * a0.x + a0.y * a0.y) + (a0.z * a0.z + a0.w * a0.w) + (a1.x * a1.x + a1.y * a1.y) + (a1.z * a1.z + a1.w * a1.w);
          ss += __shfl_xor(ss, 1); ss += __shfl_xor(ss, 2); ss += __shfl_xor(ss, 4);
          const float rstd = __builtin_amdgcn_rsqf(ss * (1.f / 64.f) + EPS);
          const f32x4 g0 = *(const f32x4*)(A.in[18] + l * 64 + ch * 8), g1 = *(const f32x4*)(A.in[18] + l * 64 + ch * 8 + 4);
          const f32x4 z0 = lo4(gt), z1 = hi4(gt);
          v4u w; w.x = pk2(silu_f(z0.x) * a0.x * rstd * g0.x, silu_f(z0.y) * a0.y * rstd * g0.y); w.y = pk2(silu_f(z0.z) * a0.z * rstd * g0.z, silu_f(z0.w) * a0.w * rstd * g0.w);
          w.z = pk2(silu_f(z1.x) * a1.x * rstd * g1.x, silu_f(z1.y) * a1.y * rstd * g1.y); w.w = pk2(silu_f(z1.z) * a1.z * rstd * g1.z, silu_f(z1.w) * a1.w * rstd * g1.w);
          *(v4u*)(MIXp + erow * D + 768 + h * 64 + ch * 8) = w; }
    }
    RET_BAR();
#undef RET_LOAD
}
}
__device__ __forceinline__ void attn_naive_unit(Frame& F_, const Args& A, int l, int b, int h, int qb, float lam, float lam_init) {
    Frame F = refresh(F_);
    LAS float* Ks = (LAS float*)F.lds;
    LAS float* Vs = Ks + 4096;
    LAS float* Bt = Vs + 4096;
    LAS float* Ob = (LAS float*)(F.lds + 36864);
    const int tid = F.tid, t = tid >> 8, r = tid & 255;
    const int Q0 = qb * 256, row = Q0 + r; const size_t grow = (size_t)b * SEQ + row;
    const bf16* PROJ = (const bf16*)(F.ws + WS_BIG);
    __syncthreads();
    if (tid < 192) Bt[tid] = A.in[6][t5_bucket(tid - 128) * 4 + h] * LOG2E;
    f32x4 q4[8];
    { const v4u* qp = (const v4u*)(PROJ + grow * NPROJ + PC_Q + h * 64 + t * 32);
#pragma unroll
      for (int i = 0; i < 4; ++i) { const v4u w = qp[i]; q4[2 * i] = (f32x4){bflo(w.x), bfhi(w.x), bflo(w.y), bfhi(w.y)}; q4[2 * i + 1] = (f32x4){bflo(w.z), bfhi(w.z), bflo(w.w), bfhi(w.w)}; } }
    f32x4 O4[16];
#pragma unroll
    for (int e = 0; e < 16; ++e) O4[e] = (f32x4){0.f, 0.f, 0.f, 0.f};
    float mrun = -1.0e30f, lsum = 0.f;
    const int cq = row >> 6, nck = (Q0 >> 6) + 4;
    for (int ck = 0; ck < nck; ++ck) {
        __syncthreads();
        { const int key = tid >> 3, seg = tid & 7; const bf16* kp = PROJ + ((size_t)b * SEQ + ck * 64 + key) * NPROJ + PC_K + h * 64 + seg * 8;
          const v4u kw = *(const v4u*)kp, vw = *(const v4u*)(kp + 256);
          LAS f32x4* kd = (LAS f32x4*)(Ks + (seg >> 2) * 2048 + key * 32 + (seg & 3) * 8); LAS f32x4* vd = (LAS f32x4*)(Vs + key * 64 + seg * 8);
          kd[0] = (f32x4){bflo(kw.x), bfhi(kw.x), bflo(kw.y), bfhi(kw.y)}; kd[1] = (f32x4){bflo(kw.z), bfhi(kw.z), bflo(kw.w), bfhi(kw.w)};
          vd[0] = (f32x4){bflo(vw.x), bfhi(vw.x), bflo(vw.y), bfhi(vw.y)}; vd[1] = (f32x4){bflo(vw.z), bfhi(vw.z), bflo(vw.w), bfhi(vw.w)}; }
        __syncthreads();
        if (ck <= cq) {
            const int kbase = ck * 64 - row;
#pragma unroll 1
            for (int j = 0; j < 64; ++j) {
                const LAS f32x4* kr = (const LAS f32x4*)(Ks + t * 2048 + j * 32);
                f32x4 a4 = q4[0] * kr[0];
#pragma unroll
                for (int d = 1; d < 8; ++d) a4 += q4[d] * kr[d];
                int rel = kbase + j; rel = rel < -128 ? -128 : rel;
                const float sj = (a4.x + a4.y) + (a4.z + a4.w) + Bt[rel + 128];
                if (sj > mrun) { const float sc = __builtin_amdgcn_exp2f(mrun - sj); lsum *= sc;
#pragma unroll
                    for (int e = 0; e < 16; ++e) O4[e] *= sc;
                    mrun = sj; }
                const float p = __builtin_amdgcn_exp2f(sj - mrun); lsum += p;
                const LAS f32x4* vr = (const LAS f32x4*)(Vs + j * 64);
#pragma unroll
                for (int e = 0; e < 16; ++e) O4[e] += vr[e] * p;
            }
        }
    }
    __syncthreads();
    const float inv = 1.0f / lsum;
    if (t == 1) {
#pragma unroll
        for (int e = 0; e < 16; ++e) *(LAS f32x4*)(Ob + r * 68 + 4 * e) = O4[e] * inv; }
    __syncthreads();
    if (t == 0) { f32x4 ss4 = (f32x4){0.f, 0.f, 0.f, 0.f};
#pragma unroll
        for (int e = 0; e < 16; ++e) { const f32x4 o = O4[e] * inv - *(const LAS f32x4*)(Ob + r * 68 + 4 * e) * lam; O4[e] = o; ss4 += o * o; }
        const float rstd = __builtin_amdgcn_rsqf(((ss4.x + ss4.y) + (ss4.z + ss4.w)) * (1.f / 64.f) + EPS) * (1.0f - lam_init);
        const f32x4* gn = (const f32x4*)(A.in[11] + l * 64); v4u* op = (v4u*)((bf16*)(F.ws + WS_MIX) + grow * D + h * 64);
#pragma unroll
        for (int e = 0; e < 16; e += 2) { const f32x4 o0 = O4[e] * gn[e] * rstd, o1 = O4[e + 1] * gn[e + 1] * rstd;
            v4u w; w.x = pk2(o0.x, o0.y); w.y = pk2(o0.z, o0.w); w.z = pk2(o1.x, o1.y); w.w = pk2(o1.z, o1.w); op[e >> 1] = w; } }
    __syncthreads();
}

__device__ __forceinline__ void ssd_naive_unit(Frame& F_, const Args& A, int l, int b, int g) {
    Frame F = refresh(F_);
    LAS float* xs = (LAS float*)F.lds;
    LAS float* Bs = xs + 64 * 256;
    LAS float* Cs = Bs + 4096;
    LAS float* dts = Cs + 4096;
    LAS float* dAs = dts + 256;
    const int tid = F.tid, hh = tid >> 7, p = (tid & 127) >> 1, nh = tid & 1, head = g * 4 + hh;
    const float Dk = A.in[16][l * 8 + head];
    float hst[32];
#pragma unroll
    for (int i = 0; i < 32; ++i) hst[i] = 0.f;
    int ch = 0; float w0 = 0.f, w1 = 0.f, w2 = 0.f, w3 = 0.f, cb = 0.f, r0 = 0.f, r1 = 0.f, r2 = 0.f;
    if (tid < 384) { ch = tid < 256 ? g * 256 + tid : tid < 320 ? 512 + g * 64 + (tid - 256) : 640 + g * 64 + (tid - 320);
        const float* cw = A.in[12] + (size_t)l * 4 * 768; w0 = cw[ch]; w1 = cw[768 + ch]; w2 = cw[2 * 768 + ch]; w3 = cw[3 * 768 + ch]; cb = A.in[13][l * 768 + ch]; }
    for (int c = 0; c < SEQ / 64; ++c) {
        __syncthreads();
        const size_t rowb = (size_t)b * SEQ + c * 64;
        if (tid < 384) { const bf16* src = ((bf16*)(F.ws + WS_BIG)) + rowb * NPROJ + PC_XBC + ch; LAS float* dst = tid < 256 ? xs + tid : tid < 320 ? Bs + (tid - 256) : Cs + (tid - 320); const int dstr = tid < 256 ? 256 : 64;
            _Pragma("unroll 16") for (int tt = 0; tt < 64; ++tt) { const float r3 = bf2f(src[(size_t)tt * NPROJ]); const float v = cb + r0 * w0 + r1 * w1 + r2 * w2 + r3 * w3; dst[tt * dstr] = silu_f(v); r0 = r1; r1 = r2; r2 = r3; } }
        else if (tid < 384 + 64) { const int tt = tid - 384;
#pragma unroll
            for (int k = 0; k < 4; ++k) { const int hd = g * 4 + k; const float xr = ((float*)(F.ws + WS_DT))[(rowb + tt) * 8 + hd] + A.in[14][l * 8 + hd]; const float dt = xr > 20.f ? xr : log1pf(__expf(xr));
                dts[tt * 4 + k] = dt; dAs[tt * 4 + k] = __expf(-__expf(A.in[15][l * 8 + hd]) * dt); } }
        __syncthreads();
        for (int tt = 0; tt < 64; ++tt) {
            const float x = xs[tt * 256 + hh * 64 + p], dt = dts[tt * 4 + hh], dA = dAs[tt * 4 + hh], cx = dt * x;
            const LAS float* Br = Bs + tt * 64 + nh * 32; const LAS float* Cr = Cs + tt * 64 + nh * 32; float a = 0.f;
#pragma unroll
            for (int i = 0; i < 32; i += 4) { const f32x4 bb = *(const LAS f32x4*)(Br + i), cc = *(const LAS f32x4*)(Cr + i);
                hst[i] = hst[i] * dA + cx * bb.x; hst[i + 1] = hst[i + 1] * dA + cx * bb.y; hst[i + 2] = hst[i + 2] * dA + cx * bb.z; hst[i + 3] = hst[i + 3] * dA + cx * bb.w;
                a += (hst[i] * cc.x + hst[i + 1] * cc.y) + (hst[i + 2] * cc.z + hst[i + 3] * cc.w); }
            a += __shfl_xor(a, 1);
            if (nh == 0) xs[tt * 256 + hh * 64 + p] = a + Dk * x;
        }
        __syncthreads();
        for (int k = 0; k < 8; ++k) { const int tt = F.wave * 8 + k; const size_t row = rowb + tt;
            const f32x4 y = *(const LAS f32x4*)(xs + tt * 256 + 4 * F.lane); const uint2 zz = *(const uint2*)(((bf16*)(F.ws + WS_BIG)) + row * NPROJ + PC_Z + g * 256 + 4 * F.lane);
            f32x4 v; v.x = y.x * silu_f(bflo(zz.x)); v.y = y.y * silu_f(bfhi(zz.x)); v.z = y.z * silu_f(bflo(zz.y)); v.w = y.w * silu_f(bfhi(zz.y));
            const float rstd = __builtin_amdgcn_rsqf(wave_sum((v.x * v.x + v.y * v.y) + (v.z * v.z + v.w * v.w)) * (1.f / 256.f) + EPS);
            const f32x4 gn = *(const f32x4*)(A.in[17] + l * 512 + g * 256 + 4 * F.lane);
            uint2 o; o.x = pk2(v.x * rstd * gn.x, v.y * rstd * gn.y); o.y = pk2(v.z * rstd * gn.z, v.w * rstd * gn.w);
            *(uint2*)(((bf16*)(F.ws + WS_MIX)) + row * D + 256 + g * 256 + 4 * F.lane) = o; }
    }
    __syncthreads();
}

__device__ __forceinline__ void ret_naive_unit(Frame& F_, const Args& A, int l, int b, int h) {
    Frame F = refresh(F_);
    constexpr int ST = 68;
    LAS float* qs = (LAS float*)F.lds; LAS float* ks = qs + 64 * ST; LAS float* vs = ks + 64 * ST; LAS float* sc = vs + 64 * ST; LAS float* Ss = sc + 64 * ST; LAS float* os = Ss + 64 * ST;
    const int tid = F.tid, ra = tid >> 3, eg = tid & 7;
    const float gam = 1.0f - exp2f(-5.0f - (float)h), lg2 = log2f(gam), g64 = exp2f(lg2 * 64.f);
    float Sreg[8];
#pragma unroll
    for (int i = 0; i < 8; ++i) Sreg[i] = 0.f;
    __syncthreads();
#pragma unroll
    for (int i = 0; i < 8; ++i) Ss[ra * ST + eg * 8 + i] = 0.f;
    for (int c = 0; c < SEQ / 64; ++c) {
        __syncthreads();
        const size_t rowb = (size_t)b * SEQ + c * 64;
        { const int tok = ra, seg = eg; const bf16* rp = ((bf16*)(F.ws + WS_BIG)) + (rowb + tok) * NPROJ;
          if (seg < 4) { float ql[8], qh[8], kl[8], kh[8];
              unpack8(*(const v4u*)(rp + PC_RQ + h * 64 + seg * 8), ql); unpack8(*(const v4u*)(rp + PC_RQ + h * 64 + 32 + seg * 8), qh);
              unpack8(*(const v4u*)(rp + PC_RK + h * 64 + seg * 8), kl); unpack8(*(const v4u*)(rp + PC_RK + h * 64 + 32 + seg * 8), kh);
              const float pos = (float)(c * 64 + tok);
#pragma unroll
              for (int i = 0; i < 8; ++i) { const int fi = seg * 8 + i; const float invf = exp2f(-(float)fi * (13.287712379549449f / 32.0f)); const float ang = pos * invf;
                  double rev = (double)ang * 0.15915494309189535; rev -= __builtin_rint(rev); const float fr = (float)rev;
                  const float sn = __builtin_amdgcn_sinf(fr), cs = __builtin_amdgcn_cosf(fr);
                  qs[tok * ST + fi] = ql[i] * cs - qh[i] * sn; qs[tok * ST + fi + 32] = ql[i] * sn + qh[i] * cs;
                  ks[tok * ST + fi] = kl[i] * cs - kh[i] * sn; ks[tok * ST + fi + 32] = kl[i] * sn + kh[i] * cs; } }
          else { float va[8], vb[8]; const int c0 = (seg - 4) * 16; unpack8(*(const v4u*)(rp + PC_RV + h * 64 + c0), va); unpack8(*(const v4u*)(rp + PC_RV + h * 64 + c0 + 8), vb);
#pragma unroll
              for (int i = 0; i < 8; ++i) { vs[tok * ST + c0 + i] = va[i]; vs[tok * ST + c0 + 8 + i] = vb[i]; } } }
        __syncthreads();
        { float a[8];
#pragma unroll
          for (int jj = 0; jj < 8; ++jj) a[jj] = 0.f;
          for (int d = 0; d < 64; d += 4) { const f32x4 qq = *(const LAS f32x4*)(qs + ra * ST + d);
#pragma unroll
              for (int jj = 0; jj < 8; ++jj) { const f32x4 kk = *(const LAS f32x4*)(ks + (jj * 8 + eg) * ST + d); a[jj] += (qq.x * kk.x + qq.y * kk.y) + (qq.z * kk.z + qq.w * kk.w); } }
#pragma unroll
          for (int jj = 0; jj < 8; ++jj) { const int s = jj * 8 + eg; const int dd = ra > s ? ra - s : s - ra; sc[ra * ST + s] = a[jj] * exp2f(lg2 * (float)dd); } }
        __syncthreads();
        { float a[8];
#pragma unroll
          for (int i = 0; i < 8; ++i) a[i] = 0.f;
          for (int s = 0; s < 64; ++s) { const float w = sc[ra * ST + s]; const f32x4 v0 = *(const LAS f32x4*)(vs + s * ST + eg * 8), v1 = *(const LAS f32x4*)(vs + s * ST + eg * 8 + 4);
              a[0] += w * v0.x; a[1] += w * v0.y; a[2] += w * v0.z; a[3] += w * v0.w; a[4] += w * v1.x; a[5] += w * v1.y; a[6] += w * v1.z; a[7] += w * v1.w; }
          const float qd = exp2f(lg2 * (float)(ra + 1));
          for (int d = 0; d < 64; ++d) { const float w = qs[ra * ST + d] * qd; const f32x4 v0 = *(const LAS f32x4*)(Ss + d * ST + eg * 8), v1 = *(const LAS f32x4*)(Ss + d * ST + eg * 8 + 4);
              a[0] += w * v0.x; a[1] += w * v0.y; a[2] += w * v0.z; a[3] += w * v0.w; a[4] += w * v1.x; a[5] += w * v1.y; a[6] += w * v1.z; a[7] += w * v1.w; }
#pragma unroll
          for (int i = 0; i < 8; ++i) os[ra * ST + eg * 8 + i] = a[i]; }
        __syncthreads();
        { float a[8];
#pragma unroll
          for (int i = 0; i < 8; ++i) a[i] = 0.f;
          for (int s = 0; s < 64; ++s) { const float w = ks[s * ST + ra] * exp2f(lg2 * (float)(63 - s)); const f32x4 v0 = *(const LAS f32x4*)(vs + s * ST + eg * 8), v1 = *(const LAS f32x4*)(vs + s * ST + eg * 8 + 4);
              a[0] += w * v0.x; a[1] += w * v0.y; a[2] += w * v0.z; a[3] += w * v0.w; a[4] += w * v1.x; a[5] += w * v1.y; a[6] += w * v1.z; a[7] += w * v1.w; }
#pragma unroll
          for (int i = 0; i < 8; ++i) { Sreg[i] = Sreg[i] * g64 + a[i]; Ss[ra * ST + eg * 8 + i] = Sreg[i]; } }
        for (int k = 0; k < 8; ++k) { const int tok = F.wave * 8 + k; const size_t row = rowb + tok;
            const float v = os[tok * ST + F.lane]; const float rstd = __builtin_amdgcn_rsqf(wave_sum(v * v) * (1.f / 64.f) + EPS);
            const float gt = bf2f(((bf16*)(F.ws + WS_BIG))[row * NPROJ + PC_RG + h * 64 + F.lane]);
            ((bf16*)(F.ws + WS_MIX))[row * D + 768 + h * 64 + F.lane] = (bf16)f2bf(silu_f(gt) * v * rstd * A.in[18][l * 64 + F.lane]); }
    }
    __syncthreads();
}
__device__ __forceinline__ void mixer_2a(Frame& F, const Args& A, int l) {
    for (int u = F.bx; u < 1536; u += F.G) {
#if !defined(BISECT) || BISECT != 2
        if (u < 512) ssd::ssd_m1_unit(F, A, l, u >> 8, (u >> 1) & 127, u & 1);
#else
        if (u < 512) {}
#endif
#if !defined(BISECT) || BISECT != 1
        else { const int v = u - 512; ret::ret_m1_unit(F, A, l, v >> 9, (v >> 2) & 127, v & 3); }
#endif
    }
}
__device__ __forceinline__ void mixer_2b(Frame& F_, const Args& A, int l) {
    Frame F = refresh(F_);
    const float lam_init = 0.8f - 0.6f * __expf(-0.3f * (float)l);
    float d1 = 0.f, d2 = 0.f;
    for (int i = 0; i < 32; ++i) { d1 += A.in[7][l * 32 + i] * A.in[8][l * 32 + i]; d2 += A.in[9][l * 32 + i] * A.in[10][l * 32 + i]; }
    const float lam = __expf(d1) - __expf(d2) + lam_init;
    if (F.bx < 64) ssd::scan_unit(F, 0, F.bx); else if (F.bx < 96) ssd::scan_unit(F, 1, F.bx - 64);
    if (F.bx < 96) {
        asm volatile("s_waitcnt vmcnt(0)" ::: "memory");
        __syncthreads();
        if (F.tid == 0) { __builtin_amdgcn_fence(__ATOMIC_RELEASE, "agent"); asm volatile("s_waitcnt vmcnt(0)" ::: "memory");
            (void)__hip_atomic_fetch_add((unsigned*)(F.ctl + CW_SCAN + 64 * l), 1u, __ATOMIC_RELAXED, __HIP_MEMORY_SCOPE_AGENT); }
    }
    const int na = F.G, j = F.bx;
    const int wpos = (F.bx >> 3) % 3;
    for (int rnd = 0; rnd < 3 || rnd * na < 512; ++rnd) {
#ifndef EXPERTS_IN_P0
        if (l == 0 && rnd == wpos) expert_weights(F, A);
#endif
        const int i = (rnd & 1) ? (rnd + 1) * na - 1 - j : rnd * na + j;
        if (i < 512) { const int qb = 63 - (i >> 3), bh = i & 7; att::attn_unit(F, A, l, bh >> 2, bh & 3, qb, lam, 1.0f - lam_init);
#if defined(DBL_PHASE) && DBL_PHASE == 23
            att::attn_unit(F, A, l, bh >> 2, bh & 3, qb, lam, 1.0f - lam_init);
#endif
        }
    }
}
__device__ __forceinline__ void mixer_2bc_seam(Frame& F, int l) {
    asm volatile("s_waitcnt vmcnt(0)" ::: "memory");
    __syncthreads();
    if (F.tid == 0) {
        unsigned* fl = (unsigned*)(F.ctl + CW_SCAN + 64 * l); unsigned sp = 0;
        while (__hip_atomic_load(fl, __ATOMIC_RELAXED, __HIP_MEMORY_SCOPE_AGENT) < 96u) { __builtin_amdgcn_s_sleep(1); if (++sp > (1u << 20)) break; }
        __builtin_amdgcn_fence(__ATOMIC_ACQUIRE, "agent");
        asm volatile("s_waitcnt vmcnt(0)" ::: "memory");
    }
    __syncthreads();
}
__device__ __forceinline__ void mixer_2c(Frame& F, const Args& A, int l) {
    for (int u = F.bx; u < 1536; u += F.G) {
#if !defined(BISECT) || BISECT != 2
        if (u < 512) ssd::ssd_m3_unit(F, A, l, u >> 8, (u >> 1) & 127, u & 1);
#else
        if (u < 512) {}
#endif
#if !defined(BISECT) || BISECT != 1
        else { const int v = u - 512; ret::ret_m3_unit(F, A, l, v >> 9, (v >> 2) & 127, v & 3); }
#endif
    }
}
__device__ __forceinline__ void gather_phase(Frame& F_) {
    Frame F = refresh(F_);
    const int gw = F.bx * NWAVES + F.wave, NGW = F.G * NWAVES, nrows = F.META[16] * 256;
    const v4u* XN8 = (const v4u*)(F.ws + WS_XN); v4u* XG8 = (v4u*)(F.ws + WS_XG8); const int* LIST = (const int*)(F.ws + WS_LIST);
    const float* XNS = (const float*)(F.ws + WS_XNS); float* XGS = (float*)(F.ws + WS_XGS);
    for (int row0 = gw; row0 < nrows; row0 += 4 * NGW) {
        int tok[4]; bool ok[4];
#pragma unroll
        for (int i = 0; i < 4; ++i) { const int row = row0 + i * NGW; ok[i] = false; tok[i] = 0;
            if (row < nrows) { const int p = row >> 8, r = row & 255; int e = 0;
#pragma unroll
                for (int k = 1; k < 8; ++k) e += (p >= F.META[8 + k]) ? 1 : 0;
                const int pos = (p - F.META[8 + e]) * 256 + r;
                if (pos < F.META[e]) { ok[i] = true; tok[i] = LIST[e * 16384 + pos]; } } }
        v4u a[4]; float s[4];
#pragma unroll
        for (int i = 0; i < 4; ++i) { a[i] = (v4u){0u, 0u, 0u, 0u}; s[i] = 0.f; if (ok[i]) { a[i] = XN8[(size_t)tok[i] * 64 + F.lane]; s[i] = XNS[tok[i]]; } }
#pragma unroll
        for (int i = 0; i < 4; ++i) { const int row = row0 + i * NGW; if (row < nrows) { XG8[(size_t)row * 64 + F.lane] = a[i]; if (F.lane == 0) XGS[row] = s[i]; } }
    }
}
__device__ __forceinline__ void zero_yacc(Frame& F_) {
    Frame F = refresh(F_);
    v4u* za = (v4u*)(F.ws + WS_XN);
    for (size_t i = (size_t)F.bx * 512 + F.tid; i < (size_t)8 * 256 * 1024 / 4; i += (size_t)F.G * 512) za[i] = (v4u){0u, 0u, 0u, 0u};
}
#if defined(DBL_PHASE) && DBL_PHASE == 40
#define GRID_BAR() do { xcd_barrier(bar); xcd_barrier(bar); } while (0)
#else
#define GRID_BAR() xcd_barrier(bar)
#endif
#ifndef DBL_PHASE
#define DBL_PHASE -1
#endif
#ifdef PROBE_A
#define STAMP(i) do { if (F.bx == 0 && threadIdx.x == 0) ((LAS unsigned long long*)(F.lds + LDSCTL_OFF + 2048))[i] = __builtin_amdgcn_s_memrealtime(); } while (0)
#else
#define STAMP(i) do { } while (0)
#endif
#define WSB(off) ((bf16*)(F.ws + (off)))
template <int l>
__device__ __forceinline__ void layer_body(Frame& F, const Args& args, const XcdBarrier& bar) {

        { pg8::Gemm g{WSB(WS_XN), (const bf16*)((const signed char*)(F.ws + WS_WIN) + (size_t)l * NPROJ * D), D / 2}; pg8::StaticOrder S; S.init(M, NPROJ, F.G, F.bx);
          pg8::EpiBf16S E{WSB(WS_BIG), NPROJ, (const float*)(F.ws + WS_XNS), (const float*)(F.ws + WS_SBI) + l * NPROJ};
          pg8::gemm_phase<pg8::EpiBf16S, pg8::StaticOrder, true, true>(F.lds, g, S, E); }
#if DBL_PHASE == 1
        { pg8::Gemm g{WSB(WS_XN), (const bf16*)((const signed char*)(F.ws + WS_WIN) + (size_t)l * NPROJ * D), D / 2}; pg8::StaticOrder S; S.init(M, NPROJ, F.G, F.bx);
          pg8::EpiBf16S E{WSB(WS_BIG), NPROJ, (const float*)(F.ws + WS_XNS), (const float*)(F.ws + WS_SBI) + l * NPROJ};
          pg8::gemm_phase<pg8::EpiBf16S, pg8::StaticOrder, true, true>(F.lds, g, S, E); }
#endif
        GRID_BAR(); STAMP(1 + 1 + (l == 0 ? 0 : 7));
        mixer_2a(F, args, l);
#if DBL_PHASE == 20
        mixer_2a(F, args, l);
#endif
        GRID_BAR();
        mixer_2b(F, args, l);
#if DBL_PHASE == 21
        mixer_2b(F, args, l);
#endif
        mixer_2bc_seam(F, l);
        mixer_2c(F, args, l);
#if DBL_PHASE == 22
        mixer_2c(F, args, l);
#endif
        GRID_BAR(); STAMP(1 + 2 + (l == 0 ? 0 : 7));
        { pg8::Gemm g{WSB(WS_MIX), WSB(WS_WOUT) + (size_t)l * D * D, D}; pg8::StaticOrder S; S.init(M, D, F.G, F.bx);
          if constexpr (l == 0) { pg8::EpiResBf<true> E{args.in[0], WSB(WS_XR), D, nullptr}; pg8::gemm_phase<pg8::EpiResBf<true>, pg8::StaticOrder, false>(F.lds, g, S, E); }
          else { pg8::EpiResBf<false> E{WSB(WS_XR), WSB(WS_XR), D, nullptr}; pg8::gemm_phase<pg8::EpiResBf<false>, pg8::StaticOrder, false>(F.lds, g, S, E); } }
#if DBL_PHASE == 41
        if constexpr (l == 0) { pg8::Gemm g{WSB(WS_MIX), WSB(WS_WOUT), D}; pg8::StaticOrder S; S.init(M, D, F.G, F.bx);
          pg8::EpiResBf<true> E{args.in[0], WSB(WS_XR), D, nullptr}; pg8::gemm_phase<pg8::EpiResBf<true>, pg8::StaticOrder, false>(F.lds, g, S, E); }
#endif
        W16 wrt{}; if constexpr (l == 1) wrt = norm_wload(args.in[22], 8);
        GRID_BAR(); STAMP(1 + 3 + (l == 0 ? 0 : 7));
        if constexpr (l == 0) {
            norm_phase<0, true, true>(F, (const float*)(F.ws + WS_XR), args.in[4], nullptr, 0);
            GRID_BAR(); STAMP(5);
            { pg8::Gemm g{WSB(WS_XN), WSB(WS_WGU), D / 2}; pg8::StaticOrder S; S.init(M, 2 * FDP, F.G, F.bx);
              pg8::EpiSwiGLU8<true> E{WSB(WS_BIG), FDP, (const float*)(F.ws + WS_XNS), (const float*)(F.ws + WS_SBD)};
              pg8::gemm_phase<pg8::EpiSwiGLU8<true>, pg8::StaticOrder, true, true>(F.lds, g, S, E); }
#if DBL_PHASE == 4
        { pg8::Gemm g{WSB(WS_XN), WSB(WS_WGU), D / 2}; pg8::StaticOrder S; S.init(M, 2 * FDP, F.G, F.bx);
              pg8::EpiSwiGLU8<true> E{WSB(WS_BIG), FDP, (const float*)(F.ws + WS_XNS), (const float*)(F.ws + WS_SBD)};
              pg8::gemm_phase<pg8::EpiSwiGLU8<true>, pg8::StaticOrder, true, true>(F.lds, g, S, E); }
#endif
            GRID_BAR(); STAMP(6);
            { pg8::Gemm g{WSB(WS_BIG), WSB(WS_WD), FDP / 2}; pg8::StaticOrder S; S.init(M, D, F.G, F.bx);
              pg8::EpiResBf<false> E{WSB(WS_XR), WSB(WS_XR), D, (const float*)(F.ws + WS_SBWD)};
              pg8::gemm_phase<pg8::EpiResBf<false>, pg8::StaticOrder, false, false, true>(F.lds, g, S, E); }
            const W16 wp7 = norm_wload(args.in[1] + (size_t)D * NIN + 2048, NIN);
            GRID_BAR(); STAMP(7);
            norm_phase<1, true, true, true>(F, (const float*)(F.ws + WS_XR), args.in[3] + D, args.in[1] + (size_t)D * NIN + 2048, NIN, wp7);
            GRID_BAR(); STAMP(8);
        } else {
            norm_phase<2, true, true, true>(F, (const float*)(F.ws + WS_XR), args.in[4] + D, args.in[22], 8, wrt);
            GRID_BAR(); STAMP(12);
            if (F.tid == 0) { int acc = 0;
                for (int e = 0; e < 8; ++e) { const int c = (int)__hip_atomic_load(F.ctl + CW_CNT + 64 * e, RLX_AGENT); F.META[e] = c; F.META[8 + e] = acc; acc += (c + 255) >> 8; }
                F.META[16] = acc; }
            __syncthreads();
            const int ptot = F.META[16];
            {
                const int p0 = 0; int np = ptot; if (np > 136) np = 136; const int slab = 0; (void)slab;
                { pg8::Gemm g{WSB(0), WSB(WS_EGU), D / 2}; pg8::GroupedOrder S{2 * FE / 256, p0, np, F.G, F.bx, 0, F.META, 0, 0, 1};
                  pg8::EpiSwiGLU8<true> E{WSB(WS_BIG), FE, (const float*)(F.ws + WS_XGS2), (const float*)(F.ws + WS_SBE)};
                  pg8::gemm_phase<pg8::EpiSwiGLU8<true>, pg8::GroupedOrder, true, true>(F.lds, g, S, E); }
#if DBL_PHASE == 5
        { pg8::Gemm g{WSB(0), WSB(WS_EGU), D / 2}; pg8::GroupedOrder S{2 * FE / 256, p0, np, F.G, F.bx, 0, F.META, 0, 0, 1};
                  pg8::EpiSwiGLU8<true> E{WSB(WS_BIG), FE, (const float*)(F.ws + WS_XGS2), (const float*)(F.ws + WS_SBE)};
                  pg8::gemm_phase<pg8::EpiSwiGLU8<true>, pg8::GroupedOrder, true, true>(F.lds, g, S, E); }
#endif
                GRID_BAR(); STAMP(14 + 2 * slab);
                { pg8::Gemm g{WSB(WS_BIG), WSB(WS_ED), FE / 2}; pg8::GroupedOrder S{D / 256, p0, np, F.G, F.bx, 1, F.META, 512, 4};
                  pg8::EpiYMoE E{WSB(WS_MIX), WSB(WS_XN), D, (const float*)(F.ws + WS_SBED), 512};
                  pg8::gemm_phase<pg8::EpiYMoE, pg8::GroupedOrder, true, false, true>(F.lds, g, S, E); }
#if DBL_PHASE == 6
        { pg8::Gemm g{WSB(WS_BIG), WSB(WS_ED), FE / 2}; pg8::GroupedOrder S{D / 256, p0, np, F.G, F.bx, 1, F.META, 512, 4};
                  pg8::EpiYMoE E{WSB(WS_MIX), WSB(WS_XN), D, (const float*)(F.ws + WS_SBED), 512};
                  pg8::gemm_phase<pg8::EpiYMoE, pg8::GroupedOrder, true, false, true>(F.lds, g, S, E); }
#endif
                GRID_BAR(); STAMP(15 + 2 * slab);
            }
#ifdef PROBE_A
            if (F.bx == 0 && threadIdx.x == 0) { const LAS unsigned long long* ts = (const LAS unsigned long long*)(F.lds + LDSCTL_OFF + 2048);
                float ta = 0.f, tbv = 0.f;
                for (int i = 1; i <= 17; ++i) { const float d = (float)(ts[i] - ts[i - 1]) * 0.01f;
                    if ((PROBE_A >> i) & 1) ta += d; if ((PROBE_B >> i) & 1) tbv += d; }
                ((float*)(F.ws + WS_CTL))[100] = ta / PROBE_SA; ((float*)(F.ws + WS_CTL))[101] = tbv / PROBE_SB * 100.0f; }
            GRID_BAR();
#endif
            combine_phase(F, args);
#ifdef PROBE_A
            GRID_BAR();
            { const float eps = ((const float*)(F.ws + WS_CTL))[100], vv = ((const float*)(F.ws + WS_CTL))[101];
              for (size_t i = (size_t)F.bx * 512 + threadIdx.x; i < (size_t)M * D; i += (size_t)F.G * 512) F.out[i] = (i == 0) ? vv : F.out[i] * (1.0f + eps); }
#endif
        }
}
__global__ void __launch_bounds__(NWAVES * 64, 2) mk_fwd(Args args) {
    extern __shared__ __attribute__((aligned(16))) unsigned char lds[];
    Frame F;
    F.lds = (LAS unsigned char*)lds;
    F.MISC = (volatile LAS unsigned*)(F.lds + MISC_OFF);
    F.META = (LAS int*)(F.lds + MISC_OFF + 64);
    F.tid = threadIdx.x; F.lane = F.tid & 63; F.wave = __builtin_amdgcn_readfirstlane(F.tid >> 6);
    F.G = gridDim.x; F.bx = blockIdx.x;
    F.ws = args.ws; F.out = args.out;
    F.ctl = (gu32*)(F.ws + WS_CTL);
    for (int u = F.tid; u < (LDS_BYTES - LDSCTL_OFF) / 4; u += NWAVES * 64) ((LAS unsigned*)(F.lds + LDSCTL_OFF))[u] = 0u;
    __syncthreads();
    XcdBarrier bar = xcd_barrier_post((unsigned*)(F.ctl + CW_BAR), F.MISC + 8);
    STAMP(0);
    p0_weights(F, args);
    __syncthreads();
#ifdef EXPERTS_IN_P0
    expert_weights(F, args);
#endif
#if DBL_PHASE == 0
    p0_weights(F, args);
    __syncthreads();
#endif
    __syncthreads();
    norm_phase<1, true>(F, args.in[0], args.in[3], args.in[1] + 2048, NIN);
    GRID_BAR(); STAMP(1);
    layer_body<0>(F, args, bar);
    layer_body<1>(F, args, bar);
}

extern "C" void kernel_launch(void* const* d_in, const int* in_sizes, int n_in, void* d_out, int out_size, void* d_ws, size_t ws_size, hipStream_t stream) {
    static int grid = 0;
    if (grid == 0) {
        if (n_in != 26 || in_sizes[0] != M * D || out_size != M * D || ws_size < WS_END) { fprintf(stderr, "kernel_launch: unexpected shapes (n_in %d, in0 %d, out %d, ws %zu); nothing launched\n", n_in, n_in > 0 ? in_sizes[0] : -1, out_size, ws_size); grid = -1; return; }
        int dev = 0, cus = 0, per_cu = 0;
        if (hipGetDevice(&dev) != hipSuccess || hipDeviceGetAttribute(&cus, hipDeviceAttributeMultiprocessorCount, dev) != hipSuccess) { grid = -1; return; }
        if (hipFuncSetAttribute((const void*)mk_fwd, hipFuncAttributeMaxDynamicSharedMemorySize, LDS_BYTES) != hipSuccess) { fprintf(stderr, "kernel_launch: hipFuncSetAttribute failed\n"); grid = -1; return; }
        if (hipOccupancyMaxActiveBlocksPerMultiprocessor(&per_cu, (const void*)mk_fwd, NWAVES * 64, LDS_BYTES) != hipSuccess || per_cu < 1) fprintf(stderr, "kernel_launch: occupancy query reports %d blocks per CU\n", per_cu);
        (void)hipGetLastError();
        grid = cus;
    }
    if (grid < 0) return;
    if (hipMemsetAsync((char*)d_ws + WS_CTL, 0, CTL_ZERO_BYTES, stream) != hipSuccess) return;
    Args a{};
    for (int i = 0; i < 26; ++i) a.in[i] = (const float*)d_in[i];
    a.out = (float*)d_out; a.ws = (unsigned char*)d_ws;
    hipLaunchKernelGGL(mk_fwd, dim3(grid), dim3(NWAVES * 64), LDS_BYTES, stream, a);
}
```
